# Optimizing an MI355X kernel written in HIP

```python
import math
import jax
import jax.numpy as jnp
from jax import lax
import numpy as np

D_MODEL = 1024
BATCH = 2
SEQ = 16384
DEPTH = 4

N_MIXERS = 2
RET_HEADS = 4
RET_QK_DIM = D_MODEL // RET_HEADS
RET_V_DIM = 2 * RET_QK_DIM
RET_CHUNK = 128
ROPE_BASE = 10000.0
DIL_PATTERN = ((128, 1), (512, 4), (2048, 16))
N_GROUPS = len(DIL_PATTERN)
HEADS_PER_GROUP = 4
ATT_HEAD_DIM = 128
ATT_Q_BLOCK = 128
D_FF = (7 * D_MODEL) // 2
N_EXPERTS = 8
TOP_K = 2
MOE_BLOCK = 512
ALPHA = (2 * DEPTH) ** 0.25
BETA = (8 * DEPTH) ** -0.25
LN_EPS = 1e-5
N_RET = (DEPTH + 1) // 2
N_ATT = DEPTH // 2

kernel_name = 'hybrid_retention_dilated_attn_moe'


def layer_norm(x, g, b):
    xf = x.astype(jnp.float32)
    mu = jnp.mean(xf, axis=-1, keepdims=True)
    var = jnp.mean(jnp.square(xf - mu), axis=-1, keepdims=True)
    return ((xf - mu) * lax.rsqrt(var + LN_EPS) * g + b).astype(x.dtype)


def rotary(x, pos):
    half = x.shape[-1] // 2
    inv = ROPE_BASE ** (-jnp.arange(half, dtype=jnp.float32) / half)
    ang = pos.astype(jnp.float32)[:, None] * inv[None, :]
    cos = jnp.cos(ang)[None, :, None, :]
    sin = jnp.sin(ang)[None, :, None, :]
    x1 = x[..., :half].astype(jnp.float32)
    x2 = x[..., half:].astype(jnp.float32)
    return jnp.concatenate([x1 * cos - x2 * sin, x2 * cos + x1 * sin], axis=-1).astype(x.dtype)


def retention(h, w_in, gn_gain, w_out):
    B, S, _ = h.shape
    H, dk, dv, C = RET_HEADS, RET_QK_DIM, RET_V_DIM, RET_CHUNK
    nC = S // C
    proj = h @ w_in
    q, k, v, g = jnp.split(proj, [H * dk, 2 * H * dk, 2 * H * dk + H * dv], axis=-1)
    pos = jnp.arange(S)
    q = rotary(q.reshape(B, S, H, dk), pos)
    k = rotary(k.reshape(B, S, H, dk), pos) * (dk ** -0.5)
    v = v.reshape(B, S, H, dv)
    log_gamma = jnp.log(1.0 - 2.0 ** (-5.0 - jnp.arange(H, dtype=jnp.float32)))
    idx = jnp.arange(C, dtype=jnp.float32)
    rel = idx[:, None] - idx[None, :]
    decay_intra = jnp.where(rel >= 0, jnp.exp(log_gamma[:, None, None] * jnp.maximum(rel, 0.0)), 0.0)
    q_dec = jnp.exp(log_gamma[None, :] * (idx[:, None] + 1.0))
    k_dec = jnp.exp(log_gamma[None, :] * (C - 1.0 - idx[:, None]))
    chunk_dec = jnp.exp(log_gamma * C)
    qc = q.reshape(B, nC, C, H, dk)
    kc = k.reshape(B, nC, C, H, dk)
    vc = v.reshape(B, nC, C, H, dv)
    scores = jnp.einsum('bnihd,bnjhd->bnhij', qc, kc).astype(jnp.float32) * decay_intra[None, None]
    intra = jnp.einsum('bnhij,bnjhe->bnihe', scores.astype(vc.dtype), vc)
    xs = (jnp.moveaxis(qc * q_dec[None, None, :, :, None], 1, 0),
          jnp.moveaxis(kc * k_dec[None, None, :, :, None], 1, 0),
          jnp.moveaxis(vc, 1, 0))

    def step(R, inp):
        qn, kn, vn = inp
        out = jnp.einsum('bihd,bhde->bihe', qn, R)
        R = chunk_dec[None, :, None, None] * R + jnp.einsum('bjhd,bjhe->bhde', kn, vn)
        return R, out

    R0 = jnp.zeros((B, H, dk, dv), jnp.float32)
    _, cross = lax.scan(step, R0, xs)
    r = (intra.astype(jnp.float32) + jnp.moveaxis(cross, 0, 1).astype(jnp.float32)).reshape(B, S, H, dv)
    mu = jnp.mean(r, axis=-1, keepdims=True)
    var = jnp.mean(jnp.square(r - mu), axis=-1, keepdims=True)
    normed = ((r - mu) * lax.rsqrt(var + LN_EPS)).reshape(B, S, H * dv) * gn_gain
    return (jax.nn.silu(g) * normed.astype(g.dtype)) @ w_out


def dilated_attention(h, w_qkv, w_out):
    B, S, _ = h.shape
    G, Hg, dh, Q = N_GROUPS, HEADS_PER_GROUP, ATT_HEAD_DIM, ATT_Q_BLOCK
    proj = (h @ w_qkv).reshape(B, S, 3, G, Hg, dh)
    qkv = jnp.transpose(proj, (2, 3, 0, 4, 1, 5))
    qs = [qkv[0, gi] * (dh ** -0.5) for gi in range(G)]
    ks_ = [qkv[1, gi] for gi in range(G)]
    vs = [qkv[2, gi] for gi in range(G)]
    offs = jnp.arange(Q)

    def block(bidx):
        s0 = bidx * Q
        qpos = s0 + offs
        outs, lses = [], []
        for gi, (win, dil) in enumerate(DIL_PATTERN):
            n_keys = win // dil + 1
            kpos = qpos[:, None] - dil * jnp.arange(n_keys)[None, :]
            valid = kpos >= 0
            kidx = jnp.maximum(kpos, 0)
            qb = lax.dynamic_slice_in_dim(qs[gi], s0, Q, axis=2)
            kg = jnp.take(ks_[gi], kidx, axis=2)
            vg = jnp.take(vs[gi], kidx, axis=2)
            logits = jnp.einsum('bhqd,bhqjd->bhqj', qb, kg).astype(jnp.float32)
            logits = jnp.where(valid[None, None], logits, -jnp.inf)
            lse = jax.nn.logsumexp(logits, axis=-1)
            p = jnp.exp(logits - lse[..., None])
            outs.append(jnp.einsum('bhqj,bhqjd->bhqd', p.astype(vg.dtype), vg))
            lses.append(lse)
        wgt = jax.nn.softmax(jnp.stack(lses, axis=0), axis=0)
        o = jnp.sum(wgt[..., None] * jnp.stack(outs, axis=0).astype(jnp.float32), axis=0)
        return o.astype(h.dtype)

    o = lax.map(block, jnp.arange(S // Q))
    o = jnp.transpose(o, (1, 0, 3, 2, 4)).reshape(B, S, Hg * dh)
    return o @ w_out


def swiglu(h, w_gate, w_up, w_down):
    return (jax.nn.silu(h @ w_gate) * (h @ w_up)) @ w_down


def moe_swiglu(h, w_router, w_gate, w_up, w_down):
    B, S, D = h.shape
    T = B * S
    xt = h.reshape(T, D)
    logits = (xt @ w_router).astype(jnp.float32)
    top_val, top_idx = lax.top_k(logits, TOP_K)
    gates = jax.nn.softmax(top_val, axis=-1)
    A = T * TOP_K
    e_flat = top_idx.reshape(A)
    tok_flat = jnp.arange(A, dtype=jnp.int32) // TOP_K
    g_flat = gates.reshape(A)
    order = jnp.argsort(e_flat)
    e_sorted = e_flat[order]
    counts = jnp.bincount(e_flat, length=N_EXPERTS)
    padded = ((counts + MOE_BLOCK - 1) // MOE_BLOCK) * MOE_BLOCK
    pad_end = jnp.cumsum(padded)
    pad_start = pad_end - padded
    start = jnp.cumsum(counts) - counts
    dest = pad_start[e_sorted] + (jnp.arange(A) - start[e_sorted])
    NB = -(-A // MOE_BLOCK) + N_EXPERTS
    P = NB * MOE_BLOCK
    tok_buf = jnp.full((P,), T, jnp.int32).at[dest].set(tok_flat[order])
    gate_buf = jnp.zeros((P,), jnp.float32).at[dest].set(g_flat[order])
    blk_exp = jnp.minimum(jnp.searchsorted(pad_end, jnp.arange(NB) * MOE_BLOCK, side='right'), N_EXPERTS - 1)
    x_pad = jnp.concatenate([xt, jnp.zeros((1, D), xt.dtype)], axis=0)

    def run_block(args):
        tok, e = args
        xb = x_pad[tok]
        return swiglu(xb, w_gate[e], w_up[e], w_down[e])

    y = lax.map(run_block, (tok_buf.reshape(NB, MOE_BLOCK), blk_exp)).reshape(P, D)
    y = y * gate_buf[:, None].astype(y.dtype)
    out = jnp.zeros((T + 1, D), y.dtype).at[tok_buf].add(y)[:T]
    return out.reshape(B, S, D)


def setup_inputs(seed: int = 0) -> dict:
    key = jax.random.key(seed)
    ks = jax.random.split(key, 16)
    f32 = jnp.float32

    def nrm(k, shape, fan_in, scale=1.0):
        return jax.random.normal(k, shape, f32) * (scale * fan_in ** -0.5)

    ret_in_cols = RET_HEADS * (2 * RET_QK_DIM + 2 * RET_V_DIM)
    ret_v_width = RET_HEADS * RET_V_DIM
    att_cols = 3 * N_GROUPS * HEADS_PER_GROUP * ATT_HEAD_DIM
    att_out_in = HEADS_PER_GROUP * ATT_HEAD_DIM
    return {
        'x': jax.random.normal(ks[0], (BATCH, SEQ, D_MODEL), f32),
        'ln_gain': 1.0 + 0.01 * jax.random.normal(ks[1], (DEPTH, 2, D_MODEL), f32),
        'ln_bias': 0.01 * jax.random.normal(ks[2], (DEPTH, 2, D_MODEL), f32),
        'ret_w_in': nrm(ks[3], (N_RET, D_MODEL, ret_in_cols), D_MODEL),
        'ret_gn_gain': 1.0 + 0.01 * jax.random.normal(ks[4], (N_RET, ret_v_width), f32),
        'ret_w_out': nrm(ks[5], (N_RET, ret_v_width, D_MODEL), ret_v_width, BETA),
        'att_w_qkv': nrm(ks[6], (N_ATT, D_MODEL, att_cols), D_MODEL),
        'att_w_out': nrm(ks[7], (N_ATT, att_out_in, D_MODEL), att_out_in, BETA),
        'ffn_w_gate': nrm(ks[8], (N_RET, D_MODEL, D_FF), D_MODEL),
        'ffn_w_up': nrm(ks[9], (N_RET, D_MODEL, D_FF), D_MODEL),
        'ffn_w_down': nrm(ks[10], (N_RET, D_FF, D_MODEL), D_FF, BETA),
        'moe_w_router': nrm(ks[11], (N_ATT, D_MODEL, N_EXPERTS), D_MODEL),
        'moe_w_gate': nrm(ks[12], (N_ATT, N_EXPERTS, D_MODEL, D_FF), D_MODEL),
        'moe_w_up': nrm(ks[13], (N_ATT, N_EXPERTS, D_MODEL, D_FF), D_MODEL),
        'moe_w_down': nrm(ks[14], (N_ATT, N_EXPERTS, D_FF, D_MODEL), D_FF, BETA),
    }


def reference(x, ln_gain, ln_bias, ret_w_in, ret_gn_gain, ret_w_out, att_w_qkv, att_w_out,
              ffn_w_gate, ffn_w_up, ffn_w_down, moe_w_router, moe_w_gate, moe_w_up, moe_w_down):
    for i in range(DEPTH):
        j = i // 2
        if i % N_MIXERS == 0:
            mix = retention(x, ret_w_in[j], ret_gn_gain[j], ret_w_out[j])
        else:
            mix = dilated_attention(x, att_w_qkv[j], att_w_out[j])
        x = layer_norm(ALPHA * x + mix, ln_gain[i, 0], ln_bias[i, 0])
        if i % 2 == 0:
            f = swiglu(x, ffn_w_gate[j], ffn_w_up[j], ffn_w_down[j])
        else:
            f = moe_swiglu(x, moe_w_router[j], moe_w_gate[j], moe_w_up[j], moe_w_down[j])
        x = layer_norm(ALPHA * x + f, ln_gain[i, 1], ln_bias[i, 1])
    return x
```

```cpp
#include <hip/hip_runtime.h>
#include <hip/hip_bf16.h>
#include <cstdio>
#include <cstdint>
#include <cmath>
namespace pg8 {
#define PG8_LAS __attribute__((address_space(3)))
typedef unsigned short bf16_t;
typedef short bf16x8 __attribute__((ext_vector_type(8)));
typedef float f32x4 __attribute__((ext_vector_type(4)));
typedef float f32x2 __attribute__((ext_vector_type(2)));
typedef unsigned u32x4 __attribute__((ext_vector_type(4)));
constexpr int BM = 256, BK = 64, HALF = 128, HTB = HALF * BK * 2  , STAGE_BYTES = 8 * HTB, NXCD = 8, WGM = 8;

__host__ __device__ __forceinline__ int lds_byte(int r, int c) { const int st = (r >> 4) * 2 + (c >> 5), rr = r & 15, cc = c & 31, ob = rr * 64 + cc * 2; return st * 1024 + (ob ^ (((ob >> 9) & 1) << 5)); }
__host__ __device__ __forceinline__ void stage_rc(int b, int& R, int& C) { const int st = b / 1024, sb = b % 1024, swz = sb ^ (((sb >> 9) & 1) << 5); R = (st >> 1) * 16 + swz / 64; C = (st & 1) * 32 + (swz % 64) / 2; }
__host__ __device__ __forceinline__ int perm32(int rho) { const int n = rho >> 4, i = rho & 15; return 8 * (i >> 2) + 4 * n + (i & 3); }

struct Unit { int pm, pn, ex; };

struct StaticOrder {
    static constexpr bool GATHER = false;
    const char* A; const char* Bt; int K;
    int nM, nN, nwg, G, c;
    __device__ void init(const void* A_, const void* Bt_, int M, int N, int K_, int G_, int c_) { A = (const char*)A_; Bt = (const char*)Bt_; K = K_; nM = M / BM; nN = N / BM; nwg = nM * nN; G = G_; c = c_; }
    __device__ bool next(int i, Unit& u) const {
        const long L = (long)i * G + c; if (L >= nwg) return false;
        int wgid = (int)L; { const int q = nwg / NXCD, r = nwg % NXCD, xcd = wgid % NXCD, off = wgid / NXCD; wgid = (xcd < r ? xcd * (q + 1) : r * (q + 1) + (xcd - r) * q) + off; }
        const int nig = WGM * nN, gid = wgid / nig, fm = gid * WGM, gsz = (nM - fm) < WGM ? (nM - fm) : WGM;
        u.pm = fm + ((wgid % nig) % gsz); u.pn = (wgid % nig) / gsz; u.ex = 0; return true;
    }
    __device__ __forceinline__ const char* a_ptr(const Unit& u) const { return A + (size_t)u.pm * ((size_t)BM * K * 2); }
    __device__ __forceinline__ const char* b_ptr(const Unit& u) const { return Bt + (size_t)u.pn * ((size_t)BM * K * 2); }
    __device__ __forceinline__ unsigned a_off(int, int, int, int) const { return 0u; }
};

__device__ __forceinline__ unsigned cvt_pk_bf16(float lo, float hi) { unsigned r; asm volatile("v_cvt_pk_bf16_f32 %0, %1, %2" : "=v"(r) : "v"(lo), "v"(hi)); return r; }

template <class Epi, class Sched, bool ALIGN_EPI>
__device__ __forceinline__ void gemm_phase(PG8_LAS unsigned char* lds, const Sched& S, const Epi& E, const int tid) {
    constexpr bool GATHER = Sched::GATHER;
    const int wid = __builtin_amdgcn_readfirstlane(tid >> 6), lane = tid & 63, wr = wid >> 2, wc = wid & 3, fr = lane & 15, fq = lane >> 4;
    const int K = S.K, nt = K / BK;
    unsigned voffA[2][2], nvoffA[2][2], voffB[2]; int sR[2], sC[2];
#pragma unroll
    for (int i = 0; i < 2; ++i) { int R, C; stage_rc(tid * 16 + i * 8192, R, C); sR[i] = R; sC[i] = C; const int Rb = Epi::PERM ? ((R & ~31) + perm32(R & 31)) : R;
        voffA[0][i] = (unsigned)(R * K + C) * 2u; voffA[1][i] = voffA[0][i]; nvoffA[0][i] = voffA[0][i]; nvoffA[1][i] = voffA[0][i]; voffB[i] = (unsigned)(Rb * K + C) * 2u; }
    const size_t kstep = (size_t)(BK * 2);
    const size_t hstep = (size_t)HALF * K * 2;
    const size_t ahstep = GATHER ? (size_t)0 : hstep;
    const unsigned ldsw = (unsigned)wid * 1024u;
    const int aoff = lds_byte(wr * 64 + fr, fq * 8), boff = lds_byte(wc * 32 + fr, fq * 8);
#define PG8_SA(b, h) (((b) * 2 + (h)) * HTB)
#define PG8_SB(b, h) ((4 + (b) * 2 + (h)) * HTB)
#define PG8_STAGE(bufoff, gbase, voff) do { _Pragma("unroll") for (int _i = 0; _i < 2; ++_i) \
        __builtin_amdgcn_global_load_lds((const unsigned*)((const char*)(gbase) + (voff)[_i]), (PG8_LAS unsigned*)(lds + (bufoff) + ldsw + _i * 8192), 16, 0, 0); } while (0)
#define PG8_STAGE_A(bufoff, gbase, h, VO) PG8_STAGE(bufoff, (gbase) + (h) * ahstep, (VO)[GATHER ? (h) : 0])
#define PG8_LDA(dst, b, h) do { _Pragma("unroll") for (int m = 0; m < 4; ++m) _Pragma("unroll") for (int k = 0; k < 2; ++k) dst[m][k] = *(const PG8_LAS bf16x8*)(lds + PG8_SA(b, h) + aoff + m * 2048 + k * 1024); } while (0)
#define PG8_LDB(dst, b, h) do { _Pragma("unroll") for (int n = 0; n < 2; ++n) _Pragma("unroll") for (int k = 0; k < 2; ++k) dst[n][k] = *(const PG8_LAS bf16x8*)(lds + PG8_SB(b, h) + boff + n * 2048 + k * 1024); } while (0)
#define PG8_MMA(ai, bj, At, Bt) do { __builtin_amdgcn_s_setprio(1); _Pragma("unroll") for (int m = 0; m < 4; ++m) _Pragma("unroll") for (int n = 0; n < 2; ++n) _Pragma("unroll") for (int k = 0; k < 2; ++k) \
        acc[ai][bj][m][n] = __builtin_amdgcn_mfma_f32_16x16x32_bf16(Bt[n][k], At[m][k], acc[ai][bj][m][n], 0, 0, 0); __builtin_amdgcn_s_setprio(0); } while (0)
#define PG8_WAIT_V(n) asm volatile("s_waitcnt vmcnt(" #n ")" ::: "memory")
#define PG8_WAIT_L(n) asm volatile("s_waitcnt lgkmcnt(" #n ")" ::: "memory")
#define PG8_BAR __builtin_amdgcn_s_barrier()
#define PG8_SCHED __builtin_amdgcn_sched_barrier(0)
    Unit cur, nxt; int ui = 0;
    if (!S.next(0, cur)) return;
    f32x4 acc[2][2][4][2];
#pragma unroll
    for (int a = 0; a < 2; ++a)
#pragma unroll
        for (int b = 0; b < 2; ++b)
#pragma unroll
            for (int m = 0; m < 4; ++m)
#pragma unroll
                for (int n = 0; n < 2; ++n) acc[a][b][m][n] = (f32x4){0.f, 0.f, 0.f, 0.f};
    bf16x8 At[4][2], B0[2][2], B1[2][2];
    const char* cA = S.a_ptr(cur); const char* cB = S.b_ptr(cur);
    if constexpr (GATHER) {
#pragma unroll
        for (int h = 0; h < 2; ++h)
#pragma unroll
            for (int i = 0; i < 2; ++i) voffA[h][i] = S.a_off(0, h * HALF + sR[i], sC[i], 0);
    }
    PG8_STAGE(PG8_SB(0, 0), cB, voffB); PG8_STAGE(PG8_SB(0, 1), cB + hstep, voffB); PG8_STAGE_A(PG8_SA(0, 0), cA, 0, voffA); PG8_STAGE_A(PG8_SA(0, 1), cA, 1, voffA);
    if (wr == 1) PG8_BAR;
    PG8_WAIT_V(2); PG8_BAR;
    PG8_STAGE(PG8_SB(1, 0), cB + kstep, voffB); PG8_STAGE_A(PG8_SA(1, 0), cA + kstep, 0, voffA); PG8_STAGE(PG8_SB(1, 1), cB + hstep + kstep, voffB);
    PG8_WAIT_V(6); PG8_BAR;
    for (;;) {
        const bool has_next = S.next(ui + 1, nxt);
        const char* nA = has_next ? S.a_ptr(nxt) : cA; const char* nB = has_next ? S.b_ptr(nxt) : cB;
        if constexpr (GATHER) {
#pragma unroll
            for (int h = 0; h < 2; ++h)
#pragma unroll
                for (int i = 0; i < 2; ++i) nvoffA[h][i] = has_next ? S.a_off(ui + 1, h * HALF + sR[i], sC[i], 0) : voffA[h][i];
        }
        for (int t = 0; t < nt; t += 2) {
            const bool last = (t == nt - 2);
            const char* a1 = cA + (size_t)(t + 1) * kstep;
            const char* a2 = last ? nA : cA + (size_t)(t + 2) * kstep; const char* b2 = last ? nB : cB + (size_t)(t + 2) * kstep;
            const char* a3 = a2 + kstep; const char* b3 = b2 + kstep;
            unsigned vo2[2][2];
#pragma unroll
            for (int h = 0; h < 2; ++h)
#pragma unroll
                for (int i = 0; i < 2; ++i) vo2[h][i] = (GATHER && last) ? nvoffA[h][i] : voffA[h][i];
            PG8_LDB(B0, 0, 0); PG8_LDB(B1, 0, 1); PG8_SCHED; PG8_LDA(At, 0, 0); PG8_STAGE_A(PG8_SA(1, 1), a1, 1, voffA);
            PG8_WAIT_V(8); PG8_WAIT_L(0); PG8_BAR; PG8_MMA(0, 0, At, B0); PG8_MMA(0, 1, At, B1); PG8_BAR; PG8_SCHED;
            PG8_LDA(At, 0, 1); PG8_STAGE(PG8_SB(0, 0), b2, voffB); PG8_STAGE(PG8_SB(0, 1), b2 + hstep, voffB); PG8_STAGE_A(PG8_SA(0, 0), a2, 0, vo2);
            PG8_WAIT_V(8); PG8_WAIT_L(0); PG8_BAR; PG8_MMA(1, 0, At, B0); PG8_MMA(1, 1, At, B1); PG8_BAR; PG8_SCHED;
            PG8_LDB(B0, 1, 0); PG8_LDB(B1, 1, 1); PG8_SCHED; PG8_LDA(At, 1, 0); PG8_STAGE_A(PG8_SA(0, 1), a2, 1, vo2);
            PG8_WAIT_V(8); PG8_WAIT_L(0); PG8_BAR; PG8_MMA(0, 0, At, B0); PG8_MMA(0, 1, At, B1); PG8_BAR; PG8_SCHED;
            PG8_LDA(At, 1, 1); PG8_STAGE(PG8_SB(1, 0), b3, voffB); PG8_STAGE(PG8_SB(1, 1), b3 + hstep, voffB); PG8_STAGE_A(PG8_SA(1, 0), a3, 0, vo2);
            PG8_WAIT_V(8); PG8_WAIT_L(0); PG8_BAR; PG8_MMA(1, 0, At, B0); PG8_MMA(1, 1, At, B1); PG8_BAR; PG8_SCHED;
        }
        if constexpr (ALIGN_EPI) { if (wr == 0) PG8_BAR; }
        E(acc, cur, wr, wc, fr, fq);
        if (!has_next) break;
#pragma unroll
        for (int a = 0; a < 2; ++a)
#pragma unroll
            for (int b = 0; b < 2; ++b)
#pragma unroll
                for (int m = 0; m < 4; ++m)
#pragma unroll
                    for (int n = 0; n < 2; ++n) acc[a][b][m][n] = (f32x4){0.f, 0.f, 0.f, 0.f};
        cur = nxt; cA = nA; cB = nB; ++ui;
        if constexpr (GATHER) {
#pragma unroll
            for (int h = 0; h < 2; ++h)
#pragma unroll
                for (int i = 0; i < 2; ++i) voffA[h][i] = nvoffA[h][i];
        }
        if constexpr (ALIGN_EPI) { if (wr == 1) PG8_BAR; }
    }
    PG8_WAIT_V(0);
    if constexpr (!ALIGN_EPI) { if (wr == 0) PG8_BAR; }
    PG8_BAR;
#undef PG8_SA
#undef PG8_SB
#undef PG8_STAGE
#undef PG8_STAGE_A
#undef PG8_LDA
#undef PG8_LDB
#undef PG8_MMA
#undef PG8_WAIT_V
#undef PG8_WAIT_L
#undef PG8_BAR
#undef PG8_SCHED
}
__device__ __forceinline__ float silu_f(float x) { return x * __builtin_amdgcn_rcpf(1.0f + __builtin_amdgcn_exp2f(-1.4426950408889634f * x)); }
__device__ __forceinline__ u32x4 pack8v(const f32x4& v0, const f32x4& v1) { u32x4 w; w.x = cvt_pk_bf16(v0[0], v0[1]); w.y = cvt_pk_bf16(v0[2], v0[3]); w.z = cvt_pk_bf16(v1[0], v1[1]); w.w = cvt_pk_bf16(v1[2], v1[3]); return w; }

struct EpiRetProj {
    static constexpr bool PERM = true;
    bf16_t* QD; bf16_t* KH; bf16_t* G; const float* tab;
    __device__ __forceinline__ void operator()(const f32x4 (&acc)[2][2][4][2], const Unit& u, int wr, int wc, int fr, int fq) const {
        const int row0 = u.pm * BM + wr * 64 + fr, cl = wc * 32 + 8 * fq;
        if (u.pn < 8) {
            const bool isq = u.pn < 4; const int h = u.pn & 3;
            const float lg = __builtin_amdgcn_logf(1.0f - __builtin_amdgcn_exp2f((float)(-5 - h)));
            bf16_t* base = (isq ? QD : KH) + h * 256 + cl;
#pragma unroll
            for (int ai = 0; ai < 2; ++ai)
#pragma unroll
                for (int m = 0; m < 4; ++m) { const int row = row0 + ai * HALF + m * 16, pos = row & 16383, ic = row & 127;
                    const float sc = isq ? __builtin_amdgcn_exp2f(lg * (float)(ic + 1)) : 0.0625f * __builtin_amdgcn_exp2f(-lg * (float)(ic + 1));
                    const f32x4* tp = (const f32x4*)(tab + ((size_t)pos * 128 + cl) * 2);
                    const f32x4 t0 = tp[0], t1 = tp[1], t2 = tp[2], t3 = tp[3];
                    const f32x4 a0 = acc[ai][0][m][0], a1 = acc[ai][0][m][1], b0 = acc[ai][1][m][0], b1 = acc[ai][1][m][1];
                    f32x4 o10, o11, o20, o21;
                    o10[0] = (a0[0] * t0[0] - b0[0] * t0[1]) * sc; o20[0] = (b0[0] * t0[0] + a0[0] * t0[1]) * sc;
                    o10[1] = (a0[1] * t0[2] - b0[1] * t0[3]) * sc; o20[1] = (b0[1] * t0[2] + a0[1] * t0[3]) * sc;
                    o10[2] = (a0[2] * t1[0] - b0[2] * t1[1]) * sc; o20[2] = (b0[2] * t1[0] + a0[2] * t1[1]) * sc;
                    o10[3] = (a0[3] * t1[2] - b0[3] * t1[3]) * sc; o20[3] = (b0[3] * t1[2] + a0[3] * t1[3]) * sc;
                    o11[0] = (a1[0] * t2[0] - b1[0] * t2[1]) * sc; o21[0] = (b1[0] * t2[0] + a1[0] * t2[1]) * sc;
                    o11[1] = (a1[1] * t2[2] - b1[1] * t2[3]) * sc; o21[1] = (b1[1] * t2[2] + a1[1] * t2[3]) * sc;
                    o11[2] = (a1[2] * t3[0] - b1[2] * t3[1]) * sc; o21[2] = (b1[2] * t3[0] + a1[2] * t3[1]) * sc;
                    o11[3] = (a1[3] * t3[2] - b1[3] * t3[3]) * sc; o21[3] = (b1[3] * t3[2] + a1[3] * t3[3]) * sc;
                    bf16_t* rp = base + (size_t)row * 1024;
                    *(u32x4*)rp = pack8v(o10, o11); *(u32x4*)(rp + 128) = pack8v(o20, o21); asm volatile("" ::: "memory"); }
        } else {
            bf16_t* base = G + (u.pn - 8) * 256 + cl;
#pragma unroll
            for (int ai = 0; ai < 2; ++ai)
#pragma unroll
                for (int m = 0; m < 4; ++m) { bf16_t* rp = base + (size_t)(row0 + ai * HALF + m * 16) * 2048;
#pragma unroll
                    for (int bj = 0; bj < 2; ++bj) { f32x4 v0 = acc[ai][bj][m][0], v1 = acc[ai][bj][m][1];
#pragma unroll
                        for (int j = 0; j < 4; ++j) { v0[j] = silu_f(v0[j]); v1[j] = silu_f(v1[j]); }
                        *(u32x4*)(rp + bj * HALF) = pack8v(v0, v1); } }
        }
    }
};
struct EpiVT {
    static constexpr bool PERM = true;
    bf16_t* VT;
    __device__ __forceinline__ void operator()(const f32x4 (&acc)[2][2][4][2], const Unit& u, int wr, int wc, int fr, int fq) const {
        const int row0 = u.pm * BM + wr * 64 + fr, c0 = u.pn * BM + wc * 32 + 8 * fq;
#pragma unroll
        for (int ai = 0; ai < 2; ++ai)
#pragma unroll
            for (int m = 0; m < 4; ++m) { const int R = row0 + ai * HALF + m * 16, h = R >> 9, e = R & 511;
#pragma unroll
                for (int bj = 0; bj < 2; ++bj) { const int c = c0 + bj * HALF, b = c >> 14, t = c & 16383, n = t >> 7, oct = (t & 127) >> 3;
                    const size_t off = ((size_t)((b * 4 + h) * 128 + n) << 16) + (size_t)(((((e >> 5) * 8 + (oct >> 1)) * 2 + (oct & 1)) * 32 + (e & 31)) * 8);
                    *(u32x4*)(VT + off) = pack8v(acc[ai][bj][m][0], acc[ai][bj][m][1]); } }
    }
};
struct EpiAddF32 {
    static constexpr bool PERM = false;
    float* X;
    __device__ __forceinline__ void operator()(const f32x4 (&acc)[2][2][4][2], const Unit& u, int wr, int wc, int fr, int fq) const {
        const int row0 = u.pm * BM + wr * 64 + fr, col0 = u.pn * BM + wc * 32 + 4 * fq;
#pragma unroll
        for (int ai = 0; ai < 2; ++ai)
#pragma unroll
            for (int m = 0; m < 4; ++m) { float* rowp = X + (size_t)(row0 + ai * HALF + m * 16) * 1024 + col0;
#pragma unroll
                for (int bj = 0; bj < 2; ++bj)
#pragma unroll
                    for (int n = 0; n < 2; ++n) { f32x4* p = (f32x4*)(rowp + bj * HALF + n * 16); *p = *p + acc[ai][bj][m][n]; } }
    }
};
struct EpiSwiGLU {
    static constexpr bool PERM = true;
    bf16_t* H;
    __device__ __forceinline__ void operator()(const f32x4 (&acc)[2][2][4][2], const Unit& u, int wr, int wc, int fr, int fq) const {
        const int row0 = u.pm * BM + wr * 64 + fr, col0 = u.pn * HALF + wc * 32 + 8 * fq;
#pragma unroll
        for (int ai = 0; ai < 2; ++ai)
#pragma unroll
            for (int m = 0; m < 4; ++m) { f32x4 v0 = acc[ai][0][m][0], v1 = acc[ai][0][m][1]; const f32x4 u0 = acc[ai][1][m][0], u1 = acc[ai][1][m][1];
#pragma unroll
                for (int j = 0; j < 4; ++j) { v0[j] = silu_f(v0[j]) * u0[j]; v1[j] = silu_f(v1[j]) * u1[j]; }
                *(u32x4*)(H + (size_t)(row0 + ai * HALF + m * 16) * 3584 + col0) = pack8v(v0, v1); }
    }
};
struct EpiQKV {
    static constexpr bool PERM = true;
    bf16_t* P;
    __device__ __forceinline__ void operator()(const f32x4 (&acc)[2][2][4][2], const Unit& u, int wr, int wc, int fr, int fq) const {
        const int row0 = u.pm * BM + wr * 64 + fr, cl = wc * 32 + 8 * fq;
        const int which = u.pn / 6, g = (u.pn % 6) >> 1, hp = u.pn & 1, sh = 2 * g;
#pragma unroll
        for (int ai = 0; ai < 2; ++ai)
#pragma unroll
            for (int m = 0; m < 4; ++m) { const int r = row0 + ai * HALF + m * 16, b = r >> 14, t = r & 16383;
                const int perm = (t & ((1 << sh) - 1)) * (16384 >> sh) + (t >> sh);
#pragma unroll
                for (int bj = 0; bj < 2; ++bj) { const int head = 2 * hp + bj;
                    bf16_t* dst = P + ((size_t)(((which * 3 + g) * 8 + b * 4 + head) * 16384 + perm) << 7) + cl;
                    *(u32x4*)dst = pack8v(acc[ai][bj][m][0], acc[ai][bj][m][1]); } }
    }
};
struct EpiBf16Y {
    static constexpr bool PERM = true;
    bf16_t* Y;
    __device__ __forceinline__ void operator()(const f32x4 (&acc)[2][2][4][2], const Unit& u, int wr, int wc, int fr, int fq) const {
        const int row0 = u.pm * BM + wr * 64 + fr, col0 = u.pn * BM + wc * 32 + 8 * fq;
#pragma unroll
        for (int ai = 0; ai < 2; ++ai)
#pragma unroll
            for (int m = 0; m < 4; ++m) { bf16_t* rp = Y + (size_t)(row0 + ai * HALF + m * 16) * 1024 + col0;
#pragma unroll
                for (int bj = 0; bj < 2; ++bj) *(u32x4*)(rp + bj * HALF) = pack8v(acc[ai][bj][m][0], acc[ai][bj][m][1]); }
    }
};
}
namespace swa {
constexpr int D = 128; constexpr float THR = 8.f; constexpr bool WSKIP = true; constexpr int LSE_LDS_OFF = 131072;
constexpr float SCALE = 0.08838834764831845f;
constexpr int NW = 8, QBLK = 32, KVBLK = 64, QB = NW * QBLK;
constexpr int SHM_V = KVBLK * D * 2, SHM_K = KVBLK * D * 2;
constexpr int LDS_BYTES = 2 * SHM_V + 2 * SHM_K + NW * 64 * 4;

using bf16 = __hip_bfloat16;
typedef short bf16x8 __attribute__((ext_vector_type(8)));
typedef short s16x4 __attribute__((ext_vector_type(4)));
typedef float f32x16 __attribute__((ext_vector_type(16)));
typedef float f32x4 __attribute__((ext_vector_type(4)));
typedef unsigned u32x4 __attribute__((ext_vector_type(4)));
template <class A, class Bt> struct same_t { static constexpr bool v = false; };
template <class A> struct same_t<A, A> { static constexpr bool v = true; };

#define KSWZ(row, colB) ((row) * 256 + ((colB) ^ (((row) & 7) << 4)))
#define SBAR() __builtin_amdgcn_sched_barrier(0)
__device__ __forceinline__ int v_st(int k, int c) { const int kk = (k & ~0xC) | ((k & 4) << 1) | ((k & 8) >> 1); return ((kk >> 3) * 4 + (c >> 5)) * 512 + ((kk & 7) * 32 + (c & 31)) * 2; }
__device__ __forceinline__ int v_rd_base(int lane) { return ((lane & 3) << 3) | (((lane >> 2) & 3) << 6) | (((lane >> 4) & 1) << 5) | (((lane >> 5) & 1) << 8); }
constexpr int v_rd_off(int d0, int ks, int half) { return d0 * 512 + ks * 4096 + half * 2048; }
__device__ __forceinline__ int crow(int r, int hi) { return (r & 3) + 8 * (r >> 2) + 4 * hi; }
__device__ __forceinline__ unsigned cvtpk(float lo, float hi) {
    unsigned r; asm volatile("v_cvt_pk_bf16_f32 %0, %1, %2" : "=v"(r) : "v"(lo), "v"(hi)); return r;
}
__device__ __forceinline__ bf16x8 pack8(f32x4 a, f32x4 b) {
    u32x4 w = {cvtpk(a[0], a[1]), cvtpk(a[2], a[3]), cvtpk(b[0], b[1]), cvtpk(b[2], b[3])};
    return *reinterpret_cast<bf16x8*>(&w);
}
template <class T> __device__ __forceinline__ bf16x8 load8(const T* p) {
    if constexpr (same_t<T, float>::v) { return pack8(*(const f32x4*)p, *(const f32x4*)(p + 4)); }
    else { return *reinterpret_cast<const bf16x8*>(p); }
}
__device__ __forceinline__ void mask_tile(f32x16& p0, f32x16& p1, int dq, unsigned W) {
    const float NEG = -__builtin_inff();
#pragma unroll
    for (int r = 0; r < 16; ++r) {
        const int c = (r & 3) + 8 * (r >> 2);
        if ((unsigned)(dq - c) >= W) p0[r] = NEG;
        if ((unsigned)(dq - c - 32) >= W) p1[r] = NEG;
    }
}
__device__ __forceinline__ void partialSM(f32x16& p0, f32x16& p1, float& m_reg, float& mn, float& alpha) {
    float pmax = p0[0]; for (int r = 1; r < 16; ++r) pmax = fmaxf(pmax, p0[r]); for (int r = 0; r < 16; ++r) pmax = fmaxf(pmax, p1[r]);
    { auto rr = __builtin_amdgcn_permlane32_swap(__float_as_uint(pmax), __float_as_uint(pmax), false, false);
      pmax = fmaxf(__uint_as_float(rr[0]), __uint_as_float(rr[1])); }
    constexpr float C2 = 1.4426950408889634f * SCALE;
    if (__builtin_expect(__all((pmax - m_reg) * SCALE <= THR), 1)) { mn = m_reg; alpha = 1.f; }
    else { mn = fmaxf(m_reg, pmax); alpha = __builtin_amdgcn_exp2f((m_reg - mn) * C2); m_reg = mn; }
    const float mnL = -mn * C2;
    for (int r = 0; r < 16; ++r) p0[r] = fmaf(p0[r], C2, mnL); for (int r = 0; r < 16; ++r) p1[r] = fmaf(p1[r], C2, mnL);
    for (int r = 0; r < 16; ++r) p0[r] = __builtin_amdgcn_exp2f(p0[r]);
}
__device__ __forceinline__ void finishSM(f32x16& p0, f32x16& p1, float alpha, float& l_reg, bf16x8& pa0, bf16x8& pa1, bf16x8& pa2, bf16x8& pa3) {
    for (int r = 0; r < 16; ++r) p1[r] = __builtin_amdgcn_exp2f(p1[r]);
    float ps = 0; for (int r = 0; r < 16; ++r) ps += p0[r]; for (int r = 0; r < 16; ++r) ps += p1[r];
    { auto rr = __builtin_amdgcn_permlane32_swap(__float_as_uint(ps), __float_as_uint(ps), false, false);
      ps = __uint_as_float(rr[0]) + __uint_as_float(rr[1]); }
    l_reg = l_reg * alpha + ps;
#define PK4(P, B_, OUT) do { unsigned a0 = cvtpk(P[B_+0], P[B_+1]), a1 = cvtpk(P[B_+2], P[B_+3]);                          \
        unsigned b0 = cvtpk(P[B_+4], P[B_+5]), b1 = cvtpk(P[B_+6], P[B_+7]);                                             \
        auto r0 = __builtin_amdgcn_permlane32_swap(a0, b0, false, false); auto r1 = __builtin_amdgcn_permlane32_swap(a1, b1, false, false); \
        u32x4 w = {r0[0], r1[0], r0[1], r1[1]}; OUT = *reinterpret_cast<bf16x8*>(&w); } while (0)
    PK4(p0, 0, pa0); PK4(p0, 8, pa1); PK4(p1, 0, pa2); PK4(p1, 8, pa3);
#undef PK4
}
template <int KB, bool SK>
__device__ __forceinline__ void qkt(f32x16& p0, f32x16& p1, const char* K_lds, int r32, int hi, const bf16x8* qr, bool act) {
    if (SK && !act) { const float NEG = -__builtin_inff();
#pragma unroll
        for (int r = 0; r < 16; ++r) { p0[r] = NEG; p1[r] = NEG; } return; }
    p0 = f32x16{}; p1 = f32x16{};
    const char* kb[4];
#pragma unroll
    for (int dd = 0; dd < 4; ++dd) kb[dd] = K_lds + KB * SHM_K + KSWZ(r32, (dd * 16 + hi * 8) * 2);
#pragma unroll
    for (int d0 = 0; d0 < 8; ++d0) { const char* a = kb[d0 & 3] + (d0 >> 2) * 128;
        bf16x8 b0 = *reinterpret_cast<const bf16x8*>(a);
        bf16x8 b1 = *reinterpret_cast<const bf16x8*>(a + 32 * 256);
        p0 = __builtin_amdgcn_mfma_f32_32x32x16_bf16(b0, qr[d0], p0, 0, 0, 0);
        p1 = __builtin_amdgcn_mfma_f32_32x32x16_bf16(b1, qr[d0], p1, 0, 0, 0); }
}
template <int VB, bool SK>
__device__ __forceinline__ void pv_tile(f32x16* o, int vb0, bf16x8 pa0, bf16x8 pa1, bf16x8 pa2, bf16x8 pa3, bool act) {
    if (SK && !act) return;
#define TRRD(dst, off) asm volatile("ds_read_b64_tr_b16 %0, %1 offset:%2" : "=&v"(dst) : "v"(vb0), "i"(off) : "memory")
#define PV_D0(d0) do { s16x4 l0, l1, l2, l3, h0, h1, h2, h3; constexpr int b_ = VB * SHM_V + v_rd_off(d0, 0, 0);     \
        TRRD(l0, b_); TRRD(h0, b_ + 2048); TRRD(l1, b_ + 4096); TRRD(h1, b_ + 6144); TRRD(l2, b_ + 8192); TRRD(h2, b_ + 10240); TRRD(l3, b_ + 12288); TRRD(h3, b_ + 14336); \
        asm volatile("s_waitcnt lgkmcnt(0)" ::: "memory"); SBAR();                 \
        o[d0] = __builtin_amdgcn_mfma_f32_32x32x16_bf16(pa0, (bf16x8){l0[0], l0[1], l0[2], l0[3], h0[0], h0[1], h0[2], h0[3]}, o[d0], 0, 0, 0);   \
        o[d0] = __builtin_amdgcn_mfma_f32_32x32x16_bf16(pa1, (bf16x8){l1[0], l1[1], l1[2], l1[3], h1[0], h1[1], h1[2], h1[3]}, o[d0], 0, 0, 0);   \
        o[d0] = __builtin_amdgcn_mfma_f32_32x32x16_bf16(pa2, (bf16x8){l2[0], l2[1], l2[2], l2[3], h2[0], h2[1], h2[2], h2[3]}, o[d0], 0, 0, 0);   \
        o[d0] = __builtin_amdgcn_mfma_f32_32x32x16_bf16(pa3, (bf16x8){l3[0], l3[1], l3[2], l3[3], h3[0], h3[1], h3[2], h3[3]}, o[d0], 0, 0, 0); } while (0)
    PV_D0(0); PV_D0(1); PV_D0(2); PV_D0(3);
#undef PV_D0
#undef TRRD
}

template <class TIn, class TOut> struct BlockRef { const TIn* Q; const TIn* K; const TIn* V; TOut* O; int P0; };
template <class TIn> struct Seam {
    int tid;
    bf16x8 qr[8];
    bf16x8 st_v0, st_v1, st_k0, st_k1; f32x4 sf0, sf1, sf2, sf3;
    f32x4 tq[16];
};
__device__ __forceinline__ int swa_jlo(int P0, int W) { const int lowk = P0 - W + 1; return lowk > 0 ? lowk / KVBLK : 0; }
#define ROW(p, k0, rr) ((p) + (size_t)((k0) + (rr)) * D + sc)
#define VMW() asm volatile("s_waitcnt vmcnt(0)" ::: "memory")
#define VMWN(n) asm volatile("s_waitcnt vmcnt(%0)" :: "i"(n) : "memory")
#define SLOAD_H(Kp, Vp, k0) do { S.st_v0 = load8<TIn>(ROW(Vp, k0, sr)); S.st_v1 = load8<TIn>(ROW(Vp, k0, 32 + sr));              \
                         S.st_k0 = load8<TIn>(ROW(Kp, k0, sr)); S.st_k1 = load8<TIn>(ROW(Kp, k0, 32 + sr)); } while (0)
#define SWRITE_HK(bf) do { *(bf16x8*)(K_lds + (bf) * SHM_K + kws) = S.st_k0; *(bf16x8*)(K_lds + (bf) * SHM_K + kws + 32 * 256) = S.st_k1; } while (0)
#define SWRITE_HV(bf) do { *(bf16x8*)(V_lds + (bf) * SHM_V + vst0) = S.st_v0; *(bf16x8*)(V_lds + (bf) * SHM_V + vst1) = S.st_v1; } while (0)
#define SWRITE_H(bf) do { SWRITE_HV(bf); SWRITE_HK(bf); } while (0)
#define SLOAD_F(p, k0) do { S.sf0 = *(const f32x4*)ROW(p, k0, sr); S.sf1 = *(const f32x4*)(ROW(p, k0, sr) + 4);                \
                            S.sf2 = *(const f32x4*)ROW(p, k0, 32 + sr); S.sf3 = *(const f32x4*)(ROW(p, k0, 32 + sr) + 4); } while (0)
#define SWRITE_KF(bf) do { *(bf16x8*)(K_lds + (bf) * SHM_K + kws) = pack8(S.sf0, S.sf1); *(bf16x8*)(K_lds + (bf) * SHM_K + kws + 32 * 256) = pack8(S.sf2, S.sf3); } while (0)
#define SWRITE_VF(bf) do { *(bf16x8*)(V_lds + (bf) * SHM_V + vst0) = pack8(S.sf0, S.sf1); *(bf16x8*)(V_lds + (bf) * SHM_V + vst1) = pack8(S.sf2, S.sf3); } while (0)
template <class TIn, class TOut>
__device__ __forceinline__ void causal_swa_prime(const BlockRef<TIn, TOut>& cur, int W, char* lds, Seam<TIn>& S) {
    constexpr bool F32 = same_t<TIn, float>::v;
    const int tid = S.tid, wid = __builtin_amdgcn_readfirstlane(tid >> 6), lane = tid & 63, r32 = lane & 31, hi = lane >> 5;
    const int sr = tid >> 4, sc = (tid & 15) * 8, kws = KSWZ(sr, sc * 2); char* K_lds = lds + 2 * SHM_V;
    const int kb0 = swa_jlo(cur.P0, W) * KVBLK;
    for (int d0 = 0; d0 < 8; ++d0) S.qr[d0] = load8<TIn>(cur.Q + (size_t)(wid * QBLK + r32) * D + d0 * 16 + hi * 8);
    if constexpr (F32) { SLOAD_F((const float*)cur.K, kb0); VMW(); SWRITE_KF(0); SBAR(); SLOAD_F((const float*)cur.V, kb0); }
    else { SLOAD_H(cur.K, cur.V, kb0); VMW(); SWRITE_HK(0); }
    __syncthreads();
}
template <class TIn, class TOut>
__device__ __forceinline__ void causal_swa_block(const BlockRef<TIn, TOut>& cur, const BlockRef<TIn, TOut>& nxt, int skv, int W, char* lds, Seam<TIn>& S) {
    constexpr bool F32 = same_t<TIn, float>::v;
    const int tid = S.tid, wid = __builtin_amdgcn_readfirstlane(tid >> 6), lane = tid & 63, r32 = lane & 31, hi = lane >> 5;
    const int j_lo = swa_jlo(cur.P0, W);
    int j_hi = (cur.P0 + QB - 1) / KVBLK + 1; if (j_hi > skv / KVBLK) j_hi = skv / KVBLK;
    const int NT = j_hi - j_lo;
    const int kbn = swa_jlo(nxt.P0, W) * KVBLK;
    const int qlo = cur.P0 + wid * QBLK, qm = qlo + r32 - 4 * hi;
    char* V_lds = lds; char* K_lds = lds + 2 * SHM_V;
    float* ws = (float*)(lds + 2 * SHM_V + 2 * SHM_K) + wid * 64; float* li_l = ws, * al_l = ws + 32;
    float m_reg = -1e30f, l_reg = 0; f32x16 o[4] = {};
    const int sr = tid >> 4, sc = (tid & 15) * 8, vst0 = v_st(sr, sc), vst1 = v_st(32 + sr, sc), kws = KSWZ(sr, sc * 2);
    const int vb0 = (int)(uintptr_t)V_lds + v_rd_base(lane);
    const TIn* Kh = cur.K; const TIn* Vh = cur.V;
#define RESC(a) do { if (__any((a) < 1.f)) { if (hi == 0) al_l[r32] = (a); asm volatile("s_waitcnt lgkmcnt(0)" ::: "memory");              \
                     for (int d_ = 0; d_ < 4; ++d_) for (int r = 0; r < 16; ++r) o[d_][r] *= al_l[crow(r, hi)]; } } while (0)
#define KBASE(t) ((j_lo + (t)) * KVBLK)
#define ACT(t) (KBASE(t) <= qlo + QBLK - 1 && KBASE(t) + KVBLK - 1 >= qlo - W + 1)
#define MASKT(P0_, P1_, t) do { const int kb_ = KBASE(t); if ((!SK || ACT(t)) && (kb_ + KVBLK - 1 > qlo || kb_ <= qlo + QBLK - 1 - W)) mask_tile(P0_, P1_, qm - kb_, (unsigned)W); } while (0)
    constexpr int NQL = F32 ? 16 : 8;
    constexpr bool SK = WSKIP && !F32;
#define SEAM_K0() do { VMWN(NQL); if constexpr (F32) { SWRITE_KF(0); SBAR(); SLOAD_F((const float*)nxt.V, kbn); } else { SWRITE_HK(0); } SBAR(); } while (0)
    f32x16 pA0, pA1, pB0, pB1; float mnA, mnB, alA, alB; bf16x8 pa0, pa1, pa2, pa3;
    if constexpr (F32) { VMW(); SWRITE_VF(0); SBAR(); } else { SWRITE_HV(0); SBAR(); }
    if (NT > 1) { if constexpr (F32) SLOAD_F((const float*)Kh, KBASE(1)); else SLOAD_H(Kh, Vh, KBASE(1)); }
    SBAR(); qkt<0, SK>(pA0, pA1, K_lds, r32, hi, S.qr, ACT(0));
    if constexpr (F32) { if (NT > 1) { VMW(); SWRITE_KF(1); SBAR(); SLOAD_F((const float*)Vh, KBASE(1)); } }
    MASKT(pA0, pA1, 0); partialSM(pA0, pA1, m_reg, mnA, alA);
    if (NT > 1) { VMW(); if constexpr (F32) { SWRITE_VF(1); SBAR(); if (NT > 2) SLOAD_F((const float*)Kh, KBASE(2)); } else SWRITE_H(1); }
    __syncthreads();
#define HALF_STEP(PX0, PX1, mnX, alX, PY0, PY1, alY, t, KB, VB, SB) do {                                                      \
        SBAR(); qkt<KB, SK>(PX0, PX1, K_lds, r32, hi, S.qr, ACT(t));                                             \
        finishSM(PY0, PY1, alY, l_reg, pa0, pa1, pa2, pa3); SBAR();                                                           \
        if ((t) + 1 < NT) { if constexpr (F32) { VMW(); SWRITE_KF(SB); SBAR(); SLOAD_F((const float*)Vh, KBASE((t) + 1)); }  \
                            else { SLOAD_H(Kh, Vh, KBASE((t) + 1)); } SBAR(); }                                               \
        pv_tile<VB, SK>(o, vb0, pa0, pa1, pa2, pa3, ACT((t) - 1)); MASKT(PX0, PX1, (t)); partialSM(PX0, PX1, m_reg, mnX, alX);                                        \
        __syncthreads();                                                                                                      \
        if ((t) + 1 < NT) { VMW(); if constexpr (F32) { SWRITE_VF(SB); SBAR(); if ((t) + 2 < NT) SLOAD_F((const float*)Kh, KBASE((t) + 2)); } \
                            else { SWRITE_H(SB); } }                                                                          \
        RESC(alX); __syncthreads(); } while (0)
    for (int t = 1; t + 1 < NT; t += 2) {
        HALF_STEP(pB0, pB1, mnB, alB, pA0, pA1, alA, t, 1, 0, 0);
        HALF_STEP(pA0, pA1, mnA, alA, pB0, pB1, alB, t + 1, 0, 1, 1);
    }
    const bool even = (NT & 1) == 0;
    if (even) { SBAR(); qkt<1, SK>(pB0, pB1, K_lds, r32, hi, S.qr, ACT(NT - 1)); SBAR(); }
#define QROW(e) (nxt.Q + (size_t)(wid * QBLK + r32) * D + ((e) >> 1) * 16 + hi * 8 + ((e) & 1) * 4)
    if constexpr (F32) { SLOAD_F((const float*)nxt.K, kbn); SBAR();
#pragma unroll
        for (int e = 0; e < 8; ++e) S.tq[e] = *(const f32x4*)QROW(e); }
    else { SLOAD_H(nxt.K, nxt.V, kbn); SBAR();
#pragma unroll
        for (int d0 = 0; d0 < 8; ++d0) S.qr[d0] = load8<TIn>(nxt.Q + (size_t)(wid * QBLK + r32) * D + d0 * 16 + hi * 8); }
    SBAR();
    finishSM(pA0, pA1, alA, l_reg, pa0, pa1, pa2, pa3); SBAR();
    if constexpr (F32) {
#pragma unroll
        for (int e = 8; e < 16; ++e) S.tq[e] = *(const f32x4*)QROW(e); SBAR(); }
#undef QROW
    pv_tile<0, SK>(o, vb0, pa0, pa1, pa2, pa3, ACT(even ? NT - 2 : NT - 1));
    if (even) { MASKT(pB0, pB1, NT - 1); partialSM(pB0, pB1, m_reg, mnB, alB); __syncthreads(); RESC(alB);
        finishSM(pB0, pB1, alB, l_reg, pa0, pa1, pa2, pa3); SBAR(); pv_tile<1, SK>(o, vb0, pa0, pa1, pa2, pa3, ACT(NT - 1)); }
    SBAR(); SEAM_K0();
    if (hi == 0) { li_l[r32] = l_reg; ((float*)(lds + LSE_LDS_OFF))[wid * QBLK + r32] = m_reg * SCALE + __logf(l_reg); } asm volatile("s_waitcnt lgkmcnt(0)" ::: "memory");
    float rli[16];
#pragma unroll
    for (int r = 0; r < 16; ++r) rli[r] = __builtin_amdgcn_rcpf(li_l[crow(r, hi)]);
    TOut* Ow = cur.O + (size_t)(wid * QBLK) * D + (size_t)(hi * 4) * D + r32;
#pragma unroll
    for (int r = 0; r < 16; ++r) { const int orow = (r & 3) + 8 * (r >> 2);
#pragma unroll
        for (int d0 = 0; d0 < 4; ++d0) { const float v = o[d0][r] * rli[r];
            if constexpr (same_t<TOut, float>::v) { Ow[orow * D + d0 * 32] = v; }
            else { const float vn = __shfl_xor(v, 1);
                   if ((r32 & 1) == 0) *(unsigned*)(Ow + orow * D + d0 * 32) = cvtpk(v, vn); } } }
    if constexpr (F32) {
#pragma unroll
        for (int d0 = 0; d0 < 8; ++d0) S.qr[d0] = pack8(S.tq[2 * d0], S.tq[2 * d0 + 1]); }
    __syncthreads();
#undef RESC
#undef KBASE
#undef ACT
#undef MASKT
#undef SEAM_K0
#undef HALF_STEP
}
#undef ROW
#undef VMW
#undef VMWN
#undef SLOAD_H
#undef SWRITE_HK
#undef SWRITE_HV
#undef SWRITE_H
#undef SLOAD_F
#undef SWRITE_KF
#undef SWRITE_VF
}
constexpr int T_TOK = 32768, DMODEL = 1024, SEQ = 16384, DFF = 3584, NEXP = 8;
constexpr float ALPHA = 1.6817928305074290f, LN_EPS = 1e-5f;
constexpr int NWAVES = 8;
constexpr size_t MiB = 1u << 20;
constexpr size_t WS_CTL = 0, CTL_ZERO_BYTES = 1 * MiB;
constexpr size_t WS_WIN = 2 * MiB, WS_WRO = 26 * MiB, WS_WQKV = 34 * MiB, WS_WAO = 52 * MiB, WS_WGU = 54 * MiB, WS_WDN = 82 * MiB;
constexpr size_t WS_TAB = 96 * MiB, WS_XB = 112 * MiB, WS_LIST = 176 * MiB, WS_TSLOT = 177 * MiB, WS_GATE = 177 * MiB + 512 * 1024;
constexpr size_t WS_BIG = 178 * MiB;
constexpr size_t BIG_QD = 0, BIG_KH = 64 * MiB, BIG_VT = 128 * MiB, BIG_G = 256 * MiB, BIG_RT = 384 * MiB;
constexpr size_t BIG_HID = 0;
constexpr size_t BIG_QKV = 0, BIG_OP = 288 * MiB, BIG_LSE = 384 * MiB, BIG_O = 386 * MiB;
constexpr size_t BIG_YP = 462 * MiB, BIG_WMGU = 594 * MiB, BIG_WMD = 706 * MiB;
constexpr size_t WS_END = WS_BIG + 762 * MiB;
constexpr int CW_TMO = 0, CW_BAR = 4096, CW_CNT = 8192;
constexpr int RING_OFF = 0, RING_BYTES = 131072, AUX_OFF = 131072, AUX_BYTES = 30720, MISC_OFF = AUX_OFF + AUX_BYTES, LDS_BYTES = MISC_OFF + 512;
static_assert(LDS_BYTES <= 163840, "LDS");

#define GAS __attribute__((address_space(1)))
#define LAS __attribute__((address_space(3)))
typedef unsigned short bf16;
typedef unsigned v4u __attribute__((ext_vector_type(4)));
typedef unsigned v2u __attribute__((ext_vector_type(2)));
typedef float f32x4 __attribute__((ext_vector_type(4)));
typedef float f32x16 __attribute__((ext_vector_type(16)));
typedef short bf16x8 __attribute__((ext_vector_type(8)));
typedef short s16x4 __attribute__((ext_vector_type(4)));
typedef GAS unsigned gu32;
#define RLX_AGENT __ATOMIC_RELAXED, __HIP_MEMORY_SCOPE_AGENT
#define LDS_WAIT() asm volatile("s_waitcnt lgkmcnt(0)" ::: "memory")
#define VM_WAIT() asm volatile("s_waitcnt vmcnt(0)" ::: "memory")
__device__ __forceinline__ unsigned f2bf(float f) { unsigned u = __builtin_bit_cast(unsigned, f); return (u + 0x7fffu + ((u >> 16) & 1u)) >> 16; }
__device__ __forceinline__ unsigned pk2(float lo, float hi) { return f2bf(lo) | (f2bf(hi) << 16); }
__device__ __forceinline__ float bflo(unsigned w) { return __builtin_bit_cast(float, w << 16); }
__device__ __forceinline__ float bfhi(unsigned w) { return __builtin_bit_cast(float, w & 0xffff0000u); }
#define XB_TMO      128
#define XB_XCNT(j)  (256  + 64 * (j))
#define XB_XSUB(j)  (1280 + 64 * (j))
#define XB_XGEN(j)  (2304 + 64 * (j))
#define XB_TOP      3328
#define XB_TOPGEN   3392
#define XCD_BAR_WORDS 3456
#define XB_SPIN_CAP (1u << 18)

__device__ __forceinline__ unsigned xb_ld(unsigned* p)              { return __hip_atomic_load(p, __ATOMIC_RELAXED, __HIP_MEMORY_SCOPE_AGENT); }
__device__ __forceinline__ unsigned xb_add(unsigned* p, unsigned v) { return __hip_atomic_fetch_add(p, v, __ATOMIC_RELAXED, __HIP_MEMORY_SCOPE_AGENT); }
__device__ __forceinline__ unsigned xb_xcc_id() { return (unsigned)__builtin_amdgcn_s_getreg((3 << 11) | 20) & 0xFu; }
#define XB_SPIN(cond, bar) do { unsigned _sp = 0; while (cond) { __builtin_amdgcn_s_sleep(1); \
    if ((++_sp & 255u) == 0u) { if (xb_ld(&(bar)[XB_TMO])) break; if (_sp > XB_SPIN_CAP) { atomicAdd(&(bar)[XB_TMO], 1u); break; } } } } while (0)

struct XcdBarrier {
    unsigned* bar; unsigned x;
    volatile LAS unsigned* st;
};

__device__ __forceinline__ XcdBarrier xcd_barrier_post(unsigned* bar, volatile LAS unsigned* st) {
    XcdBarrier b; b.bar = bar; b.x = xb_xcc_id(); b.st = st;
    if (threadIdx.x == 0) (void)xb_add(&bar[XB_XCNT(b.x)], 1u);
    return b;
}
__device__ __forceinline__ void xcd_barrier_complete(unsigned* bar, unsigned x, unsigned& nloc, unsigned& nx) {
    const unsigned G = gridDim.x * gridDim.y * gridDim.z;
    unsigned sum, cnt, mine, sp = 0u;
    for (;;) {
        sum = 0u; cnt = 0u; mine = 0u;
#pragma unroll
        for (unsigned j = 0; j < 16; ++j) { const unsigned c = xb_ld(&bar[XB_XCNT(j)]); sum += c; cnt += (c > 0u) ? 1u : 0u; mine = (j == x) ? c : mine; }
        if (sum == G) break;
        __builtin_amdgcn_s_sleep(1);
        if ((++sp & 255u) == 0u) { if (xb_ld(&bar[XB_TMO])) break; if (sp > XB_SPIN_CAP) { atomicAdd(&bar[XB_TMO], 1u); break; } }
    }
    nloc = mine > 0u ? mine : 1u; nx = cnt > 0u ? cnt : 1u;
}

__device__ __forceinline__ void xcd_barrier(const XcdBarrier& b) {
    asm volatile("s_waitcnt vmcnt(0)" ::: "memory");
    __syncthreads();
    if (threadIdx.x == 0) {
        unsigned* bar = b.bar;
        __builtin_amdgcn_s_waitcnt(0);
        unsigned nloc = b.st[0], nx = b.st[1];
        if (nloc == 0u) { xcd_barrier_complete(bar, b.x, nloc, nx); b.st[0] = nloc; b.st[1] = nx; }
        const unsigned old = xb_add(&bar[XB_XSUB(b.x)], 1u);
        const unsigned gen = old / nloc;
        if (old + 1u == (gen + 1u) * nloc) {
            __builtin_amdgcn_fence(__ATOMIC_RELEASE, "agent");
            asm volatile("s_waitcnt vmcnt(0)" ::: "memory");
            const unsigned og = xb_add(&bar[XB_TOP], 1u);
            const unsigned tg = og / nx;
            if (og + 1u == (tg + 1u) * nx) xb_add(&bar[XB_TOPGEN], 1u);
            else XB_SPIN(xb_ld(&bar[XB_TOPGEN]) == tg, bar);
            __builtin_amdgcn_fence(__ATOMIC_ACQUIRE, "agent");
            xb_add(&bar[XB_XGEN(b.x)], 1u);
            asm volatile("s_waitcnt vmcnt(0)" ::: "memory");
        } else {
            XB_SPIN(xb_ld(&bar[XB_XGEN(b.x)]) == gen, bar);
            __builtin_amdgcn_fence(__ATOMIC_ACQUIRE, "agent");
            asm volatile("s_waitcnt vmcnt(0)" ::: "memory");
        }
    }
    __syncthreads();
}
struct Args { const float* in[15]; float* out; unsigned char* ws; };
struct Frame {
    LAS unsigned char* lds;
    volatile LAS unsigned* MISC;
    int tid, lane, wave, G, c;
};
__device__ __forceinline__ unsigned long long arg_u64(const Frame& F, int k) { const unsigned long long v = ((const LAS unsigned long long*)(F.lds + MISC_OFF + 128))[k];
    return ((unsigned long long)(unsigned)__builtin_amdgcn_readfirstlane((int)(unsigned)(v >> 32)) << 32) | (unsigned long long)(unsigned)__builtin_amdgcn_readfirstlane((int)(unsigned)v); }
#define ARGI(F, k) ((const float*)(const GAS float*)arg_u64(F, (k)))
#define ARGX(F) ((float*)(GAS float*)arg_u64(F, 15))
#define ARGWS(F) ((unsigned char*)(GAS unsigned char*)arg_u64(F, 16))
#define F_CTL(F) ((gu32*)(ARGWS(F) + WS_CTL))
__device__ __forceinline__ void frame_refresh(Frame& F) { int t = F.tid; asm volatile("" : "+v"(t)); F.tid = t; F.lane = t & 63; F.wave = __builtin_amdgcn_readfirstlane(t >> 6); unsigned l = (unsigned)(uintptr_t)F.lds; int c_ = F.c, g_ = F.G; asm volatile("" : "+s"(l), "+s"(c_), "+s"(g_)); F.lds = (LAS unsigned char*)(uintptr_t)l; F.c = c_; F.G = g_; }
__device__ __forceinline__ float wave_sum(float v) {
#pragma unroll
    for (int o = 1; o < 64; o <<= 1) v += __shfl_xor(v, o);
    return v;
}
__device__ __forceinline__ s16x4 vtr(const LAS unsigned char* p) { return __builtin_bit_cast(s16x4, __builtin_amdgcn_ds_read_tr16_b64_v4i16((LAS s16x4*)p)); }
__device__ __forceinline__ int crow(int r, int hi) { return (r & 3) + 8 * (r >> 2) + 4 * hi; }

__device__ __forceinline__ void tr_item(const float* W, int K, int N, bf16* WT, int k0, int n0, int drow0, LAS float* scr, int lane) {
#pragma unroll 8
    for (int i = 0; i < 32; ++i) { const int kk = 2 * i + (lane >> 5); scr[kk * 33 + (lane & 31)] = W[(size_t)(k0 + kk) * N + n0 + (lane & 31)]; }
    LDS_WAIT(); asm volatile("" ::: "memory");
    const int c = lane & 7;
#pragma unroll
    for (int j = 0; j < 4; ++j) { const int n = (lane >> 3) + 8 * j; const LAS float* s = scr + (8 * c) * 33 + n;
        v4u o; o.x = pk2(s[0 * 33], s[1 * 33]); o.y = pk2(s[2 * 33], s[3 * 33]); o.z = pk2(s[4 * 33], s[5 * 33]); o.w = pk2(s[6 * 33], s[7 * 33]);
        *(GAS v4u*)(WT + (size_t)(drow0 + n) * K + k0 + 8 * c) = o; }
    LDS_WAIT(); asm volatile("" ::: "memory");
}
template <int MAP> __device__ __forceinline__ void tr_matrix_item(const float* W, int K, int N, bf16* WT, int item, LAS float* scr, int lane) {
    const int nblk = N / 32, kb = item / nblk, nb = item - kb * nblk, n0 = 32 * nb; int dr = n0;
    if (MAP == 1) dr = n0 < 2048 ? n0 : (n0 < 4096 ? n0 + 2048 : n0 - 2048);
    if (MAP == 2) dr = (n0 >> 7) * 256 + (n0 & 127);
    if (MAP == 3) dr = (n0 >> 7) * 256 + 128 + (n0 & 127);
    tr_item(W, K, N, WT, 64 * kb, n0, dr, scr, lane);
}
__device__ __forceinline__ void p0_prologue(Frame& F) {
    LAS float* scr = (LAS float*)(F.lds + RING_OFF + F.wave * 16384);
    const int gw = F.c * NWAVES + F.wave, NGW = F.G * NWAVES;
    constexpr int I_WIN = 16 * 192, I_WRO = 32 * 32, I_QKV = 16 * 144, I_WAO = 8 * 32, I_GU = 16 * 112, I_DN = 56 * 32;
    constexpr int PERJ = I_WIN + I_WRO + I_QKV + I_WAO + 2 * I_GU + I_DN;
    for (int it = gw; it < 2 * PERJ; it += NGW) {
        const int j = it / PERJ; int r = it - j * PERJ;
        if (r < I_WIN) { tr_matrix_item<1>(ARGI(F, 3) + (size_t)j * 1024 * 6144, 1024, 6144, (bf16*)(ARGWS(F) + WS_WIN) + (size_t)j * 6144 * 1024, r, scr, F.lane); continue; } r -= I_WIN;
        if (r < I_WRO) { tr_matrix_item<0>(ARGI(F, 5) + (size_t)j * 2048 * 1024, 2048, 1024, (bf16*)(ARGWS(F) + WS_WRO) + (size_t)j * 1024 * 2048, r, scr, F.lane); continue; } r -= I_WRO;
        if (r < I_QKV) { tr_matrix_item<0>(ARGI(F, 6) + (size_t)j * 1024 * 4608, 1024, 4608, (bf16*)(ARGWS(F) + WS_WQKV) + (size_t)j * 4608 * 1024, r, scr, F.lane); continue; } r -= I_QKV;
        if (r < I_WAO) { tr_matrix_item<0>(ARGI(F, 7) + (size_t)j * 512 * 1024, 512, 1024, (bf16*)(ARGWS(F) + WS_WAO) + (size_t)j * 1024 * 512, r, scr, F.lane); continue; } r -= I_WAO;
        if (r < I_GU) { tr_matrix_item<2>(ARGI(F, 8) + (size_t)j * 1024 * 3584, 1024, 3584, (bf16*)(ARGWS(F) + WS_WGU) + (size_t)j * 7168 * 1024, r, scr, F.lane); continue; } r -= I_GU;
        if (r < I_GU) { tr_matrix_item<3>(ARGI(F, 9) + (size_t)j * 1024 * 3584, 1024, 3584, (bf16*)(ARGWS(F) + WS_WGU) + (size_t)j * 7168 * 1024, r, scr, F.lane); continue; } r -= I_GU;
        tr_matrix_item<0>(ARGI(F, 10) + (size_t)j * 3584 * 1024, 3584, 1024, (bf16*)(ARGWS(F) + WS_WDN) + (size_t)j * 1024 * 3584, r, scr, F.lane);
    }
    { float* tab = (float*)(ARGWS(F) + WS_TAB); const int gt = F.c * 512 + F.tid, NT = F.G * 512;
      for (int e = gt; e < SEQ * 128; e += NT) { const int pos = e >> 7, cc = e & 127;
          const double ang = (double)pos * exp(-9.210340371976184 * (double)cc * (1.0 / 128.0)); double sn, cs; sincos(ang, &sn, &cs);
          typedef float f32x2t __attribute__((ext_vector_type(2))); *(GAS f32x2t*)(tab + (size_t)e * 2) = (f32x2t){(float)cs, (float)sn}; } }
    { const float* x = ARGI(F, 0); bf16* XB = (bf16*)(ARGWS(F) + WS_XB);
      for (int m = gw; m < T_TOK; m += NGW) { const GAS f32x4* xr = (const GAS f32x4*)(x + (size_t)m * DMODEL) + F.lane; GAS f32x4* xo = (GAS f32x4*)(ARGX(F) + (size_t)m * DMODEL) + F.lane;
          GAS unsigned long long* o8 = (GAS unsigned long long*)(XB + (size_t)m * DMODEL) + F.lane;
#pragma unroll
          for (int jj = 0; jj < 4; ++jj) { const f32x4 v = xr[64 * jj]; xo[64 * jj] = v * ALPHA; o8[64 * jj] = (unsigned long long)pk2(v.x, v.y) | ((unsigned long long)pk2(v.z, v.w) << 32); } } }
}
__device__ __forceinline__ void moe_convert(Frame& F, int j) {
    LAS float* scr = (LAS float*)(F.lds + RING_OFF + F.wave * 16384);
    const int gw = F.c * NWAVES + F.wave, NGW = F.G * NWAVES;
    constexpr int I_GU = 16 * 112, I_DN = 56 * 32, PERE = 2 * I_GU + I_DN;
    bf16* WMGU = (bf16*)(ARGWS(F) + WS_BIG + BIG_WMGU); bf16* WMD = (bf16*)(ARGWS(F) + WS_BIG + BIG_WMD);
    for (int it = gw; it < NEXP * PERE; it += NGW) {
        const int e = it / PERE; int r = it - e * PERE; const size_t wofs = ((size_t)j * NEXP + e) * 1024 * 3584;
        if (r < I_GU) { tr_matrix_item<2>(ARGI(F, 12) + wofs, 1024, 3584, WMGU + (size_t)e * 7168 * 1024, r, scr, F.lane); continue; } r -= I_GU;
        if (r < I_GU) { tr_matrix_item<3>(ARGI(F, 13) + wofs, 1024, 3584, WMGU + (size_t)e * 7168 * 1024, r, scr, F.lane); continue; } r -= I_GU;
        tr_matrix_item<0>(ARGI(F, 14) + wofs, 3584, 1024, WMD + (size_t)e * 1024 * 3584, r, scr, F.lane);
    }
}
template <int MODE, bool FINAL> __device__ __forceinline__ void ln_pass(Frame& F, int li  , int sub  , int j) {
    const int gw = F.c * NWAVES + F.wave, NGW = F.G * NWAVES;
    const float* gain = ARGI(F, 1) + (size_t)(li * 2 + sub) * DMODEL; const float* bias = ARGI(F, 2) + (size_t)(li * 2 + sub) * DMODEL;
    f32x4 gv[4], bv[4];
#pragma unroll
    for (int jj = 0; jj < 4; ++jj) { gv[jj] = ((const GAS f32x4*)gain)[F.lane + 64 * jj]; bv[jj] = ((const GAS f32x4*)bias)[F.lane + 64 * jj]; }
    bf16* XB = (bf16*)(ARGWS(F) + WS_XB);
    int rtb[8];
    if (MODE == 2) { int acc = 0;
#pragma unroll
        for (int e = 0; e < 8; ++e) { rtb[e] = acc; const int cnt = (int)__hip_atomic_load(F_CTL(F) + CW_CNT + (j * 8 + e) * 64, RLX_AGENT); acc += (cnt + 255) >> 8; } }
    const unsigned* tslot = (const unsigned*)(ARGWS(F) + WS_TSLOT); const float* gate = (const float*)(ARGWS(F) + WS_GATE); const bf16* YP = (const bf16*)(ARGWS(F) + WS_BIG + BIG_YP);
    for (int m = gw; m < T_TOK; m += NGW) {
        GAS f32x4* xr = (GAS f32x4*)(ARGX(F) + (size_t)m * DMODEL) + F.lane;
        f32x4 v[4]; float s = 0.f;
#pragma unroll
        for (int jj = 0; jj < 4; ++jj) v[jj] = xr[64 * jj];
        if (MODE == 2) {
#pragma unroll
            for (int k = 0; k < 2; ++k) { const unsigned ts = tslot[2 * m + k]; const float gk = gate[2 * m + k]; const int e = (int)(ts >> 20), slot = (int)(ts & 0xfffffu);
                int rb = 0;
#pragma unroll
                for (int q = 0; q < 8; ++q) rb = (q == e) ? rtb[q] : rb;
                const GAS v2u* yr = (const GAS v2u*)(YP + ((size_t)rb * 256 + slot) * DMODEL) + F.lane;
#pragma unroll
                for (int jj = 0; jj < 4; ++jj) { const v2u w = yr[64 * jj]; v[jj].x += gk * bflo(w.x); v[jj].y += gk * bfhi(w.x); v[jj].z += gk * bflo(w.y); v[jj].w += gk * bfhi(w.y); } }
        }
#pragma unroll
        for (int jj = 0; jj < 4; ++jj) s += (v[jj].x + v[jj].y) + (v[jj].z + v[jj].w);
        const float mean = wave_sum(s) * (1.f / DMODEL); float s2 = 0.f;
#pragma unroll
        for (int jj = 0; jj < 4; ++jj) { v[jj] = v[jj] - mean; s2 += (v[jj].x * v[jj].x + v[jj].y * v[jj].y) + (v[jj].z * v[jj].z + v[jj].w * v[jj].w); }
        const float rstd = 1.f / sqrtf(wave_sum(s2) * (1.f / DMODEL) + LN_EPS);
        GAS unsigned long long* o8 = (GAS unsigned long long*)(XB + (size_t)m * DMODEL) + F.lane;
#pragma unroll
        for (int jj = 0; jj < 4; ++jj) { const f32x4 o = v[jj] * rstd * gv[jj] + bv[jj];
            xr[64 * jj] = FINAL ? o : o * ALPHA;
            if (!FINAL) o8[64 * jj] = (unsigned long long)pk2(o.x, o.y) | ((unsigned long long)pk2(o.z, o.w) << 32); }
    }
}
__device__ __forceinline__ void ln_route_pass(Frame& F, int li, int j) {
    const float* gain = ARGI(F, 1) + (size_t)(li * 2) * DMODEL; const float* bias = ARGI(F, 2) + (size_t)(li * 2) * DMODEL;
    LAS float* WRT = (LAS float*)(F.lds + RING_OFF);
    LAS float* SELG = (LAS float*)(F.lds + RING_OFF + 32768);
    LAS int* SELE = (LAS int*)(F.lds + RING_OFF + 32768 + 1024);
    LAS int* LCNT = (LAS int*)(F.lds + RING_OFF + 32768 + 2048);
    const float* wr = ARGI(F, 11) + (size_t)j * DMODEL * NEXP;
    for (int i = F.tid; i < DMODEL * NEXP; i += 512) { const int d = i >> 3, e = i & 7; WRT[e * DMODEL + d] = wr[i]; }
    if (F.tid < 16) LCNT[F.tid] = 0;
    f32x4 gv[4], bv[4];
#pragma unroll
    for (int jj = 0; jj < 4; ++jj) { gv[jj] = ((const GAS f32x4*)gain)[F.lane + 64 * jj]; bv[jj] = ((const GAS f32x4*)bias)[F.lane + 64 * jj]; }
    bf16* XB = (bf16*)(ARGWS(F) + WS_XB);
    __syncthreads();
    const int ntok = T_TOK / F.G, tok0 = F.c * ntok;
    for (int tl = F.wave; tl < ntok; tl += NWAVES) { const int m = tok0 + tl;
        GAS f32x4* xr = (GAS f32x4*)(ARGX(F) + (size_t)m * DMODEL) + F.lane;
        f32x4 v[4]; float s = 0.f;
#pragma unroll
        for (int jj = 0; jj < 4; ++jj) { v[jj] = xr[64 * jj]; s += (v[jj].x + v[jj].y) + (v[jj].z + v[jj].w); }
        const float mean = wave_sum(s) * (1.f / DMODEL); float s2 = 0.f;
#pragma unroll
        for (int jj = 0; jj < 4; ++jj) { v[jj] = v[jj] - mean; s2 += (v[jj].x * v[jj].x + v[jj].y * v[jj].y) + (v[jj].z * v[jj].z + v[jj].w * v[jj].w); }
        const float rstd = 1.f / sqrtf(wave_sum(s2) * (1.f / DMODEL) + LN_EPS);
        GAS unsigned long long* o8 = (GAS unsigned long long*)(XB + (size_t)m * DMODEL) + F.lane;
        float lg[8];
#pragma unroll
        for (int e = 0; e < 8; ++e) lg[e] = 0.f;
#pragma unroll
        for (int jj = 0; jj < 4; ++jj) { const f32x4 o = v[jj] * rstd * gv[jj] + bv[jj]; v[jj] = o;
            xr[64 * jj] = o * ALPHA; o8[64 * jj] = (unsigned long long)pk2(o.x, o.y) | ((unsigned long long)pk2(o.z, o.w) << 32);
#pragma unroll
            for (int e = 0; e < 8; ++e) { const f32x4 w = *(const LAS f32x4*)(WRT + e * DMODEL + 4 * F.lane + 256 * jj); lg[e] += (o.x * w.x + o.y * w.y) + (o.z * w.z + o.w * w.w); } }
#pragma unroll
        for (int e = 0; e < 8; ++e) lg[e] = wave_sum(lg[e]);
        int e1 = 0; float v1 = lg[0];
#pragma unroll
        for (int e = 1; e < 8; ++e) if (lg[e] > v1) { v1 = lg[e]; e1 = e; }
        int e2 = -1; float v2 = -3.0e38f;
#pragma unroll
        for (int e = 0; e < 8; ++e) if (e != e1 && lg[e] > v2) { v2 = lg[e]; e2 = e; }
        const float g1 = 1.f / (1.f + __expf(v2 - v1)), g2 = 1.f - g1;
        if (F.lane == 0) { SELE[2 * tl] = e1; SELE[2 * tl + 1] = e2; SELG[2 * tl] = g1; SELG[2 * tl + 1] = g2; }
    }
    __syncthreads();
    int myrank = 0, mye = 0;
    if (F.tid < 2 * ntok) { mye = SELE[F.tid]; myrank = __hip_atomic_fetch_add(LCNT + mye, 1, __ATOMIC_RELAXED, __HIP_MEMORY_SCOPE_WORKGROUP); }
    __syncthreads();
    if (F.tid < 8) LCNT[8 + F.tid] = (int)__hip_atomic_fetch_add(F_CTL(F) + CW_CNT + (j * 8 + F.tid) * 64, (unsigned)LCNT[F.tid], RLX_AGENT);
    __syncthreads();
    if (F.tid < 2 * ntok) { const int slot = LCNT[8 + mye] + myrank; const int tok = tok0 + (F.tid >> 1);
        ((int*)(ARGWS(F) + WS_LIST))[mye * T_TOK + slot] = tok;
        ((unsigned*)(ARGWS(F) + WS_TSLOT))[2 * tok + (F.tid & 1)] = ((unsigned)mye << 20) | (unsigned)slot;
        ((float*)(ARGWS(F) + WS_GATE))[2 * tok + (F.tid & 1)] = SELG[F.tid]; }
    __syncthreads();
}
__device__ __forceinline__ int off64(int row, int colbyte) { return row * 128 + (colbyte ^ ((((row >> 1) & 1) << 6) | (((row >> 3) & 1) << 5))); }
__device__ __forceinline__ float log2_gamma(int h) { return __builtin_amdgcn_logf(1.0f - __builtin_amdgcn_exp2f((float)(-5 - h))); }

__device__ __forceinline__ void ret_state_phase(Frame& F) {
    const int c = F.c; if (c >= 256) return;
    const int dt = c & 3, et = (c >> 2) & 7, h = (c >> 5) & 3, b = c >> 7;
    const int w = F.wave, lane = F.lane, dq = w & 3, eh = w >> 2, g = lane >> 4, l15 = lane & 15, q = l15 >> 2, p = l15 & 3;
    const bf16* KH = (const bf16*)(ARGWS(F) + WS_BIG + BIG_KH) + (size_t)b * SEQ * 1024 + h * 256 + dt * 64;
    const bf16* VT = (const bf16*)(ARGWS(F) + WS_BIG + BIG_VT) + ((size_t)((b * 4 + h) * 128) << 16);
    bf16* RT = (bf16*)(ARGWS(F) + WS_BIG + BIG_RT) + ((size_t)((b * 4 + h) * 128) << 17);
    const float dec = __builtin_amdgcn_exp2f(128.f * log2_gamma(h));
    const int r0 = F.tid >> 3, ch = F.tid & 7;
    const bf16* kp0 = KH + (size_t)r0 * 1024 + ch * 8; const bf16* kp1 = kp0 + (size_t)64 * 1024;
    const int lo0 = off64(r0, ch * 16), lo1 = off64(r0 + 64, ch * 16);
    int voff[4][2];
#pragma unroll
    for (int ks = 0; ks < 4; ++ks)
#pragma unroll
        for (int x = 0; x < 2; ++x) { const int e = 64 * et + 16 * (2 * eh + x) + l15, oct = 4 * ks + g; voff[ks][x] = ((((e >> 5) * 8 + (oct >> 1)) * 2 + (oct & 1)) * 32 + (e & 31)) * 8; }
    int roff[2];
#pragma unroll
    for (int x = 0; x < 2; ++x) { const int e = 64 * et + 16 * (2 * eh + x) + l15, d = 64 * dt + 16 * dq + 4 * g; roff[x] = ((((e >> 5) * 16 + (d >> 4)) * 2 + ((d >> 3) & 1)) * 32 + (e & 31)) * 8 + (d & 7); }
    float z0 = 0.f; asm volatile("" : "+v"(z0));
    f32x4 acc[2] = {(f32x4){z0, z0, z0, z0}, (f32x4){z0, z0, z0, z0}};
    v4u k0 = *(const GAS v4u*)kp0, k1 = *(const GAS v4u*)kp1;
    bf16x8 vf[4][2];
#pragma unroll
    for (int ks = 0; ks < 4; ++ks)
#pragma unroll
        for (int x = 0; x < 2; ++x) vf[ks][x] = *(const GAS bf16x8*)(VT + voff[ks][x]);
    for (int n = 0; n < 128; ++n) {
        LAS unsigned char* buf = F.lds + RING_OFF + (n & 1) * 16384;
        *(LAS v4u*)(buf + lo0) = k0; *(LAS v4u*)(buf + lo1) = k1;
        bf16x8 vn[4][2];
        if (n + 1 < 128) { k0 = *(const GAS v4u*)(kp0 + (size_t)(n + 1) * 128 * 1024); k1 = *(const GAS v4u*)(kp1 + (size_t)(n + 1) * 128 * 1024);
#pragma unroll
            for (int ks = 0; ks < 4; ++ks)
#pragma unroll
                for (int x = 0; x < 2; ++x) vn[ks][x] = *(const GAS bf16x8*)(VT + ((size_t)(n + 1) << 16) + voff[ks][x]); }
        else {
#pragma unroll
            for (int ks = 0; ks < 4; ++ks)
#pragma unroll
                for (int x = 0; x < 2; ++x) vn[ks][x] = vf[ks][x]; }
        __syncthreads();
        if (n > 0) {
#pragma unroll
            for (int x = 0; x < 2; ++x) { v2u o; o.x = pk2(acc[x][0], acc[x][1]); o.y = pk2(acc[x][2], acc[x][3]); *(GAS v2u*)(RT + ((size_t)n << 17) + roff[x]) = o; } }
#pragma unroll
        for (int ks = 0; ks < 4; ++ks) {
            const s16x4 t0 = vtr(buf + off64(32 * ks + 8 * g + q, 32 * dq + 8 * p)), t1 = vtr(buf + off64(32 * ks + 8 * g + 4 + q, 32 * dq + 8 * p));
            const bf16x8 a = (bf16x8){t0[0], t0[1], t0[2], t0[3], t1[0], t1[1], t1[2], t1[3]};
#pragma unroll
            for (int x = 0; x < 2; ++x) acc[x] = __builtin_amdgcn_mfma_f32_16x16x32_bf16(a, vf[ks][x], acc[x], 0, 0, 0);
        }
#pragma unroll
        for (int x = 0; x < 2; ++x) acc[x] = acc[x] * dec;
#pragma unroll
        for (int ks = 0; ks < 4; ++ks)
#pragma unroll
            for (int x = 0; x < 2; ++x) vf[ks][x] = vn[ks][x];
    }
    __syncthreads();
}

__device__ __forceinline__ void ret_out_phase(Frame& F, int j) {
    const int w = F.wave, lane = F.lane, r32 = lane & 31, hi = lane >> 5, tid = F.tid;
    LAS unsigned char* QDI = F.lds + RING_OFF;
    LAS unsigned char* KHI = F.lds + RING_OFF + 65536;
    LAS unsigned char* PI = KHI;
    LAS float* STAT = (LAS float*)(F.lds + AUX_OFF);
    LAS unsigned char* YST = F.lds + RING_OFF;
    const bf16* QD = (const bf16*)(ARGWS(F) + WS_BIG + BIG_QD); const bf16* KH = (const bf16*)(ARGWS(F) + WS_BIG + BIG_KH);
    const bf16* VT = (const bf16*)(ARGWS(F) + WS_BIG + BIG_VT); const bf16* RT = (const bf16*)(ARGWS(F) + WS_BIG + BIG_RT);
    bf16* GY = (bf16*)(ARGWS(F) + WS_BIG + BIG_G);
    const float* gn = ARGI(F, 4) + (size_t)j * 2048;
    const int ib = w & 3, jb0 = 2 * (w >> 2), jb1 = jb0 + 1;
    for (int U = F.c; U < 1024; U += F.G) {
        const int n = U & 127, h = (U >> 7) & 3, b = U >> 9;
        const size_t tok0 = (size_t)b * SEQ + (size_t)n * 128;
        { int tid1 = tid; asm volatile("" : "+v"(tid1)); v4u qv[8], kv[8];
#pragma unroll
          for (int k = 0; k < 8; ++k) { const int x = tid1 + 512 * k, row = x >> 5, chk = x & 31; const size_t go = (tok0 + row) * 1024 + h * 256 + chk * 8;
              qv[k] = *(const GAS v4u*)(QD + go); kv[k] = *(const GAS v4u*)(KH + go); }
#pragma unroll
          for (int k = 0; k < 8; ++k) { const int x = tid1 + 512 * k, row = x >> 5, chk = x & 31; const int lo = row * 512 + ((chk * 16) ^ ((row & 7) << 4));
              *(LAS v4u*)(QDI + lo) = qv[k]; *(LAS v4u*)(KHI + lo) = kv[k]; } }
        __syncthreads();
        f32x16 s0 = {}, s1 = {};
        { const int qrow = 32 * ib + r32, k0row = 32 * jb0 + r32, k1row = 32 * jb1 + r32;
          if (jb0 <= ib) {
#pragma unroll
            for (int ks = 0; ks < 16; ++ks) { const int cb = (16 * ks + 8 * hi) * 2;
                const bf16x8 qf = *(const LAS bf16x8*)(QDI + qrow * 512 + (cb ^ ((qrow & 7) << 4)));
                const bf16x8 kf0 = *(const LAS bf16x8*)(KHI + k0row * 512 + (cb ^ ((k0row & 7) << 4)));
                s0 = __builtin_amdgcn_mfma_f32_32x32x16_bf16(kf0, qf, s0, 0, 0, 0);
                if (jb1 <= ib) { const bf16x8 kf1 = *(const LAS bf16x8*)(KHI + k1row * 512 + (cb ^ ((k1row & 7) << 4))); s1 = __builtin_amdgcn_mfma_f32_32x32x16_bf16(kf1, qf, s1, 0, 0, 0); } } } }
        __syncthreads();
        { int r32p = r32, hip = hi; asm volatile("" : "+v"(r32p), "+v"(hip)); const int i = 32 * ib + r32p;
#pragma unroll
          for (int qq = 0; qq < 4; ++qq) {
              const int j0 = 32 * jb0 + 8 * qq + 4 * hip, j1 = j0 + 32;
              float a0 = s0[4 * qq], a1 = s0[4 * qq + 1], a2 = s0[4 * qq + 2], a3 = s0[4 * qq + 3];
              float c0 = s1[4 * qq], c1 = s1[4 * qq + 1], c2 = s1[4 * qq + 2], c3 = s1[4 * qq + 3];
              if (j0 + 0 > i) a0 = 0.f; if (j0 + 1 > i) a1 = 0.f; if (j0 + 2 > i) a2 = 0.f; if (j0 + 3 > i) a3 = 0.f;
              if (j1 + 0 > i) c0 = 0.f; if (j1 + 1 > i) c1 = 0.f; if (j1 + 2 > i) c2 = 0.f; if (j1 + 3 > i) c3 = 0.f;
              v2u o; o.x = pk2(a0, a1); o.y = pk2(a2, a3); *(LAS v2u*)(PI + i * 256 + ((j0 * 2) ^ ((i & 7) << 4))) = o;
              v2u o2; o2.x = pk2(c0, c1); o2.y = pk2(c2, c3); *(LAS v2u*)(PI + i * 256 + ((j1 * 2) ^ ((i & 7) << 4))) = o2; } }
        __syncthreads();
        f32x16 acc[4][2];
#pragma unroll
        for (int rb = 0; rb < 4; ++rb) { acc[rb][0] = (f32x16){}; acc[rb][1] = (f32x16){}; }
        { const int nsteps = n > 0 ? 24 : 8;
          const bf16* vt = VT + ((size_t)((b * 4 + h) * 128 + n) << 16) + (size_t)(((2 * w) * 8 * 2 + hi) * 32 + r32) * 8;
          const bf16* rt = RT + ((size_t)((b * 4 + h) * 128 + n) << 17) + (size_t)(((2 * w) * 16 * 2 + hi) * 32 + r32) * 8;
          const int xr = (r32 & 7) << 4, rowp = r32 * 256;
#define R2B_LOAD(dst, sidx) do { int sp_ = (sidx); sp_ = sp_ < nsteps ? sp_ : nsteps - 1; const bf16* p_ = sp_ < 8 ? vt + sp_ * 512 : rt + (sp_ - 8) * 512; const int o1_ = sp_ < 8 ? 4096 : 8192; \
              dst[0] = *(const GAS bf16x8*)p_; dst[1] = *(const GAS bf16x8*)(p_ + o1_); } while (0)
          bf16x8 Bq[3][2];
          R2B_LOAD(Bq[0], 0); R2B_LOAD(Bq[1], 1);
          for (int s3 = 0; s3 < nsteps; s3 += 3) {
#pragma unroll
              for (int uu = 0; uu < 3; ++uu) { const int st = s3 + uu;
                  R2B_LOAD(Bq[(uu + 2) % 3], st + 2);
                  if (st < nsteps) { const bool pv = st < 8; const int ks = pv ? st : st - 8, cb = ((32 * ks + 16 * hi) ^ xr) + (pv ? 65536 : 0), sh = pv ? 0 : 1;
#pragma unroll
                      for (int rb = 0; rb < 4; ++rb) if (!pv || st <= 2 * rb + 1) {
                          const bf16x8 af = *(const LAS bf16x8*)(QDI + (((32 * 256) * rb + rowp) << sh) + cb);
                          acc[rb][0] = __builtin_amdgcn_mfma_f32_32x32x16_bf16(Bq[uu][0], af, acc[rb][0], 0, 0, 0);
                          acc[rb][1] = __builtin_amdgcn_mfma_f32_32x32x16_bf16(Bq[uu][1], af, acc[rb][1], 0, 0, 0); } } } }
#undef R2B_LOAD
        }
#pragma unroll
        for (int rb = 0; rb < 4; ++rb) { float s = 0.f, qs = 0.f;
#pragma unroll
            for (int et = 0; et < 2; ++et)
#pragma unroll
                for (int r = 0; r < 16; ++r) { const float v = acc[rb][et][r]; s += v; qs += v * v; }
            s += __shfl_xor(s, 32); qs += __shfl_xor(qs, 32);
            if (hi == 0) { STAT[((32 * rb + r32) * 8 + w) * 2] = s; STAT[((32 * rb + r32) * 8 + w) * 2 + 1] = qs; } }
        __syncthreads();
        int r32b = r32, hib = hi; asm volatile("" : "+v"(r32b), "+v"(hib));
#pragma unroll
        for (int rb = 0; rb < 4; ++rb) { const int i = 32 * rb + r32b; float s = 0.f, qs = 0.f;
#pragma unroll
            for (int ww = 0; ww < 8; ++ww) { s += STAT[(i * 8 + ww) * 2]; qs += STAT[(i * 8 + ww) * 2 + 1]; }
            const float mean = s * (1.f / 512.f), var = qs * (1.f / 512.f) - mean * mean, rstd = 1.f / sqrtf(fmaxf(var, 0.f) + LN_EPS);
#pragma unroll
            for (int et = 0; et < 2; ++et)
#pragma unroll
                for (int qq = 0; qq < 4; ++qq) { const int e = 64 * w + 32 * et + 8 * qq + 4 * hib;
                    v2u o; o.x = pk2((acc[rb][et][4 * qq] - mean) * rstd, (acc[rb][et][4 * qq + 1] - mean) * rstd); o.y = pk2((acc[rb][et][4 * qq + 2] - mean) * rstd, (acc[rb][et][4 * qq + 3] - mean) * rstd);
                    *(LAS v2u*)(YST + i * 1024 + ((e * 2) ^ ((i & 63) << 4))) = o; } }
        __syncthreads();
        { int tid6 = tid; asm volatile("" : "+v"(tid6)); const int chk = tid6 & 63; const f32x4 g0 = *(const GAS f32x4*)(gn + h * 512 + chk * 8), g1 = *(const GAS f32x4*)(gn + h * 512 + chk * 8 + 4);
#pragma unroll 4
          for (int k = 0; k < 16; ++k) { const int row = (tid6 >> 6) + 8 * k;
              const v4u y = *(const LAS v4u*)(YST + row * 1024 + ((chk * 16) ^ ((row & 63) << 4)));
              bf16* gp = GY + (tok0 + row) * 2048 + h * 512 + chk * 8; const v4u gg = *(const GAS v4u*)gp;
              v4u o; o.x = pk2(bflo(y.x) * g0.x * bflo(gg.x), bfhi(y.x) * g0.y * bfhi(gg.x)); o.y = pk2(bflo(y.y) * g0.z * bflo(gg.y), bfhi(y.y) * g0.w * bfhi(gg.y));
              o.z = pk2(bflo(y.z) * g1.x * bflo(gg.z), bfhi(y.z) * g1.y * bfhi(gg.z)); o.w = pk2(bflo(y.w) * g1.z * bflo(gg.w), bfhi(y.w) * g1.w * bfhi(gg.w));
              *(GAS v4u*)gp = o; } }
        __syncthreads();
    }
}
typedef swa::BlockRef<swa::bf16, swa::bf16> ABlk;
__device__ __forceinline__ float* att_lse(Frame& F, int L) {
    const int g = L >> 9, rem = L & 511, sh = 2 * g, seq = rem >> (6 - sh), qb = rem & ((64 >> sh) - 1);
    return (float*)(ARGWS(F) + WS_BIG + BIG_LSE) + (size_t)g * 131072 + (size_t)seq * (size_t)(SEQ >> sh) + (size_t)qb * 256;
}
__device__ __forceinline__ ABlk att_ref(Frame& F, int L) {
    const int g = L >> 9, rem = L & 511, sh = 2 * g, seq = rem >> (6 - sh), qb = rem & ((64 >> sh) - 1);
    const size_t base = (size_t)g * 131072 + (size_t)seq * (size_t)(SEQ >> sh);
    const swa::bf16* P = (const swa::bf16*)(ARGWS(F) + WS_BIG + BIG_QKV); constexpr size_t WH = (size_t)3 * 131072 * 128;
    ABlk r; r.Q = P + (base + (size_t)qb * 256) * 128; r.K = P + WH + base * 128; r.V = P + 2 * WH + base * 128;
    r.O = (swa::bf16*)(ARGWS(F) + WS_BIG + BIG_OP) + (base + (size_t)qb * 256) * 128; r.P0 = qb * 256;
    return r;
}
__device__ __forceinline__ void attn_phase(Frame& F) {
    extern __shared__ __attribute__((aligned(16))) unsigned char lds_dyn[];
    char* const ldsg = (char*)lds_dyn;
    int L = F.c; const int total = 1536, stride = F.G;
    if (L >= total) return;
    ABlk cur = att_ref(F, L);
    const int W = 129 + (F.G >> 20);
    swa::Seam<swa::bf16> S; S.tid = F.tid;
    swa::causal_swa_prime<swa::bf16, swa::bf16>(cur, W, ldsg, S);
    for (;;) {
        const bool last = L + stride >= total;
        const int Ln = last ? L : L + stride;
        const ABlk nxt = last ? cur : att_ref(F, Ln);
        const int skv = SEQ >> (2 * (L >> 9));
        swa::causal_swa_block<swa::bf16, swa::bf16>(cur, nxt, skv, W, ldsg, S);
        if (F.tid < 256) att_lse(F, L)[F.tid] = ((const LAS float*)(F.lds + swa::LSE_LDS_OFF))[F.tid];
        if (last) break;
        cur = nxt; L = Ln;
    }
}
__device__ __forceinline__ void attn_merge_phase(Frame& F) {
    const int gw = F.c * NWAVES + F.wave, NGW = F.G * NWAVES, hd = F.lane >> 4, chk = F.lane & 15;
    const bf16* OP = (const bf16*)(ARGWS(F) + WS_BIG + BIG_OP); const float* LSE = (const float*)(ARGWS(F) + WS_BIG + BIG_LSE); bf16* O = (bf16*)(ARGWS(F) + WS_BIG + BIG_O);
    for (int m = gw; m < T_TOK; m += NGW) { const int b = m >> 14, t = m & 16383;
        size_t row[3]; float ls[3];
#pragma unroll
        for (int g = 0; g < 3; ++g) { const int sh = 2 * g; row[g] = (size_t)g * 131072 + (size_t)(b * 4 + hd) * SEQ + (size_t)((t & ((1 << sh) - 1)) * (SEQ >> sh) + (t >> sh)); ls[g] = LSE[row[g]]; }
        const float mx = fmaxf(ls[0], fmaxf(ls[1], ls[2])); float wg[3]; float ws = 0.f;
#pragma unroll
        for (int g = 0; g < 3; ++g) { wg[g] = __expf(ls[g] - mx); ws += wg[g]; }
        const float inv = 1.f / ws; float o[8] = {0.f, 0.f, 0.f, 0.f, 0.f, 0.f, 0.f, 0.f};
#pragma unroll
        for (int g = 0; g < 3; ++g) { const v4u v = *(const GAS v4u*)(OP + row[g] * 128 + chk * 8); const float wt = wg[g] * inv;
            o[0] += wt * bflo(v.x); o[1] += wt * bfhi(v.x); o[2] += wt * bflo(v.y); o[3] += wt * bfhi(v.y); o[4] += wt * bflo(v.z); o[5] += wt * bfhi(v.z); o[6] += wt * bflo(v.w); o[7] += wt * bfhi(v.w); }
        v4u w; w.x = pk2(o[0], o[1]); w.y = pk2(o[2], o[3]); w.z = pk2(o[4], o[5]); w.w = pk2(o[6], o[7]);
        *(GAS v4u*)(O + (size_t)m * 512 + hd * 128 + chk * 8) = w; }
}
template <bool GATHER_, int NCT> struct MoeOrder {
    static constexpr bool GATHER = GATHER_;
    const char* A; const char* Bt; int K; size_t bstride; int G, c; int rtb[9]; const LAS int* idx;
    __device__ __forceinline__ bool next(int i, pg8::Unit& u) const {
        const int L = i * G + c; if (L >= rtb[8] * NCT) return false;
        const int rt = L / NCT; int e = 0;
#pragma unroll
        for (int k = 1; k < 8; ++k) e += (rtb[k] <= rt) ? 1 : 0;
        u.pm = rt; u.pn = L - rt * NCT; u.ex = e; return true;
    }
    __device__ __forceinline__ const char* a_ptr(const pg8::Unit& u) const { return GATHER ? A : A + (size_t)u.pm * ((size_t)256 * K * 2); }
    __device__ __forceinline__ const char* b_ptr(const pg8::Unit& u) const { return Bt + (size_t)u.ex * bstride + (size_t)u.pn * ((size_t)256 * K * 2); }
    __device__ __forceinline__ unsigned a_off(int ui, int row, int C, int) const { return (unsigned)idx[ui * 256 + row] * (unsigned)(K * 2) + (unsigned)(C * 2); }
};
template <bool GATHER_, int NCT> __device__ __forceinline__ void moe_order_init(Frame& F, MoeOrder<GATHER_, NCT>& S, int j, int cnt[8]) {
    int acc = 0;
#pragma unroll
    for (int e = 0; e < 8; ++e) { S.rtb[e] = acc; cnt[e] = __builtin_amdgcn_readfirstlane((int)__hip_atomic_load(F_CTL(F) + CW_CNT + (j * 8 + e) * 64, RLX_AGENT)); acc += (cnt[e] + 255) >> 8; }
    S.rtb[8] = acc; S.G = F.G; S.c = F.c; S.idx = (const LAS int*)(F.lds + AUX_OFF);
}
__global__ void __launch_bounds__(NWAVES * 64, 2) fwd_kernel(Args args) {
    extern __shared__ __attribute__((aligned(16))) unsigned char lds[];
    Frame F;
    F.lds = (LAS unsigned char*)lds;
    F.MISC = (volatile LAS unsigned*)(F.lds + MISC_OFF);
    F.tid = threadIdx.x; F.lane = F.tid & 63; F.wave = __builtin_amdgcn_readfirstlane(F.tid >> 6);
    F.G = gridDim.x; F.c = blockIdx.x;
    for (int u = F.tid; u < 32; u += NWAVES * 64) ((LAS unsigned*)(F.lds + MISC_OFF))[u] = 0u;
    if (F.tid == 0) { LAS unsigned long long* tb = (LAS unsigned long long*)(F.lds + MISC_OFF + 128);
#pragma unroll
        for (int i = 0; i < 15; ++i) tb[i] = (unsigned long long)args.in[i];
        tb[15] = (unsigned long long)args.out; tb[16] = (unsigned long long)args.ws; }
    __syncthreads();
    XcdBarrier bar = xcd_barrier_post((unsigned*)(F_CTL(F) + CW_BAR), F.MISC + 8);
#ifdef STAMP_A
#define STAMP_HERE(idx) do { if (threadIdx.x == 0) ((volatile LAS unsigned long long*)(F.lds + AUX_OFF + 16384))[(idx)] = wall_clock64(); } while (0)
#else
#define STAMP_HERE(idx) do { } while (0)
#endif
#define GRID_BAR(idx) do { XcdBarrier bb_ = bar; asm volatile("" : "+s"(bb_.bar), "+s"(bb_.x)); xcd_barrier(bb_); STAMP_HERE(idx); } while (0)
#define WSP ARGWS(F)
#define BIGP (ARGWS(F) + WS_BIG)
#define XBP ((bf16*)(ARGWS(F) + WS_XB))

#ifndef ONLY
#define ONLY -1
#endif
#define RUN(n) (ONLY < 0 || ONLY == (n))
    STAMP_HERE(0);
    if (RUN(0)) { frame_refresh(F); p0_prologue(F); }
    GRID_BAR(1);

#pragma unroll
    for (int j = 0; j < 2; ++j) {
        if (RUN(1)) { frame_refresh(F);
            const bf16* Win = (const bf16*)(WSP + WS_WIN) + (size_t)j * 6144 * 1024;
#ifndef SKIP_RP
            { pg8::StaticOrder S; S.init(XBP, Win, T_TOK, 4096, 1024, F.G, F.c);
              pg8::EpiRetProj E{(bf16*)(BIGP + BIG_QD), (bf16*)(BIGP + BIG_KH), (bf16*)(BIGP + BIG_G), (const float*)(WSP + WS_TAB)};
              pg8::gemm_phase<pg8::EpiRetProj, pg8::StaticOrder, true>(F.lds + RING_OFF, S, E, F.tid); }
#endif
#ifndef SKIP_VT
            { pg8::StaticOrder S; S.init(Win + (size_t)4096 * 1024, XBP, 2048, T_TOK, 1024, F.G, F.c);
              pg8::EpiVT E{(bf16*)(BIGP + BIG_VT)};
              pg8::gemm_phase<pg8::EpiVT, pg8::StaticOrder, true>(F.lds + RING_OFF, S, E, F.tid); }
#endif
        }
        GRID_BAR(1 + 16 * j + 1);
        if (RUN(2)) { frame_refresh(F); ret_state_phase(F); }
        GRID_BAR(1 + 16 * j + 2);
        if (RUN(3)) { frame_refresh(F); ret_out_phase(F, j); }
        GRID_BAR(1 + 16 * j + 3);
        if (RUN(4)) { frame_refresh(F);
            pg8::StaticOrder S; S.init(BIGP + BIG_G, (const bf16*)(WSP + WS_WRO) + (size_t)j * 1024 * 2048, T_TOK, 1024, 2048, F.G, F.c);
            pg8::EpiAddF32 E{ARGX(F)};
            pg8::gemm_phase<pg8::EpiAddF32, pg8::StaticOrder, true>(F.lds + RING_OFF, S, E, F.tid);
        }
        GRID_BAR(1 + 16 * j + 4);
        if (RUN(5)) { frame_refresh(F); ln_pass<0, false>(F, 2 * j, 0, j); }
        if (RUN(6)) { frame_refresh(F); moe_convert(F, j); }
        GRID_BAR(1 + 16 * j + 5);
        if (RUN(7)) { frame_refresh(F);
            pg8::StaticOrder S; S.init(XBP, (const bf16*)(WSP + WS_WGU) + (size_t)j * 7168 * 1024, T_TOK, 7168, 1024, F.G, F.c);
            pg8::EpiSwiGLU E{(bf16*)(BIGP + BIG_HID)};
            pg8::gemm_phase<pg8::EpiSwiGLU, pg8::StaticOrder, true>(F.lds + RING_OFF, S, E, F.tid);
        }
        GRID_BAR(1 + 16 * j + 6);
        if (RUN(8)) { frame_refresh(F);
            pg8::StaticOrder S; S.init(BIGP + BIG_HID, (const bf16*)(WSP + WS_WDN) + (size_t)j * 1024 * 3584, T_TOK, 1024, 3584, F.G, F.c);
            pg8::EpiAddF32 E{ARGX(F)};
            pg8::gemm_phase<pg8::EpiAddF32, pg8::StaticOrder, true>(F.lds + RING_OFF, S, E, F.tid);
        }
        GRID_BAR(1 + 16 * j + 7);
        if (RUN(5)) { frame_refresh(F); ln_pass<0, false>(F, 2 * j, 1, j); }
        GRID_BAR(1 + 16 * j + 8);
        if (RUN(9)) { frame_refresh(F);
            pg8::StaticOrder S; S.init(XBP, (const bf16*)(WSP + WS_WQKV) + (size_t)j * 4608 * 1024, T_TOK, 4608, 1024, F.G, F.c);
            pg8::EpiQKV E{(bf16*)(BIGP + BIG_QKV)};
            pg8::gemm_phase<pg8::EpiQKV, pg8::StaticOrder, true>(F.lds + RING_OFF, S, E, F.tid);
        }
        GRID_BAR(1 + 16 * j + 9);
        if (RUN(10)) { frame_refresh(F); attn_phase(F); }
        GRID_BAR(1 + 16 * j + 10);
        if (RUN(11)) { frame_refresh(F); attn_merge_phase(F); }
        GRID_BAR(1 + 16 * j + 11);
        if (RUN(12)) { frame_refresh(F);
            pg8::StaticOrder S; S.init(BIGP + BIG_O, (const bf16*)(WSP + WS_WAO) + (size_t)j * 1024 * 512, T_TOK, 1024, 512, F.G, F.c);
            pg8::EpiAddF32 E{ARGX(F)};
            pg8::gemm_phase<pg8::EpiAddF32, pg8::StaticOrder, true>(F.lds + RING_OFF, S, E, F.tid);
        }
        GRID_BAR(1 + 16 * j + 12);
        if (RUN(13)) { frame_refresh(F); ln_route_pass(F, 2 * j + 1, j); }
        GRID_BAR(1 + 16 * j + 13);
        if (RUN(14)) {
            frame_refresh(F); MoeOrder<true, 28> S; int cnt[8]; moe_order_init(F, S, j, cnt);
            S.A = (const char*)XBP; S.Bt = (const char*)(BIGP + BIG_WMGU); S.K = 1024; S.bstride = (size_t)7168 * 1024 * 2;
            const int* list = (const int*)(WSP + WS_LIST); LAS int* idx = (LAS int*)(F.lds + AUX_OFF);
            pg8::Unit u;
            for (int ui = 0; S.next(ui, u) && ui < 30; ++ui)
                if (F.tid < 256) { const int e = u.ex; int rb = 0, ce = 0;
#pragma unroll
                    for (int q = 0; q < 8; ++q) { rb = (q == e) ? S.rtb[q] : rb; ce = (q == e) ? cnt[q] : ce; }
                    const int slot = (u.pm - rb) * 256 + F.tid; idx[ui * 256 + F.tid] = list[e * T_TOK + (slot < ce ? slot : 0)]; }
            __syncthreads();
            pg8::EpiSwiGLU E{(bf16*)(BIGP + BIG_HID)};
            pg8::gemm_phase<pg8::EpiSwiGLU, MoeOrder<true, 28>, true>(F.lds + RING_OFF, S, E, F.tid);
        }
        GRID_BAR(1 + 16 * j + 14);
        if (RUN(15)) {
            frame_refresh(F); MoeOrder<false, 4> S; int cnt[8]; moe_order_init(F, S, j, cnt);
            S.A = (const char*)(BIGP + BIG_HID); S.Bt = (const char*)(BIGP + BIG_WMD); S.K = 3584; S.bstride = (size_t)1024 * 3584 * 2;
            pg8::EpiBf16Y E{(bf16*)(BIGP + BIG_YP)};
            pg8::gemm_phase<pg8::EpiBf16Y, MoeOrder<false, 4>, true>(F.lds + RING_OFF, S, E, F.tid);
        }
        GRID_BAR(1 + 16 * j + 15);
        if (RUN(16)) { frame_refresh(F); if (j == 0) ln_pass<2, false>(F, 1, 1, 0); else ln_pass<2, true>(F, 3, 1, 1); }
        if (j == 0) GRID_BAR(1 + 16 * j + 16);
    }
#ifdef STAMP_A
    GRID_BAR(34);
    { if (blockIdx.x == 0 && threadIdx.x == 0) { volatile LAS unsigned long long* ts = (volatile LAS unsigned long long*)(F.lds + AUX_OFF + 16384);
          float* vv = (float*)(ARGWS(F) + 65536); vv[0] = (float)(ts[STAMP_A + STAMP_AN] - ts[STAMP_A]) * 0.01f; vv[1] = (float)(ts[STAMP_B + STAMP_BN] - ts[STAMP_B]) * 0.01f; } }
    GRID_BAR(35);
    { const float* vv = (const float*)(ARGWS(F) + 65536); const float va = vv[0], vb = vv[1];
      float* out = ARGX(F); const float c = sqrtf(va);
      for (size_t i = (size_t)blockIdx.x * 512 + threadIdx.x; i < (size_t)T_TOK * DMODEL; i += (size_t)gridDim.x * 512) out[i] = (i == 0) ? vb : c; }
#endif
}

extern "C" void kernel_launch(void* const* d_in, const int* in_sizes, int n_in, void* d_out, int out_size, void* d_ws, size_t ws_size, hipStream_t stream) {
    static int grid = 0;
    if (grid == 0) {
        if (n_in != 15 || out_size != T_TOK * DMODEL || ws_size < WS_END) { fprintf(stderr, "kernel_launch: unexpected shapes / workspace (n_in %d, out %d, ws %zu < %zu)\n", n_in, out_size, ws_size, (size_t)WS_END); grid = -1; return; }
        int dev = 0, cus = 0, per_cu = 0;
        if (hipGetDevice(&dev) != hipSuccess || hipDeviceGetAttribute(&cus, hipDeviceAttributeMultiprocessorCount, dev) != hipSuccess) { grid = -1; return; }
        if (hipFuncSetAttribute((const void*)fwd_kernel, hipFuncAttributeMaxDynamicSharedMemorySize, LDS_BYTES) != hipSuccess) { fprintf(stderr, "kernel_launch: hipFuncSetAttribute failed\n"); grid = -1; return; }
        if (hipOccupancyMaxActiveBlocksPerMultiprocessor(&per_cu, (const void*)fwd_kernel, NWAVES * 64, LDS_BYTES) != hipSuccess || per_cu < 1) { fprintf(stderr, "kernel_launch: occupancy query says %d\n", per_cu); }
        (void)hipGetLastError();
        if (cus < 256) { fprintf(stderr, "kernel_launch: this kernel needs 256 CUs (found %d)\n", cus); grid = -1; return; }
        grid = 256;
    }
    if (grid < 0) return;
    if (hipMemsetAsync((char*)d_ws + WS_CTL, 0, CTL_ZERO_BYTES, stream) != hipSuccess) return;
    Args a{};
    for (int i = 0; i < 15; ++i) a.in[i] = (const float*)d_in[i];
    a.out = (float*)d_out; a.ws = (unsigned char*)d_ws;
    hipLaunchKernelGGL(fwd_kernel, dim3(grid), dim3(NWAVES * 64), LDS_BYTES, stream, a);
}
```

```cpp
#include <hip/hip_runtime.h>
#include <hip/hip_bf16.h>
#include <cstdio>
#include <cstdint>
#include <cmath>
namespace pg8 {
#define PG8_LAS __attribute__((address_space(3)))
typedef unsigned short bf16_t;
typedef short bf16x8 __attribute__((ext_vector_type(8)));
typedef float f32x4 __attribute__((ext_vector_type(4)));
typedef float f32x2 __attribute__((ext_vector_type(2)));
typedef unsigned u32x4 __attribute__((ext_vector_type(4)));
constexpr int BM = 256, BK = 64, HALF = 128, HTB = HALF * BK * 2  , STAGE_BYTES = 8 * HTB, NXCD = 8, WGM = 8;

__host__ __device__ __forceinline__ int lds_byte(int r, int c) { const int st = (r >> 4) * 2 + (c >> 5), rr = r & 15, cc = c & 31, ob = rr * 64 + cc * 2; return st * 1024 + (ob ^ (((ob >> 9) & 1) << 5)); }
__host__ __device__ __forceinline__ void stage_rc(int b, int& R, int& C) { const int st = b / 1024, sb = b % 1024, swz = sb ^ (((sb >> 9) & 1) << 5); R = (st >> 1) * 16 + swz / 64; C = (st & 1) * 32 + (swz % 64) / 2; }
__host__ __device__ __forceinline__ int perm32(int rho) { const int n = rho >> 4, i = rho & 15; return 8 * (i >> 2) + 4 * n + (i & 3); }

struct Unit { int pm, pn, ex; };

struct StaticOrder {
    static constexpr bool GATHER = false;
    const char* A; const char* Bt; int K;
    int nM, nN, nwg, G, c;
    __device__ void init(const void* A_, const void* Bt_, int M, int N, int K_, int G_, int c_) { A = (const char*)A_; Bt = (const char*)Bt_; K = K_; nM = M / BM; nN = N / BM; nwg = nM * nN; G = G_; c = c_; }
    __device__ bool next(int i, Unit& u) const {
        const long L = (long)i * G + c; if (L >= nwg) return false;
        int wgid = (int)L; { const int q = nwg / NXCD, r = nwg % NXCD, xcd = wgid % NXCD, off = wgid / NXCD; wgid = (xcd < r ? xcd * (q + 1) : r * (q + 1) + (xcd - r) * q) + off; }
        const int nig = WGM * nN, gid = wgid / nig, fm = gid * WGM, gsz = (nM - fm) < WGM ? (nM - fm) : WGM;
        u.pm = fm + ((wgid % nig) % gsz); u.pn = (wgid % nig) / gsz; u.ex = 0; return true;
    }
    __device__ __forceinline__ const char* a_ptr(const Unit& u) const { return A + (size_t)u.pm * ((size_t)BM * K * 2); }
    __device__ __forceinline__ const char* b_ptr(const Unit& u) const { return Bt + (size_t)u.pn * ((size_t)BM * K * 2); }
    __device__ __forceinline__ unsigned a_off(int, int, int, int) const { return 0u; }
};

__device__ __forceinline__ unsigned cvt_pk_bf16(float lo, float hi) { unsigned r; asm volatile("v_cvt_pk_bf16_f32 %0, %1, %2" : "=v"(r) : "v"(lo), "v"(hi)); return r; }

template <class Epi, class Sched, bool ALIGN_EPI>
__device__ __forceinline__ void gemm_phase(PG8_LAS unsigned char* lds, const Sched& S, const Epi& E, const int tid) {
    constexpr bool GATHER = Sched::GATHER;
    const int wid = __builtin_amdgcn_readfirstlane(tid >> 6), lane = tid & 63, wr = wid >> 2, wc = wid & 3, fr = lane & 15, fq = lane >> 4;
    const int K = S.K, nt = K / BK;
    unsigned voffA[2][2], nvoffA[2][2], voffB[2]; int sR[2], sC[2];
#pragma unroll
    for (int i = 0; i < 2; ++i) { int R, C; stage_rc(tid * 16 + i * 8192, R, C); sR[i] = R; sC[i] = C; const int Rb = Epi::PERM ? ((R & ~31) + perm32(R & 31)) : R;
        voffA[0][i] = (unsigned)(R * K + C) * 2u; voffA[1][i] = voffA[0][i]; nvoffA[0][i] = voffA[0][i]; nvoffA[1][i] = voffA[0][i]; voffB[i] = (unsigned)(Rb * K + C) * 2u; }
    const size_t kstep = (size_t)(BK * 2);
    const size_t hstep = (size_t)HALF * K * 2;
    const size_t ahstep = GATHER ? (size_t)0 : hstep;
    const unsigned ldsw = (unsigned)wid * 1024u;
    const int aoff = lds_byte(wr * 64 + fr, fq * 8), boff = lds_byte(wc * 32 + fr, fq * 8);
#define PG8_SA(b, h) (((b) * 2 + (h)) * HTB)
#define PG8_SB(b, h) ((4 + (b) * 2 + (h)) * HTB)
#define PG8_STAGE(bufoff, gbase, voff) do { _Pragma("unroll") for (int _i = 0; _i < 2; ++_i) \
        __builtin_amdgcn_global_load_lds((const unsigned*)((const char*)(gbase) + (voff)[_i]), (PG8_LAS unsigned*)(lds + (bufoff) + ldsw + _i * 8192), 16, 0, 0); } while (0)
#define PG8_STAGE_A(bufoff, gbase, h, VO) PG8_STAGE(bufoff, (gbase) + (h) * ahstep, (VO)[GATHER ? (h) : 0])
#define PG8_LDA(dst, b, h) do { _Pragma("unroll") for (int m = 0; m < 4; ++m) _Pragma("unroll") for (int k = 0; k < 2; ++k) dst[m][k] = *(const PG8_LAS bf16x8*)(lds + PG8_SA(b, h) + aoff + m * 2048 + k * 1024); } while (0)
#define PG8_LDB(dst, b, h) do { _Pragma("unroll") for (int n = 0; n < 2; ++n) _Pragma("unroll") for (int k = 0; k < 2; ++k) dst[n][k] = *(const PG8_LAS bf16x8*)(lds + PG8_SB(b, h) + boff + n * 2048 + k * 1024); } while (0)
#define PG8_MMA(ai, bj, At, Bt) do { __builtin_amdgcn_s_setprio(1); _Pragma("unroll") for (int m = 0; m < 4; ++m) _Pragma("unroll") for (int n = 0; n < 2; ++n) _Pragma("unroll") for (int k = 0; k < 2; ++k) \
        acc[ai][bj][m][n] = __builtin_amdgcn_mfma_f32_16x16x32_bf16(Bt[n][k], At[m][k], acc[ai][bj][m][n], 0, 0, 0); __builtin_amdgcn_s_setprio(0); } while (0)
#define PG8_WAIT_V(n) asm volatile("s_waitcnt vmcnt(" #n ")" ::: "memory")
#define PG8_WAIT_L(n) asm volatile("s_waitcnt lgkmcnt(" #n ")" ::: "memory")
#define PG8_BAR __builtin_amdgcn_s_barrier()
#define PG8_SCHED __builtin_amdgcn_sched_barrier(0)
    Unit cur, nxt; int ui = 0;
    if (!S.next(0, cur)) return;
    f32x4 acc[2][2][4][2];
#pragma unroll
    for (int a = 0; a < 2; ++a)
#pragma unroll
        for (int b = 0; b < 2; ++b)
#pragma unroll
            for (int m = 0; m < 4; ++m)
#pragma unroll
                for (int n = 0; n < 2; ++n) acc[a][b][m][n] = (f32x4){0.f, 0.f, 0.f, 0.f};
    bf16x8 At[4][2], B0[2][2], B1[2][2];
    const char* cA = S.a_ptr(cur); const char* cB = S.b_ptr(cur);
    if constexpr (GATHER) {
#pragma unroll
        for (int h = 0; h < 2; ++h)
#pragma unroll
            for (int i = 0; i < 2; ++i) voffA[h][i] = S.a_off(0, h * HALF + sR[i], sC[i], 0);
    }
    PG8_STAGE(PG8_SB(0, 0), cB, voffB); PG8_STAGE(PG8_SB(0, 1), cB + hstep, voffB); PG8_STAGE_A(PG8_SA(0, 0), cA, 0, voffA); PG8_STAGE_A(PG8_SA(0, 1), cA, 1, voffA);
    if (wr == 1) PG8_BAR;
    PG8_WAIT_V(2); PG8_BAR;
    PG8_STAGE(PG8_SB(1, 0), cB + kstep, voffB); PG8_STAGE_A(PG8_SA(1, 0), cA + kstep, 0, voffA); PG8_STAGE(PG8_SB(1, 1), cB + hstep + kstep, voffB);
    PG8_WAIT_V(6); PG8_BAR;
    for (;;) {
        const bool has_next = S.next(ui + 1, nxt);
        const char* nA = has_next ? S.a_ptr(nxt) : cA; const char* nB = has_next ? S.b_ptr(nxt) : cB;
        if constexpr (GATHER) {
#pragma unroll
            for (int h = 0; h < 2; ++h)
#pragma unroll
                for (int i = 0; i < 2; ++i) nvoffA[h][i] = has_next ? S.a_off(ui + 1, h * HALF + sR[i], sC[i], 0) : voffA[h][i];
        }
        for (int t = 0; t < nt; t += 2) {
            const bool last = (t == nt - 2);
            const char* a1 = cA + (size_t)(t + 1) * kstep;
            const char* a2 = last ? nA : cA + (size_t)(t + 2) * kstep; const char* b2 = last ? nB : cB + (size_t)(t + 2) * kstep;
            const char* a3 = a2 + kstep; const char* b3 = b2 + kstep;
            unsigned vo2[2][2];
#pragma unroll
            for (int h = 0; h < 2; ++h)
#pragma unroll
                for (int i = 0; i < 2; ++i) vo2[h][i] = (GATHER && last) ? nvoffA[h][i] : voffA[h][i];
            PG8_LDB(B0, 0, 0); PG8_LDB(B1, 0, 1); PG8_SCHED; PG8_LDA(At, 0, 0); PG8_STAGE_A(PG8_SA(1, 1), a1, 1, voffA);
            PG8_WAIT_V(8); PG8_WAIT_L(0); PG8_BAR; PG8_MMA(0, 0, At, B0); PG8_MMA(0, 1, At, B1); PG8_BAR; PG8_SCHED;
            PG8_LDA(At, 0, 1); PG8_STAGE(PG8_SB(0, 0), b2, voffB); PG8_STAGE(PG8_SB(0, 1), b2 + hstep, voffB); PG8_STAGE_A(PG8_SA(0, 0), a2, 0, vo2);
            PG8_WAIT_V(8); PG8_WAIT_L(0); PG8_BAR; PG8_MMA(1, 0, At, B0); PG8_MMA(1, 1, At, B1); PG8_BAR; PG8_SCHED;
            PG8_LDB(B0, 1, 0); PG8_LDB(B1, 1, 1); PG8_SCHED; PG8_LDA(At, 1, 0); PG8_STAGE_A(PG8_SA(0, 1), a2, 1, vo2);
            PG8_WAIT_V(8); PG8_WAIT_L(0); PG8_BAR; PG8_MMA(0, 0, At, B0); PG8_MMA(0, 1, At, B1); PG8_BAR; PG8_SCHED;
            PG8_LDA(At, 1, 1); PG8_STAGE(PG8_SB(1, 0), b3, voffB); PG8_STAGE(PG8_SB(1, 1), b3 + hstep, voffB); PG8_STAGE_A(PG8_SA(1, 0), a3, 0, vo2);
            PG8_WAIT_V(8); PG8_WAIT_L(0); PG8_BAR; PG8_MMA(1, 0, At, B0); PG8_MMA(1, 1, At, B1); PG8_BAR; PG8_SCHED;
        }
        if constexpr (ALIGN_EPI) { if (wr == 0) PG8_BAR; }
        E(acc, cur, wr, wc, fr, fq);
        if (!has_next) break;
#pragma unroll
        for (int a = 0; a < 2; ++a)
#pragma unroll
            for (int b = 0; b < 2; ++b)
#pragma unroll
                for (int m = 0; m < 4; ++m)
#pragma unroll
                    for (int n = 0; n < 2; ++n) acc[a][b][m][n] = (f32x4){0.f, 0.f, 0.f, 0.f};
        cur = nxt; cA = nA; cB = nB; ++ui;
        if constexpr (GATHER) {
#pragma unroll
            for (int h = 0; h < 2; ++h)
#pragma unroll
                for (int i = 0; i < 2; ++i) voffA[h][i] = nvoffA[h][i];
        }
        if constexpr (ALIGN_EPI) { if (wr == 1) PG8_BAR; }
    }
    PG8_WAIT_V(0);
    if constexpr (!ALIGN_EPI) { if (wr == 0) PG8_BAR; }
    PG8_BAR;
#undef PG8_SA
#undef PG8_SB
#undef PG8_STAGE
#undef PG8_STAGE_A
#undef PG8_LDA
#undef PG8_LDB
#undef PG8_MMA
#undef PG8_WAIT_V
#undef PG8_WAIT_L
#undef PG8_BAR
#undef PG8_SCHED
}
__device__ __forceinline__ float silu_f(float x) { return x * __builtin_amdgcn_rcpf(1.0f + __builtin_amdgcn_exp2f(-1.4426950408889634f * x)); }
__device__ __forceinline__ u32x4 pack8v(const f32x4& v0, const f32x4& v1) { u32x4 w; w.x = cvt_pk_bf16(v0[0], v0[1]); w.y = cvt_pk_bf16(v0[2], v0[3]); w.z = cvt_pk_bf16(v1[0], v1[1]); w.w = cvt_pk_bf16(v1[2], v1[3]); return w; }

struct EpiRetProj {
    static constexpr bool PERM = true;
    bf16_t* QD; bf16_t* KH; bf16_t* G; const float* tab;
    __device__ __forceinline__ void operator()(const f32x4 (&acc)[2][2][4][2], const Unit& u, int wr, int wc, int fr, int fq) const {
        const int row0 = u.pm * BM + wr * 64 + fr, cl = wc * 32 + 8 * fq;
        if (u.pn < 8) {
            const bool isq = u.pn < 4; const int h = u.pn & 3;
            const float lg = __builtin_amdgcn_logf(1.0f - __builtin_amdgcn_exp2f((float)(-5 - h)));
            bf16_t* base = (isq ? QD : KH) + h * 256 + cl;
#pragma unroll
            for (int ai = 0; ai < 2; ++ai)
#pragma unroll
                for (int m = 0; m < 4; ++m) { const int row = row0 + ai * HALF + m * 16, pos = row & 16383, ic = row & 127;
                    const float sc = isq ? __builtin_amdgcn_exp2f(lg * (float)(ic + 1)) : 0.0625f * __builtin_amdgcn_exp2f(-lg * (float)(ic + 1));
                    const f32x4* tp = (const f32x4*)(tab + ((size_t)pos * 128 + cl) * 2);
                    const f32x4 t0 = tp[0], t1 = tp[1], t2 = tp[2], t3 = tp[3];
                    const f32x4 a0 = acc[ai][0][m][0], a1 = acc[ai][0][m][1], b0 = acc[ai][1][m][0], b1 = acc[ai][1][m][1];
                    f32x4 o10, o11, o20, o21;
                    o10[0] = (a0[0] * t0[0] - b0[0] * t0[1]) * sc; o20[0] = (b0[0] * t0[0] + a0[0] * t0[1]) * sc;
                    o10[1] = (a0[1] * t0[2] - b0[1] * t0[3]) * sc; o20[1] = (b0[1] * t0[2] + a0[1] * t0[3]) * sc;
                    o10[2] = (a0[2] * t1[0] - b0[2] * t1[1]) * sc; o20[2] = (b0[2] * t1[0] + a0[2] * t1[1]) * sc;
                    o10[3] = (a0[3] * t1[2] - b0[3] * t1[3]) * sc; o20[3] = (b0[3] * t1[2] + a0[3] * t1[3]) * sc;
                    o11[0] = (a1[0] * t2[0] - b1[0] * t2[1]) * sc; o21[0] = (b1[0] * t2[0] + a1[0] * t2[1]) * sc;
                    o11[1] = (a1[1] * t2[2] - b1[1] * t2[3]) * sc; o21[1] = (b1[1] * t2[2] + a1[1] * t2[3]) * sc;
                    o11[2] = (a1[2] * t3[0] - b1[2] * t3[1]) * sc; o21[2] = (b1[2] * t3[0] + a1[2] * t3[1]) * sc;
                    o11[3] = (a1[3] * t3[2] - b1[3] * t3[3]) * sc; o21[3] = (b1[3] * t3[2] + a1[3] * t3[3]) * sc;
                    bf16_t* rp = base + (size_t)row * 1024;
                    *(u32x4*)rp = pack8v(o10, o11); *(u32x4*)(rp + 128) = pack8v(o20, o21); asm volatile("" ::: "memory"); }
        } else {
            bf16_t* base = G + (u.pn - 8) * 256 + cl;
#pragma unroll
            for (int ai = 0; ai < 2; ++ai)
#pragma unroll
                for (int m = 0; m < 4; ++m) { bf16_t* rp = base + (size_t)(row0 + ai * HALF + m * 16) * 2048;
#pragma unroll
                    for (int bj = 0; bj < 2; ++bj) { f32x4 v0 = acc[ai][bj][m][0], v1 = acc[ai][bj][m][1];
#pragma unroll
                        for (int j = 0; j < 4; ++j) { v0[j] = silu_f(v0[j]); v1[j] = silu_f(v1[j]); }
                        *(u32x4*)(rp + bj * HALF) = pack8v(v0, v1); } }
        }
    }
};
struct EpiVT {
    static constexpr bool PERM = true;
    bf16_t* VT;
    __device__ __forceinline__ void operator()(const f32x4 (&acc)[2][2][4][2], const Unit& u, int wr, int wc, int fr, int fq) const {
        const int row0 = u.pm * BM + wr * 64 + fr, c0 = u.pn * BM + wc * 32 + 8 * fq;
#pragma unroll
        for (int ai = 0; ai < 2; ++ai)
#pragma unroll
            for (int m = 0; m < 4; ++m) { const int R = row0 + ai * HALF + m * 16, h = R >> 9, e = R & 511;
#pragma unroll
                for (int bj = 0; bj < 2; ++bj) { const int c = c0 + bj * HALF, b = c >> 14, t = c & 16383, n = t >> 7, oct = (t & 127) >> 3;
                    const size_t off = ((size_t)((b * 4 + h) * 128 + n) << 16) + (size_t)(((((e >> 5) * 8 + (oct >> 1)) * 2 + (oct & 1)) * 32 + (e & 31)) * 8);
                    *(u32x4*)(VT + off) = pack8v(acc[ai][bj][m][0], acc[ai][bj][m][1]); } }
    }
};
struct EpiAddBf16 {
    static constexpr bool PERM = true;
    bf16_t* XB; float alpha;
    __device__ __forceinline__ void operator()(const f32x4 (&acc)[2][2][4][2], const Unit& u, int wr, int wc, int fr, int fq) const {
        const int row0 = u.pm * BM + wr * 64 + fr, col0 = u.pn * BM + wc * 32 + 8 * fq;
#pragma unroll
        for (int ai = 0; ai < 2; ++ai)
#pragma unroll
            for (int m = 0; m < 4; ++m) { bf16_t* rowp = XB + (size_t)(row0 + ai * HALF + m * 16) * 1024 + col0;
#pragma unroll
                for (int bj = 0; bj < 2; ++bj) { const u32x4 x = *(const u32x4*)(rowp + bj * HALF); f32x4 v0 = acc[ai][bj][m][0], v1 = acc[ai][bj][m][1];
                    v0[0] += alpha * __builtin_bit_cast(float, x.x << 16); v0[1] += alpha * __builtin_bit_cast(float, x.x & 0xffff0000u);
                    v0[2] += alpha * __builtin_bit_cast(float, x.y << 16); v0[3] += alpha * __builtin_bit_cast(float, x.y & 0xffff0000u);
                    v1[0] += alpha * __builtin_bit_cast(float, x.z << 16); v1[1] += alpha * __builtin_bit_cast(float, x.z & 0xffff0000u);
                    v1[2] += alpha * __builtin_bit_cast(float, x.w << 16); v1[3] += alpha * __builtin_bit_cast(float, x.w & 0xffff0000u);
                    *(u32x4*)(rowp + bj * HALF) = pack8v(v0, v1); } }
    }
};
struct EpiSwiGLU {
    static constexpr bool PERM = true;
    bf16_t* H;
    __device__ __forceinline__ void operator()(const f32x4 (&acc)[2][2][4][2], const Unit& u, int wr, int wc, int fr, int fq) const {
        const int row0 = u.pm * BM + wr * 64 + fr, col0 = u.pn * HALF + wc * 32 + 8 * fq;
#pragma unroll
        for (int ai = 0; ai < 2; ++ai)
#pragma unroll
            for (int m = 0; m < 4; ++m) { f32x4 v0 = acc[ai][0][m][0], v1 = acc[ai][0][m][1]; const f32x4 u0 = acc[ai][1][m][0], u1 = acc[ai][1][m][1];
#pragma unroll
                for (int j = 0; j < 4; ++j) { v0[j] = silu_f(v0[j]) * u0[j]; v1[j] = silu_f(v1[j]) * u1[j]; }
                *(u32x4*)(H + (size_t)(row0 + ai * HALF + m * 16) * 3584 + col0) = pack8v(v0, v1); }
    }
};
struct EpiQKV {
    static constexpr bool PERM = true;
    bf16_t* P;
    __device__ __forceinline__ void operator()(const f32x4 (&acc)[2][2][4][2], const Unit& u, int wr, int wc, int fr, int fq) const {
        const int row0 = u.pm * BM + wr * 64 + fr, cl = wc * 32 + 8 * fq;
        const int which = u.pn / 6, g = (u.pn % 6) >> 1, hp = u.pn & 1, sh = 2 * g;
#pragma unroll
        for (int ai = 0; ai < 2; ++ai)
#pragma unroll
            for (int m = 0; m < 4; ++m) { const int r = row0 + ai * HALF + m * 16, b = r >> 14, t = r & 16383;
                const int perm = (t & ((1 << sh) - 1)) * (16384 >> sh) + (t >> sh);
#pragma unroll
                for (int bj = 0; bj < 2; ++bj) { const int head = 2 * hp + bj;
                    bf16_t* dst = P + ((size_t)(((which * 3 + g) * 8 + b * 4 + head) * 16384 + perm) << 7) + cl;
                    *(u32x4*)dst = pack8v(acc[ai][bj][m][0], acc[ai][bj][m][1]); } }
    }
};
struct EpiBf16Y {
    static constexpr bool PERM = true;
    bf16_t* Y;
    __device__ __forceinline__ void operator()(const f32x4 (&acc)[2][2][4][2], const Unit& u, int wr, int wc, int fr, int fq) const {
        const int row0 = u.pm * BM + wr * 64 + fr, col0 = u.pn * BM + wc * 32 + 8 * fq;
#pragma unroll
        for (int ai = 0; ai < 2; ++ai)
#pragma unroll
            for (int m = 0; m < 4; ++m) { bf16_t* rp = Y + (size_t)(row0 + ai * HALF + m * 16) * 1024 + col0;
#pragma unroll
                for (int bj = 0; bj < 2; ++bj) *(u32x4*)(rp + bj * HALF) = pack8v(acc[ai][bj][m][0], acc[ai][bj][m][1]); }
    }
};
}
namespace swa {
constexpr int D = 128; constexpr float THR = 8.f; constexpr bool WSKIP = true; constexpr int LSE_LDS_OFF = 131072;
constexpr float SCALE = 0.08838834764831845f;
constexpr int NW = 8, QBLK = 32, KVBLK = 64, QB = NW * QBLK;
constexpr int SHM_V = KVBLK * D * 2, SHM_K = KVBLK * D * 2;
constexpr int LDS_BYTES = 2 * SHM_V + 2 * SHM_K + NW * 64 * 4;

using bf16 = __hip_bfloat16;
typedef short bf16x8 __attribute__((ext_vector_type(8)));
typedef short s16x4 __attribute__((ext_vector_type(4)));
typedef float f32x16 __attribute__((ext_vector_type(16)));
typedef float f32x4 __attribute__((ext_vector_type(4)));
typedef unsigned u32x4 __attribute__((ext_vector_type(4)));
template <class A, class Bt> struct same_t { static constexpr bool v = false; };
template <class A> struct same_t<A, A> { static constexpr bool v = true; };

#define KSWZ(row, colB) ((row) * 256 + ((colB) ^ (((row) & 7) << 4)))
#define SBAR() __builtin_amdgcn_sched_barrier(0)
__device__ __forceinline__ int v_st(int k, int c) { const int kk = (k & ~0xC) | ((k & 4) << 1) | ((k & 8) >> 1); return ((kk >> 3) * 4 + (c >> 5)) * 512 + ((kk & 7) * 32 + (c & 31)) * 2; }
__device__ __forceinline__ int v_rd_base(int lane) { return ((lane & 3) << 3) | (((lane >> 2) & 3) << 6) | (((lane >> 4) & 1) << 5) | (((lane >> 5) & 1) << 8); }
constexpr int v_rd_off(int d0, int ks, int half) { return d0 * 512 + ks * 4096 + half * 2048; }
__device__ __forceinline__ int crow(int r, int hi) { return (r & 3) + 8 * (r >> 2) + 4 * hi; }
__device__ __forceinline__ unsigned cvtpk(float lo, float hi) {
    unsigned r; asm volatile("v_cvt_pk_bf16_f32 %0, %1, %2" : "=v"(r) : "v"(lo), "v"(hi)); return r;
}
__device__ __forceinline__ bf16x8 pack8(f32x4 a, f32x4 b) {
    u32x4 w = {cvtpk(a[0], a[1]), cvtpk(a[2], a[3]), cvtpk(b[0], b[1]), cvtpk(b[2], b[3])};
    return *reinterpret_cast<bf16x8*>(&w);
}
template <class T> __device__ __forceinline__ bf16x8 load8(const T* p) {
    if constexpr (same_t<T, float>::v) { return pack8(*(const f32x4*)p, *(const f32x4*)(p + 4)); }
    else { return *reinterpret_cast<const bf16x8*>(p); }
}
__device__ __forceinline__ void mask_tile(f32x16& p0, f32x16& p1, int dq, unsigned W) {
    const float NEG = -__builtin_inff();
#pragma unroll
    for (int r = 0; r < 16; ++r) {
        const int c = (r & 3) + 8 * (r >> 2);
        if ((unsigned)(dq - c) >= W) p0[r] = NEG;
        if ((unsigned)(dq - c - 32) >= W) p1[r] = NEG;
    }
}
__device__ __forceinline__ void partialSM(f32x16& p0, f32x16& p1, float& m_reg, float& mn, float& alpha) {
    float pmax = p0[0]; for (int r = 1; r < 16; ++r) pmax = fmaxf(pmax, p0[r]); for (int r = 0; r < 16; ++r) pmax = fmaxf(pmax, p1[r]);
    { auto rr = __builtin_amdgcn_permlane32_swap(__float_as_uint(pmax), __float_as_uint(pmax), false, false);
      pmax = fmaxf(__uint_as_float(rr[0]), __uint_as_float(rr[1])); }
    constexpr float C2 = 1.4426950408889634f * SCALE;
    if (__builtin_expect(__all((pmax - m_reg) * SCALE <= THR), 1)) { mn = m_reg; alpha = 1.f; }
    else { mn = fmaxf(m_reg, pmax); alpha = __builtin_amdgcn_exp2f((m_reg - mn) * C2); m_reg = mn; }
    const float mnL = -mn * C2;
    for (int r = 0; r < 16; ++r) p0[r] = fmaf(p0[r], C2, mnL); for (int r = 0; r < 16; ++r) p1[r] = fmaf(p1[r], C2, mnL);
    for (int r = 0; r < 16; ++r) p0[r] = __builtin_amdgcn_exp2f(p0[r]);
}
__device__ __forceinline__ void finishSM(f32x16& p0, f32x16& p1, float alpha, float& l_reg, bf16x8& pa0, bf16x8& pa1, bf16x8& pa2, bf16x8& pa3) {
    for (int r = 0; r < 16; ++r) p1[r] = __builtin_amdgcn_exp2f(p1[r]);
    float ps = 0; for (int r = 0; r < 16; ++r) ps += p0[r]; for (int r = 0; r < 16; ++r) ps += p1[r];
    { auto rr = __builtin_amdgcn_permlane32_swap(__float_as_uint(ps), __float_as_uint(ps), false, false);
      ps = __uint_as_float(rr[0]) + __uint_as_float(rr[1]); }
    l_reg = l_reg * alpha + ps;
#define PK4(P, B_, OUT) do { unsigned a0 = cvtpk(P[B_+0], P[B_+1]), a1 = cvtpk(P[B_+2], P[B_+3]);                          \
        unsigned b0 = cvtpk(P[B_+4], P[B_+5]), b1 = cvtpk(P[B_+6], P[B_+7]);                                             \
        auto r0 = __builtin_amdgcn_permlane32_swap(a0, b0, false, false); auto r1 = __builtin_amdgcn_permlane32_swap(a1, b1, false, false); \
        u32x4 w = {r0[0], r1[0], r0[1], r1[1]}; OUT = *reinterpret_cast<bf16x8*>(&w); } while (0)
    PK4(p0, 0, pa0); PK4(p0, 8, pa1); PK4(p1, 0, pa2); PK4(p1, 8, pa3);
#undef PK4
}
template <int KB, bool SK>
__device__ __forceinline__ void qkt(f32x16& p0, f32x16& p1, const char* K_lds, int r32, int hi, const bf16x8* qr, bool act) {
    if (SK && !act) { const float NEG = -__builtin_inff();
#pragma unroll
        for (int r = 0; r < 16; ++r) { p0[r] = NEG; p1[r] = NEG; } return; }
    p0 = f32x16{}; p1 = f32x16{};
    const char* kb[4];
#pragma unroll
    for (int dd = 0; dd < 4; ++dd) kb[dd] = K_lds + KB * SHM_K + KSWZ(r32, (dd * 16 + hi * 8) * 2);
#pragma unroll
    for (int d0 = 0; d0 < 8; ++d0) { const char* a = kb[d0 & 3] + (d0 >> 2) * 128;
        bf16x8 b0 = *reinterpret_cast<const bf16x8*>(a);
        bf16x8 b1 = *reinterpret_cast<const bf16x8*>(a + 32 * 256);
        p0 = __builtin_amdgcn_mfma_f32_32x32x16_bf16(b0, qr[d0], p0, 0, 0, 0);
        p1 = __builtin_amdgcn_mfma_f32_32x32x16_bf16(b1, qr[d0], p1, 0, 0, 0); }
}
template <int VB, bool SK>
__device__ __forceinline__ void pv_tile(f32x16* o, int vb0, bf16x8 pa0, bf16x8 pa1, bf16x8 pa2, bf16x8 pa3, bool act) {
    if (SK && !act) return;
#define TRRD(dst, off) asm volatile("ds_read_b64_tr_b16 %0, %1 offset:%2" : "=&v"(dst) : "v"(vb0), "i"(off) : "memory")
#define PV_D0(d0) do { s16x4 l0, l1, l2, l3, h0, h1, h2, h3; constexpr int b_ = VB * SHM_V + v_rd_off(d0, 0, 0);     \
        TRRD(l0, b_); TRRD(h0, b_ + 2048); TRRD(l1, b_ + 4096); TRRD(h1, b_ + 6144); TRRD(l2, b_ + 8192); TRRD(h2, b_ + 10240); TRRD(l3, b_ + 12288); TRRD(h3, b_ + 14336); \
        asm volatile("s_waitcnt lgkmcnt(0)" ::: "memory"); SBAR();                 \
        o[d0] = __builtin_amdgcn_mfma_f32_32x32x16_bf16(pa0, (bf16x8){l0[0], l0[1], l0[2], l0[3], h0[0], h0[1], h0[2], h0[3]}, o[d0], 0, 0, 0);   \
        o[d0] = __builtin_amdgcn_mfma_f32_32x32x16_bf16(pa1, (bf16x8){l1[0], l1[1], l1[2], l1[3], h1[0], h1[1], h1[2], h1[3]}, o[d0], 0, 0, 0);   \
        o[d0] = __builtin_amdgcn_mfma_f32_32x32x16_bf16(pa2, (bf16x8){l2[0], l2[1], l2[2], l2[3], h2[0], h2[1], h2[2], h2[3]}, o[d0], 0, 0, 0);   \
        o[d0] = __builtin_amdgcn_mfma_f32_32x32x16_bf16(pa3, (bf16x8){l3[0], l3[1], l3[2], l3[3], h3[0], h3[1], h3[2], h3[3]}, o[d0], 0, 0, 0); } while (0)
    PV_D0(0); PV_D0(1); PV_D0(2); PV_D0(3);
#undef PV_D0
#undef TRRD
}

template <class TIn, class TOut> struct BlockRef { const TIn* Q; const TIn* K; const TIn* V; TOut* O; int P0; };
template <class TIn> struct Seam {
    int tid;
    bf16x8 qr[8];
    bf16x8 st_v0, st_v1, st_k0, st_k1; f32x4 sf0, sf1, sf2, sf3;
    f32x4 tq[16];
};
__device__ __forceinline__ int swa_jlo(int P0, int W) { const int lowk = P0 - W + 1; return lowk > 0 ? lowk / KVBLK : 0; }
#define ROW(p, k0, rr) ((p) + (size_t)((k0) + (rr)) * D + sc)
#define VMW() asm volatile("s_waitcnt vmcnt(0)" ::: "memory")
#define VMWN(n) asm volatile("s_waitcnt vmcnt(%0)" :: "i"(n) : "memory")
#define SLOAD_H(Kp, Vp, k0) do { S.st_v0 = load8<TIn>(ROW(Vp, k0, sr)); S.st_v1 = load8<TIn>(ROW(Vp, k0, 32 + sr));              \
                         S.st_k0 = load8<TIn>(ROW(Kp, k0, sr)); S.st_k1 = load8<TIn>(ROW(Kp, k0, 32 + sr)); } while (0)
#define SWRITE_HK(bf) do { *(bf16x8*)(K_lds + (bf) * SHM_K + kws) = S.st_k0; *(bf16x8*)(K_lds + (bf) * SHM_K + kws + 32 * 256) = S.st_k1; } while (0)
#define SWRITE_HV(bf) do { *(bf16x8*)(V_lds + (bf) * SHM_V + vst0) = S.st_v0; *(bf16x8*)(V_lds + (bf) * SHM_V + vst1) = S.st_v1; } while (0)
#define SWRITE_H(bf) do { SWRITE_HV(bf); SWRITE_HK(bf); } while (0)
#define SLOAD_F(p, k0) do { S.sf0 = *(const f32x4*)ROW(p, k0, sr); S.sf1 = *(const f32x4*)(ROW(p, k0, sr) + 4);                \
                            S.sf2 = *(const f32x4*)ROW(p, k0, 32 + sr); S.sf3 = *(const f32x4*)(ROW(p, k0, 32 + sr) + 4); } while (0)
#define SWRITE_KF(bf) do { *(bf16x8*)(K_lds + (bf) * SHM_K + kws) = pack8(S.sf0, S.sf1); *(bf16x8*)(K_lds + (bf) * SHM_K + kws + 32 * 256) = pack8(S.sf2, S.sf3); } while (0)
#define SWRITE_VF(bf) do { *(bf16x8*)(V_lds + (bf) * SHM_V + vst0) = pack8(S.sf0, S.sf1); *(bf16x8*)(V_lds + (bf) * SHM_V + vst1) = pack8(S.sf2, S.sf3); } while (0)
template <class TIn, class TOut>
__device__ __forceinline__ void causal_swa_prime(const BlockRef<TIn, TOut>& cur, int W, char* lds, Seam<TIn>& S) {
    constexpr bool F32 = same_t<TIn, float>::v;
    const int tid = S.tid, wid = __builtin_amdgcn_readfirstlane(tid >> 6), lane = tid & 63, r32 = lane & 31, hi = lane >> 5;
    const int sr = tid >> 4, sc = (tid & 15) * 8, kws = KSWZ(sr, sc * 2); char* K_lds = lds + 2 * SHM_V;
    const int kb0 = swa_jlo(cur.P0, W) * KVBLK;
    for (int d0 = 0; d0 < 8; ++d0) S.qr[d0] = load8<TIn>(cur.Q + (size_t)(wid * QBLK + r32) * D + d0 * 16 + hi * 8);
    if constexpr (F32) { SLOAD_F((const float*)cur.K, kb0); VMW(); SWRITE_KF(0); SBAR(); SLOAD_F((const float*)cur.V, kb0); }
    else { SLOAD_H(cur.K, cur.V, kb0); VMW(); SWRITE_HK(0); }
    __syncthreads();
}
template <class TIn, class TOut>
__device__ __forceinline__ void causal_swa_block(const BlockRef<TIn, TOut>& cur, const BlockRef<TIn, TOut>& nxt, int skv, int W, char* lds, Seam<TIn>& S) {
    constexpr bool F32 = same_t<TIn, float>::v;
    const int tid = S.tid, wid = __builtin_amdgcn_readfirstlane(tid >> 6), lane = tid & 63, r32 = lane & 31, hi = lane >> 5;
    const int j_lo = swa_jlo(cur.P0, W);
    int j_hi = (cur.P0 + QB - 1) / KVBLK + 1; if (j_hi > skv / KVBLK) j_hi = skv / KVBLK;
    const int NT = j_hi - j_lo;
    const int kbn = swa_jlo(nxt.P0, W) * KVBLK;
    const int qlo = cur.P0 + wid * QBLK, qm = qlo + r32 - 4 * hi;
    char* V_lds = lds; char* K_lds = lds + 2 * SHM_V;
    float* ws = (float*)(lds + 2 * SHM_V + 2 * SHM_K) + wid * 64; float* li_l = ws, * al_l = ws + 32;
    float m_reg = -1e30f, l_reg = 0; f32x16 o[4] = {};
    const int sr = tid >> 4, sc = (tid & 15) * 8, vst0 = v_st(sr, sc), vst1 = v_st(32 + sr, sc), kws = KSWZ(sr, sc * 2);
    const int vb0 = (int)(uintptr_t)V_lds + v_rd_base(lane);
    const TIn* Kh = cur.K; const TIn* Vh = cur.V;
#define RESC(a) do { if (__any((a) < 1.f)) { if (hi == 0) al_l[r32] = (a); asm volatile("s_waitcnt lgkmcnt(0)" ::: "memory");              \
                     for (int d_ = 0; d_ < 4; ++d_) for (int r = 0; r < 16; ++r) o[d_][r] *= al_l[crow(r, hi)]; } } while (0)
#define KBASE(t) ((j_lo + (t)) * KVBLK)
#define ACT(t) (KBASE(t) <= qlo + QBLK - 1 && KBASE(t) + KVBLK - 1 >= qlo - W + 1)
#define MASKT(P0_, P1_, t) do { const int kb_ = KBASE(t); if ((!SK || ACT(t)) && (kb_ + KVBLK - 1 > qlo || kb_ <= qlo + QBLK - 1 - W)) mask_tile(P0_, P1_, qm - kb_, (unsigned)W); } while (0)
    constexpr int NQL = F32 ? 16 : 8;
    constexpr bool SK = WSKIP && !F32;
#define SEAM_K0() do { VMWN(NQL); if constexpr (F32) { SWRITE_KF(0); SBAR(); SLOAD_F((const float*)nxt.V, kbn); } else { SWRITE_HK(0); } SBAR(); } while (0)
    f32x16 pA0, pA1, pB0, pB1; float mnA, mnB, alA, alB; bf16x8 pa0, pa1, pa2, pa3;
    if constexpr (F32) { VMW(); SWRITE_VF(0); SBAR(); } else { SWRITE_HV(0); SBAR(); }
    if (NT > 1) { if constexpr (F32) SLOAD_F((const float*)Kh, KBASE(1)); else SLOAD_H(Kh, Vh, KBASE(1)); }
    SBAR(); qkt<0, SK>(pA0, pA1, K_lds, r32, hi, S.qr, ACT(0));
    if constexpr (F32) { if (NT > 1) { VMW(); SWRITE_KF(1); SBAR(); SLOAD_F((const float*)Vh, KBASE(1)); } }
    MASKT(pA0, pA1, 0); partialSM(pA0, pA1, m_reg, mnA, alA);
    if (NT > 1) { VMW(); if constexpr (F32) { SWRITE_VF(1); SBAR(); if (NT > 2) SLOAD_F((const float*)Kh, KBASE(2)); } else SWRITE_H(1); }
    __syncthreads();
#define HALF_STEP(PX0, PX1, mnX, alX, PY0, PY1, alY, t, KB, VB, SB) do {                                                      \
        SBAR(); qkt<KB, SK>(PX0, PX1, K_lds, r32, hi, S.qr, ACT(t));                                             \
        finishSM(PY0, PY1, alY, l_reg, pa0, pa1, pa2, pa3); SBAR();                                                           \
        if ((t) + 1 < NT) { if constexpr (F32) { VMW(); SWRITE_KF(SB); SBAR(); SLOAD_F((const float*)Vh, KBASE((t) + 1)); }  \
                            else { SLOAD_H(Kh, Vh, KBASE((t) + 1)); } SBAR(); }                                               \
        pv_tile<VB, SK>(o, vb0, pa0, pa1, pa2, pa3, ACT((t) - 1)); MASKT(PX0, PX1, (t)); partialSM(PX0, PX1, m_reg, mnX, alX);                                        \
        __syncthreads();                                                                                                      \
        if ((t) + 1 < NT) { VMW(); if constexpr (F32) { SWRITE_VF(SB); SBAR(); if ((t) + 2 < NT) SLOAD_F((const float*)Kh, KBASE((t) + 2)); } \
                            else { SWRITE_H(SB); } }                                                                          \
        RESC(alX); __syncthreads(); } while (0)
    for (int t = 1; t + 1 < NT; t += 2) {
        HALF_STEP(pB0, pB1, mnB, alB, pA0, pA1, alA, t, 1, 0, 0);
        HALF_STEP(pA0, pA1, mnA, alA, pB0, pB1, alB, t + 1, 0, 1, 1);
    }
    const bool even = (NT & 1) == 0;
    if (even) { SBAR(); qkt<1, SK>(pB0, pB1, K_lds, r32, hi, S.qr, ACT(NT - 1)); SBAR(); }
#define QROW(e) (nxt.Q + (size_t)(wid * QBLK + r32) * D + ((e) >> 1) * 16 + hi * 8 + ((e) & 1) * 4)
    if constexpr (F32) { SLOAD_F((const float*)nxt.K, kbn); SBAR();
#pragma unroll
        for (int e = 0; e < 8; ++e) S.tq[e] = *(const f32x4*)QROW(e); }
    else { SLOAD_H(nxt.K, nxt.V, kbn); SBAR();
#pragma unroll
        for (int d0 = 0; d0 < 8; ++d0) S.qr[d0] = load8<TIn>(nxt.Q + (size_t)(wid * QBLK + r32) * D + d0 * 16 + hi * 8); }
    SBAR();
    finishSM(pA0, pA1, alA, l_reg, pa0, pa1, pa2, pa3); SBAR();
    if constexpr (F32) {
#pragma unroll
        for (int e = 8; e < 16; ++e) S.tq[e] = *(const f32x4*)QROW(e); SBAR(); }
#undef QROW
    pv_tile<0, SK>(o, vb0, pa0, pa1, pa2, pa3, ACT(even ? NT - 2 : NT - 1));
    if (even) { MASKT(pB0, pB1, NT - 1); partialSM(pB0, pB1, m_reg, mnB, alB); __syncthreads(); RESC(alB);
        finishSM(pB0, pB1, alB, l_reg, pa0, pa1, pa2, pa3); SBAR(); pv_tile<1, SK>(o, vb0, pa0, pa1, pa2, pa3, ACT(NT - 1)); }
    SBAR(); SEAM_K0();
    if (hi == 0) { li_l[r32] = l_reg; ((float*)(lds + LSE_LDS_OFF))[wid * QBLK + r32] = m_reg * SCALE + __logf(l_reg); } asm volatile("s_waitcnt lgkmcnt(0)" ::: "memory");
    float rli[16];
#pragma unroll
    for (int r = 0; r < 16; ++r) rli[r] = __builtin_amdgcn_rcpf(li_l[crow(r, hi)]);
    TOut* Ow = cur.O + (size_t)(wid * QBLK) * D + (size_t)(hi * 4) * D + r32;
#pragma unroll
    for (int r = 0; r < 16; ++r) { const int orow = (r & 3) + 8 * (r >> 2);
#pragma unroll
        for (int d0 = 0; d0 < 4; ++d0) { const float v = o[d0][r] * rli[r];
            if constexpr (same_t<TOut, float>::v) { Ow[orow * D + d0 * 32] = v; }
            else { const float vn = __shfl_xor(v, 1);
                   if ((r32 & 1) == 0) *(unsigned*)(Ow + orow * D + d0 * 32) = cvtpk(v, vn); } } }
    if constexpr (F32) {
#pragma unroll
        for (int d0 = 0; d0 < 8; ++d0) S.qr[d0] = pack8(S.tq[2 * d0], S.tq[2 * d0 + 1]); }
    __syncthreads();
#undef RESC
#undef KBASE
#undef ACT
#undef MASKT
#undef SEAM_K0
#undef HALF_STEP
}
#undef ROW
#undef VMW
#undef VMWN
#undef SLOAD_H
#undef SWRITE_HK
#undef SWRITE_HV
#undef SWRITE_H
#undef SLOAD_F
#undef SWRITE_KF
#undef SWRITE_VF
}
constexpr int T_TOK = 32768, DMODEL = 1024, SEQ = 16384, DFF = 3584, NEXP = 8;
constexpr float ALPHA = 1.6817928305074290f, LN_EPS = 1e-5f;
constexpr int NWAVES = 8;
constexpr size_t MiB = 1u << 20;
constexpr size_t WS_CTL = 0, CTL_ZERO_BYTES = 1 * MiB;
constexpr size_t WS_WIN = 2 * MiB, WS_WRO = 26 * MiB, WS_WQKV = 34 * MiB, WS_WAO = 52 * MiB, WS_WGU = 54 * MiB, WS_WDN = 82 * MiB;
constexpr size_t WS_TAB = 96 * MiB, WS_XB = 112 * MiB, WS_LIST = 176 * MiB, WS_TSLOT = 177 * MiB, WS_GATE = 177 * MiB + 512 * 1024;
constexpr size_t WS_BIG = 178 * MiB;
constexpr size_t BIG_QD = 0, BIG_KH = 64 * MiB, BIG_VT = 128 * MiB, BIG_G = 256 * MiB, BIG_RT = 384 * MiB;
constexpr size_t BIG_HID = 0;
constexpr size_t BIG_QKV = 0, BIG_OP = 288 * MiB, BIG_LSE = 384 * MiB, BIG_O = 386 * MiB;
constexpr size_t BIG_YP = 462 * MiB, BIG_WMGU = 594 * MiB, BIG_WMD = 706 * MiB;
constexpr size_t WS_END = WS_BIG + 762 * MiB;
constexpr int CW_TMO = 0, CW_BAR = 4096, CW_CNT = 8192;
constexpr int RING_OFF = 0, RING_BYTES = 131072, AUX_OFF = 131072, AUX_BYTES = 30720, MISC_OFF = AUX_OFF + AUX_BYTES, LDS_BYTES = MISC_OFF + 512;
static_assert(LDS_BYTES <= 163840, "LDS");

#define GAS __attribute__((address_space(1)))
#define LAS __attribute__((address_space(3)))
typedef unsigned short bf16;
typedef unsigned v4u __attribute__((ext_vector_type(4)));
typedef unsigned v2u __attribute__((ext_vector_type(2)));
typedef float f32x4 __attribute__((ext_vector_type(4)));
typedef float f32x16 __attribute__((ext_vector_type(16)));
typedef short bf16x8 __attribute__((ext_vector_type(8)));
typedef short s16x4 __attribute__((ext_vector_type(4)));
typedef GAS unsigned gu32;
#define RLX_AGENT __ATOMIC_RELAXED, __HIP_MEMORY_SCOPE_AGENT
#define LDS_WAIT() asm volatile("s_waitcnt lgkmcnt(0)" ::: "memory")
#define VM_WAIT() asm volatile("s_waitcnt vmcnt(0)" ::: "memory")
__device__ __forceinline__ unsigned f2bf(float f) { unsigned u = __builtin_bit_cast(unsigned, f); return (u + 0x7fffu + ((u >> 16) & 1u)) >> 16; }
__device__ __forceinline__ unsigned pk2(float lo, float hi) { return f2bf(lo) | (f2bf(hi) << 16); }
__device__ __forceinline__ float bflo(unsigned w) { return __builtin_bit_cast(float, w << 16); }
__device__ __forceinline__ float bfhi(unsigned w) { return __builtin_bit_cast(float, w & 0xffff0000u); }
#define XB_TMO      128
#define XB_XCNT(j)  (256  + 64 * (j))
#define XB_XSUB(j)  (1280 + 64 * (j))
#define XB_XGEN(j)  (2304 + 64 * (j))
#define XB_TOP      3328
#define XB_TOPGEN   3392
#define XCD_BAR_WORDS 3456
#define XB_SPIN_CAP (1u << 18)

__device__ __forceinline__ unsigned xb_ld(unsigned* p)              { return __hip_atomic_load(p, __ATOMIC_RELAXED, __HIP_MEMORY_SCOPE_AGENT); }
__device__ __forceinline__ unsigned xb_add(unsigned* p, unsigned v) { return __hip_atomic_fetch_add(p, v, __ATOMIC_RELAXED, __HIP_MEMORY_SCOPE_AGENT); }
__device__ __forceinline__ unsigned xb_xcc_id() { return (unsigned)__builtin_amdgcn_s_getreg((3 << 11) | 20) & 0xFu; }
#define XB_SPIN(cond, bar) do { unsigned _sp = 0; while (cond) { __builtin_amdgcn_s_sleep(1); \
    if ((++_sp & 255u) == 0u) { if (xb_ld(&(bar)[XB_TMO])) break; if (_sp > XB_SPIN_CAP) { atomicAdd(&(bar)[XB_TMO], 1u); break; } } } } while (0)

struct XcdBarrier {
    unsigned* bar; unsigned x;
    volatile LAS unsigned* st;
};

__device__ __forceinline__ XcdBarrier xcd_barrier_post(unsigned* bar, volatile LAS unsigned* st) {
    XcdBarrier b; b.bar = bar; b.x = xb_xcc_id(); b.st = st;
    if (threadIdx.x == 0) (void)xb_add(&bar[XB_XCNT(b.x)], 1u);
    return b;
}
__device__ __forceinline__ void xcd_barrier_complete(unsigned* bar, unsigned x, unsigned& nloc, unsigned& nx) {
    const unsigned G = gridDim.x * gridDim.y * gridDim.z;
    unsigned sum, cnt, mine, sp = 0u;
    for (;;) {
        sum = 0u; cnt = 0u; mine = 0u;
#pragma unroll
        for (unsigned j = 0; j < 16; ++j) { const unsigned c = xb_ld(&bar[XB_XCNT(j)]); sum += c; cnt += (c > 0u) ? 1u : 0u; mine = (j == x) ? c : mine; }
        if (sum == G) break;
        __builtin_amdgcn_s_sleep(1);
        if ((++sp & 255u) == 0u) { if (xb_ld(&bar[XB_TMO])) break; if (sp > XB_SPIN_CAP) { atomicAdd(&bar[XB_TMO], 1u); break; } }
    }
    nloc = mine > 0u ? mine : 1u; nx = cnt > 0u ? cnt : 1u;
}

__device__ __forceinline__ void xcd_barrier(const XcdBarrier& b) {
    asm volatile("s_waitcnt vmcnt(0)" ::: "memory");
    __syncthreads();
    if (threadIdx.x == 0) {
        unsigned* bar = b.bar;
        __builtin_amdgcn_s_waitcnt(0);
        unsigned nloc = b.st[0], nx = b.st[1];
        if (nloc == 0u) { xcd_barrier_complete(bar, b.x, nloc, nx); b.st[0] = nloc; b.st[1] = nx; }
        const unsigned old = xb_add(&bar[XB_XSUB(b.x)], 1u);
        const unsigned gen = old / nloc;
        if (old + 1u == (gen + 1u) * nloc) {
            __builtin_amdgcn_fence(__ATOMIC_RELEASE, "agent");
            asm volatile("s_waitcnt vmcnt(0)" ::: "memory");
            const unsigned og = xb_add(&bar[XB_TOP], 1u);
            const unsigned tg = og / nx;
            if (og + 1u == (tg + 1u) * nx) xb_add(&bar[XB_TOPGEN], 1u);
            else XB_SPIN(xb_ld(&bar[XB_TOPGEN]) == tg, bar);
            __builtin_amdgcn_fence(__ATOMIC_ACQUIRE, "agent");
            xb_add(&bar[XB_XGEN(b.x)], 1u);
            asm volatile("s_waitcnt vmcnt(0)" ::: "memory");
        } else {
            XB_SPIN(xb_ld(&bar[XB_XGEN(b.x)]) == gen, bar);
            __builtin_amdgcn_fence(__ATOMIC_ACQUIRE, "agent");
            asm volatile("s_waitcnt vmcnt(0)" ::: "memory");
        }
    }
    __syncthreads();
}
struct Args { const float* in[15]; float* out; unsigned char* ws; };
struct Frame {
    LAS unsigned char* lds;
    volatile LAS unsigned* MISC;
    int tid, lane, wave, G, c;
};
__device__ __forceinline__ unsigned long long arg_u64(const Frame& F, int k) { const unsigned long long v = ((const LAS unsigned long long*)(F.lds + MISC_OFF + 128))[k];
    return ((unsigned long long)(unsigned)__builtin_amdgcn_readfirstlane((int)(unsigned)(v >> 32)) << 32) | (unsigned long long)(unsigned)__builtin_amdgcn_readfirstlane((int)(unsigned)v); }
#define ARGI(F, k) ((const float*)(const GAS float*)arg_u64(F, (k)))
#define ARGX(F) ((float*)(GAS float*)arg_u64(F, 15))
#define ARGWS(F) ((unsigned char*)(GAS unsigned char*)arg_u64(F, 16))
#define F_CTL(F) ((gu32*)(ARGWS(F) + WS_CTL))
__device__ __forceinline__ void frame_refresh(Frame& F) { int t = F.tid; asm volatile("" : "+v"(t)); F.tid = t; F.lane = t & 63; F.wave = __builtin_amdgcn_readfirstlane(t >> 6); unsigned l = (unsigned)(uintptr_t)F.lds; int c_ = F.c, g_ = F.G; asm volatile("" : "+s"(l), "+s"(c_), "+s"(g_)); F.lds = (LAS unsigned char*)(uintptr_t)l; F.c = c_; F.G = g_; }
__device__ __forceinline__ float wave_sum(float v) {
#pragma unroll
    for (int o = 1; o < 64; o <<= 1) v += __shfl_xor(v, o);
    return v;
}
__device__ __forceinline__ s16x4 vtr(const LAS unsigned char* p) { return __builtin_bit_cast(s16x4, __builtin_amdgcn_ds_read_tr16_b64_v4i16((LAS s16x4*)p)); }
__device__ __forceinline__ int crow(int r, int hi) { return (r & 3) + 8 * (r >> 2) + 4 * hi; }

__device__ __forceinline__ void tr_item(const float* W, int K, int N, bf16* WT, int k0, int n0, int drow0, LAS float* scr, int lane) {
#pragma unroll 8
    for (int i = 0; i < 32; ++i) { const int kk = 2 * i + (lane >> 5); scr[kk * 33 + (lane & 31)] = W[(size_t)(k0 + kk) * N + n0 + (lane & 31)]; }
    LDS_WAIT(); asm volatile("" ::: "memory");
    const int c = lane & 7;
#pragma unroll
    for (int j = 0; j < 4; ++j) { const int n = (lane >> 3) + 8 * j; const LAS float* s = scr + (8 * c) * 33 + n;
        v4u o; o.x = pk2(s[0 * 33], s[1 * 33]); o.y = pk2(s[2 * 33], s[3 * 33]); o.z = pk2(s[4 * 33], s[5 * 33]); o.w = pk2(s[6 * 33], s[7 * 33]);
        *(GAS v4u*)(WT + (size_t)(drow0 + n) * K + k0 + 8 * c) = o; }
    LDS_WAIT(); asm volatile("" ::: "memory");
}
template <int MAP> __device__ __forceinline__ void tr_matrix_item(const float* W, int K, int N, bf16* WT, int item, LAS float* scr, int lane) {
    const int nblk = N / 32, kb = item / nblk, nb = item - kb * nblk, n0 = 32 * nb; int dr = n0;
    if (MAP == 1) dr = n0 < 2048 ? n0 : (n0 < 4096 ? n0 + 2048 : n0 - 2048);
    if (MAP == 2) dr = (n0 >> 7) * 256 + (n0 & 127);
    if (MAP == 3) dr = (n0 >> 7) * 256 + 128 + (n0 & 127);
    tr_item(W, K, N, WT, 64 * kb, n0, dr, scr, lane);
}
__device__ __forceinline__ void p0_prologue(Frame& F) {
    LAS float* scr = (LAS float*)(F.lds + RING_OFF + F.wave * 16384);
    const int gw = F.c * NWAVES + F.wave, NGW = F.G * NWAVES;
    constexpr int I_WIN = 16 * 192, I_WRO = 32 * 32, I_QKV = 16 * 144, I_WAO = 8 * 32, I_GU = 16 * 112, I_DN = 56 * 32;
    constexpr int PERJ = I_WIN + I_WRO + I_QKV + I_WAO + 2 * I_GU + I_DN;
    for (int it = gw; it < 2 * PERJ; it += NGW) {
        const int j = it / PERJ; int r = it - j * PERJ;
        if (r < I_WIN) { tr_matrix_item<1>(ARGI(F, 3) + (size_t)j * 1024 * 6144, 1024, 6144, (bf16*)(ARGWS(F) + WS_WIN) + (size_t)j * 6144 * 1024, r, scr, F.lane); continue; } r -= I_WIN;
        if (r < I_WRO) { tr_matrix_item<0>(ARGI(F, 5) + (size_t)j * 2048 * 1024, 2048, 1024, (bf16*)(ARGWS(F) + WS_WRO) + (size_t)j * 1024 * 2048, r, scr, F.lane); continue; } r -= I_WRO;
        if (r < I_QKV) { tr_matrix_item<0>(ARGI(F, 6) + (size_t)j * 1024 * 4608, 1024, 4608, (bf16*)(ARGWS(F) + WS_WQKV) + (size_t)j * 4608 * 1024, r, scr, F.lane); continue; } r -= I_QKV;
        if (r < I_WAO) { tr_matrix_item<0>(ARGI(F, 7) + (size_t)j * 512 * 1024, 512, 1024, (bf16*)(ARGWS(F) + WS_WAO) + (size_t)j * 1024 * 512, r, scr, F.lane); continue; } r -= I_WAO;
        if (r < I_GU) { tr_matrix_item<2>(ARGI(F, 8) + (size_t)j * 1024 * 3584, 1024, 3584, (bf16*)(ARGWS(F) + WS_WGU) + (size_t)j * 7168 * 1024, r, scr, F.lane); continue; } r -= I_GU;
        if (r < I_GU) { tr_matrix_item<3>(ARGI(F, 9) + (size_t)j * 1024 * 3584, 1024, 3584, (bf16*)(ARGWS(F) + WS_WGU) + (size_t)j * 7168 * 1024, r, scr, F.lane); continue; } r -= I_GU;
        tr_matrix_item<0>(ARGI(F, 10) + (size_t)j * 3584 * 1024, 3584, 1024, (bf16*)(ARGWS(F) + WS_WDN) + (size_t)j * 1024 * 3584, r, scr, F.lane);
    }
    { float* tab = (float*)(ARGWS(F) + WS_TAB); const int gt = F.c * 512 + F.tid, NT = F.G * 512;
      for (int e = gt; e < SEQ * 128; e += NT) { const int pos = e >> 7, cc = e & 127;
          const double ang = (double)pos * exp(-9.210340371976184 * (double)cc * (1.0 / 128.0)); double sn, cs; sincos(ang, &sn, &cs);
          typedef float f32x2t __attribute__((ext_vector_type(2))); *(GAS f32x2t*)(tab + (size_t)e * 2) = (f32x2t){(float)cs, (float)sn}; } }
    { const float* x = ARGI(F, 0); bf16* XB = (bf16*)(ARGWS(F) + WS_XB);
      for (int m = gw; m < T_TOK; m += NGW) { const GAS f32x4* xr = (const GAS f32x4*)(x + (size_t)m * DMODEL) + F.lane;
          GAS unsigned long long* o8 = (GAS unsigned long long*)(XB + (size_t)m * DMODEL) + F.lane;
#pragma unroll
          for (int jj = 0; jj < 4; ++jj) { const f32x4 v = xr[64 * jj]; o8[64 * jj] = (unsigned long long)pk2(v.x, v.y) | ((unsigned long long)pk2(v.z, v.w) << 32); } } }
}
__device__ __forceinline__ void moe_convert(Frame& F, int j) {
    LAS float* scr = (LAS float*)(F.lds + RING_OFF + F.wave * 16384);
    const int gw = F.c * NWAVES + F.wave, NGW = F.G * NWAVES;
    constexpr int I_GU = 16 * 112, I_DN = 56 * 32, PERE = 2 * I_GU + I_DN;
    bf16* WMGU = (bf16*)(ARGWS(F) + WS_BIG + BIG_WMGU); bf16* WMD = (bf16*)(ARGWS(F) + WS_BIG + BIG_WMD);
    for (int it = gw; it < NEXP * PERE; it += NGW) {
        const int e = it / PERE; int r = it - e * PERE; const size_t wofs = ((size_t)j * NEXP + e) * 1024 * 3584;
        if (r < I_GU) { tr_matrix_item<2>(ARGI(F, 12) + wofs, 1024, 3584, WMGU + (size_t)e * 7168 * 1024, r, scr, F.lane); continue; } r -= I_GU;
        if (r < I_GU) { tr_matrix_item<3>(ARGI(F, 13) + wofs, 1024, 3584, WMGU + (size_t)e * 7168 * 1024, r, scr, F.lane); continue; } r -= I_GU;
        tr_matrix_item<0>(ARGI(F, 14) + wofs, 3584, 1024, WMD + (size_t)e * 1024 * 3584, r, scr, F.lane);
    }
}
__device__ __forceinline__ void unpack8(const v4u w, float (&v)[8]) { v[0] = bflo(w.x); v[1] = bfhi(w.x); v[2] = bflo(w.y); v[3] = bfhi(w.y); v[4] = bflo(w.z); v[5] = bfhi(w.z); v[6] = bflo(w.w); v[7] = bfhi(w.w); }
template <int MODE, bool FINAL> __device__ __forceinline__ void ln_pass(Frame& F, int li  , int sub  , int j) {
    const int gw = F.c * NWAVES + F.wave, NGW = F.G * NWAVES;
    const float* gain = ARGI(F, 1) + (size_t)(li * 2 + sub) * DMODEL; const float* bias = ARGI(F, 2) + (size_t)(li * 2 + sub) * DMODEL;
    float gv[2][8], bv[2][8];
#pragma unroll
    for (int q = 0; q < 2; ++q)
#pragma unroll
        for (int h2 = 0; h2 < 2; ++h2) { const f32x4 g4 = *(const GAS f32x4*)(gain + 512 * q + 8 * F.lane + 4 * h2), b4 = *(const GAS f32x4*)(bias + 512 * q + 8 * F.lane + 4 * h2);
#pragma unroll
            for (int k = 0; k < 4; ++k) { gv[q][4 * h2 + k] = g4[k]; bv[q][4 * h2 + k] = b4[k]; } }
    bf16* XB = (bf16*)(ARGWS(F) + WS_XB);
    int rtb[8];
    if (MODE == 2) { int acc = 0;
#pragma unroll
        for (int e = 0; e < 8; ++e) { rtb[e] = acc; const int cnt = (int)__hip_atomic_load(F_CTL(F) + CW_CNT + (j * 8 + e) * 64, RLX_AGENT); acc += (cnt + 255) >> 8; } }
    const unsigned* tslot = (const unsigned*)(ARGWS(F) + WS_TSLOT); const float* gate = (const float*)(ARGWS(F) + WS_GATE); const bf16* YP = (const bf16*)(ARGWS(F) + WS_BIG + BIG_YP);
    for (int m = gw; m < T_TOK; m += NGW) {
        GAS v4u* xr = (GAS v4u*)(XB + (size_t)m * DMODEL) + F.lane;
        float v[2][8]; float s = 0.f;
#pragma unroll
        for (int q = 0; q < 2; ++q) unpack8(xr[64 * q], v[q]);
        if (MODE == 2) {
#pragma unroll
            for (int q = 0; q < 2; ++q)
#pragma unroll
                for (int k = 0; k < 8; ++k) v[q][k] *= ALPHA;
#pragma unroll
            for (int k2 = 0; k2 < 2; ++k2) { const unsigned ts = tslot[2 * m + k2]; const float gk = gate[2 * m + k2]; const int e = (int)(ts >> 20), slot = (int)(ts & 0xfffffu);
                int rb = 0;
#pragma unroll
                for (int q = 0; q < 8; ++q) rb = (q == e) ? rtb[q] : rb;
                const GAS v4u* yr = (const GAS v4u*)(YP + ((size_t)rb * 256 + slot) * DMODEL) + F.lane;
#pragma unroll
                for (int q = 0; q < 2; ++q) { float y[8]; unpack8(yr[64 * q], y);
#pragma unroll
                    for (int k = 0; k < 8; ++k) v[q][k] += gk * y[k]; } }
        }
#pragma unroll
        for (int q = 0; q < 2; ++q)
#pragma unroll
            for (int k = 0; k < 8; ++k) s += v[q][k];
        const float mean = wave_sum(s) * (1.f / DMODEL); float s2 = 0.f;
#pragma unroll
        for (int q = 0; q < 2; ++q)
#pragma unroll
            for (int k = 0; k < 8; ++k) { v[q][k] -= mean; s2 += v[q][k] * v[q][k]; }
        const float rstd = 1.f / sqrtf(wave_sum(s2) * (1.f / DMODEL) + LN_EPS);
#pragma unroll
        for (int q = 0; q < 2; ++q) { float o[8];
#pragma unroll
            for (int k = 0; k < 8; ++k) o[k] = v[q][k] * rstd * gv[q][k] + bv[q][k];
            if (FINAL) { GAS f32x4* op = (GAS f32x4*)(ARGX(F) + (size_t)m * DMODEL + 512 * q + 8 * F.lane); op[0] = (f32x4){o[0], o[1], o[2], o[3]}; op[1] = (f32x4){o[4], o[5], o[6], o[7]}; }
            else { v4u w; w.x = pk2(o[0], o[1]); w.y = pk2(o[2], o[3]); w.z = pk2(o[4], o[5]); w.w = pk2(o[6], o[7]); xr[64 * q] = w; } }
    }
}
__device__ __forceinline__ void ln_route_pass(Frame& F, int li, int j) {
    const float* gain = ARGI(F, 1) + (size_t)(li * 2) * DMODEL; const float* bias = ARGI(F, 2) + (size_t)(li * 2) * DMODEL;
    LAS float* WRT = (LAS float*)(F.lds + RING_OFF);
    LAS float* SELG = (LAS float*)(F.lds + RING_OFF + 32768);
    LAS int* SELE = (LAS int*)(F.lds + RING_OFF + 32768 + 1024);
    LAS int* LCNT = (LAS int*)(F.lds + RING_OFF + 32768 + 2048);
    const float* wr = ARGI(F, 11) + (size_t)j * DMODEL * NEXP;
    for (int i = F.tid; i < DMODEL * NEXP; i += 512) { const int d = i >> 3, e = i & 7; WRT[e * DMODEL + d] = wr[i]; }
    if (F.tid < 16) LCNT[F.tid] = 0;
    float gv[2][8], bv[2][8];
#pragma unroll
    for (int q = 0; q < 2; ++q)
#pragma unroll
        for (int h2 = 0; h2 < 2; ++h2) { const f32x4 g4 = *(const GAS f32x4*)(gain + 512 * q + 8 * F.lane + 4 * h2), b4 = *(const GAS f32x4*)(bias + 512 * q + 8 * F.lane + 4 * h2);
#pragma unroll
            for (int k = 0; k < 4; ++k) { gv[q][4 * h2 + k] = g4[k]; bv[q][4 * h2 + k] = b4[k]; } }
    bf16* XB = (bf16*)(ARGWS(F) + WS_XB);
    __syncthreads();
    const int ntok = T_TOK / F.G, tok0 = F.c * ntok;
    for (int tl = F.wave; tl < ntok; tl += NWAVES) { const int m = tok0 + tl;
        GAS v4u* xr = (GAS v4u*)(XB + (size_t)m * DMODEL) + F.lane;
        float v[2][8]; float s = 0.f;
#pragma unroll
        for (int q = 0; q < 2; ++q) unpack8(xr[64 * q], v[q]);
#pragma unroll
        for (int q = 0; q < 2; ++q)
#pragma unroll
            for (int k = 0; k < 8; ++k) s += v[q][k];
        const float mean = wave_sum(s) * (1.f / DMODEL); float s2 = 0.f;
#pragma unroll
        for (int q = 0; q < 2; ++q)
#pragma unroll
            for (int k = 0; k < 8; ++k) { v[q][k] -= mean; s2 += v[q][k] * v[q][k]; }
        const float rstd = 1.f / sqrtf(wave_sum(s2) * (1.f / DMODEL) + LN_EPS);
        float lg[8];
#pragma unroll
        for (int e = 0; e < 8; ++e) lg[e] = 0.f;
#pragma unroll
        for (int q = 0; q < 2; ++q) { float o[8];
#pragma unroll
            for (int k = 0; k < 8; ++k) o[k] = v[q][k] * rstd * gv[q][k] + bv[q][k];
            v4u w; w.x = pk2(o[0], o[1]); w.y = pk2(o[2], o[3]); w.z = pk2(o[4], o[5]); w.w = pk2(o[6], o[7]); xr[64 * q] = w;
#pragma unroll
            for (int e = 0; e < 8; ++e) { const f32x4 w0 = *(const LAS f32x4*)(WRT + e * DMODEL + 512 * q + 8 * F.lane), w1 = *(const LAS f32x4*)(WRT + e * DMODEL + 512 * q + 8 * F.lane + 4);
                lg[e] += ((o[0] * w0.x + o[1] * w0.y) + (o[2] * w0.z + o[3] * w0.w)) + ((o[4] * w1.x + o[5] * w1.y) + (o[6] * w1.z + o[7] * w1.w)); } }
#pragma unroll
        for (int e = 0; e < 8; ++e) lg[e] = wave_sum(lg[e]);
        int e1 = 0; float v1 = lg[0];
#pragma unroll
        for (int e = 1; e < 8; ++e) if (lg[e] > v1) { v1 = lg[e]; e1 = e; }
        int e2 = -1; float v2 = -3.0e38f;
#pragma unroll
        for (int e = 0; e < 8; ++e) if (e != e1 && lg[e] > v2) { v2 = lg[e]; e2 = e; }
        const float g1 = 1.f / (1.f + __expf(v2 - v1)), g2 = 1.f - g1;
        if (F.lane == 0) { SELE[2 * tl] = e1; SELE[2 * tl + 1] = e2; SELG[2 * tl] = g1; SELG[2 * tl + 1] = g2; }
    }
    __syncthreads();
    int myrank = 0, mye = 0;
    if (F.tid < 2 * ntok) { mye = SELE[F.tid]; myrank = __hip_atomic_fetch_add(LCNT + mye, 1, __ATOMIC_RELAXED, __HIP_MEMORY_SCOPE_WORKGROUP); }
    __syncthreads();
    if (F.tid < 8) LCNT[8 + F.tid] = (int)__hip_atomic_fetch_add(F_CTL(F) + CW_CNT + (j * 8 + F.tid) * 64, (unsigned)LCNT[F.tid], RLX_AGENT);
    __syncthreads();
    if (F.tid < 2 * ntok) { const int slot = LCNT[8 + mye] + myrank; const int tok = tok0 + (F.tid >> 1);
        ((int*)(ARGWS(F) + WS_LIST))[mye * T_TOK + slot] = tok;
        ((unsigned*)(ARGWS(F) + WS_TSLOT))[2 * tok + (F.tid & 1)] = ((unsigned)mye << 20) | (unsigned)slot;
        ((float*)(ARGWS(F) + WS_GATE))[2 * tok + (F.tid & 1)] = SELG[F.tid]; }
    __syncthreads();
}
__device__ __forceinline__ int off64(int row, int colbyte) { return row * 128 + (colbyte ^ ((((row >> 1) & 1) << 6) | (((row >> 3) & 1) << 5))); }
__device__ __forceinline__ float log2_gamma(int h) { return __builtin_amdgcn_logf(1.0f - __builtin_amdgcn_exp2f((float)(-5 - h))); }

__device__ __forceinline__ void ret_state_phase(Frame& F) {
    const int c = F.c; if (c >= 256) return;
    const int dt = c & 3, et = (c >> 2) & 7, h = (c >> 5) & 3, b = c >> 7;
    const int w = F.wave, lane = F.lane, dq = w & 3, eh = w >> 2, g = lane >> 4, l15 = lane & 15, q = l15 >> 2, p = l15 & 3;
    const bf16* KH = (const bf16*)(ARGWS(F) + WS_BIG + BIG_KH) + (size_t)b * SEQ * 1024 + h * 256 + dt * 64;
    const bf16* VT = (const bf16*)(ARGWS(F) + WS_BIG + BIG_VT) + ((size_t)((b * 4 + h) * 128) << 16);
    bf16* RT = (bf16*)(ARGWS(F) + WS_BIG + BIG_RT) + ((size_t)((b * 4 + h) * 128) << 17);
    const float dec = __builtin_amdgcn_exp2f(128.f * log2_gamma(h));
    const int r0 = F.tid >> 3, ch = F.tid & 7;
    const bf16* kp0 = KH + (size_t)r0 * 1024 + ch * 8; const bf16* kp1 = kp0 + (size_t)64 * 1024;
    const int lo0 = off64(r0, ch * 16), lo1 = off64(r0 + 64, ch * 16);
    int voff[4][2];
#pragma unroll
    for (int ks = 0; ks < 4; ++ks)
#pragma unroll
        for (int x = 0; x < 2; ++x) { const int e = 64 * et + 16 * (2 * eh + x) + l15, oct = 4 * ks + g; voff[ks][x] = ((((e >> 5) * 8 + (oct >> 1)) * 2 + (oct & 1)) * 32 + (e & 31)) * 8; }
    int roff[2];
#pragma unroll
    for (int x = 0; x < 2; ++x) { const int e = 64 * et + 16 * (2 * eh + x) + l15, d = 64 * dt + 16 * dq + 4 * g; roff[x] = ((((e >> 5) * 16 + (d >> 4)) * 2 + ((d >> 3) & 1)) * 32 + (e & 31)) * 8 + (d & 7); }
    float z0 = 0.f; asm volatile("" : "+v"(z0));
    f32x4 acc[2] = {(f32x4){z0, z0, z0, z0}, (f32x4){z0, z0, z0, z0}};
    v4u k0 = *(const GAS v4u*)kp0, k1 = *(const GAS v4u*)kp1;
    bf16x8 vf[4][2];
#pragma unroll
    for (int ks = 0; ks < 4; ++ks)
#pragma unroll
        for (int x = 0; x < 2; ++x) vf[ks][x] = *(const GAS bf16x8*)(VT + voff[ks][x]);
    for (int n = 0; n < 128; ++n) {
        LAS unsigned char* buf = F.lds + RING_OFF + (n & 1) * 16384;
        *(LAS v4u*)(buf + lo0) = k0; *(LAS v4u*)(buf + lo1) = k1;
        bf16x8 vn[4][2];
        if (n + 1 < 128) { k0 = *(const GAS v4u*)(kp0 + (size_t)(n + 1) * 128 * 1024); k1 = *(const GAS v4u*)(kp1 + (size_t)(n + 1) * 128 * 1024);
#pragma unroll
            for (int ks = 0; ks < 4; ++ks)
#pragma unroll
                for (int x = 0; x < 2; ++x) vn[ks][x] = *(const GAS bf16x8*)(VT + ((size_t)(n + 1) << 16) + voff[ks][x]); }
        else {
#pragma unroll
            for (int ks = 0; ks < 4; ++ks)
#pragma unroll
                for (int x = 0; x < 2; ++x) vn[ks][x] = vf[ks][x]; }
        __syncthreads();
        if (n > 0) {
#pragma unroll
            for (int x = 0; x < 2; ++x) { v2u o; o.x = pk2(acc[x][0], acc[x][1]); o.y = pk2(acc[x][2], acc[x][3]); *(GAS v2u*)(RT + ((size_t)n << 17) + roff[x]) = o; } }
#pragma unroll
        for (int ks = 0; ks < 4; ++ks) {
            const s16x4 t0 = vtr(buf + off64(32 * ks + 8 * g + q, 32 * dq + 8 * p)), t1 = vtr(buf + off64(32 * ks + 8 * g + 4 + q, 32 * dq + 8 * p));
            const bf16x8 a = (bf16x8){t0[0], t0[1], t0[2], t0[3], t1[0], t1[1], t1[2], t1[3]};
#pragma unroll
            for (int x = 0; x < 2; ++x) acc[x] = __builtin_amdgcn_mfma_f32_16x16x32_bf16(a, vf[ks][x], acc[x], 0, 0, 0);
        }
#pragma unroll
        for (int x = 0; x < 2; ++x) acc[x] = acc[x] * dec;
#pragma unroll
        for (int ks = 0; ks < 4; ++ks)
#pragma unroll
            for (int x = 0; x < 2; ++x) vf[ks][x] = vn[ks][x];
    }
    __syncthreads();
}

__device__ __forceinline__ void ret_out_phase(Frame& F, int j) {
    const int w = F.wave, lane = F.lane, r32 = lane & 31, hi = lane >> 5, tid = F.tid;
    LAS unsigned char* QDI = F.lds + RING_OFF;
    LAS unsigned char* KHI = F.lds + RING_OFF + 65536;
    LAS unsigned char* PI = KHI;
    LAS float* STAT = (LAS float*)(F.lds + AUX_OFF);
    LAS unsigned char* YST = F.lds + RING_OFF;
    const bf16* QD = (const bf16*)(ARGWS(F) + WS_BIG + BIG_QD); const bf16* KH = (const bf16*)(ARGWS(F) + WS_BIG + BIG_KH);
    const bf16* VT = (const bf16*)(ARGWS(F) + WS_BIG + BIG_VT); const bf16* RT = (const bf16*)(ARGWS(F) + WS_BIG + BIG_RT);
    bf16* GY = (bf16*)(ARGWS(F) + WS_BIG + BIG_G);
    const float* gn = ARGI(F, 4) + (size_t)j * 2048;
    const int ib = w & 3, jb0 = 2 * (w >> 2), jb1 = jb0 + 1;
    for (int U = F.c; U < 1024; U += F.G) {
        const int n = U & 127, h = (U >> 7) & 3, b = U >> 9;
        const size_t tok0 = (size_t)b * SEQ + (size_t)n * 128;
        { int tid1 = tid; asm volatile("" : "+v"(tid1)); v4u qv[8], kv[8];
#pragma unroll
          for (int k = 0; k < 8; ++k) { const int x = tid1 + 512 * k, row = x >> 5, chk = x & 31; const size_t go = (tok0 + row) * 1024 + h * 256 + chk * 8;
              qv[k] = *(const GAS v4u*)(QD + go); kv[k] = *(const GAS v4u*)(KH + go); }
#pragma unroll
          for (int k = 0; k < 8; ++k) { const int x = tid1 + 512 * k, row = x >> 5, chk = x & 31; const int lo = row * 512 + ((chk * 16) ^ ((row & 7) << 4));
              *(LAS v4u*)(QDI + lo) = qv[k]; *(LAS v4u*)(KHI + lo) = kv[k]; } }
        __syncthreads();
        f32x16 s0 = {}, s1 = {};
        { const int qrow = 32 * ib + r32, k0row = 32 * jb0 + r32, k1row = 32 * jb1 + r32;
          if (jb0 <= ib) {
#pragma unroll
            for (int ks = 0; ks < 16; ++ks) { const int cb = (16 * ks + 8 * hi) * 2;
                const bf16x8 qf = *(const LAS bf16x8*)(QDI + qrow * 512 + (cb ^ ((qrow & 7) << 4)));
                const bf16x8 kf0 = *(const LAS bf16x8*)(KHI + k0row * 512 + (cb ^ ((k0row & 7) << 4)));
                s0 = __builtin_amdgcn_mfma_f32_32x32x16_bf16(kf0, qf, s0, 0, 0, 0);
                if (jb1 <= ib) { const bf16x8 kf1 = *(const LAS bf16x8*)(KHI + k1row * 512 + (cb ^ ((k1row & 7) << 4))); s1 = __builtin_amdgcn_mfma_f32_32x32x16_bf16(kf1, qf, s1, 0, 0, 0); } } } }
        __syncthreads();
        { int r32p = r32, hip = hi; asm volatile("" : "+v"(r32p), "+v"(hip)); const int i = 32 * ib + r32p;
#pragma unroll
          for (int qq = 0; qq < 4; ++qq) {
              const int j0 = 32 * jb0 + 8 * qq + 4 * hip, j1 = j0 + 32;
              float a0 = s0[4 * qq], a1 = s0[4 * qq + 1], a2 = s0[4 * qq + 2], a3 = s0[4 * qq + 3];
              float c0 = s1[4 * qq], c1 = s1[4 * qq + 1], c2 = s1[4 * qq + 2], c3 = s1[4 * qq + 3];
              if (j0 + 0 > i) a0 = 0.f; if (j0 + 1 > i) a1 = 0.f; if (j0 + 2 > i) a2 = 0.f; if (j0 + 3 > i) a3 = 0.f;
              if (j1 + 0 > i) c0 = 0.f; if (j1 + 1 > i) c1 = 0.f; if (j1 + 2 > i) c2 = 0.f; if (j1 + 3 > i) c3 = 0.f;
              v2u o; o.x = pk2(a0, a1); o.y = pk2(a2, a3); *(LAS v2u*)(PI + i * 256 + ((j0 * 2) ^ ((i & 7) << 4))) = o;
              v2u o2; o2.x = pk2(c0, c1); o2.y = pk2(c2, c3); *(LAS v2u*)(PI + i * 256 + ((j1 * 2) ^ ((i & 7) << 4))) = o2; } }
        __syncthreads();
        f32x16 acc[4][2];
#pragma unroll
        for (int rb = 0; rb < 4; ++rb) { acc[rb][0] = (f32x16){}; acc[rb][1] = (f32x16){}; }
        { const int nsteps = n > 0 ? 24 : 8;
          const bf16* vt = VT + ((size_t)((b * 4 + h) * 128 + n) << 16) + (size_t)(((2 * w) * 8 * 2 + hi) * 32 + r32) * 8;
          const bf16* rt = RT + ((size_t)((b * 4 + h) * 128 + n) << 17) + (size_t)(((2 * w) * 16 * 2 + hi) * 32 + r32) * 8;
          const int xr = (r32 & 7) << 4, rowp = r32 * 256;
#define R2B_LOAD(dst, sidx) do { int sp_ = (sidx); sp_ = sp_ < nsteps ? sp_ : nsteps - 1; const bf16* p_ = sp_ < 8 ? vt + sp_ * 512 : rt + (sp_ - 8) * 512; const int o1_ = sp_ < 8 ? 4096 : 8192; \
              dst[0] = *(const GAS bf16x8*)p_; dst[1] = *(const GAS bf16x8*)(p_ + o1_); } while (0)
          bf16x8 Bq[3][2];
          R2B_LOAD(Bq[0], 0); R2B_LOAD(Bq[1], 1);
          for (int s3 = 0; s3 < nsteps; s3 += 3) {
#pragma unroll
              for (int uu = 0; uu < 3; ++uu) { const int st = s3 + uu;
                  R2B_LOAD(Bq[(uu + 2) % 3], st + 2);
                  if (st < nsteps) { const bool pv = st < 8; const int ks = pv ? st : st - 8, cb = ((32 * ks + 16 * hi) ^ xr) + (pv ? 65536 : 0), sh = pv ? 0 : 1;
#pragma unroll
                      for (int rb = 0; rb < 4; ++rb) if (!pv || st <= 2 * rb + 1) {
                          const bf16x8 af = *(const LAS bf16x8*)(QDI + (((32 * 256) * rb + rowp) << sh) + cb);
                          acc[rb][0] = __builtin_amdgcn_mfma_f32_32x32x16_bf16(Bq[uu][0], af, acc[rb][0], 0, 0, 0);
                          acc[rb][1] = __builtin_amdgcn_mfma_f32_32x32x16_bf16(Bq[uu][1], af, acc[rb][1], 0, 0, 0); } } } }
#undef R2B_LOAD
        }
#pragma unroll
        for (int rb = 0; rb < 4; ++rb) { float s = 0.f, qs = 0.f;
#pragma unroll
            for (int et = 0; et < 2; ++et)
#pragma unroll
                for (int r = 0; r < 16; ++r) { const float v = acc[rb][et][r]; s += v; qs += v * v; }
            s += __shfl_xor(s, 32); qs += __shfl_xor(qs, 32);
            if (hi == 0) { STAT[((32 * rb + r32) * 8 + w) * 2] = s; STAT[((32 * rb + r32) * 8 + w) * 2 + 1] = qs; } }
        __syncthreads();
        int r32b = r32, hib = hi; asm volatile("" : "+v"(r32b), "+v"(hib));
#pragma unroll
        for (int rb = 0; rb < 4; ++rb) { const int i = 32 * rb + r32b; float s = 0.f, qs = 0.f;
#pragma unroll
            for (int ww = 0; ww < 8; ++ww) { s += STAT[(i * 8 + ww) * 2]; qs += STAT[(i * 8 + ww) * 2 + 1]; }
            const float mean = s * (1.f / 512.f), var = qs * (1.f / 512.f) - mean * mean, rstd = 1.f / sqrtf(fmaxf(var, 0.f) + LN_EPS);
#pragma unroll
            for (int et = 0; et < 2; ++et)
#pragma unroll
                for (int qq = 0; qq < 4; ++qq) { const int e = 64 * w + 32 * et + 8 * qq + 4 * hib;
                    v2u o; o.x = pk2((acc[rb][et][4 * qq] - mean) * rstd, (acc[rb][et][4 * qq + 1] - mean) * rstd); o.y = pk2((acc[rb][et][4 * qq + 2] - mean) * rstd, (acc[rb][et][4 * qq + 3] - mean) * rstd);
                    *(LAS v2u*)(YST + i * 1024 + ((e * 2) ^ ((i & 63) << 4))) = o; } }
        __syncthreads();
        { int tid6 = tid; asm volatile("" : "+v"(tid6)); const int chk = tid6 & 63; const f32x4 g0 = *(const GAS f32x4*)(gn + h * 512 + chk * 8), g1 = *(const GAS f32x4*)(gn + h * 512 + chk * 8 + 4);
#pragma unroll 4
          for (int k = 0; k < 16; ++k) { const int row = (tid6 >> 6) + 8 * k;
              const v4u y = *(const LAS v4u*)(YST + row * 1024 + ((chk * 16) ^ ((row & 63) << 4)));
              bf16* gp = GY + (tok0 + row) * 2048 + h * 512 + chk * 8; const v4u gg = *(const GAS v4u*)gp;
              v4u o; o.x = pk2(bflo(y.x) * g0.x * bflo(gg.x), bfhi(y.x) * g0.y * bfhi(gg.x)); o.y = pk2(bflo(y.y) * g0.z * bflo(gg.y), bfhi(y.y) * g0.w * bfhi(gg.y));
              o.z = pk2(bflo(y.z) * g1.x * bflo(gg.z), bfhi(y.z) * g1.y * bfhi(gg.z)); o.w = pk2(bflo(y.w) * g1.z * bflo(gg.w), bfhi(y.w) * g1.w * bfhi(gg.w));
              *(GAS v4u*)gp = o; } }
        __syncthreads();
    }
}
typedef swa::BlockRef<swa::bf16, swa::bf16> ABlk;
__device__ __forceinline__ float* att_lse(Frame& F, int L) {
    const int g = L >> 9, rem = L & 511, sh = 2 * g, seq = rem >> (6 - sh), qb = rem & ((64 >> sh) - 1);
    return (float*)(ARGWS(F) + WS_BIG + BIG_LSE) + (size_t)g * 131072 + (size_t)seq * (size_t)(SEQ >> sh) + (size_t)qb * 256;
}
__device__ __forceinline__ ABlk att_ref(Frame& F, int L) {
    const int g = L >> 9, rem = L & 511, sh = 2 * g, seq = rem >> (6 - sh), qb = rem & ((64 >> sh) - 1);
    const size_t base = (size_t)g * 131072 + (size_t)seq * (size_t)(SEQ >> sh);
    const swa::bf16* P = (const swa::bf16*)(ARGWS(F) + WS_BIG + BIG_QKV); constexpr size_t WH = (size_t)3 * 131072 * 128;
    ABlk r; r.Q = P + (base + (size_t)qb * 256) * 128; r.K = P + WH + base * 128; r.V = P + 2 * WH + base * 128;
    r.O = (swa::bf16*)(ARGWS(F) + WS_BIG + BIG_OP) + (base + (size_t)qb * 256) * 128; r.P0 = qb * 256;
    return r;
}
__device__ __forceinline__ void attn_phase(Frame& F) {
    extern __shared__ __attribute__((aligned(16))) unsigned char lds_dyn[];
    char* const ldsg = (char*)lds_dyn;
    int L = F.c; const int total = 1536, stride = F.G;
    if (L >= total) return;
    ABlk cur = att_ref(F, L);
    const int W = 129 + (F.G >> 20);
    swa::Seam<swa::bf16> S; S.tid = F.tid;
    swa::causal_swa_prime<swa::bf16, swa::bf16>(cur, W, ldsg, S);
    for (;;) {
        const bool last = L + stride >= total;
        const int Ln = last ? L : L + stride;
        const ABlk nxt = last ? cur : att_ref(F, Ln);
        const int skv = SEQ >> (2 * (L >> 9));
        swa::causal_swa_block<swa::bf16, swa::bf16>(cur, nxt, skv, W, ldsg, S);
        if (F.tid < 256) att_lse(F, L)[F.tid] = ((const LAS float*)(F.lds + swa::LSE_LDS_OFF))[F.tid];
        if (last) break;
        cur = nxt; L = Ln;
    }
}
__device__ __forceinline__ void attn_merge_phase(Frame& F) {
    const int gw = F.c * NWAVES + F.wave, NGW = F.G * NWAVES, hd = F.lane >> 4, chk = F.lane & 15;
    const bf16* OP = (const bf16*)(ARGWS(F) + WS_BIG + BIG_OP); const float* LSE = (const float*)(ARGWS(F) + WS_BIG + BIG_LSE); bf16* O = (bf16*)(ARGWS(F) + WS_BIG + BIG_O);
    for (int m = gw; m < T_TOK; m += NGW) { const int b = m >> 14, t = m & 16383;
        size_t row[3]; float ls[3];
#pragma unroll
        for (int g = 0; g < 3; ++g) { const int sh = 2 * g; row[g] = (size_t)g * 131072 + (size_t)(b * 4 + hd) * SEQ + (size_t)((t & ((1 << sh) - 1)) * (SEQ >> sh) + (t >> sh)); ls[g] = LSE[row[g]]; }
        const float mx = fmaxf(ls[0], fmaxf(ls[1], ls[2])); float wg[3]; float ws = 0.f;
#pragma unroll
        for (int g = 0; g < 3; ++g) { wg[g] = __expf(ls[g] - mx); ws += wg[g]; }
        const float inv = 1.f / ws; float o[8] = {0.f, 0.f, 0.f, 0.f, 0.f, 0.f, 0.f, 0.f};
#pragma unroll
        for (int g = 0; g < 3; ++g) { const v4u v = *(const GAS v4u*)(OP + row[g] * 128 + chk * 8); const float wt = wg[g] * inv;
            o[0] += wt * bflo(v.x); o[1] += wt * bfhi(v.x); o[2] += wt * bflo(v.y); o[3] += wt * bfhi(v.y); o[4] += wt * bflo(v.z); o[5] += wt * bfhi(v.z); o[6] += wt * bflo(v.w); o[7] += wt * bfhi(v.w); }
        v4u w; w.x = pk2(o[0], o[1]); w.y = pk2(o[2], o[3]); w.z = pk2(o[4], o[5]); w.w = pk2(o[6], o[7]);
        *(GAS v4u*)(O + (size_t)m * 512 + hd * 128 + chk * 8) = w; }
}
template <bool GATHER_, int NCT> struct MoeOrder {
    static constexpr bool GATHER = GATHER_;
    const char* A; const char* Bt; int K; size_t bstride; int G, c; int rtb[9]; const LAS int* idx;
    __device__ __forceinline__ bool next(int i, pg8::Unit& u) const {
        const int L = i * G + c; if (L >= rtb[8] * NCT) return false;
        const int rt = L / NCT; int e = 0;
#pragma unroll
        for (int k = 1; k < 8; ++k) e += (rtb[k] <= rt) ? 1 : 0;
        u.pm = rt; u.pn = L - rt * NCT; u.ex = e; return true;
    }
    __device__ __forceinline__ const char* a_ptr(const pg8::Unit& u) const { return GATHER ? A : A + (size_t)u.pm * ((size_t)256 * K * 2); }
    __device__ __forceinline__ const char* b_ptr(const pg8::Unit& u) const { return Bt + (size_t)u.ex * bstride + (size_t)u.pn * ((size_t)256 * K * 2); }
    __device__ __forceinline__ unsigned a_off(int ui, int row, int C, int) const { return (unsigned)idx[ui * 256 + row] * (unsigned)(K * 2) + (unsigned)(C * 2); }
};
template <bool GATHER_, int NCT> __device__ __forceinline__ void moe_order_init(Frame& F, MoeOrder<GATHER_, NCT>& S, int j, int cnt[8]) {
    int acc = 0;
#pragma unroll
    for (int e = 0; e < 8; ++e) { S.rtb[e] = acc; cnt[e] = __builtin_amdgcn_readfirstlane((int)__hip_atomic_load(F_CTL(F) + CW_CNT + (j * 8 + e) * 64, RLX_AGENT)); acc += (cnt[e] + 255) >> 8; }
    S.rtb[8] = acc; S.G = F.G; S.c = F.c; S.idx = (const LAS int*)(F.lds + AUX_OFF);
}
__global__ void __launch_bounds__(NWAVES * 64, 2) fwd_kernel(Args args) {
    extern __shared__ __attribute__((aligned(16))) unsigned char lds[];
    Frame F;
    F.lds = (LAS unsigned char*)lds;
    F.MISC = (volatile LAS unsigned*)(F.lds + MISC_OFF);
    F.tid = threadIdx.x; F.lane = F.tid & 63; F.wave = __builtin_amdgcn_readfirstlane(F.tid >> 6);
    F.G = gridDim.x; F.c = blockIdx.x;
    for (int u = F.tid; u < 32; u += NWAVES * 64) ((LAS unsigned*)(F.lds + MISC_OFF))[u] = 0u;
    if (F.tid == 0) { LAS unsigned long long* tb = (LAS unsigned long long*)(F.lds + MISC_OFF + 128);
#pragma unroll
        for (int i = 0; i < 15; ++i) tb[i] = (unsigned long long)args.in[i];
        tb[15] = (unsigned long long)args.out; tb[16] = (unsigned long long)args.ws; }
    __syncthreads();
    XcdBarrier bar = xcd_barrier_post((unsigned*)(F_CTL(F) + CW_BAR), F.MISC + 8);
#ifdef STAMP_A
#define STAMP_HERE(idx) do { if (threadIdx.x == 0) ((volatile LAS unsigned long long*)(F.lds + AUX_OFF + 16384))[(idx)] = wall_clock64(); } while (0)
#else
#define STAMP_HERE(idx) do { } while (0)
#endif
#define GRID_BAR(idx) do { XcdBarrier bb_ = bar; asm volatile("" : "+s"(bb_.bar), "+s"(bb_.x)); xcd_barrier(bb_); STAMP_HERE(idx); } while (0)
#define WSP ARGWS(F)
#define BIGP (ARGWS(F) + WS_BIG)
#define XBP ((bf16*)(ARGWS(F) + WS_XB))

#ifndef ONLY
#define ONLY -1
#endif
#define RUN(n) (ONLY < 0 || ONLY == (n))
    STAMP_HERE(0);
    if (RUN(0)) { frame_refresh(F); p0_prologue(F); }
    GRID_BAR(1);

#pragma unroll
    for (int j = 0; j < 2; ++j) {
        if (RUN(1)) { frame_refresh(F);
            const bf16* Win = (const bf16*)(WSP + WS_WIN) + (size_t)j * 6144 * 1024;
#ifndef SKIP_RP
            { pg8::StaticOrder S; S.init(XBP, Win, T_TOK, 4096, 1024, F.G, F.c);
              pg8::EpiRetProj E{(bf16*)(BIGP + BIG_QD), (bf16*)(BIGP + BIG_KH), (bf16*)(BIGP + BIG_G), (const float*)(WSP + WS_TAB)};
              pg8::gemm_phase<pg8::EpiRetProj, pg8::StaticOrder, true>(F.lds + RING_OFF, S, E, F.tid); }
#endif
#ifndef SKIP_VT
            { pg8::StaticOrder S; S.init(Win + (size_t)4096 * 1024, XBP, 2048, T_TOK, 1024, F.G, F.c);
              pg8::EpiVT E{(bf16*)(BIGP + BIG_VT)};
              pg8::gemm_phase<pg8::EpiVT, pg8::StaticOrder, true>(F.lds + RING_OFF, S, E, F.tid); }
#endif
        }
        GRID_BAR(1 + 16 * j + 1);
        if (RUN(2)) { frame_refresh(F); ret_state_phase(F); }
        GRID_BAR(1 + 16 * j + 2);
        if (RUN(3)) { frame_refresh(F); ret_out_phase(F, j); }
        GRID_BAR(1 + 16 * j + 3);
        if (RUN(4)) { frame_refresh(F);
            pg8::StaticOrder S; S.init(BIGP + BIG_G, (const bf16*)(WSP + WS_WRO) + (size_t)j * 1024 * 2048, T_TOK, 1024, 2048, F.G, F.c);
            pg8::EpiAddBf16 E{XBP, ALPHA};
            pg8::gemm_phase<pg8::EpiAddBf16, pg8::StaticOrder, true>(F.lds + RING_OFF, S, E, F.tid);
        }
        GRID_BAR(1 + 16 * j + 4);
        if (RUN(5)) { frame_refresh(F); ln_pass<0, false>(F, 2 * j, 0, j); }
        if (RUN(6)) { frame_refresh(F); moe_convert(F, j); }
        GRID_BAR(1 + 16 * j + 5);
        if (RUN(7)) { frame_refresh(F);
            pg8::StaticOrder S; S.init(XBP, (const bf16*)(WSP + WS_WGU) + (size_t)j * 7168 * 1024, T_TOK, 7168, 1024, F.G, F.c);
            pg8::EpiSwiGLU E{(bf16*)(BIGP + BIG_HID)};
            pg8::gemm_phase<pg8::EpiSwiGLU, pg8::StaticOrder, true>(F.lds + RING_OFF, S, E, F.tid);
        }
        GRID_BAR(1 + 16 * j + 6);
        if (RUN(8)) { frame_refresh(F);
            pg8::StaticOrder S; S.init(BIGP + BIG_HID, (const bf16*)(WSP + WS_WDN) + (size_t)j * 1024 * 3584, T_TOK, 1024, 3584, F.G, F.c);
            pg8::EpiAddBf16 E{XBP, ALPHA};
            pg8::gemm_phase<pg8::EpiAddBf16, pg8::StaticOrder, true>(F.lds + RING_OFF, S, E, F.tid);
        }
        GRID_BAR(1 + 16 * j + 7);
        if (RUN(5)) { frame_refresh(F); ln_pass<0, false>(F, 2 * j, 1, j); }
        GRID_BAR(1 + 16 * j + 8);
        if (RUN(9)) { frame_refresh(F);
            pg8::StaticOrder S; S.init(XBP, (const bf16*)(WSP + WS_WQKV) + (size_t)j * 4608 * 1024, T_TOK, 4608, 1024, F.G, F.c);
            pg8::EpiQKV E{(bf16*)(BIGP + BIG_QKV)};
            pg8::gemm_phase<pg8::EpiQKV, pg8::StaticOrder, true>(F.lds + RING_OFF, S, E, F.tid);
        }
        GRID_BAR(1 + 16 * j + 9);
        if (RUN(10)) { frame_refresh(F); attn_phase(F); }
        GRID_BAR(1 + 16 * j + 10);
        if (RUN(11)) { frame_refresh(F); attn_merge_phase(F); }
        GRID_BAR(1 + 16 * j + 11);
        if (RUN(12)) { frame_refresh(F);
            pg8::StaticOrder S; S.init(BIGP + BIG_O, (const bf16*)(WSP + WS_WAO) + (size_t)j * 1024 * 512, T_TOK, 1024, 512, F.G, F.c);
            pg8::EpiAddBf16 E{XBP, ALPHA};
            pg8::gemm_phase<pg8::EpiAddBf16, pg8::StaticOrder, true>(F.lds + RING_OFF, S, E, F.tid);
        }
        GRID_BAR(1 + 16 * j + 12);
        if (RUN(13)) { frame_refresh(F); ln_route_pass(F, 2 * j + 1, j); }
        GRID_BAR(1 + 16 * j + 13);
        if (RUN(14)) {
            frame_refresh(F); MoeOrder<true, 28> S; int cnt[8]; moe_order_init(F, S, j, cnt);
            S.A = (const char*)XBP; S.Bt = (const char*)(BIGP + BIG_WMGU); S.K = 1024; S.bstride = (size_t)7168 * 1024 * 2;
            const int* list = (const int*)(WSP + WS_LIST); LAS int* idx = (LAS int*)(F.lds + AUX_OFF);
            pg8::Unit u;
            for (int ui = 0; S.next(ui, u) && ui < 30; ++ui)
                if (F.tid < 256) { const int e = u.ex; int rb = 0, ce = 0;
#pragma unroll
                    for (int q = 0; q < 8; ++q) { rb = (q == e) ? S.rtb[q] : rb; ce = (q == e) ? cnt[q] : ce; }
                    const int slot = (u.pm - rb) * 256 + F.tid; idx[ui * 256 + F.tid] = list[e * T_TOK + (slot < ce ? slot : 0)]; }
            __syncthreads();
            pg8::EpiSwiGLU E{(bf16*)(BIGP + BIG_HID)};
            pg8::gemm_phase<pg8::EpiSwiGLU, MoeOrder<true, 28>, true>(F.lds + RING_OFF, S, E, F.tid);
        }
        GRID_BAR(1 + 16 * j + 14);
        if (RUN(15)) {
            frame_refresh(F); MoeOrder<false, 4> S; int cnt[8]; moe_order_init(F, S, j, cnt);
            S.A = (const char*)(BIGP + BIG_HID); S.Bt = (const char*)(BIGP + BIG_WMD); S.K = 3584; S.bstride = (size_t)1024 * 3584 * 2;
            pg8::EpiBf16Y E{(bf16*)(BIGP + BIG_YP)};
            pg8::gemm_phase<pg8::EpiBf16Y, MoeOrder<false, 4>, true>(F.lds + RING_OFF, S, E, F.tid);
        }
        GRID_BAR(1 + 16 * j + 15);
        if (RUN(16)) { frame_refresh(F); if (j == 0) ln_pass<2, false>(F, 1, 1, 0); else ln_pass<2, true>(F, 3, 1, 1); }
        if (j == 0) GRID_BAR(1 + 16 * j + 16);
    }
#ifdef STAMP_A
    GRID_BAR(34);
    { if (blockIdx.x == 0 && threadIdx.x == 0) { volatile LAS unsigned long long* ts = (volatile LAS unsigned long long*)(F.lds + AUX_OFF + 16384);
          float* vv = (float*)(ARGWS(F) + 65536); vv[0] = (float)(ts[STAMP_A + STAMP_AN] - ts[STAMP_A]) * 0.01f; vv[1] = (float)(ts[STAMP_B + STAMP_BN] - ts[STAMP_B]) * 0.01f; } }
    GRID_BAR(35);
    { const float* vv = (const float*)(ARGWS(F) + 65536); const float va = vv[0], vb = vv[1];
      float* out = ARGX(F); const float c = sqrtf(va);
      for (size_t i = (size_t)blockIdx.x * 512 + threadIdx.x; i < (size_t)T_TOK * DMODEL; i += (size_t)gridDim.x * 512) out[i] = (i == 0) ? vb : c; }
#endif
}

extern "C" void kernel_launch(void* const* d_in, const int* in_sizes, int n_in, void* d_out, int out_size, void* d_ws, size_t ws_size, hipStream_t stream) {
    static int grid = 0;
    if (grid == 0) {
        if (n_in != 15 || out_size != T_TOK * DMODEL || ws_size < WS_END) { fprintf(stderr, "kernel_launch: unexpected shapes / workspace (n_in %d, out %d, ws %zu < %zu)\n", n_in, out_size, ws_size, (size_t)WS_END); grid = -1; return; }
        int dev = 0, cus = 0, per_cu = 0;
        if (hipGetDevice(&dev) != hipSuccess || hipDeviceGetAttribute(&cus, hipDeviceAttributeMultiprocessorCount, dev) != hipSuccess) { grid = -1; return; }
        if (hipFuncSetAttribute((const void*)fwd_kernel, hipFuncAttributeMaxDynamicSharedMemorySize, LDS_BYTES) != hipSuccess) { fprintf(stderr, "kernel_launch: hipFuncSetAttribute failed\n"); grid = -1; return; }
        if (hipOccupancyMaxActiveBlocksPerMultiprocessor(&per_cu, (const void*)fwd_kernel, NWAVES * 64, LDS_BYTES) != hipSuccess || per_cu < 1) { fprintf(stderr, "kernel_launch: occupancy query says %d\n", per_cu); }
        (void)hipGetLastError();
        if (cus < 256) { fprintf(stderr, "kernel_launch: this kernel needs 256 CUs (found %d)\n", cus); grid = -1; return; }
        grid = 256;
    }
    if (grid < 0) return;
    if (hipMemsetAsync((char*)d_ws + WS_CTL, 0, CTL_ZERO_BYTES, stream) != hipSuccess) return;
    Args a{};
    for (int i = 0; i < 15; ++i) a.in[i] = (const float*)d_in[i];
    a.out = (float*)d_out; a.ws = (unsigned char*)d_ws;
    hipLaunchKernelGGL(fwd_kernel, dim3(grid), dim3(NWAVES * 64), LDS_BYTES, stream, a);
}
```

```cpp
#include <hip/hip_runtime.h>
#include <hip/hip_bf16.h>
#include <cstdio>
#include <cstdint>
#include <cmath>
namespace pg8 {
#define PG8_LAS __attribute__((address_space(3)))
typedef unsigned short bf16_t;
typedef short bf16x8 __attribute__((ext_vector_type(8)));
typedef float f32x4 __attribute__((ext_vector_type(4)));
typedef float f32x2 __attribute__((ext_vector_type(2)));
typedef unsigned u32x4 __attribute__((ext_vector_type(4)));
constexpr int BM = 256, BK = 64, HALF = 128, HTB = HALF * BK * 2  , STAGE_BYTES = 8 * HTB, NXCD = 8, WGM = 8;

__host__ __device__ __forceinline__ int lds_byte(int r, int c) { const int st = (r >> 4) * 2 + (c >> 5), rr = r & 15, cc = c & 31, ob = rr * 64 + cc * 2; return st * 1024 + (ob ^ (((ob >> 9) & 1) << 5)); }
__host__ __device__ __forceinline__ void stage_rc(int b, int& R, int& C) { const int st = b / 1024, sb = b % 1024, swz = sb ^ (((sb >> 9) & 1) << 5); R = (st >> 1) * 16 + swz / 64; C = (st & 1) * 32 + (swz % 64) / 2; }
__host__ __device__ __forceinline__ int perm32(int rho) { const int n = rho >> 4, i = rho & 15; return 8 * (i >> 2) + 4 * n + (i & 3); }

struct Unit { int pm, pn, ex; };

struct StaticOrder {
    static constexpr bool GATHER = false;
    const char* A; const char* Bt; int K;
    int nM, nN, nwg, G, c;
    __device__ void init(const void* A_, const void* Bt_, int M, int N, int K_, int G_, int c_) { A = (const char*)A_; Bt = (const char*)Bt_; K = K_; nM = M / BM; nN = N / BM; nwg = nM * nN; G = G_; c = c_; }
    __device__ bool next(int i, Unit& u) const {
        const long L = (long)i * G + c; if (L >= nwg) return false;
        int wgid = (int)L; { const int q = nwg / NXCD, r = nwg % NXCD, xcd = wgid % NXCD, off = wgid / NXCD; wgid = (xcd < r ? xcd * (q + 1) : r * (q + 1) + (xcd - r) * q) + off; }
        const int nig = WGM * nN, gid = wgid / nig, fm = gid * WGM, gsz = (nM - fm) < WGM ? (nM - fm) : WGM;
        u.pm = fm + ((wgid % nig) % gsz); u.pn = (wgid % nig) / gsz; u.ex = 0; return true;
    }
    __device__ __forceinline__ const char* a_ptr(const Unit& u) const { return A + (size_t)u.pm * ((size_t)BM * K * 2); }
    __device__ __forceinline__ const char* b_ptr(const Unit& u) const { return Bt + (size_t)u.pn * ((size_t)BM * K * 2); }
    __device__ __forceinline__ unsigned a_off(int, int, int, int) const { return 0u; }
    __device__ __forceinline__ int kt() const { return K / BK; }
};

__device__ __forceinline__ unsigned cvt_pk_bf16(float lo, float hi) { unsigned r; asm volatile("v_cvt_pk_bf16_f32 %0, %1, %2" : "=v"(r) : "v"(lo), "v"(hi)); return r; }

template <class Epi, class Sched, bool ALIGN_EPI>
__device__ __forceinline__ void gemm_phase(PG8_LAS unsigned char* lds, const Sched& S, const Epi& E, const int tid) {
    constexpr bool GATHER = Sched::GATHER;
    const int wid = __builtin_amdgcn_readfirstlane(tid >> 6), lane = tid & 63, wr = wid >> 2, wc = wid & 3, fr = lane & 15, fq = lane >> 4;
    const int K = S.K, nt = S.kt();
    unsigned voffA[2][2], nvoffA[2][2], voffB[2]; int sR[2], sC[2];
#pragma unroll
    for (int i = 0; i < 2; ++i) { int R, C; stage_rc(tid * 16 + i * 8192, R, C); sR[i] = R; sC[i] = C; const int Rb = Epi::PERM ? ((R & ~31) + perm32(R & 31)) : R;
        voffA[0][i] = (unsigned)(R * K + C) * 2u; voffA[1][i] = voffA[0][i]; nvoffA[0][i] = voffA[0][i]; nvoffA[1][i] = voffA[0][i]; voffB[i] = (unsigned)(Rb * K + C) * 2u; }
    const size_t kstep = (size_t)(BK * 2);
    const size_t hstep = (size_t)HALF * K * 2;
    const size_t ahstep = GATHER ? (size_t)0 : hstep;
    const unsigned ldsw = (unsigned)wid * 1024u;
    const int aoff = lds_byte(wr * 64 + fr, fq * 8), boff = lds_byte(wc * 32 + fr, fq * 8);
#define PG8_SA(b, h) (((b) * 2 + (h)) * HTB)
#define PG8_SB(b, h) ((4 + (b) * 2 + (h)) * HTB)
#define PG8_STAGE(bufoff, gbase, voff) do { _Pragma("unroll") for (int _i = 0; _i < 2; ++_i) \
        __builtin_amdgcn_global_load_lds((const unsigned*)((const char*)(gbase) + (voff)[_i]), (PG8_LAS unsigned*)(lds + (bufoff) + ldsw + _i * 8192), 16, 0, 0); } while (0)
#define PG8_STAGE_A(bufoff, gbase, h, VO) PG8_STAGE(bufoff, (gbase) + (h) * ahstep, (VO)[GATHER ? (h) : 0])
#define PG8_LDA(dst, b, h) do { _Pragma("unroll") for (int m = 0; m < 4; ++m) _Pragma("unroll") for (int k = 0; k < 2; ++k) dst[m][k] = *(const PG8_LAS bf16x8*)(lds + PG8_SA(b, h) + aoff + m * 2048 + k * 1024); } while (0)
#define PG8_LDB(dst, b, h) do { _Pragma("unroll") for (int n = 0; n < 2; ++n) _Pragma("unroll") for (int k = 0; k < 2; ++k) dst[n][k] = *(const PG8_LAS bf16x8*)(lds + PG8_SB(b, h) + boff + n * 2048 + k * 1024); } while (0)
#define PG8_MMA(ai, bj, At, Bt) do { __builtin_amdgcn_s_setprio(1); _Pragma("unroll") for (int m = 0; m < 4; ++m) _Pragma("unroll") for (int n = 0; n < 2; ++n) _Pragma("unroll") for (int k = 0; k < 2; ++k) \
        acc[ai][bj][m][n] = __builtin_amdgcn_mfma_f32_16x16x32_bf16(Bt[n][k], At[m][k], acc[ai][bj][m][n], 0, 0, 0); __builtin_amdgcn_s_setprio(0); } while (0)
#define PG8_WAIT_V(n) asm volatile("s_waitcnt vmcnt(" #n ")" ::: "memory")
#define PG8_WAIT_L(n) asm volatile("s_waitcnt lgkmcnt(" #n ")" ::: "memory")
#define PG8_BAR __builtin_amdgcn_s_barrier()
#define PG8_SCHED __builtin_amdgcn_sched_barrier(0)
    Unit cur, nxt; int ui = 0;
    if (!S.next(0, cur)) return;
    f32x4 acc[2][2][4][2];
#pragma unroll
    for (int a = 0; a < 2; ++a)
#pragma unroll
        for (int b = 0; b < 2; ++b)
#pragma unroll
            for (int m = 0; m < 4; ++m)
#pragma unroll
                for (int n = 0; n < 2; ++n) acc[a][b][m][n] = (f32x4){0.f, 0.f, 0.f, 0.f};
    bf16x8 At[4][2], B0[2][2], B1[2][2];
    const char* cA = S.a_ptr(cur); const char* cB = S.b_ptr(cur);
    if constexpr (GATHER) {
#pragma unroll
        for (int h = 0; h < 2; ++h)
#pragma unroll
            for (int i = 0; i < 2; ++i) voffA[h][i] = S.a_off(0, h * HALF + sR[i], sC[i], 0);
    }
    PG8_STAGE(PG8_SB(0, 0), cB, voffB); PG8_STAGE(PG8_SB(0, 1), cB + hstep, voffB); PG8_STAGE_A(PG8_SA(0, 0), cA, 0, voffA); PG8_STAGE_A(PG8_SA(0, 1), cA, 1, voffA);
    if (wr == 1) PG8_BAR;
    PG8_WAIT_V(2); PG8_BAR;
    PG8_STAGE(PG8_SB(1, 0), cB + kstep, voffB); PG8_STAGE_A(PG8_SA(1, 0), cA + kstep, 0, voffA); PG8_STAGE(PG8_SB(1, 1), cB + hstep + kstep, voffB);
    PG8_WAIT_V(6); PG8_BAR;
    for (;;) {
        const bool has_next = S.next(ui + 1, nxt);
        const char* nA = has_next ? S.a_ptr(nxt) : cA; const char* nB = has_next ? S.b_ptr(nxt) : cB;
        if constexpr (GATHER) {
#pragma unroll
            for (int h = 0; h < 2; ++h)
#pragma unroll
                for (int i = 0; i < 2; ++i) nvoffA[h][i] = has_next ? S.a_off(ui + 1, h * HALF + sR[i], sC[i], 0) : voffA[h][i];
        }
        for (int t = 0; t < nt; t += 2) {
            const bool last = (t == nt - 2);
            const char* a1 = cA + (size_t)(t + 1) * kstep;
            const char* a2 = last ? nA : cA + (size_t)(t + 2) * kstep; const char* b2 = last ? nB : cB + (size_t)(t + 2) * kstep;
            const char* a3 = a2 + kstep; const char* b3 = b2 + kstep;
            unsigned vo2[2][2];
#pragma unroll
            for (int h = 0; h < 2; ++h)
#pragma unroll
                for (int i = 0; i < 2; ++i) vo2[h][i] = (GATHER && last) ? nvoffA[h][i] : voffA[h][i];
            PG8_LDB(B0, 0, 0); PG8_LDB(B1, 0, 1); PG8_SCHED; PG8_LDA(At, 0, 0); PG8_STAGE_A(PG8_SA(1, 1), a1, 1, voffA);
            PG8_WAIT_V(8); PG8_WAIT_L(0); PG8_BAR; PG8_MMA(0, 0, At, B0); PG8_MMA(0, 1, At, B1); PG8_BAR; PG8_SCHED;
            PG8_LDA(At, 0, 1); PG8_STAGE(PG8_SB(0, 0), b2, voffB); PG8_STAGE(PG8_SB(0, 1), b2 + hstep, voffB); PG8_STAGE_A(PG8_SA(0, 0), a2, 0, vo2);
            PG8_WAIT_V(8); PG8_WAIT_L(0); PG8_BAR; PG8_MMA(1, 0, At, B0); PG8_MMA(1, 1, At, B1); PG8_BAR; PG8_SCHED;
            PG8_LDB(B0, 1, 0); PG8_LDB(B1, 1, 1); PG8_SCHED; PG8_LDA(At, 1, 0); PG8_STAGE_A(PG8_SA(0, 1), a2, 1, vo2);
            PG8_WAIT_V(8); PG8_WAIT_L(0); PG8_BAR; PG8_MMA(0, 0, At, B0); PG8_MMA(0, 1, At, B1); PG8_BAR; PG8_SCHED;
            PG8_LDA(At, 1, 1); PG8_STAGE(PG8_SB(1, 0), b3, voffB); PG8_STAGE(PG8_SB(1, 1), b3 + hstep, voffB); PG8_STAGE_A(PG8_SA(1, 0), a3, 0, vo2);
            PG8_WAIT_V(8); PG8_WAIT_L(0); PG8_BAR; PG8_MMA(1, 0, At, B0); PG8_MMA(1, 1, At, B1); PG8_BAR; PG8_SCHED;
        }
        if constexpr (ALIGN_EPI) { if (wr == 0) PG8_BAR; }
        E(acc, cur, wr, wc, fr, fq);
        if (!has_next) break;
#pragma unroll
        for (int a = 0; a < 2; ++a)
#pragma unroll
            for (int b = 0; b < 2; ++b)
#pragma unroll
                for (int m = 0; m < 4; ++m)
#pragma unroll
                    for (int n = 0; n < 2; ++n) acc[a][b][m][n] = (f32x4){0.f, 0.f, 0.f, 0.f};
        cur = nxt; cA = nA; cB = nB; ++ui;
        if constexpr (GATHER) {
#pragma unroll
            for (int h = 0; h < 2; ++h)
#pragma unroll
                for (int i = 0; i < 2; ++i) voffA[h][i] = nvoffA[h][i];
        }
        if constexpr (ALIGN_EPI) { if (wr == 1) PG8_BAR; }
    }
    PG8_WAIT_V(0);
    if constexpr (!ALIGN_EPI) { if (wr == 0) PG8_BAR; }
    PG8_BAR;
#undef PG8_SA
#undef PG8_SB
#undef PG8_STAGE
#undef PG8_STAGE_A
#undef PG8_LDA
#undef PG8_LDB
#undef PG8_MMA
#undef PG8_WAIT_V
#undef PG8_WAIT_L
#undef PG8_BAR
#undef PG8_SCHED
}
__device__ __forceinline__ float silu_f(float x) { return x * __builtin_amdgcn_rcpf(1.0f + __builtin_amdgcn_exp2f(-1.4426950408889634f * x)); }
__device__ __forceinline__ u32x4 pack8v(const f32x4& v0, const f32x4& v1) { u32x4 w; w.x = cvt_pk_bf16(v0[0], v0[1]); w.y = cvt_pk_bf16(v0[2], v0[3]); w.z = cvt_pk_bf16(v1[0], v1[1]); w.w = cvt_pk_bf16(v1[2], v1[3]); return w; }

struct EpiRetProj {
    static constexpr bool PERM = true;
    bf16_t* QD; bf16_t* KH; bf16_t* G; const float* tab;
    __device__ __forceinline__ void operator()(const f32x4 (&acc)[2][2][4][2], const Unit& u, int wr, int wc, int fr, int fq) const {
        const int row0 = u.pm * BM + wr * 64 + fr, cl = wc * 32 + 8 * fq;
        if (u.pn < 8) {
            const bool isq = u.pn < 4; const int h = u.pn & 3;
            const float lg = __builtin_amdgcn_logf(1.0f - __builtin_amdgcn_exp2f((float)(-5 - h)));
            bf16_t* base = (isq ? QD : KH) + h * 256 + cl;
#pragma unroll
            for (int ai = 0; ai < 2; ++ai)
#pragma unroll
                for (int m = 0; m < 4; ++m) { const int row = row0 + ai * HALF + m * 16, pos = row & 16383, ic = row & 127;
                    const float sc = isq ? __builtin_amdgcn_exp2f(lg * (float)(ic + 1)) : 0.0625f * __builtin_amdgcn_exp2f(-lg * (float)(ic + 1));
                    const f32x4* tp = (const f32x4*)(tab + ((size_t)pos * 128 + cl) * 2);
                    const f32x4 t0 = tp[0], t1 = tp[1], t2 = tp[2], t3 = tp[3];
                    const f32x4 a0 = acc[ai][0][m][0], a1 = acc[ai][0][m][1], b0 = acc[ai][1][m][0], b1 = acc[ai][1][m][1];
                    f32x4 o10, o11, o20, o21;
                    o10[0] = (a0[0] * t0[0] - b0[0] * t0[1]) * sc; o20[0] = (b0[0] * t0[0] + a0[0] * t0[1]) * sc;
                    o10[1] = (a0[1] * t0[2] - b0[1] * t0[3]) * sc; o20[1] = (b0[1] * t0[2] + a0[1] * t0[3]) * sc;
                    o10[2] = (a0[2] * t1[0] - b0[2] * t1[1]) * sc; o20[2] = (b0[2] * t1[0] + a0[2] * t1[1]) * sc;
                    o10[3] = (a0[3] * t1[2] - b0[3] * t1[3]) * sc; o20[3] = (b0[3] * t1[2] + a0[3] * t1[3]) * sc;
                    o11[0] = (a1[0] * t2[0] - b1[0] * t2[1]) * sc; o21[0] = (b1[0] * t2[0] + a1[0] * t2[1]) * sc;
                    o11[1] = (a1[1] * t2[2] - b1[1] * t2[3]) * sc; o21[1] = (b1[1] * t2[2] + a1[1] * t2[3]) * sc;
                    o11[2] = (a1[2] * t3[0] - b1[2] * t3[1]) * sc; o21[2] = (b1[2] * t3[0] + a1[2] * t3[1]) * sc;
                    o11[3] = (a1[3] * t3[2] - b1[3] * t3[3]) * sc; o21[3] = (b1[3] * t3[2] + a1[3] * t3[3]) * sc;
                    bf16_t* rp = base + (size_t)row * 1024;
                    *(u32x4*)rp = pack8v(o10, o11); *(u32x4*)(rp + 128) = pack8v(o20, o21); asm volatile("" ::: "memory"); }
        } else {
            bf16_t* base = G + (u.pn - 8) * 256 + cl;
#pragma unroll
            for (int ai = 0; ai < 2; ++ai)
#pragma unroll
                for (int m = 0; m < 4; ++m) { bf16_t* rp = base + (size_t)(row0 + ai * HALF + m * 16) * 2048;
#pragma unroll
                    for (int bj = 0; bj < 2; ++bj) { f32x4 v0 = acc[ai][bj][m][0], v1 = acc[ai][bj][m][1];
#pragma unroll
                        for (int j = 0; j < 4; ++j) { v0[j] = silu_f(v0[j]); v1[j] = silu_f(v1[j]); }
                        *(u32x4*)(rp + bj * HALF) = pack8v(v0, v1); } }
        }
    }
};
struct EpiVT {
    static constexpr bool PERM = true;
    bf16_t* VT;
    __device__ __forceinline__ void operator()(const f32x4 (&acc)[2][2][4][2], const Unit& u, int wr, int wc, int fr, int fq) const {
        const int row0 = u.pm * BM + wr * 64 + fr, c0 = u.pn * BM + wc * 32 + 8 * fq;
#pragma unroll
        for (int ai = 0; ai < 2; ++ai)
#pragma unroll
            for (int m = 0; m < 4; ++m) { const int R = row0 + ai * HALF + m * 16, h = R >> 9, e = R & 511;
#pragma unroll
                for (int bj = 0; bj < 2; ++bj) { const int c = c0 + bj * HALF, b = c >> 14, t = c & 16383, n = t >> 7, oct = (t & 127) >> 3;
                    const size_t off = ((size_t)((b * 4 + h) * 128 + n) << 16) + (size_t)(((((e >> 5) * 8 + (oct >> 1)) * 2 + (oct & 1)) * 32 + (e & 31)) * 8);
                    *(u32x4*)(VT + off) = pack8v(acc[ai][bj][m][0], acc[ai][bj][m][1]); } }
    }
};
struct EpiAddBf16 {
    static constexpr bool PERM = true;
    bf16_t* XB; float alpha;
    __device__ __forceinline__ void operator()(const f32x4 (&acc)[2][2][4][2], const Unit& u, int wr, int wc, int fr, int fq) const {
        const int row0 = u.pm * BM + wr * 64 + fr, col0 = u.pn * BM + wc * 32 + 8 * fq;
#pragma unroll
        for (int ai = 0; ai < 2; ++ai)
#pragma unroll
            for (int m = 0; m < 4; ++m) { bf16_t* rowp = XB + (size_t)(row0 + ai * HALF + m * 16) * 1024 + col0;
#pragma unroll
                for (int bj = 0; bj < 2; ++bj) { const u32x4 x = *(const u32x4*)(rowp + bj * HALF); f32x4 v0 = acc[ai][bj][m][0], v1 = acc[ai][bj][m][1];
                    v0[0] += alpha * __builtin_bit_cast(float, x.x << 16); v0[1] += alpha * __builtin_bit_cast(float, x.x & 0xffff0000u);
                    v0[2] += alpha * __builtin_bit_cast(float, x.y << 16); v0[3] += alpha * __builtin_bit_cast(float, x.y & 0xffff0000u);
                    v1[0] += alpha * __builtin_bit_cast(float, x.z << 16); v1[1] += alpha * __builtin_bit_cast(float, x.z & 0xffff0000u);
                    v1[2] += alpha * __builtin_bit_cast(float, x.w << 16); v1[3] += alpha * __builtin_bit_cast(float, x.w & 0xffff0000u);
                    *(u32x4*)(rowp + bj * HALF) = pack8v(v0, v1); } }
    }
};
struct EpiSwiGLU {
    static constexpr bool PERM = true;
    bf16_t* H;
    __device__ __forceinline__ void operator()(const f32x4 (&acc)[2][2][4][2], const Unit& u, int wr, int wc, int fr, int fq) const {
        const int row0 = u.pm * BM + wr * 64 + fr, col0 = u.pn * HALF + wc * 32 + 8 * fq;
#pragma unroll
        for (int ai = 0; ai < 2; ++ai)
#pragma unroll
            for (int m = 0; m < 4; ++m) { f32x4 v0 = acc[ai][0][m][0], v1 = acc[ai][0][m][1]; const f32x4 u0 = acc[ai][1][m][0], u1 = acc[ai][1][m][1];
#pragma unroll
                for (int j = 0; j < 4; ++j) { v0[j] = silu_f(v0[j]) * u0[j]; v1[j] = silu_f(v1[j]) * u1[j]; }
                *(u32x4*)(H + (size_t)(row0 + ai * HALF + m * 16) * 3584 + col0) = pack8v(v0, v1); }
    }
};
struct EpiQKV {
    static constexpr bool PERM = true;
    bf16_t* P;
    __device__ __forceinline__ void operator()(const f32x4 (&acc)[2][2][4][2], const Unit& u, int wr, int wc, int fr, int fq) const {
        const int row0 = u.pm * BM + wr * 64 + fr, cl = wc * 32 + 8 * fq;
        const int which = u.pn / 6, g = (u.pn % 6) >> 1, hp = u.pn & 1, sh = 2 * g;
#pragma unroll
        for (int ai = 0; ai < 2; ++ai)
#pragma unroll
            for (int m = 0; m < 4; ++m) { const int r = row0 + ai * HALF + m * 16, b = r >> 14, t = r & 16383;
                const int perm = (t & ((1 << sh) - 1)) * (16384 >> sh) + (t >> sh);
#pragma unroll
                for (int bj = 0; bj < 2; ++bj) { const int head = 2 * hp + bj;
                    bf16_t* dst = P + ((size_t)(((which * 3 + g) * 8 + b * 4 + head) * 16384 + perm) << 7) + cl;
                    *(u32x4*)dst = pack8v(acc[ai][bj][m][0], acc[ai][bj][m][1]); } }
    }
};
struct EpiBf16Y {
    static constexpr bool PERM = true;
    bf16_t* Y;
    __device__ __forceinline__ void operator()(const f32x4 (&acc)[2][2][4][2], const Unit& u, int wr, int wc, int fr, int fq) const {
        const int row0 = u.pm * BM + wr * 64 + fr, col0 = u.pn * BM + wc * 32 + 8 * fq;
#pragma unroll
        for (int ai = 0; ai < 2; ++ai)
#pragma unroll
            for (int m = 0; m < 4; ++m) { bf16_t* rp = Y + (size_t)(row0 + ai * HALF + m * 16) * 1024 + col0;
#pragma unroll
                for (int bj = 0; bj < 2; ++bj) *(u32x4*)(rp + bj * HALF) = pack8v(acc[ai][bj][m][0], acc[ai][bj][m][1]); }
    }
};
struct EpiF32Slab {
    static constexpr bool PERM = false;
    float* S;
    __device__ __forceinline__ void operator()(const f32x4 (&acc)[2][2][4][2], const Unit& u, int wr, int wc, int fr, int fq) const {
        float* base = S + ((size_t)u.ex << 16) + (size_t)(wr * 64 + fr) * 256 + wc * 32 + 4 * fq;
#pragma unroll
        for (int ai = 0; ai < 2; ++ai)
#pragma unroll
            for (int m = 0; m < 4; ++m) { float* rowp = base + (size_t)(ai * HALF + m * 16) * 256;
#pragma unroll
                for (int bj = 0; bj < 2; ++bj)
#pragma unroll
                    for (int n = 0; n < 2; ++n) *(f32x4*)(rowp + bj * HALF + n * 16) = acc[ai][bj][m][n]; }
    }
};
}
namespace swa {
constexpr int D = 128; constexpr float THR = 8.f; constexpr bool WSKIP = true; constexpr int LSE_LDS_OFF = 131072;
constexpr float SCALE = 0.08838834764831845f;
constexpr int NW = 8, QBLK = 32, KVBLK = 64, QB = NW * QBLK;
constexpr int SHM_V = KVBLK * D * 2, SHM_K = KVBLK * D * 2;
constexpr int LDS_BYTES = 2 * SHM_V + 2 * SHM_K + NW * 64 * 4;

using bf16 = __hip_bfloat16;
typedef short bf16x8 __attribute__((ext_vector_type(8)));
typedef short s16x4 __attribute__((ext_vector_type(4)));
typedef float f32x16 __attribute__((ext_vector_type(16)));
typedef float f32x4 __attribute__((ext_vector_type(4)));
typedef unsigned u32x4 __attribute__((ext_vector_type(4)));
template <class A, class Bt> struct same_t { static constexpr bool v = false; };
template <class A> struct same_t<A, A> { static constexpr bool v = true; };

#define KSWZ(row, colB) ((row) * 256 + ((colB) ^ (((row) & 7) << 4)))
#define SBAR() __builtin_amdgcn_sched_barrier(0)
__device__ __forceinline__ int v_st(int k, int c) { const int kk = (k & ~0xC) | ((k & 4) << 1) | ((k & 8) >> 1); return ((kk >> 3) * 4 + (c >> 5)) * 512 + ((kk & 7) * 32 + (c & 31)) * 2; }
__device__ __forceinline__ int v_rd_base(int lane) { return ((lane & 3) << 3) | (((lane >> 2) & 3) << 6) | (((lane >> 4) & 1) << 5) | (((lane >> 5) & 1) << 8); }
constexpr int v_rd_off(int d0, int ks, int half) { return d0 * 512 + ks * 4096 + half * 2048; }
__device__ __forceinline__ int crow(int r, int hi) { return (r & 3) + 8 * (r >> 2) + 4 * hi; }
__device__ __forceinline__ unsigned cvtpk(float lo, float hi) {
    unsigned r; asm volatile("v_cvt_pk_bf16_f32 %0, %1, %2" : "=v"(r) : "v"(lo), "v"(hi)); return r;
}
__device__ __forceinline__ bf16x8 pack8(f32x4 a, f32x4 b) {
    u32x4 w = {cvtpk(a[0], a[1]), cvtpk(a[2], a[3]), cvtpk(b[0], b[1]), cvtpk(b[2], b[3])};
    return *reinterpret_cast<bf16x8*>(&w);
}
template <class T> __device__ __forceinline__ bf16x8 load8(const T* p) {
    if constexpr (same_t<T, float>::v) { return pack8(*(const f32x4*)p, *(const f32x4*)(p + 4)); }
    else { return *reinterpret_cast<const bf16x8*>(p); }
}
__device__ __forceinline__ void mask_tile(f32x16& p0, f32x16& p1, int dq, unsigned W) {
    const float NEG = -__builtin_inff();
#pragma unroll
    for (int r = 0; r < 16; ++r) {
        const int c = (r & 3) + 8 * (r >> 2);
        if ((unsigned)(dq - c) >= W) p0[r] = NEG;
        if ((unsigned)(dq - c - 32) >= W) p1[r] = NEG;
    }
}
__device__ __forceinline__ void partialSM(f32x16& p0, f32x16& p1, float& m_reg, float& mn, float& alpha) {
    float pmax = p0[0]; for (int r = 1; r < 16; ++r) pmax = fmaxf(pmax, p0[r]); for (int r = 0; r < 16; ++r) pmax = fmaxf(pmax, p1[r]);
    { auto rr = __builtin_amdgcn_permlane32_swap(__float_as_uint(pmax), __float_as_uint(pmax), false, false);
      pmax = fmaxf(__uint_as_float(rr[0]), __uint_as_float(rr[1])); }
    constexpr float C2 = 1.4426950408889634f * SCALE;
    if (__builtin_expect(__all((pmax - m_reg) * SCALE <= THR), 1)) { mn = m_reg; alpha = 1.f; }
    else { mn = fmaxf(m_reg, pmax); alpha = __builtin_amdgcn_exp2f((m_reg - mn) * C2); m_reg = mn; }
    const float mnL = -mn * C2;
    for (int r = 0; r < 16; ++r) p0[r] = fmaf(p0[r], C2, mnL); for (int r = 0; r < 16; ++r) p1[r] = fmaf(p1[r], C2, mnL);
    for (int r = 0; r < 16; ++r) p0[r] = __builtin_amdgcn_exp2f(p0[r]);
}
__device__ __forceinline__ void finishSM(f32x16& p0, f32x16& p1, float alpha, float& l_reg, bf16x8& pa0, bf16x8& pa1, bf16x8& pa2, bf16x8& pa3) {
    for (int r = 0; r < 16; ++r) p1[r] = __builtin_amdgcn_exp2f(p1[r]);
    float ps = 0; for (int r = 0; r < 16; ++r) ps += p0[r]; for (int r = 0; r < 16; ++r) ps += p1[r];
    { auto rr = __builtin_amdgcn_permlane32_swap(__float_as_uint(ps), __float_as_uint(ps), false, false);
      ps = __uint_as_float(rr[0]) + __uint_as_float(rr[1]); }
    l_reg = l_reg * alpha + ps;
#define PK4(P, B_, OUT) do { unsigned a0 = cvtpk(P[B_+0], P[B_+1]), a1 = cvtpk(P[B_+2], P[B_+3]);                          \
        unsigned b0 = cvtpk(P[B_+4], P[B_+5]), b1 = cvtpk(P[B_+6], P[B_+7]);                                             \
        auto r0 = __builtin_amdgcn_permlane32_swap(a0, b0, false, false); auto r1 = __builtin_amdgcn_permlane32_swap(a1, b1, false, false); \
        u32x4 w = {r0[0], r1[0], r0[1], r1[1]}; OUT = *reinterpret_cast<bf16x8*>(&w); } while (0)
    PK4(p0, 0, pa0); PK4(p0, 8, pa1); PK4(p1, 0, pa2); PK4(p1, 8, pa3);
#undef PK4
}
template <int KB, bool SK>
__device__ __forceinline__ void qkt(f32x16& p0, f32x16& p1, const char* K_lds, int r32, int hi, const bf16x8* qr, bool act) {
    if (SK && !act) { const float NEG = -__builtin_inff();
#pragma unroll
        for (int r = 0; r < 16; ++r) { p0[r] = NEG; p1[r] = NEG; } return; }
    p0 = f32x16{}; p1 = f32x16{};
    const char* kb[4];
#pragma unroll
    for (int dd = 0; dd < 4; ++dd) kb[dd] = K_lds + KB * SHM_K + KSWZ(r32, (dd * 16 + hi * 8) * 2);
#pragma unroll
    for (int d0 = 0; d0 < 8; ++d0) { const char* a = kb[d0 & 3] + (d0 >> 2) * 128;
        bf16x8 b0 = *reinterpret_cast<const bf16x8*>(a);
        bf16x8 b1 = *reinterpret_cast<const bf16x8*>(a + 32 * 256);
        p0 = __builtin_amdgcn_mfma_f32_32x32x16_bf16(b0, qr[d0], p0, 0, 0, 0);
        p1 = __builtin_amdgcn_mfma_f32_32x32x16_bf16(b1, qr[d0], p1, 0, 0, 0); }
}
template <int VB, bool SK>
__device__ __forceinline__ void pv_tile(f32x16* o, int vb0, bf16x8 pa0, bf16x8 pa1, bf16x8 pa2, bf16x8 pa3, bool act) {
    if (SK && !act) return;
#define TRRD(dst, off) asm volatile("ds_read_b64_tr_b16 %0, %1 offset:%2" : "=&v"(dst) : "v"(vb0), "i"(off) : "memory")
#define PV_D0(d0) do { s16x4 l0, l1, l2, l3, h0, h1, h2, h3; constexpr int b_ = VB * SHM_V + v_rd_off(d0, 0, 0);     \
        TRRD(l0, b_); TRRD(h0, b_ + 2048); TRRD(l1, b_ + 4096); TRRD(h1, b_ + 6144); TRRD(l2, b_ + 8192); TRRD(h2, b_ + 10240); TRRD(l3, b_ + 12288); TRRD(h3, b_ + 14336); \
        asm volatile("s_waitcnt lgkmcnt(0)" ::: "memory"); SBAR();                 \
        o[d0] = __builtin_amdgcn_mfma_f32_32x32x16_bf16(pa0, (bf16x8){l0[0], l0[1], l0[2], l0[3], h0[0], h0[1], h0[2], h0[3]}, o[d0], 0, 0, 0);   \
        o[d0] = __builtin_amdgcn_mfma_f32_32x32x16_bf16(pa1, (bf16x8){l1[0], l1[1], l1[2], l1[3], h1[0], h1[1], h1[2], h1[3]}, o[d0], 0, 0, 0);   \
        o[d0] = __builtin_amdgcn_mfma_f32_32x32x16_bf16(pa2, (bf16x8){l2[0], l2[1], l2[2], l2[3], h2[0], h2[1], h2[2], h2[3]}, o[d0], 0, 0, 0);   \
        o[d0] = __builtin_amdgcn_mfma_f32_32x32x16_bf16(pa3, (bf16x8){l3[0], l3[1], l3[2], l3[3], h3[0], h3[1], h3[2], h3[3]}, o[d0], 0, 0, 0); } while (0)
    PV_D0(0); PV_D0(1); PV_D0(2); PV_D0(3);
#undef PV_D0
#undef TRRD
}

template <class TIn, class TOut> struct BlockRef { const TIn* Q; const TIn* K; const TIn* V; TOut* O; int P0; };
template <class TIn> struct Seam {
    int tid;
    bf16x8 qr[8];
    bf16x8 st_v0, st_v1, st_k0, st_k1; f32x4 sf0, sf1, sf2, sf3;
    f32x4 tq[16];
};
__device__ __forceinline__ int swa_jlo(int P0, int W) { const int lowk = P0 - W + 1; return lowk > 0 ? lowk / KVBLK : 0; }
#define ROW(p, k0, rr) ((p) + (size_t)((k0) + (rr)) * D + sc)
#define VMW() asm volatile("s_waitcnt vmcnt(0)" ::: "memory")
#define VMWN(n) asm volatile("s_waitcnt vmcnt(%0)" :: "i"(n) : "memory")
#define SLOAD_H(Kp, Vp, k0) do { S.st_v0 = load8<TIn>(ROW(Vp, k0, sr)); S.st_v1 = load8<TIn>(ROW(Vp, k0, 32 + sr));              \
                         S.st_k0 = load8<TIn>(ROW(Kp, k0, sr)); S.st_k1 = load8<TIn>(ROW(Kp, k0, 32 + sr)); } while (0)
#define SWRITE_HK(bf) do { *(bf16x8*)(K_lds + (bf) * SHM_K + kws) = S.st_k0; *(bf16x8*)(K_lds + (bf) * SHM_K + kws + 32 * 256) = S.st_k1; } while (0)
#define SWRITE_HV(bf) do { *(bf16x8*)(V_lds + (bf) * SHM_V + vst0) = S.st_v0; *(bf16x8*)(V_lds + (bf) * SHM_V + vst1) = S.st_v1; } while (0)
#define SWRITE_H(bf) do { SWRITE_HV(bf); SWRITE_HK(bf); } while (0)
#define SLOAD_F(p, k0) do { S.sf0 = *(const f32x4*)ROW(p, k0, sr); S.sf1 = *(const f32x4*)(ROW(p, k0, sr) + 4);                \
                            S.sf2 = *(const f32x4*)ROW(p, k0, 32 + sr); S.sf3 = *(const f32x4*)(ROW(p, k0, 32 + sr) + 4); } while (0)
#define SWRITE_KF(bf) do { *(bf16x8*)(K_lds + (bf) * SHM_K + kws) = pack8(S.sf0, S.sf1); *(bf16x8*)(K_lds + (bf) * SHM_K + kws + 32 * 256) = pack8(S.sf2, S.sf3); } while (0)
#define SWRITE_VF(bf) do { *(bf16x8*)(V_lds + (bf) * SHM_V + vst0) = pack8(S.sf0, S.sf1); *(bf16x8*)(V_lds + (bf) * SHM_V + vst1) = pack8(S.sf2, S.sf3); } while (0)
template <class TIn, class TOut>
__device__ __forceinline__ void causal_swa_prime(const BlockRef<TIn, TOut>& cur, int W, char* lds, Seam<TIn>& S) {
    constexpr bool F32 = same_t<TIn, float>::v;
    const int tid = S.tid, wid = __builtin_amdgcn_readfirstlane(tid >> 6), lane = tid & 63, r32 = lane & 31, hi = lane >> 5;
    const int sr = tid >> 4, sc = (tid & 15) * 8, kws = KSWZ(sr, sc * 2); char* K_lds = lds + 2 * SHM_V;
    const int kb0 = swa_jlo(cur.P0, W) * KVBLK;
    for (int d0 = 0; d0 < 8; ++d0) S.qr[d0] = load8<TIn>(cur.Q + (size_t)(wid * QBLK + r32) * D + d0 * 16 + hi * 8);
    if constexpr (F32) { SLOAD_F((const float*)cur.K, kb0); VMW(); SWRITE_KF(0); SBAR(); SLOAD_F((const float*)cur.V, kb0); }
    else { SLOAD_H(cur.K, cur.V, kb0); VMW(); SWRITE_HK(0); }
    __syncthreads();
}
template <class TIn, class TOut>
__device__ __forceinline__ void causal_swa_block(const BlockRef<TIn, TOut>& cur, const BlockRef<TIn, TOut>& nxt, int skv, int W, char* lds, Seam<TIn>& S) {
    constexpr bool F32 = same_t<TIn, float>::v;
    const int tid = S.tid, wid = __builtin_amdgcn_readfirstlane(tid >> 6), lane = tid & 63, r32 = lane & 31, hi = lane >> 5;
    const int j_lo = swa_jlo(cur.P0, W);
    int j_hi = (cur.P0 + QB - 1) / KVBLK + 1; if (j_hi > skv / KVBLK) j_hi = skv / KVBLK;
    const int NT = j_hi - j_lo;
    const int kbn = swa_jlo(nxt.P0, W) * KVBLK;
    const int qlo = cur.P0 + wid * QBLK, qm = qlo + r32 - 4 * hi;
    char* V_lds = lds; char* K_lds = lds + 2 * SHM_V;
    float* ws = (float*)(lds + 2 * SHM_V + 2 * SHM_K) + wid * 64; float* li_l = ws, * al_l = ws + 32;
    float m_reg = -1e30f, l_reg = 0; f32x16 o[4] = {};
    const int sr = tid >> 4, sc = (tid & 15) * 8, vst0 = v_st(sr, sc), vst1 = v_st(32 + sr, sc), kws = KSWZ(sr, sc * 2);
    const int vb0 = (int)(uintptr_t)V_lds + v_rd_base(lane);
    const TIn* Kh = cur.K; const TIn* Vh = cur.V;
#define RESC(a) do { if (__any((a) < 1.f)) { if (hi == 0) al_l[r32] = (a); asm volatile("s_waitcnt lgkmcnt(0)" ::: "memory");              \
                     for (int d_ = 0; d_ < 4; ++d_) for (int r = 0; r < 16; ++r) o[d_][r] *= al_l[crow(r, hi)]; } } while (0)
#define KBASE(t) ((j_lo + (t)) * KVBLK)
#define ACT(t) (KBASE(t) <= qlo + QBLK - 1 && KBASE(t) + KVBLK - 1 >= qlo - W + 1)
#define MASKT(P0_, P1_, t) do { const int kb_ = KBASE(t); if ((!SK || ACT(t)) && (kb_ + KVBLK - 1 > qlo || kb_ <= qlo + QBLK - 1 - W)) mask_tile(P0_, P1_, qm - kb_, (unsigned)W); } while (0)
    constexpr int NQL = F32 ? 16 : 8;
    constexpr bool SK = WSKIP && !F32;
#define SEAM_K0() do { VMWN(NQL); if constexpr (F32) { SWRITE_KF(0); SBAR(); SLOAD_F((const float*)nxt.V, kbn); } else { SWRITE_HK(0); } SBAR(); } while (0)
    f32x16 pA0, pA1, pB0, pB1; float mnA, mnB, alA, alB; bf16x8 pa0, pa1, pa2, pa3;
    if constexpr (F32) { VMW(); SWRITE_VF(0); SBAR(); } else { SWRITE_HV(0); SBAR(); }
    if (NT > 1) { if constexpr (F32) SLOAD_F((const float*)Kh, KBASE(1)); else SLOAD_H(Kh, Vh, KBASE(1)); }
    SBAR(); qkt<0, SK>(pA0, pA1, K_lds, r32, hi, S.qr, ACT(0));
    if constexpr (F32) { if (NT > 1) { VMW(); SWRITE_KF(1); SBAR(); SLOAD_F((const float*)Vh, KBASE(1)); } }
    MASKT(pA0, pA1, 0); partialSM(pA0, pA1, m_reg, mnA, alA);
    if (NT > 1) { VMW(); if constexpr (F32) { SWRITE_VF(1); SBAR(); if (NT > 2) SLOAD_F((const float*)Kh, KBASE(2)); } else SWRITE_H(1); }
    __syncthreads();
#define HALF_STEP(PX0, PX1, mnX, alX, PY0, PY1, alY, t, KB, VB, SB) do {                                                      \
        SBAR(); qkt<KB, SK>(PX0, PX1, K_lds, r32, hi, S.qr, ACT(t));                                             \
        finishSM(PY0, PY1, alY, l_reg, pa0, pa1, pa2, pa3); SBAR();                                                           \
        if ((t) + 1 < NT) { if constexpr (F32) { VMW(); SWRITE_KF(SB); SBAR(); SLOAD_F((const float*)Vh, KBASE((t) + 1)); }  \
                            else { SLOAD_H(Kh, Vh, KBASE((t) + 1)); } SBAR(); }                                               \
        pv_tile<VB, SK>(o, vb0, pa0, pa1, pa2, pa3, ACT((t) - 1)); MASKT(PX0, PX1, (t)); partialSM(PX0, PX1, m_reg, mnX, alX);                                        \
        __syncthreads();                                                                                                      \
        if ((t) + 1 < NT) { VMW(); if constexpr (F32) { SWRITE_VF(SB); SBAR(); if ((t) + 2 < NT) SLOAD_F((const float*)Kh, KBASE((t) + 2)); } \
                            else { SWRITE_H(SB); } }                                                                          \
        RESC(alX); __syncthreads(); } while (0)
    for (int t = 1; t + 1 < NT; t += 2) {
        HALF_STEP(pB0, pB1, mnB, alB, pA0, pA1, alA, t, 1, 0, 0);
        HALF_STEP(pA0, pA1, mnA, alA, pB0, pB1, alB, t + 1, 0, 1, 1);
    }
    const bool even = (NT & 1) == 0;
    if (even) { SBAR(); qkt<1, SK>(pB0, pB1, K_lds, r32, hi, S.qr, ACT(NT - 1)); SBAR(); }
#define QROW(e) (nxt.Q + (size_t)(wid * QBLK + r32) * D + ((e) >> 1) * 16 + hi * 8 + ((e) & 1) * 4)
    if constexpr (F32) { SLOAD_F((const float*)nxt.K, kbn); SBAR();
#pragma unroll
        for (int e = 0; e < 8; ++e) S.tq[e] = *(const f32x4*)QROW(e); }
    else { SLOAD_H(nxt.K, nxt.V, kbn); SBAR();
#pragma unroll
        for (int d0 = 0; d0 < 8; ++d0) S.qr[d0] = load8<TIn>(nxt.Q + (size_t)(wid * QBLK + r32) * D + d0 * 16 + hi * 8); }
    SBAR();
    finishSM(pA0, pA1, alA, l_reg, pa0, pa1, pa2, pa3); SBAR();
    if constexpr (F32) {
#pragma unroll
        for (int e = 8; e < 16; ++e) S.tq[e] = *(const f32x4*)QROW(e); SBAR(); }
#undef QROW
    pv_tile<0, SK>(o, vb0, pa0, pa1, pa2, pa3, ACT(even ? NT - 2 : NT - 1));
    if (even) { MASKT(pB0, pB1, NT - 1); partialSM(pB0, pB1, m_reg, mnB, alB); __syncthreads(); RESC(alB);
        finishSM(pB0, pB1, alB, l_reg, pa0, pa1, pa2, pa3); SBAR(); pv_tile<1, SK>(o, vb0, pa0, pa1, pa2, pa3, ACT(NT - 1)); }
    SBAR(); SEAM_K0();
    if (hi == 0) { li_l[r32] = l_reg; ((float*)(lds + LSE_LDS_OFF))[wid * QBLK + r32] = m_reg * SCALE + __logf(l_reg); } asm volatile("s_waitcnt lgkmcnt(0)" ::: "memory");
    float rli[16];
#pragma unroll
    for (int r = 0; r < 16; ++r) rli[r] = __builtin_amdgcn_rcpf(li_l[crow(r, hi)]);
    TOut* Ow = cur.O + (size_t)(wid * QBLK) * D + (size_t)(hi * 4) * D + r32;
#pragma unroll
    for (int r = 0; r < 16; ++r) { const int orow = (r & 3) + 8 * (r >> 2);
#pragma unroll
        for (int d0 = 0; d0 < 4; ++d0) { const float v = o[d0][r] * rli[r];
            if constexpr (same_t<TOut, float>::v) { Ow[orow * D + d0 * 32] = v; }
            else { const float vn = __shfl_xor(v, 1);
                   if ((r32 & 1) == 0) *(unsigned*)(Ow + orow * D + d0 * 32) = cvtpk(v, vn); } } }
    if constexpr (F32) {
#pragma unroll
        for (int d0 = 0; d0 < 8; ++d0) S.qr[d0] = pack8(S.tq[2 * d0], S.tq[2 * d0 + 1]); }
    __syncthreads();
#undef RESC
#undef KBASE
#undef ACT
#undef MASKT
#undef SEAM_K0
#undef HALF_STEP
}
#undef ROW
#undef VMW
#undef VMWN
#undef SLOAD_H
#undef SWRITE_HK
#undef SWRITE_HV
#undef SWRITE_H
#undef SLOAD_F
#undef SWRITE_KF
#undef SWRITE_VF
}
constexpr int T_TOK = 32768, DMODEL = 1024, SEQ = 16384, DFF = 3584, NEXP = 8;
constexpr float ALPHA = 1.6817928305074290f, LN_EPS = 1e-5f;
constexpr int NWAVES = 8;
constexpr size_t MiB = 1u << 20;
constexpr size_t WS_CTL = 0, CTL_ZERO_BYTES = 1 * MiB;
constexpr size_t WS_WIN = 2 * MiB, WS_WRO = 26 * MiB, WS_WQKV = 34 * MiB, WS_WAO = 52 * MiB, WS_WGU = 54 * MiB, WS_WDN = 82 * MiB;
constexpr size_t WS_TAB = 96 * MiB, WS_XB = 112 * MiB;
constexpr size_t WS_LIST = 176 * MiB, WS_TSLOT = 178 * MiB, WS_GATE = 178 * MiB + 256 * 1024, WS_LC = 178 * MiB + 512 * 1024;
constexpr size_t WS_BIG = 179 * MiB;
constexpr size_t BIG_QD = 0, BIG_KH = 64 * MiB, BIG_VT = 128 * MiB, BIG_G = 256 * MiB, BIG_RT = 384 * MiB;
constexpr size_t BIG_HID = 0;
constexpr size_t BIG_QKV = 0, BIG_OP = 288 * MiB, BIG_LSE = 384 * MiB, BIG_O = 386 * MiB;
constexpr size_t BIG_YP = 462 * MiB, BIG_WMGU = 594 * MiB, BIG_WMD = 706 * MiB;
constexpr size_t WS_SLAB = WS_BIG + 762 * MiB;
constexpr size_t WS_END = WS_SLAB + 32 * MiB;
constexpr int CW_TMO = 0, CW_BAR = 4096, CW_CNT = 8192;
constexpr int RING_OFF = 0, RING_BYTES = 131072, AUX_OFF = 131072, AUX_BYTES = 30720, MISC_OFF = AUX_OFF + AUX_BYTES, LDS_BYTES = MISC_OFF + 512;
static_assert(LDS_BYTES <= 163840, "LDS");

#define GAS __attribute__((address_space(1)))
#define LAS __attribute__((address_space(3)))
typedef unsigned short bf16;
typedef unsigned v4u __attribute__((ext_vector_type(4)));
typedef unsigned v2u __attribute__((ext_vector_type(2)));
typedef float f32x4 __attribute__((ext_vector_type(4)));
typedef float f32x16 __attribute__((ext_vector_type(16)));
typedef short bf16x8 __attribute__((ext_vector_type(8)));
typedef short s16x4 __attribute__((ext_vector_type(4)));
typedef GAS unsigned gu32;
#define RLX_AGENT __ATOMIC_RELAXED, __HIP_MEMORY_SCOPE_AGENT
#define LDS_WAIT() asm volatile("s_waitcnt lgkmcnt(0)" ::: "memory")
#define VM_WAIT() asm volatile("s_waitcnt vmcnt(0)" ::: "memory")
__device__ __forceinline__ unsigned f2bf(float f) { unsigned u = __builtin_bit_cast(unsigned, f); return (u + 0x7fffu + ((u >> 16) & 1u)) >> 16; }
__device__ __forceinline__ unsigned pk2(float lo, float hi) { return f2bf(lo) | (f2bf(hi) << 16); }
__device__ __forceinline__ float bflo(unsigned w) { return __builtin_bit_cast(float, w << 16); }
__device__ __forceinline__ float bfhi(unsigned w) { return __builtin_bit_cast(float, w & 0xffff0000u); }
#define XB_TMO      128
#define XB_XCNT(j)  (256  + 64 * (j))
#define XB_XSUB(j)  (1280 + 64 * (j))
#define XB_XGEN(j)  (2304 + 64 * (j))
#define XB_TOP      3328
#define XB_TOPGEN   3392
#define XCD_BAR_WORDS 3456
#define XB_SPIN_CAP (1u << 18)

__device__ __forceinline__ unsigned xb_ld(unsigned* p)              { return __hip_atomic_load(p, __ATOMIC_RELAXED, __HIP_MEMORY_SCOPE_AGENT); }
__device__ __forceinline__ unsigned xb_add(unsigned* p, unsigned v) { return __hip_atomic_fetch_add(p, v, __ATOMIC_RELAXED, __HIP_MEMORY_SCOPE_AGENT); }
__device__ __forceinline__ unsigned xb_xcc_id() { return (unsigned)__builtin_amdgcn_s_getreg((3 << 11) | 20) & 0xFu; }
#define XB_SPIN(cond, bar) do { unsigned _sp = 0; while (cond) { __builtin_amdgcn_s_sleep(1); \
    if ((++_sp & 255u) == 0u) { if (xb_ld(&(bar)[XB_TMO])) break; if (_sp > XB_SPIN_CAP) { atomicAdd(&(bar)[XB_TMO], 1u); break; } } } } while (0)

struct XcdBarrier {
    unsigned* bar; unsigned x;
    volatile LAS unsigned* st;
};

__device__ __forceinline__ XcdBarrier xcd_barrier_post(unsigned* bar, volatile LAS unsigned* st) {
    XcdBarrier b; b.bar = bar; b.x = xb_xcc_id(); b.st = st;
    if (threadIdx.x == 0) (void)xb_add(&bar[XB_XCNT(b.x)], 1u);
    return b;
}
__device__ __forceinline__ void xcd_barrier_complete(unsigned* bar, unsigned x, unsigned& nloc, unsigned& nx) {
    const unsigned G = gridDim.x * gridDim.y * gridDim.z;
    unsigned sum, cnt, mine, sp = 0u;
    for (;;) {
        sum = 0u; cnt = 0u; mine = 0u;
#pragma unroll
        for (unsigned j = 0; j < 16; ++j) { const unsigned c = xb_ld(&bar[XB_XCNT(j)]); sum += c; cnt += (c > 0u) ? 1u : 0u; mine = (j == x) ? c : mine; }
        if (sum == G) break;
        __builtin_amdgcn_s_sleep(1);
        if ((++sp & 255u) == 0u) { if (xb_ld(&bar[XB_TMO])) break; if (sp > XB_SPIN_CAP) { atomicAdd(&bar[XB_TMO], 1u); break; } }
    }
    nloc = mine > 0u ? mine : 1u; nx = cnt > 0u ? cnt : 1u;
}

__device__ __forceinline__ void xcd_barrier(const XcdBarrier& b) {
    asm volatile("s_waitcnt vmcnt(0)" ::: "memory");
    __syncthreads();
    if (threadIdx.x == 0) {
        unsigned* bar = b.bar;
        __builtin_amdgcn_s_waitcnt(0);
        unsigned nloc = b.st[0], nx = b.st[1];
        if (nloc == 0u) { xcd_barrier_complete(bar, b.x, nloc, nx); b.st[0] = nloc; b.st[1] = nx; }
        const unsigned old = xb_add(&bar[XB_XSUB(b.x)], 1u);
        const unsigned gen = old / nloc;
        if (old + 1u == (gen + 1u) * nloc) {
            __builtin_amdgcn_fence(__ATOMIC_RELEASE, "agent");
            asm volatile("s_waitcnt vmcnt(0)" ::: "memory");
            const unsigned og = xb_add(&bar[XB_TOP], 1u);
            const unsigned tg = og / nx;
            if (og + 1u == (tg + 1u) * nx) xb_add(&bar[XB_TOPGEN], 1u);
            else XB_SPIN(xb_ld(&bar[XB_TOPGEN]) == tg, bar);
            __builtin_amdgcn_fence(__ATOMIC_ACQUIRE, "agent");
            xb_add(&bar[XB_XGEN(b.x)], 1u);
            asm volatile("s_waitcnt vmcnt(0)" ::: "memory");
        } else {
            XB_SPIN(xb_ld(&bar[XB_XGEN(b.x)]) == gen, bar);
            __builtin_amdgcn_fence(__ATOMIC_ACQUIRE, "agent");
            asm volatile("s_waitcnt vmcnt(0)" ::: "memory");
        }
    }
    __syncthreads();
}
struct Args { const float* in[15]; float* out; unsigned char* ws; };
struct Frame {
    LAS unsigned char* lds;
    volatile LAS unsigned* MISC;
    int tid, lane, wave, G, c;
};
__device__ __forceinline__ unsigned long long arg_u64(const Frame& F, int k) { const unsigned long long v = ((const LAS unsigned long long*)(F.lds + MISC_OFF + 128))[k];
    return ((unsigned long long)(unsigned)__builtin_amdgcn_readfirstlane((int)(unsigned)(v >> 32)) << 32) | (unsigned long long)(unsigned)__builtin_amdgcn_readfirstlane((int)(unsigned)v); }
#define ARGI(F, k) ((const float*)(const GAS float*)arg_u64(F, (k)))
#define ARGX(F) ((float*)(GAS float*)arg_u64(F, 15))
#define ARGWS(F) ((unsigned char*)(GAS unsigned char*)arg_u64(F, 16))
#define F_CTL(F) ((gu32*)(ARGWS(F) + WS_CTL))
__device__ __forceinline__ void frame_refresh(Frame& F) { int t = F.tid; asm volatile("" : "+v"(t)); F.tid = t; F.lane = t & 63; F.wave = __builtin_amdgcn_readfirstlane(t >> 6); unsigned l = (unsigned)(uintptr_t)F.lds; int c_ = F.c, g_ = F.G; asm volatile("" : "+s"(l), "+s"(c_), "+s"(g_)); F.lds = (LAS unsigned char*)(uintptr_t)l; F.c = c_; F.G = g_; }
__device__ __forceinline__ float wave_sum(float v) {
#pragma unroll
    for (int o = 1; o < 64; o <<= 1) v += __shfl_xor(v, o);
    return v;
}
__device__ __forceinline__ s16x4 vtr(const LAS unsigned char* p) { return __builtin_bit_cast(s16x4, __builtin_amdgcn_ds_read_tr16_b64_v4i16((LAS s16x4*)p)); }
__device__ __forceinline__ int crow(int r, int hi) { return (r & 3) + 8 * (r >> 2) + 4 * hi; }

__device__ __forceinline__ void tr_item(const float* W, int K, int N, bf16* WT, int k0, int n0, int drow0, LAS float* scr, int lane) {
#pragma unroll 8
    for (int i = 0; i < 32; ++i) { const int kk = 2 * i + (lane >> 5); scr[kk * 33 + (lane & 31)] = W[(size_t)(k0 + kk) * N + n0 + (lane & 31)]; }
    LDS_WAIT(); asm volatile("" ::: "memory");
    const int c = lane & 7;
#pragma unroll
    for (int j = 0; j < 4; ++j) { const int n = (lane >> 3) + 8 * j; const LAS float* s = scr + (8 * c) * 33 + n;
        v4u o; o.x = pk2(s[0 * 33], s[1 * 33]); o.y = pk2(s[2 * 33], s[3 * 33]); o.z = pk2(s[4 * 33], s[5 * 33]); o.w = pk2(s[6 * 33], s[7 * 33]);
        *(GAS v4u*)(WT + (size_t)(drow0 + n) * K + k0 + 8 * c) = o; }
    LDS_WAIT(); asm volatile("" ::: "memory");
}
template <int MAP> __device__ __forceinline__ void tr_matrix_item(const float* W, int K, int N, bf16* WT, int item, LAS float* scr, int lane) {
    const int nblk = N / 32, kb = item / nblk, nb = item - kb * nblk, n0 = 32 * nb; int dr = n0;
    if (MAP == 1) dr = n0 < 2048 ? n0 : (n0 < 4096 ? n0 + 2048 : n0 - 2048);
    if (MAP == 2) dr = (n0 >> 7) * 256 + (n0 & 127);
    if (MAP == 3) dr = (n0 >> 7) * 256 + 128 + (n0 & 127);
    tr_item(W, K, N, WT, 64 * kb, n0, dr, scr, lane);
}
__device__ __forceinline__ void p0_prologue(Frame& F) {
    LAS float* scr = (LAS float*)(F.lds + RING_OFF + F.wave * 16384);
    const int gw = F.c * NWAVES + F.wave, NGW = F.G * NWAVES;
    constexpr int I_WIN = 16 * 192, I_WRO = 32 * 32, I_QKV = 16 * 144, I_WAO = 8 * 32, I_GU = 16 * 112, I_DN = 56 * 32;
    constexpr int PERJ = I_WIN + I_WRO + I_QKV + I_WAO + 2 * I_GU + I_DN;
    for (int it = gw; it < 2 * PERJ; it += NGW) {
        const int j = it / PERJ; int r = it - j * PERJ;
        if (r < I_WIN) { tr_matrix_item<1>(ARGI(F, 3) + (size_t)j * 1024 * 6144, 1024, 6144, (bf16*)(ARGWS(F) + WS_WIN) + (size_t)j * 6144 * 1024, r, scr, F.lane); continue; } r -= I_WIN;
        if (r < I_WRO) { tr_matrix_item<0>(ARGI(F, 5) + (size_t)j * 2048 * 1024, 2048, 1024, (bf16*)(ARGWS(F) + WS_WRO) + (size_t)j * 1024 * 2048, r, scr, F.lane); continue; } r -= I_WRO;
        if (r < I_QKV) { tr_matrix_item<0>(ARGI(F, 6) + (size_t)j * 1024 * 4608, 1024, 4608, (bf16*)(ARGWS(F) + WS_WQKV) + (size_t)j * 4608 * 1024, r, scr, F.lane); continue; } r -= I_QKV;
        if (r < I_WAO) { tr_matrix_item<0>(ARGI(F, 7) + (size_t)j * 512 * 1024, 512, 1024, (bf16*)(ARGWS(F) + WS_WAO) + (size_t)j * 1024 * 512, r, scr, F.lane); continue; } r -= I_WAO;
        if (r < I_GU) { tr_matrix_item<2>(ARGI(F, 8) + (size_t)j * 1024 * 3584, 1024, 3584, (bf16*)(ARGWS(F) + WS_WGU) + (size_t)j * 7168 * 1024, r, scr, F.lane); continue; } r -= I_GU;
        if (r < I_GU) { tr_matrix_item<3>(ARGI(F, 9) + (size_t)j * 1024 * 3584, 1024, 3584, (bf16*)(ARGWS(F) + WS_WGU) + (size_t)j * 7168 * 1024, r, scr, F.lane); continue; } r -= I_GU;
        tr_matrix_item<0>(ARGI(F, 10) + (size_t)j * 3584 * 1024, 3584, 1024, (bf16*)(ARGWS(F) + WS_WDN) + (size_t)j * 1024 * 3584, r, scr, F.lane);
    }
    { float* tab = (float*)(ARGWS(F) + WS_TAB); const int gt = F.c * 512 + F.tid, NT = F.G * 512;
      for (int e = gt; e < SEQ * 128; e += NT) { const int pos = e >> 7, cc = e & 127;
          const double ang = (double)pos * exp(-9.210340371976184 * (double)cc * (1.0 / 128.0)); double sn, cs; sincos(ang, &sn, &cs);
          typedef float f32x2t __attribute__((ext_vector_type(2))); *(GAS f32x2t*)(tab + (size_t)e * 2) = (f32x2t){(float)cs, (float)sn}; } }
    { const float* x = ARGI(F, 0); bf16* XB = (bf16*)(ARGWS(F) + WS_XB);
      for (int m = gw; m < T_TOK; m += NGW) { const GAS f32x4* xr = (const GAS f32x4*)(x + (size_t)m * DMODEL) + F.lane;
          GAS unsigned long long* o8 = (GAS unsigned long long*)(XB + (size_t)m * DMODEL) + F.lane;
#pragma unroll
          for (int jj = 0; jj < 4; ++jj) { const f32x4 v = xr[64 * jj]; o8[64 * jj] = (unsigned long long)pk2(v.x, v.y) | ((unsigned long long)pk2(v.z, v.w) << 32); } } }
}
__device__ __forceinline__ void moe_convert(Frame& F, int j) {
    LAS float* scr = (LAS float*)(F.lds + RING_OFF + F.wave * 16384);
    const int gw = F.c * NWAVES + F.wave, NGW = F.G * NWAVES;
    constexpr int I_GU = 16 * 112, I_DN = 56 * 32, PERE = 2 * I_GU + I_DN;
    bf16* WMGU = (bf16*)(ARGWS(F) + WS_BIG + BIG_WMGU); bf16* WMD = (bf16*)(ARGWS(F) + WS_BIG + BIG_WMD);
    for (int it = gw; it < NEXP * PERE; it += NGW) {
        const int e = it / PERE; int r = it - e * PERE; const size_t wofs = ((size_t)j * NEXP + e) * 1024 * 3584;
        if (r < I_GU) { tr_matrix_item<2>(ARGI(F, 12) + wofs, 1024, 3584, WMGU + (size_t)e * 7168 * 1024, r, scr, F.lane); continue; } r -= I_GU;
        if (r < I_GU) { tr_matrix_item<3>(ARGI(F, 13) + wofs, 1024, 3584, WMGU + (size_t)e * 7168 * 1024, r, scr, F.lane); continue; } r -= I_GU;
        tr_matrix_item<0>(ARGI(F, 14) + wofs, 3584, 1024, WMD + (size_t)e * 1024 * 3584, r, scr, F.lane);
    }
}
__device__ __forceinline__ void moe_prefix_lds(Frame& F, LAS int* PB) {
    const int* LC = (const int*)(ARGWS(F) + WS_LC);
    for (int i = F.tid; i < 2048; i += 512) PB[i] = LC[i];
    __syncthreads();
    { const int e = F.wave, l = F.lane;
      const int v0 = PB[(4 * l) * 8 + e], v1 = PB[(4 * l + 1) * 8 + e], v2 = PB[(4 * l + 2) * 8 + e], v3 = PB[(4 * l + 3) * 8 + e];
      const int tot = v0 + v1 + v2 + v3; int inc = tot;
#pragma unroll
      for (int o = 1; o < 64; o <<= 1) { const int t = __shfl_up(inc, o); inc += (l >= o) ? t : 0; }
      const int ex = inc - tot;
      PB[(4 * l) * 8 + e] = ex; PB[(4 * l + 1) * 8 + e] = ex + v0; PB[(4 * l + 2) * 8 + e] = ex + v0 + v1; PB[(4 * l + 3) * 8 + e] = ex + v0 + v1 + v2;
      if (l == 63) PB[2048 + e] = inc; }
    __syncthreads();
}
__device__ __forceinline__ void unpack8(const v4u w, float (&v)[8]) { v[0] = bflo(w.x); v[1] = bfhi(w.x); v[2] = bflo(w.y); v[3] = bfhi(w.y); v[4] = bflo(w.z); v[5] = bfhi(w.z); v[6] = bflo(w.w); v[7] = bfhi(w.w); }
template <int MODE, bool FINAL> __device__ __forceinline__ void ln_pass(Frame& F, int li  , int sub  , int j) {
    const int gw = F.c * NWAVES + F.wave, NGW = F.G * NWAVES;
    const float* gain = ARGI(F, 1) + (size_t)(li * 2 + sub) * DMODEL; const float* bias = ARGI(F, 2) + (size_t)(li * 2 + sub) * DMODEL;
    float gv[2][8], bv[2][8];
#pragma unroll
    for (int q = 0; q < 2; ++q)
#pragma unroll
        for (int h2 = 0; h2 < 2; ++h2) { const f32x4 g4 = *(const GAS f32x4*)(gain + 512 * q + 8 * F.lane + 4 * h2), b4 = *(const GAS f32x4*)(bias + 512 * q + 8 * F.lane + 4 * h2);
#pragma unroll
            for (int k = 0; k < 4; ++k) { gv[q][4 * h2 + k] = g4[k]; bv[q][4 * h2 + k] = b4[k]; } }
    bf16* XB = (bf16*)(ARGWS(F) + WS_XB);
    int rtb[8]; LAS int* PB = (LAS int*)(F.lds + RING_OFF);
    if (MODE == 2) { moe_prefix_lds(F, PB); int acc = 0;
#pragma unroll
        for (int e = 0; e < 8; ++e) { rtb[e] = acc; acc += (PB[2048 + e] + 255) >> 8; } }
    const unsigned* tslot = (const unsigned*)(ARGWS(F) + WS_TSLOT); const float* gate = (const float*)(ARGWS(F) + WS_GATE); const bf16* YP = (const bf16*)(ARGWS(F) + WS_BIG + BIG_YP);
    for (int m = gw; m < T_TOK; m += NGW) {
        GAS v4u* xr = (GAS v4u*)(XB + (size_t)m * DMODEL) + F.lane;
        float v[2][8]; float s = 0.f;
#pragma unroll
        for (int q = 0; q < 2; ++q) unpack8(xr[64 * q], v[q]);
        if (MODE == 2) {
#pragma unroll
            for (int q = 0; q < 2; ++q)
#pragma unroll
                for (int k = 0; k < 8; ++k) v[q][k] *= ALPHA;
#pragma unroll
            for (int k2 = 0; k2 < 2; ++k2) { const unsigned ts = tslot[2 * m + k2]; const float gk = gate[2 * m + k2]; const int e = (int)(ts >> 20), slot = PB[(m >> 7) * 8 + e] + (int)(ts & 0xfffffu);
                int rb = 0;
#pragma unroll
                for (int q = 0; q < 8; ++q) rb = (q == e) ? rtb[q] : rb;
                const int yrow = rb * 256 + slot;
                if (yrow < 65536) { const GAS v4u* yr = (const GAS v4u*)(YP + (size_t)yrow * DMODEL) + F.lane;
#pragma unroll
                    for (int q = 0; q < 2; ++q) { float y[8]; unpack8(yr[64 * q], y);
#pragma unroll
                        for (int k = 0; k < 8; ++k) v[q][k] += gk * y[k]; } }
                else { const int lr = yrow - 65536, tl = lr >> 8, r = lr & 255;
                    const float* SL = (const float*)(ARGWS(F) + WS_SLAB);
#pragma unroll
                    for (int q = 0; q < 2; ++q) { const int col = 512 * q + 8 * F.lane, ct = col >> 8, cc = col & 255;
#pragma unroll
                        for (int kp = 0; kp < 4; ++kp) { const GAS f32x4* sp = (const GAS f32x4*)(SL + ((size_t)(kp * 32 + tl * 4 + ct) << 16) + (size_t)r * 256 + cc); const f32x4 a0 = sp[0], a1 = sp[1];
                            v[q][0] += gk * a0.x; v[q][1] += gk * a0.y; v[q][2] += gk * a0.z; v[q][3] += gk * a0.w; v[q][4] += gk * a1.x; v[q][5] += gk * a1.y; v[q][6] += gk * a1.z; v[q][7] += gk * a1.w; } } } }
        }
#pragma unroll
        for (int q = 0; q < 2; ++q)
#pragma unroll
            for (int k = 0; k < 8; ++k) s += v[q][k];
        const float mean = wave_sum(s) * (1.f / DMODEL); float s2 = 0.f;
#pragma unroll
        for (int q = 0; q < 2; ++q)
#pragma unroll
            for (int k = 0; k < 8; ++k) { v[q][k] -= mean; s2 += v[q][k] * v[q][k]; }
        const float rstd = 1.f / sqrtf(wave_sum(s2) * (1.f / DMODEL) + LN_EPS);
#pragma unroll
        for (int q = 0; q < 2; ++q) { float o[8];
#pragma unroll
            for (int k = 0; k < 8; ++k) o[k] = v[q][k] * rstd * gv[q][k] + bv[q][k];
            if (FINAL) { GAS f32x4* op = (GAS f32x4*)(ARGX(F) + (size_t)m * DMODEL + 512 * q + 8 * F.lane); op[0] = (f32x4){o[0], o[1], o[2], o[3]}; op[1] = (f32x4){o[4], o[5], o[6], o[7]}; }
            else { v4u w; w.x = pk2(o[0], o[1]); w.y = pk2(o[2], o[3]); w.z = pk2(o[4], o[5]); w.w = pk2(o[6], o[7]); xr[64 * q] = w; } }
    }
}
__device__ __forceinline__ void ln_route_pass(Frame& F, int li, int j) {
    const float* gain = ARGI(F, 1) + (size_t)(li * 2) * DMODEL; const float* bias = ARGI(F, 2) + (size_t)(li * 2) * DMODEL;
    LAS float* WRT = (LAS float*)(F.lds + RING_OFF);
    LAS float* SELG = (LAS float*)(F.lds + RING_OFF + 32768);
    LAS int* SELE = (LAS int*)(F.lds + RING_OFF + 32768 + 1024);
    const float* wr = ARGI(F, 11) + (size_t)j * DMODEL * NEXP;
    for (int i = F.tid; i < DMODEL * NEXP; i += 512) { const int d = i >> 3, e = i & 7; WRT[e * DMODEL + d] = wr[i]; }
    float gv[2][8], bv[2][8];
#pragma unroll
    for (int q = 0; q < 2; ++q)
#pragma unroll
        for (int h2 = 0; h2 < 2; ++h2) { const f32x4 g4 = *(const GAS f32x4*)(gain + 512 * q + 8 * F.lane + 4 * h2), b4 = *(const GAS f32x4*)(bias + 512 * q + 8 * F.lane + 4 * h2);
#pragma unroll
            for (int k = 0; k < 4; ++k) { gv[q][4 * h2 + k] = g4[k]; bv[q][4 * h2 + k] = b4[k]; } }
    bf16* XB = (bf16*)(ARGWS(F) + WS_XB);
    __syncthreads();
    const int ntok = T_TOK / F.G, tok0 = F.c * ntok;
    for (int tl = F.wave; tl < ntok; tl += NWAVES) { const int m = tok0 + tl;
        GAS v4u* xr = (GAS v4u*)(XB + (size_t)m * DMODEL) + F.lane;
        float v[2][8]; float s = 0.f;
#pragma unroll
        for (int q = 0; q < 2; ++q) unpack8(xr[64 * q], v[q]);
#pragma unroll
        for (int q = 0; q < 2; ++q)
#pragma unroll
            for (int k = 0; k < 8; ++k) s += v[q][k];
        const float mean = wave_sum(s) * (1.f / DMODEL); float s2 = 0.f;
#pragma unroll
        for (int q = 0; q < 2; ++q)
#pragma unroll
            for (int k = 0; k < 8; ++k) { v[q][k] -= mean; s2 += v[q][k] * v[q][k]; }
        const float rstd = 1.f / sqrtf(wave_sum(s2) * (1.f / DMODEL) + LN_EPS);
        float lg[8];
#pragma unroll
        for (int e = 0; e < 8; ++e) lg[e] = 0.f;
#pragma unroll
        for (int q = 0; q < 2; ++q) { float o[8];
#pragma unroll
            for (int k = 0; k < 8; ++k) o[k] = v[q][k] * rstd * gv[q][k] + bv[q][k];
            v4u w; w.x = pk2(o[0], o[1]); w.y = pk2(o[2], o[3]); w.z = pk2(o[4], o[5]); w.w = pk2(o[6], o[7]); xr[64 * q] = w;
#pragma unroll
            for (int e = 0; e < 8; ++e) { const f32x4 w0 = *(const LAS f32x4*)(WRT + e * DMODEL + 512 * q + 8 * F.lane), w1 = *(const LAS f32x4*)(WRT + e * DMODEL + 512 * q + 8 * F.lane + 4);
                lg[e] += ((o[0] * w0.x + o[1] * w0.y) + (o[2] * w0.z + o[3] * w0.w)) + ((o[4] * w1.x + o[5] * w1.y) + (o[6] * w1.z + o[7] * w1.w)); } }
#pragma unroll
        for (int e = 0; e < 8; ++e) lg[e] = wave_sum(lg[e]);
        int e1 = 0; float v1 = lg[0];
#pragma unroll
        for (int e = 1; e < 8; ++e) if (lg[e] > v1) { v1 = lg[e]; e1 = e; }
        int e2 = -1; float v2 = -3.0e38f;
#pragma unroll
        for (int e = 0; e < 8; ++e) if (e != e1 && lg[e] > v2) { v2 = lg[e]; e2 = e; }
        const float g1 = 1.f / (1.f + __expf(v2 - v1)), g2 = 1.f - g1;
        if (F.lane == 0) { SELE[2 * tl] = e1; SELE[2 * tl + 1] = e2; SELG[2 * tl] = g1; SELG[2 * tl + 1] = g2; }
    }
    __syncthreads();
    int myrank = 0, mye = 0;
    if (F.tid < 2 * ntok) { mye = SELE[F.tid];
        for (int i2 = 0; i2 < F.tid; ++i2) myrank += (SELE[i2] == mye) ? 1 : 0; }
    if (F.tid < 8) { int cnt = 0; for (int i2 = 0; i2 < 2 * ntok; ++i2) cnt += (SELE[i2] == F.tid) ? 1 : 0; ((int*)(ARGWS(F) + WS_LC))[F.c * 8 + F.tid] = cnt; }
    if (F.tid < 2 * ntok) { const int tok = tok0 + (F.tid >> 1);
        ((int*)(ARGWS(F) + WS_LIST))[(F.c * 8 + mye) * 256 + myrank] = tok;
        ((unsigned*)(ARGWS(F) + WS_TSLOT))[2 * tok + (F.tid & 1)] = ((unsigned)mye << 20) | (unsigned)myrank;
        ((float*)(ARGWS(F) + WS_GATE))[2 * tok + (F.tid & 1)] = SELG[F.tid]; }
    __syncthreads();
}
#define LDS_BAR() do { asm volatile("s_waitcnt lgkmcnt(0)" ::: "memory"); __builtin_amdgcn_s_barrier(); asm volatile("" ::: "memory"); } while (0)
__device__ __forceinline__ int off64(int row, int colbyte) { return row * 128 + (colbyte ^ ((((row >> 1) & 1) << 6) | (((row >> 3) & 1) << 5))); }
__device__ __forceinline__ float log2_gamma(int h) { return __builtin_amdgcn_logf(1.0f - __builtin_amdgcn_exp2f((float)(-5 - h))); }

__device__ __forceinline__ void ret_state_phase(Frame& F) {
    const int c = F.c; if (c >= 256) return;
    const int dt = c & 3, et = (c >> 2) & 7, h = (c >> 5) & 3, b = c >> 7;
    const int w = F.wave, lane = F.lane, dq = w & 3, eh = w >> 2, g = lane >> 4, l15 = lane & 15, q = l15 >> 2, p = l15 & 3;
    const bf16* KH = (const bf16*)(ARGWS(F) + WS_BIG + BIG_KH) + (size_t)b * SEQ * 1024 + h * 256 + dt * 64;
    const bf16* VT = (const bf16*)(ARGWS(F) + WS_BIG + BIG_VT) + ((size_t)((b * 4 + h) * 128) << 16);
    bf16* RT = (bf16*)(ARGWS(F) + WS_BIG + BIG_RT) + ((size_t)((b * 4 + h) * 128) << 17);
    const float dec = __builtin_amdgcn_exp2f(128.f * log2_gamma(h));
    const int r0 = F.tid >> 3, ch = F.tid & 7;
    const bf16* kp0 = KH + (size_t)r0 * 1024 + ch * 8; const bf16* kp1 = kp0 + (size_t)64 * 1024;
    const int lo0 = off64(r0, ch * 16), lo1 = off64(r0 + 64, ch * 16);
    int voff[4][2];
#pragma unroll
    for (int ks = 0; ks < 4; ++ks)
#pragma unroll
        for (int x = 0; x < 2; ++x) { const int e = 64 * et + 16 * (2 * eh + x) + l15, oct = 4 * ks + g; voff[ks][x] = ((((e >> 5) * 8 + (oct >> 1)) * 2 + (oct & 1)) * 32 + (e & 31)) * 8; }
    int roff[2];
#pragma unroll
    for (int x = 0; x < 2; ++x) { const int e = 64 * et + 16 * (2 * eh + x) + l15, d = 64 * dt + 16 * dq + 4 * g; roff[x] = ((((e >> 5) * 16 + (d >> 4)) * 2 + ((d >> 3) & 1)) * 32 + (e & 31)) * 8 + (d & 7); }
    float z0 = 0.f; asm volatile("" : "+v"(z0));
    f32x4 acc[2] = {(f32x4){z0, z0, z0, z0}, (f32x4){z0, z0, z0, z0}};
    v4u kq[4][2]; bf16x8 vq[4][4][2];
#define R2A_LOAD(st, nn) do { const int n_ = (nn) < 128 ? (nn) : 127; kq[st][0] = *(const GAS v4u*)(kp0 + (size_t)n_ * 128 * 1024); kq[st][1] = *(const GAS v4u*)(kp1 + (size_t)n_ * 128 * 1024); \
        _Pragma("unroll") for (int ks = 0; ks < 4; ++ks) _Pragma("unroll") for (int x = 0; x < 2; ++x) vq[st][ks][x] = *(const GAS bf16x8*)(VT + ((size_t)n_ << 16) + voff[ks][x]); } while (0)
    R2A_LOAD(0, 0); R2A_LOAD(1, 1); R2A_LOAD(2, 2);
    for (int n4 = 0; n4 < 128; n4 += 4) {
#pragma unroll
        for (int u4 = 0; u4 < 4; ++u4) { const int n = n4 + u4;
            LAS unsigned char* buf = F.lds + RING_OFF + (u4 & 1) * 16384;
            *(LAS v4u*)(buf + lo0) = kq[u4][0]; *(LAS v4u*)(buf + lo1) = kq[u4][1];
            R2A_LOAD((u4 + 3) & 3, n + 3);
            LDS_BAR();
            if (n > 0) {
#pragma unroll
                for (int x = 0; x < 2; ++x) { v2u o; o.x = pk2(acc[x][0], acc[x][1]); o.y = pk2(acc[x][2], acc[x][3]); *(GAS v2u*)(RT + ((size_t)n << 17) + roff[x]) = o; } }
#pragma unroll
            for (int ks = 0; ks < 4; ++ks) {
                const s16x4 t0 = vtr(buf + off64(32 * ks + 8 * g + q, 32 * dq + 8 * p)), t1 = vtr(buf + off64(32 * ks + 8 * g + 4 + q, 32 * dq + 8 * p));
                const bf16x8 a = (bf16x8){t0[0], t0[1], t0[2], t0[3], t1[0], t1[1], t1[2], t1[3]};
#pragma unroll
                for (int x = 0; x < 2; ++x) acc[x] = __builtin_amdgcn_mfma_f32_16x16x32_bf16(a, vq[u4][ks][x], acc[x], 0, 0, 0);
            }
#pragma unroll
            for (int x = 0; x < 2; ++x) acc[x] = acc[x] * dec;
        }
    }
#undef R2A_LOAD
    __syncthreads();
}

__device__ __forceinline__ void ret_out_phase(Frame& F, int j, bf16* YOUT) {
    const int w = F.wave, lane = F.lane, r32 = lane & 31, hi = lane >> 5, tid = F.tid;
    LAS unsigned char* QDI = F.lds + RING_OFF;
    LAS unsigned char* KHI = F.lds + RING_OFF + 65536;
    LAS unsigned char* PI = KHI;
    LAS float* STAT = (LAS float*)(F.lds + AUX_OFF);
    LAS unsigned char* YST = F.lds + RING_OFF;
    const bf16* QD = (const bf16*)(ARGWS(F) + WS_BIG + BIG_QD); const bf16* KH = (const bf16*)(ARGWS(F) + WS_BIG + BIG_KH);
    const bf16* VT = (const bf16*)(ARGWS(F) + WS_BIG + BIG_VT); const bf16* RT = (const bf16*)(ARGWS(F) + WS_BIG + BIG_RT);
    const bf16* GIN = (const bf16*)(ARGWS(F) + WS_BIG + BIG_G);
    const float* gn = ARGI(F, 4) + (size_t)j * 2048;
    const int ib = w & 3, jb0 = 2 * (w >> 2), jb1 = jb0 + 1;
    for (int U = F.c; U < 1024; U += F.G) {
        const int n = U & 127, h = (U >> 7) & 3, b = U >> 9;
        const size_t tok0 = (size_t)b * SEQ + (size_t)n * 128;
        { int tid1 = tid; asm volatile("" : "+v"(tid1)); v4u qv[8], kv[8];
#pragma unroll
          for (int k = 0; k < 8; ++k) { const int x = tid1 + 512 * k, row = x >> 5, chk = x & 31; const size_t go = (tok0 + row) * 1024 + h * 256 + chk * 8;
              qv[k] = *(const GAS v4u*)(QD + go); kv[k] = *(const GAS v4u*)(KH + go); }
#pragma unroll
          for (int k = 0; k < 8; ++k) { const int x = tid1 + 512 * k, row = x >> 5, chk = x & 31; const int lo = row * 512 + ((chk * 16) ^ ((row & 7) << 4));
              *(LAS v4u*)(QDI + lo) = qv[k]; *(LAS v4u*)(KHI + lo) = kv[k]; } }
        LDS_BAR();
        f32x16 s0 = {}, s1 = {};
        { const int qrow = 32 * ib + r32, k0row = 32 * jb0 + r32, k1row = 32 * jb1 + r32;
          if (jb0 <= ib) {
#pragma unroll
            for (int ks = 0; ks < 16; ++ks) { const int cb = (16 * ks + 8 * hi) * 2;
                const bf16x8 qf = *(const LAS bf16x8*)(QDI + qrow * 512 + (cb ^ ((qrow & 7) << 4)));
                const bf16x8 kf0 = *(const LAS bf16x8*)(KHI + k0row * 512 + (cb ^ ((k0row & 7) << 4)));
                s0 = __builtin_amdgcn_mfma_f32_32x32x16_bf16(kf0, qf, s0, 0, 0, 0);
                if (jb1 <= ib) { const bf16x8 kf1 = *(const LAS bf16x8*)(KHI + k1row * 512 + (cb ^ ((k1row & 7) << 4))); s1 = __builtin_amdgcn_mfma_f32_32x32x16_bf16(kf1, qf, s1, 0, 0, 0); } } } }
        LDS_BAR();
        { int r32p = r32, hip = hi; asm volatile("" : "+v"(r32p), "+v"(hip)); const int i = 32 * ib + r32p;
#pragma unroll
          for (int qq = 0; qq < 4; ++qq) {
              const int j0 = 32 * jb0 + 8 * qq + 4 * hip, j1 = j0 + 32;
              float a0 = s0[4 * qq], a1 = s0[4 * qq + 1], a2 = s0[4 * qq + 2], a3 = s0[4 * qq + 3];
              float c0 = s1[4 * qq], c1 = s1[4 * qq + 1], c2 = s1[4 * qq + 2], c3 = s1[4 * qq + 3];
              if (j0 + 0 > i) a0 = 0.f; if (j0 + 1 > i) a1 = 0.f; if (j0 + 2 > i) a2 = 0.f; if (j0 + 3 > i) a3 = 0.f;
              if (j1 + 0 > i) c0 = 0.f; if (j1 + 1 > i) c1 = 0.f; if (j1 + 2 > i) c2 = 0.f; if (j1 + 3 > i) c3 = 0.f;
              v2u o; o.x = pk2(a0, a1); o.y = pk2(a2, a3); *(LAS v2u*)(PI + i * 256 + ((j0 * 2) ^ ((i & 7) << 4))) = o;
              v2u o2; o2.x = pk2(c0, c1); o2.y = pk2(c2, c3); *(LAS v2u*)(PI + i * 256 + ((j1 * 2) ^ ((i & 7) << 4))) = o2; } }
        LDS_BAR();
        f32x16 acc[4][2];
#pragma unroll
        for (int rb = 0; rb < 4; ++rb) { acc[rb][0] = (f32x16){}; acc[rb][1] = (f32x16){}; }
        { const int nsteps = n > 0 ? 24 : 8;
          const bf16* vt = VT + ((size_t)((b * 4 + h) * 128 + n) << 16) + (size_t)(((2 * w) * 8 * 2 + hi) * 32 + r32) * 8;
          const bf16* rt = RT + ((size_t)((b * 4 + h) * 128 + n) << 17) + (size_t)(((2 * w) * 16 * 2 + hi) * 32 + r32) * 8;
          const int xr = (r32 & 7) << 4, rowp = r32 * 256;
#define R2B_LOAD(dst, sidx) do { int sp_ = (sidx); sp_ = sp_ < nsteps ? sp_ : nsteps - 1; const bf16* p_ = sp_ < 8 ? vt + sp_ * 512 : rt + (sp_ - 8) * 512; const int o1_ = sp_ < 8 ? 4096 : 8192; \
              dst[0] = *(const GAS bf16x8*)p_; dst[1] = *(const GAS bf16x8*)(p_ + o1_); } while (0)
          bf16x8 Bq[6][2];
          R2B_LOAD(Bq[0], 0); R2B_LOAD(Bq[1], 1); R2B_LOAD(Bq[2], 2); R2B_LOAD(Bq[3], 3); R2B_LOAD(Bq[4], 4);
          for (int s3 = 0; s3 < nsteps; s3 += 6) {
#pragma unroll
              for (int uu = 0; uu < 6; ++uu) { const int st = s3 + uu;
                  R2B_LOAD(Bq[(uu + 5) % 6], st + 5);
                  if (st < nsteps) { const bool pv = st < 8; const int ks = pv ? st : st - 8, cb = ((32 * ks + 16 * hi) ^ xr) + (pv ? 65536 : 0), sh = pv ? 0 : 1;
#pragma unroll
                      for (int rb = 0; rb < 4; ++rb) if (!pv || st <= 2 * rb + 1) {
                          const bf16x8 af = *(const LAS bf16x8*)(QDI + (((32 * 256) * rb + rowp) << sh) + cb);
                          acc[rb][0] = __builtin_amdgcn_mfma_f32_32x32x16_bf16(Bq[uu][0], af, acc[rb][0], 0, 0, 0);
                          acc[rb][1] = __builtin_amdgcn_mfma_f32_32x32x16_bf16(Bq[uu][1], af, acc[rb][1], 0, 0, 0); } } } }
#undef R2B_LOAD
        }
#pragma unroll
        for (int rb = 0; rb < 4; ++rb) { float s = 0.f, qs = 0.f;
#pragma unroll
            for (int et = 0; et < 2; ++et)
#pragma unroll
                for (int r = 0; r < 16; ++r) { const float v = acc[rb][et][r]; s += v; qs += v * v; }
            s += __shfl_xor(s, 32); qs += __shfl_xor(qs, 32);
            if (hi == 0) { STAT[((32 * rb + r32) * 8 + w) * 2] = s; STAT[((32 * rb + r32) * 8 + w) * 2 + 1] = qs; } }
        LDS_BAR();
        int r32b = r32, hib = hi; asm volatile("" : "+v"(r32b), "+v"(hib));
#pragma unroll
        for (int rb = 0; rb < 4; ++rb) { const int i = 32 * rb + r32b; float s = 0.f, qs = 0.f;
#pragma unroll
            for (int ww = 0; ww < 8; ++ww) { s += STAT[(i * 8 + ww) * 2]; qs += STAT[(i * 8 + ww) * 2 + 1]; }
            const float mean = s * (1.f / 512.f), var = qs * (1.f / 512.f) - mean * mean, rstd = 1.f / sqrtf(fmaxf(var, 0.f) + LN_EPS);
#pragma unroll
            for (int et = 0; et < 2; ++et)
#pragma unroll
                for (int qq = 0; qq < 4; ++qq) { const int e = 64 * w + 32 * et + 8 * qq + 4 * hib;
                    v2u o; o.x = pk2((acc[rb][et][4 * qq] - mean) * rstd, (acc[rb][et][4 * qq + 1] - mean) * rstd); o.y = pk2((acc[rb][et][4 * qq + 2] - mean) * rstd, (acc[rb][et][4 * qq + 3] - mean) * rstd);
                    *(LAS v2u*)(YST + i * 1024 + ((e * 2) ^ ((i & 63) << 4))) = o; } }
        LDS_BAR();
        { int tid6 = tid; asm volatile("" : "+v"(tid6)); const int chk = tid6 & 63; const f32x4 g0 = *(const GAS f32x4*)(gn + h * 512 + chk * 8), g1 = *(const GAS f32x4*)(gn + h * 512 + chk * 8 + 4);
#pragma unroll
          for (int k = 0; k < 16; ++k) { const int row = (tid6 >> 6) + 8 * k;
              const v4u y = *(const LAS v4u*)(YST + row * 1024 + ((chk * 16) ^ ((row & 63) << 4)));
              const size_t go6 = (tok0 + row) * 2048 + h * 512 + chk * 8; const v4u gg = *(const GAS v4u*)(GIN + go6);
              v4u o; o.x = pk2(bflo(y.x) * g0.x * bflo(gg.x), bfhi(y.x) * g0.y * bfhi(gg.x)); o.y = pk2(bflo(y.y) * g0.z * bflo(gg.y), bfhi(y.y) * g0.w * bfhi(gg.y));
              o.z = pk2(bflo(y.z) * g1.x * bflo(gg.z), bfhi(y.z) * g1.y * bfhi(gg.z)); o.w = pk2(bflo(y.w) * g1.z * bflo(gg.w), bfhi(y.w) * g1.w * bfhi(gg.w));
              *(GAS v4u*)(YOUT + go6) = o; } }
        __syncthreads();
    }
}
typedef swa::BlockRef<swa::bf16, swa::bf16> ABlk;
__device__ __forceinline__ float* att_lse(Frame& F, int L) {
    const int g = L >> 9, rem = L & 511, sh = 2 * g, seq = rem >> (6 - sh), qb = rem & ((64 >> sh) - 1);
    return (float*)(ARGWS(F) + WS_BIG + BIG_LSE) + (size_t)g * 131072 + (size_t)seq * (size_t)(SEQ >> sh) + (size_t)qb * 256;
}
__device__ __forceinline__ ABlk att_ref(Frame& F, int L) {
    const int g = L >> 9, rem = L & 511, sh = 2 * g, seq = rem >> (6 - sh), qb = rem & ((64 >> sh) - 1);
    const size_t base = (size_t)g * 131072 + (size_t)seq * (size_t)(SEQ >> sh);
    const swa::bf16* P = (const swa::bf16*)(ARGWS(F) + WS_BIG + BIG_QKV); constexpr size_t WH = (size_t)3 * 131072 * 128;
    ABlk r; r.Q = P + (base + (size_t)qb * 256) * 128; r.K = P + WH + base * 128; r.V = P + 2 * WH + base * 128;
    r.O = (swa::bf16*)(ARGWS(F) + WS_BIG + BIG_OP) + (base + (size_t)qb * 256) * 128; r.P0 = qb * 256;
    return r;
}
__device__ __forceinline__ void attn_phase(Frame& F) {
    extern __shared__ __attribute__((aligned(16))) unsigned char lds_dyn[];
    char* const ldsg = (char*)lds_dyn;
    int L = F.c; const int total = 1536, stride = F.G;
    if (L >= total) return;
    ABlk cur = att_ref(F, L);
    const int W = 129 + (F.G >> 20);
    swa::Seam<swa::bf16> S; S.tid = F.tid;
    swa::causal_swa_prime<swa::bf16, swa::bf16>(cur, W, ldsg, S);
    for (;;) {
        const bool last = L + stride >= total;
        const int Ln = last ? L : L + stride;
        const ABlk nxt = last ? cur : att_ref(F, Ln);
        const int skv = SEQ >> (2 * (L >> 9));
        swa::causal_swa_block<swa::bf16, swa::bf16>(cur, nxt, skv, W, ldsg, S);
        if (F.tid < 256) att_lse(F, L)[F.tid] = ((const LAS float*)(F.lds + swa::LSE_LDS_OFF))[F.tid];
        if (last) break;
        cur = nxt; L = Ln;
    }
}
__device__ __forceinline__ void attn_merge_phase(Frame& F) {
    const int gw = F.c * NWAVES + F.wave, NGW = F.G * NWAVES, hd = F.lane >> 4, chk = F.lane & 15;
    const bf16* OP = (const bf16*)(ARGWS(F) + WS_BIG + BIG_OP); const float* LSE = (const float*)(ARGWS(F) + WS_BIG + BIG_LSE); bf16* O = (bf16*)(ARGWS(F) + WS_BIG + BIG_O);
    for (int m = gw; m < T_TOK; m += NGW) { const int b = m >> 14, t = m & 16383;
        size_t row[3]; float ls[3];
#pragma unroll
        for (int g = 0; g < 3; ++g) { const int sh = 2 * g; row[g] = (size_t)g * 131072 + (size_t)(b * 4 + hd) * SEQ + (size_t)((t & ((1 << sh) - 1)) * (SEQ >> sh) + (t >> sh)); ls[g] = LSE[row[g]]; }
        const float mx = fmaxf(ls[0], fmaxf(ls[1], ls[2])); float wg[3]; float ws = 0.f;
#pragma unroll
        for (int g = 0; g < 3; ++g) { wg[g] = __expf(ls[g] - mx); ws += wg[g]; }
        const float inv = 1.f / ws; float o[8] = {0.f, 0.f, 0.f, 0.f, 0.f, 0.f, 0.f, 0.f};
#pragma unroll
        for (int g = 0; g < 3; ++g) { const v4u v = *(const GAS v4u*)(OP + row[g] * 128 + chk * 8); const float wt = wg[g] * inv;
            o[0] += wt * bflo(v.x); o[1] += wt * bfhi(v.x); o[2] += wt * bflo(v.y); o[3] += wt * bfhi(v.y); o[4] += wt * bflo(v.z); o[5] += wt * bfhi(v.z); o[6] += wt * bflo(v.w); o[7] += wt * bfhi(v.w); }
        v4u w; w.x = pk2(o[0], o[1]); w.y = pk2(o[2], o[3]); w.z = pk2(o[4], o[5]); w.w = pk2(o[6], o[7]);
        *(GAS v4u*)(O + (size_t)m * 512 + hd * 128 + chk * 8) = w; }
}
template <bool GATHER_, int NCT> struct MoeOrder {
    static constexpr bool GATHER = GATHER_;
    const char* A; const char* Bt; int K; size_t bstride; int G, c; int rtb[9]; const LAS int* idx;
    __device__ __forceinline__ bool next(int i, pg8::Unit& u) const {
        const int L = i * G + c; if (L >= rtb[8] * NCT) return false;
        const int rt = L / NCT; int e = 0;
#pragma unroll
        for (int k = 1; k < 8; ++k) e += (rtb[k] <= rt) ? 1 : 0;
        u.pm = rt; u.pn = L - rt * NCT; u.ex = e; return true;
    }
    __device__ __forceinline__ const char* a_ptr(const pg8::Unit& u) const { return GATHER ? A : A + (size_t)u.pm * ((size_t)256 * K * 2); }
    __device__ __forceinline__ const char* b_ptr(const pg8::Unit& u) const { return Bt + (size_t)u.ex * bstride + (size_t)u.pn * ((size_t)256 * K * 2); }
    __device__ __forceinline__ unsigned a_off(int ui, int row, int C, int) const { return (unsigned)idx[ui * 256 + row] * (unsigned)(K * 2) + (unsigned)(C * 2); }
    __device__ __forceinline__ int kt() const { return K / 64; }
};
struct MoeDownMain {
    static constexpr bool GATHER = false;
    const char* A; const char* Bt; int K; size_t bstride; int G, c; int rtb[9];
    __device__ __forceinline__ bool next(int i, pg8::Unit& u) const {
        if (G != 256) { const int L = i * G + c; if (L >= 1024) return false; u.pm = L >> 2; u.pn = L & 3; }
        else { if (i >= 4) return false; const int xcd = c & 7, k = c >> 3; u.pm = i * 64 + (xcd << 3) + (k >> 2); u.pn = k & 3; }
        int e = 0;
#pragma unroll
        for (int k2 = 1; k2 < 8; ++k2) e += (rtb[k2] <= u.pm) ? 1 : 0;
        u.ex = e; return true;
    }
    __device__ __forceinline__ const char* a_ptr(const pg8::Unit& u) const { return A + (size_t)u.pm * ((size_t)256 * K * 2); }
    __device__ __forceinline__ const char* b_ptr(const pg8::Unit& u) const { return Bt + (size_t)u.ex * bstride + (size_t)u.pn * ((size_t)256 * K * 2); }
    __device__ __forceinline__ unsigned a_off(int, int, int, int) const { return 0u; }
    __device__ __forceinline__ int kt() const { return K / 64; }
};
struct MoeDownTail {
    static constexpr bool GATHER = false;
    const char* A; const char* Bt; int K; size_t bstride; int G, c; int rtb[9];
    __device__ __forceinline__ bool next(int i, pg8::Unit& u) const {
        const int nl = rtb[8] - 256; if (i > 0 || c >= nl * 16) return false;
        const int t = c >> 2; u.pm = 256 + (t >> 2); u.pn = t & 3; u.ex = (c & 3) * 32 + t; return true;
    }
    __device__ __forceinline__ int expert(const pg8::Unit& u) const { int e = 0;
#pragma unroll
        for (int k2 = 1; k2 < 8; ++k2) e += (rtb[k2] <= u.pm) ? 1 : 0;
        return e; }
    __device__ __forceinline__ const char* a_ptr(const pg8::Unit& u) const { return A + (size_t)u.pm * ((size_t)256 * K * 2) + (size_t)(c & 3) * (896 * 2); }
    __device__ __forceinline__ const char* b_ptr(const pg8::Unit& u) const { return Bt + (size_t)expert(u) * bstride + (size_t)u.pn * ((size_t)256 * K * 2) + (size_t)(c & 3) * (896 * 2); }
    __device__ __forceinline__ unsigned a_off(int, int, int, int) const { return 0u; }
    __device__ __forceinline__ int kt() const { return 14; }
};
__device__ __forceinline__ void moe_rtb(const LAS int* PB, int (&rtb)[9], int (&cnt)[8]) {
    int acc = 0;
#pragma unroll
    for (int e = 0; e < 8; ++e) { rtb[e] = acc; cnt[e] = __builtin_amdgcn_readfirstlane(PB[2048 + e]); acc += (cnt[e] + 255) >> 8; }
    rtb[8] = acc;
}
__global__ void __launch_bounds__(NWAVES * 64, 2) fwd_kernel(Args args) {
    extern __shared__ __attribute__((aligned(16))) unsigned char lds[];
    Frame F;
    F.lds = (LAS unsigned char*)lds;
    F.MISC = (volatile LAS unsigned*)(F.lds + MISC_OFF);
    F.tid = threadIdx.x; F.lane = F.tid & 63; F.wave = __builtin_amdgcn_readfirstlane(F.tid >> 6);
    F.G = gridDim.x; F.c = blockIdx.x;
    for (int u = F.tid; u < 32; u += NWAVES * 64) ((LAS unsigned*)(F.lds + MISC_OFF))[u] = 0u;
    if (F.tid == 0) { LAS unsigned long long* tb = (LAS unsigned long long*)(F.lds + MISC_OFF + 128);
#pragma unroll
        for (int i = 0; i < 15; ++i) tb[i] = (unsigned long long)args.in[i];
        tb[15] = (unsigned long long)args.out; tb[16] = (unsigned long long)args.ws; }
    __syncthreads();
    XcdBarrier bar = xcd_barrier_post((unsigned*)(F_CTL(F) + CW_BAR), F.MISC + 8);
#ifdef STAMP_A
#define STAMP_HERE(idx) do { if (threadIdx.x == 0) ((volatile LAS unsigned long long*)(F.lds + AUX_OFF + 16384))[(idx)] = wall_clock64(); } while (0)
#else
#define STAMP_HERE(idx) do { } while (0)
#endif
#define GRID_BAR(idx) do { XcdBarrier bb_ = bar; asm volatile("" : "+s"(bb_.bar), "+s"(bb_.x)); xcd_barrier(bb_); STAMP_HERE(idx); } while (0)
#define WSP ARGWS(F)
#define BIGP (ARGWS(F) + WS_BIG)
#define XBP ((bf16*)(ARGWS(F) + WS_XB))

#ifndef ONLY
#define ONLY -1
#endif
#define RUN(n) (ONLY < 0 || ONLY == (n))
    STAMP_HERE(0);
#ifndef DBL
#define DBL 0
#endif
    if (DBL & 1) { frame_refresh(F); p0_prologue(F); }
    if (RUN(0)) { frame_refresh(F); p0_prologue(F); }
    GRID_BAR(1);

#pragma unroll
    for (int j = 0; j < 2; ++j) {
        for (int rep_ = 0; rep_ < ((DBL & 256) ? 2 : 1); ++rep_) if (RUN(1)) { frame_refresh(F);
            const bf16* Win = (const bf16*)(WSP + WS_WIN) + (size_t)j * 6144 * 1024;
#ifndef SKIP_RP
            { pg8::StaticOrder S; S.init(XBP, Win, T_TOK, 4096, 1024, F.G, F.c);
              pg8::EpiRetProj E{(bf16*)(BIGP + BIG_QD), (bf16*)(BIGP + BIG_KH), (bf16*)(BIGP + BIG_G), (const float*)(WSP + WS_TAB)};
              pg8::gemm_phase<pg8::EpiRetProj, pg8::StaticOrder, true>(F.lds + RING_OFF, S, E, F.tid); }
#endif
#ifndef SKIP_VT
            { pg8::StaticOrder S; S.init(Win + (size_t)4096 * 1024, XBP, 2048, T_TOK, 1024, F.G, F.c);
              pg8::EpiVT E{(bf16*)(BIGP + BIG_VT)};
              pg8::gemm_phase<pg8::EpiVT, pg8::StaticOrder, true>(F.lds + RING_OFF, S, E, F.tid); }
#endif
        }
        GRID_BAR(1 + 16 * j + 1);
        if (DBL & 4) { frame_refresh(F); ret_state_phase(F); }
        if (RUN(2)) { frame_refresh(F); ret_state_phase(F); }
        GRID_BAR(1 + 16 * j + 2);
        if (DBL & 8) { frame_refresh(F); ret_out_phase(F, j, (bf16*)(BIGP + 640 * MiB)); }
        if (RUN(3)) { frame_refresh(F); ret_out_phase(F, j, (bf16*)(BIGP + BIG_G)); }
        GRID_BAR(1 + 16 * j + 3);
        if (RUN(4)) { frame_refresh(F);
            pg8::StaticOrder S; S.init(BIGP + BIG_G, (const bf16*)(WSP + WS_WRO) + (size_t)j * 1024 * 2048, T_TOK, 1024, 2048, F.G, F.c);
            pg8::EpiAddBf16 E{XBP, ALPHA};
            pg8::gemm_phase<pg8::EpiAddBf16, pg8::StaticOrder, true>(F.lds + RING_OFF, S, E, F.tid);
        }
        GRID_BAR(1 + 16 * j + 4);
        if (RUN(5)) { frame_refresh(F); ln_pass<0, false>(F, 2 * j, 0, j); }
        if (DBL & 2) { frame_refresh(F); moe_convert(F, j); }
        if (RUN(6)) { frame_refresh(F); moe_convert(F, j); }
        GRID_BAR(1 + 16 * j + 5);
        for (int rep_ = 0; rep_ < ((DBL & 64) ? 2 : 1); ++rep_) if (RUN(7)) { frame_refresh(F);
            pg8::StaticOrder S; S.init(XBP, (const bf16*)(WSP + WS_WGU) + (size_t)j * 7168 * 1024, T_TOK, 7168, 1024, F.G, F.c);
            pg8::EpiSwiGLU E{(bf16*)(BIGP + BIG_HID)};
            pg8::gemm_phase<pg8::EpiSwiGLU, pg8::StaticOrder, true>(F.lds + RING_OFF, S, E, F.tid);
        }
        GRID_BAR(1 + 16 * j + 6);
        if (RUN(8)) { frame_refresh(F);
            pg8::StaticOrder S; S.init(BIGP + BIG_HID, (const bf16*)(WSP + WS_WDN) + (size_t)j * 1024 * 3584, T_TOK, 1024, 3584, F.G, F.c);
            pg8::EpiAddBf16 E{XBP, ALPHA};
            pg8::gemm_phase<pg8::EpiAddBf16, pg8::StaticOrder, true>(F.lds + RING_OFF, S, E, F.tid);
        }
        GRID_BAR(1 + 16 * j + 7);
        if (RUN(5)) { frame_refresh(F); ln_pass<0, false>(F, 2 * j, 1, j); }
        GRID_BAR(1 + 16 * j + 8);
        if (RUN(9)) { frame_refresh(F);
            pg8::StaticOrder S; S.init(XBP, (const bf16*)(WSP + WS_WQKV) + (size_t)j * 4608 * 1024, T_TOK, 4608, 1024, F.G, F.c);
            pg8::EpiQKV E{(bf16*)(BIGP + BIG_QKV)};
            pg8::gemm_phase<pg8::EpiQKV, pg8::StaticOrder, true>(F.lds + RING_OFF, S, E, F.tid);
        }
        GRID_BAR(1 + 16 * j + 9);
        if (DBL & 16) { frame_refresh(F); attn_phase(F); }
        if (RUN(10)) { frame_refresh(F); attn_phase(F); }
        GRID_BAR(1 + 16 * j + 10);
        if (DBL & 32) { frame_refresh(F); attn_merge_phase(F); }
        if (RUN(11)) { frame_refresh(F); attn_merge_phase(F); }
        GRID_BAR(1 + 16 * j + 11);
        if (RUN(12)) { frame_refresh(F);
            pg8::StaticOrder S; S.init(BIGP + BIG_O, (const bf16*)(WSP + WS_WAO) + (size_t)j * 1024 * 512, T_TOK, 1024, 512, F.G, F.c);
            pg8::EpiAddBf16 E{XBP, ALPHA};
            pg8::gemm_phase<pg8::EpiAddBf16, pg8::StaticOrder, true>(F.lds + RING_OFF, S, E, F.tid);
        }
        GRID_BAR(1 + 16 * j + 12);
        if (RUN(13)) { frame_refresh(F); ln_route_pass(F, 2 * j + 1, j); }
        GRID_BAR(1 + 16 * j + 13);
        for (int rep_ = 0; rep_ < ((DBL & 512) ? 2 : 1); ++rep_) if (RUN(14)) {
            frame_refresh(F); MoeOrder<true, 28> S; int cnt[8];
            LAS int* PB = (LAS int*)(F.lds + RING_OFF); moe_prefix_lds(F, PB); moe_rtb(PB, S.rtb, cnt);
            S.G = F.G; S.c = F.c; S.idx = (const LAS int*)(F.lds + AUX_OFF);
            S.A = (const char*)XBP; S.Bt = (const char*)(BIGP + BIG_WMGU); S.K = 1024; S.bstride = (size_t)7168 * 1024 * 2;
            const int* BL = (const int*)(WSP + WS_LIST); LAS int* idx = (LAS int*)(F.lds + AUX_OFF);
            pg8::Unit u; int nun = 0;
            for (int ui = 0; S.next(ui, u) && ui < 30; ++ui) { nun = ui + 1;
                if (F.tid < 256) { const int e = u.ex; int rb = 0, ce = 0;
#pragma unroll
                    for (int q = 0; q < 8; ++q) { rb = (q == e) ? S.rtb[q] : rb; ce = (q == e) ? cnt[q] : ce; }
                    int slot = (u.pm - rb) * 256 + F.tid; slot = slot < ce ? slot : 0;
                    int lo = 0;
#pragma unroll
                    for (int st = 128; st > 0; st >>= 1) lo = (PB[(lo + st) * 8 + e] <= slot) ? lo + st : lo;
                    idx[ui * 256 + F.tid] = (lo * 8 + e) * 256 + (slot - PB[lo * 8 + e]); } }
            if (F.tid < 256) {
#pragma unroll 10
                for (int ui = 0; ui < 30; ++ui) if (ui < nun) idx[ui * 256 + F.tid] = BL[idx[ui * 256 + F.tid]]; }
            __syncthreads();
            pg8::EpiSwiGLU E{(bf16*)(BIGP + BIG_HID)};
            pg8::gemm_phase<pg8::EpiSwiGLU, MoeOrder<true, 28>, true>(F.lds + RING_OFF, S, E, F.tid);
        }
        GRID_BAR(1 + 16 * j + 14);
        for (int rep_ = 0; rep_ < ((DBL & 128) ? 2 : 1); ++rep_) if (RUN(15)) {
            frame_refresh(F);
            int rtb5[9], cnt5[8]; { LAS int* PB = (LAS int*)(F.lds + RING_OFF); moe_prefix_lds(F, PB); moe_rtb(PB, rtb5, cnt5); __syncthreads(); }
            { MoeDownMain S;
#pragma unroll
              for (int e = 0; e < 9; ++e) S.rtb[e] = rtb5[e];
              S.G = F.G; S.c = F.c; S.A = (const char*)(BIGP + BIG_HID); S.Bt = (const char*)(BIGP + BIG_WMD); S.K = 3584; S.bstride = (size_t)1024 * 3584 * 2;
              pg8::EpiBf16Y E{(bf16*)(BIGP + BIG_YP)};
              pg8::gemm_phase<pg8::EpiBf16Y, MoeDownMain, true>(F.lds + RING_OFF, S, E, F.tid); }
            frame_refresh(F);
            { MoeDownTail S;
#pragma unroll
              for (int e = 0; e < 9; ++e) S.rtb[e] = rtb5[e];
              S.G = F.G; S.c = F.c; S.A = (const char*)(BIGP + BIG_HID); S.Bt = (const char*)(BIGP + BIG_WMD); S.K = 3584; S.bstride = (size_t)1024 * 3584 * 2;
              pg8::EpiF32Slab E{(float*)(WSP + WS_SLAB)};
              pg8::gemm_phase<pg8::EpiF32Slab, MoeDownTail, false>(F.lds + RING_OFF, S, E, F.tid); }
        }
        GRID_BAR(1 + 16 * j + 15);
        if (RUN(16)) { frame_refresh(F); if (j == 0) ln_pass<2, false>(F, 1, 1, 0); else ln_pass<2, true>(F, 3, 1, 1); }
        if (j == 0) GRID_BAR(1 + 16 * j + 16);
    }
#ifdef STAMP_A
    GRID_BAR(34);
    { if (blockIdx.x == 0 && threadIdx.x == 0) { volatile LAS unsigned long long* ts = (volatile LAS unsigned long long*)(F.lds + AUX_OFF + 16384);
          float* vv = (float*)(ARGWS(F) + 65536); vv[0] = (float)(ts[STAMP_A + STAMP_AN] - ts[STAMP_A]) * 0.01f; vv[1] = (float)(ts[STAMP_B + STAMP_BN] - ts[STAMP_B]) * 0.01f; } }
    GRID_BAR(35);
    { const float* vv = (const float*)(ARGWS(F) + 65536); const float va = vv[0], vb = vv[1];
      float* out = ARGX(F); const float c = sqrtf(va);
      for (size_t i = (size_t)blockIdx.x * 512 + threadIdx.x; i < (size_t)T_TOK * DMODEL; i += (size_t)gridDim.x * 512) out[i] = (i == 0) ? vb : c; }
#endif
}

extern "C" void kernel_launch(void* const* d_in, const int* in_sizes, int n_in, void* d_out, int out_size, void* d_ws, size_t ws_size, hipStream_t stream) {
    static int grid = 0;
    if (grid == 0) {
        if (n_in != 15 || out_size != T_TOK * DMODEL || ws_size < WS_END) { fprintf(stderr, "kernel_launch: unexpected shapes / workspace (n_in %d, out %d, ws %zu < %zu)\n", n_in, out_size, ws_size, (size_t)WS_END); grid = -1; return; }
        int dev = 0, cus = 0, per_cu = 0;
        if (hipGetDevice(&dev) != hipSuccess || hipDeviceGetAttribute(&cus, hipDeviceAttributeMultiprocessorCount, dev) != hipSuccess) { grid = -1; return; }
        if (hipFuncSetAttribute((const void*)fwd_kernel, hipFuncAttributeMaxDynamicSharedMemorySize, LDS_BYTES) != hipSuccess) { fprintf(stderr, "kernel_launch: hipFuncSetAttribute failed\n"); grid = -1; return; }
        if (hipOccupancyMaxActiveBlocksPerMultiprocessor(&per_cu, (const void*)fwd_kernel, NWAVES * 64, LDS_BYTES) != hipSuccess || per_cu < 1) { fprintf(stderr, "kernel_launch: occupancy query says %d\n", per_cu); }
        (void)hipGetLastError();
        if (cus < 256) { fprintf(stderr, "kernel_launch: this kernel needs 256 CUs (found %d)\n", cus); grid = -1; return; }
        grid = 256;
    }
    if (grid < 0) return;
    if (hipMemsetAsync((char*)d_ws + WS_CTL, 0, CTL_ZERO_BYTES, stream) != hipSuccess) return;
    Args a{};
    for (int i = 0; i < 15; ++i) a.in[i] = (const float*)d_in[i];
    a.out = (float*)d_out; a.ws = (unsigned char*)d_ws;
    hipLaunchKernelGGL(fwd_kernel, dim3(grid), dim3(NWAVES * 64), LDS_BYTES, stream, a);
}
```

```cpp
#include <hip/hip_runtime.h>
#include <hip/hip_bf16.h>
#include <cstdio>
#include <cstdint>
#include <cmath>
namespace pg8 {
#define PG8_LAS __attribute__((address_space(3)))
typedef unsigned short bf16_t;
typedef short bf16x8 __attribute__((ext_vector_type(8)));
typedef float f32x4 __attribute__((ext_vector_type(4)));
typedef float f32x2 __attribute__((ext_vector_type(2)));
typedef unsigned u32x4 __attribute__((ext_vector_type(4)));
constexpr int BM = 256, BK = 64, HALF = 128, HTB = HALF * BK * 2  , STAGE_BYTES = 8 * HTB, NXCD = 8, WGM = 8;

__host__ __device__ __forceinline__ int lds_byte(int r, int c) { const int st = (r >> 4) * 2 + (c >> 5), rr = r & 15, cc = c & 31, ob = rr * 64 + cc * 2; return st * 1024 + (ob ^ (((ob >> 9) & 1) << 5)); }
__host__ __device__ __forceinline__ void stage_rc(int b, int& R, int& C) { const int st = b / 1024, sb = b % 1024, swz = sb ^ (((sb >> 9) & 1) << 5); R = (st >> 1) * 16 + swz / 64; C = (st & 1) * 32 + (swz % 64) / 2; }
__host__ __device__ __forceinline__ int perm32(int rho) { const int n = rho >> 4, i = rho & 15; return 8 * (i >> 2) + 4 * n + (i & 3); }

struct Unit { int pm, pn, ex; };

struct StaticOrder {
    static constexpr bool GATHER = false;
    const char* A; const char* Bt; int K;
    int nM, nN, nwg, G, c;
    __device__ void init(const void* A_, const void* Bt_, int M, int N, int K_, int G_, int c_) { A = (const char*)A_; Bt = (const char*)Bt_; K = K_; nM = M / BM; nN = N / BM; nwg = nM * nN; G = G_; c = c_; }
    __device__ bool next(int i, Unit& u) const {
        const long L = (long)i * G + c; if (L >= nwg) return false;
        int wgid = (int)L; { const int q = nwg / NXCD, r = nwg % NXCD, xcd = wgid % NXCD, off = wgid / NXCD; wgid = (xcd < r ? xcd * (q + 1) : r * (q + 1) + (xcd - r) * q) + off; }
        const int nig = WGM * nN, gid = wgid / nig, fm = gid * WGM, gsz = (nM - fm) < WGM ? (nM - fm) : WGM;
        u.pm = fm + ((wgid % nig) % gsz); u.pn = (wgid % nig) / gsz; u.ex = 0; return true;
    }
    __device__ __forceinline__ const char* a_ptr(const Unit& u) const { return A + (size_t)u.pm * ((size_t)BM * K * 2); }
    __device__ __forceinline__ const char* b_ptr(const Unit& u) const { return Bt + (size_t)u.pn * ((size_t)BM * K * 2); }
    __device__ __forceinline__ unsigned a_off(int, int, int, int) const { return 0u; }
    __device__ __forceinline__ int kt() const { return K / BK; }
};

__device__ __forceinline__ unsigned cvt_pk_bf16(float lo, float hi) { unsigned r; asm volatile("v_cvt_pk_bf16_f32 %0, %1, %2" : "=v"(r) : "v"(lo), "v"(hi)); return r; }

template <class Epi, class Sched, bool ALIGN_EPI>
__device__ __forceinline__ void gemm_phase(PG8_LAS unsigned char* lds, const Sched& S, const Epi& E, const int tid) {
    constexpr bool GATHER = Sched::GATHER;
    const int wid = __builtin_amdgcn_readfirstlane(tid >> 6), lane = tid & 63, wr = wid >> 2, wc = wid & 3, fr = lane & 15, fq = lane >> 4;
    const int K = S.K, nt = S.kt();
    unsigned voffA[2][2], nvoffA[2][2], voffB[2]; int sR[2], sC[2];
#pragma unroll
    for (int i = 0; i < 2; ++i) { int R, C; stage_rc(tid * 16 + i * 8192, R, C); sR[i] = R; sC[i] = C; const int Rb = Epi::PERM ? ((R & ~31) + perm32(R & 31)) : R;
        voffA[0][i] = (unsigned)(R * K + C) * 2u; voffA[1][i] = voffA[0][i]; nvoffA[0][i] = voffA[0][i]; nvoffA[1][i] = voffA[0][i]; voffB[i] = (unsigned)(Rb * K + C) * 2u; }
    const size_t kstep = (size_t)(BK * 2);
    const size_t hstep = (size_t)HALF * K * 2;
    const size_t ahstep = GATHER ? (size_t)0 : hstep;
    const unsigned ldsw = (unsigned)wid * 1024u;
    const int aoff = lds_byte(wr * 64 + fr, fq * 8), boff = lds_byte(wc * 32 + fr, fq * 8);
#define PG8_SA(b, h) (((b) * 2 + (h)) * HTB)
#define PG8_SB(b, h) ((4 + (b) * 2 + (h)) * HTB)
#define PG8_STAGE(bufoff, gbase, voff) do { _Pragma("unroll") for (int _i = 0; _i < 2; ++_i) \
        __builtin_amdgcn_global_load_lds((const unsigned*)((const char*)(gbase) + (voff)[_i]), (PG8_LAS unsigned*)(lds + (bufoff) + ldsw + _i * 8192), 16, 0, 0); } while (0)
#define PG8_STAGE_A(bufoff, gbase, h, VO) PG8_STAGE(bufoff, (gbase) + (h) * ahstep, (VO)[GATHER ? (h) : 0])
#define PG8_LDA(dst, b, h) do { _Pragma("unroll") for (int m = 0; m < 4; ++m) _Pragma("unroll") for (int k = 0; k < 2; ++k) dst[m][k] = *(const PG8_LAS bf16x8*)(lds + PG8_SA(b, h) + aoff + m * 2048 + k * 1024); } while (0)
#define PG8_LDB(dst, b, h) do { _Pragma("unroll") for (int n = 0; n < 2; ++n) _Pragma("unroll") for (int k = 0; k < 2; ++k) dst[n][k] = *(const PG8_LAS bf16x8*)(lds + PG8_SB(b, h) + boff + n * 2048 + k * 1024); } while (0)
#define PG8_MMA(ai, bj, At, Bt) do { __builtin_amdgcn_s_setprio(1); _Pragma("unroll") for (int m = 0; m < 4; ++m) _Pragma("unroll") for (int n = 0; n < 2; ++n) _Pragma("unroll") for (int k = 0; k < 2; ++k) \
        acc[ai][bj][m][n] = __builtin_amdgcn_mfma_f32_16x16x32_bf16(Bt[n][k], At[m][k], acc[ai][bj][m][n], 0, 0, 0); __builtin_amdgcn_s_setprio(0); } while (0)
#define PG8_WAIT_V(n) asm volatile("s_waitcnt vmcnt(" #n ")" ::: "memory")
#define PG8_WAIT_L(n) asm volatile("s_waitcnt lgkmcnt(" #n ")" ::: "memory")
#define PG8_BAR __builtin_amdgcn_s_barrier()
#define PG8_SCHED __builtin_amdgcn_sched_barrier(0)
    Unit cur, nxt; int ui = 0;
    if (!S.next(0, cur)) return;
    f32x4 acc[2][2][4][2];
#pragma unroll
    for (int a = 0; a < 2; ++a)
#pragma unroll
        for (int b = 0; b < 2; ++b)
#pragma unroll
            for (int m = 0; m < 4; ++m)
#pragma unroll
                for (int n = 0; n < 2; ++n) acc[a][b][m][n] = (f32x4){0.f, 0.f, 0.f, 0.f};
    bf16x8 At[4][2], B0[2][2], B1[2][2];
    const char* cA = S.a_ptr(cur); const char* cB = S.b_ptr(cur);
    if constexpr (GATHER) {
#pragma unroll
        for (int h = 0; h < 2; ++h)
#pragma unroll
            for (int i = 0; i < 2; ++i) voffA[h][i] = S.a_off(0, h * HALF + sR[i], sC[i], 0);
    }
    PG8_STAGE(PG8_SB(0, 0), cB, voffB); PG8_STAGE(PG8_SB(0, 1), cB + hstep, voffB); PG8_STAGE_A(PG8_SA(0, 0), cA, 0, voffA); PG8_STAGE_A(PG8_SA(0, 1), cA, 1, voffA);
    if (wr == 1) PG8_BAR;
    PG8_WAIT_V(2); PG8_BAR;
    PG8_STAGE(PG8_SB(1, 0), cB + kstep, voffB); PG8_STAGE_A(PG8_SA(1, 0), cA + kstep, 0, voffA); PG8_STAGE(PG8_SB(1, 1), cB + hstep + kstep, voffB);
    PG8_WAIT_V(6); PG8_BAR;
    for (;;) {
        const bool has_next = S.next(ui + 1, nxt);
        const char* nA = has_next ? S.a_ptr(nxt) : cA; const char* nB = has_next ? S.b_ptr(nxt) : cB;
        if constexpr (GATHER) {
#pragma unroll
            for (int h = 0; h < 2; ++h)
#pragma unroll
                for (int i = 0; i < 2; ++i) nvoffA[h][i] = has_next ? S.a_off(ui + 1, h * HALF + sR[i], sC[i], 0) : voffA[h][i];
        }
        for (int t = 0; t < nt; t += 2) {
            const bool last = (t == nt - 2);
            const char* a1 = cA + (size_t)(t + 1) * kstep;
            const char* a2 = last ? nA : cA + (size_t)(t + 2) * kstep; const char* b2 = last ? nB : cB + (size_t)(t + 2) * kstep;
            const char* a3 = a2 + kstep; const char* b3 = b2 + kstep;
            unsigned vo2[2][2];
#pragma unroll
            for (int h = 0; h < 2; ++h)
#pragma unroll
                for (int i = 0; i < 2; ++i) vo2[h][i] = (GATHER && last) ? nvoffA[h][i] : voffA[h][i];
            PG8_LDB(B0, 0, 0); PG8_LDB(B1, 0, 1); PG8_SCHED; PG8_LDA(At, 0, 0); PG8_STAGE_A(PG8_SA(1, 1), a1, 1, voffA);
            PG8_WAIT_V(8); PG8_WAIT_L(0); PG8_BAR; PG8_MMA(0, 0, At, B0); PG8_MMA(0, 1, At, B1); PG8_BAR; PG8_SCHED;
            PG8_LDA(At, 0, 1); PG8_STAGE(PG8_SB(0, 0), b2, voffB); PG8_STAGE(PG8_SB(0, 1), b2 + hstep, voffB); PG8_STAGE_A(PG8_SA(0, 0), a2, 0, vo2);
            PG8_WAIT_V(8); PG8_WAIT_L(0); PG8_BAR; PG8_MMA(1, 0, At, B0); PG8_MMA(1, 1, At, B1); PG8_BAR; PG8_SCHED;
            PG8_LDB(B0, 1, 0); PG8_LDB(B1, 1, 1); PG8_SCHED; PG8_LDA(At, 1, 0); PG8_STAGE_A(PG8_SA(0, 1), a2, 1, vo2);
            PG8_WAIT_V(8); PG8_WAIT_L(0); PG8_BAR; PG8_MMA(0, 0, At, B0); PG8_MMA(0, 1, At, B1); PG8_BAR; PG8_SCHED;
            PG8_LDA(At, 1, 1); PG8_STAGE(PG8_SB(1, 0), b3, voffB); PG8_STAGE(PG8_SB(1, 1), b3 + hstep, voffB); PG8_STAGE_A(PG8_SA(1, 0), a3, 0, vo2);
            PG8_WAIT_V(8); PG8_WAIT_L(0); PG8_BAR; PG8_MMA(1, 0, At, B0); PG8_MMA(1, 1, At, B1); PG8_BAR; PG8_SCHED;
        }
        if constexpr (ALIGN_EPI) { if (wr == 0) PG8_BAR; }
        E(acc, cur, wr, wc, fr, fq);
        if (!has_next) break;
#pragma unroll
        for (int a = 0; a < 2; ++a)
#pragma unroll
            for (int b = 0; b < 2; ++b)
#pragma unroll
                for (int m = 0; m < 4; ++m)
#pragma unroll
                    for (int n = 0; n < 2; ++n) acc[a][b][m][n] = (f32x4){0.f, 0.f, 0.f, 0.f};
        cur = nxt; cA = nA; cB = nB; ++ui;
        if constexpr (GATHER) {
#pragma unroll
            for (int h = 0; h < 2; ++h)
#pragma unroll
                for (int i = 0; i < 2; ++i) voffA[h][i] = nvoffA[h][i];
        }
        if constexpr (ALIGN_EPI) { if (wr == 1) PG8_BAR; }
    }
    PG8_WAIT_V(0);
    if constexpr (!ALIGN_EPI) { if (wr == 0) PG8_BAR; }
    PG8_BAR;
#undef PG8_SA
#undef PG8_SB
#undef PG8_STAGE
#undef PG8_STAGE_A
#undef PG8_LDA
#undef PG8_LDB
#undef PG8_MMA
#undef PG8_WAIT_V
#undef PG8_WAIT_L
#undef PG8_BAR
#undef PG8_SCHED
}
__device__ __forceinline__ float silu_f(float x) { return x * __builtin_amdgcn_rcpf(1.0f + __builtin_amdgcn_exp2f(-1.4426950408889634f * x)); }
__device__ __forceinline__ u32x4 pack8v(const f32x4& v0, const f32x4& v1) { u32x4 w; w.x = cvt_pk_bf16(v0[0], v0[1]); w.y = cvt_pk_bf16(v0[2], v0[3]); w.z = cvt_pk_bf16(v1[0], v1[1]); w.w = cvt_pk_bf16(v1[2], v1[3]); return w; }

struct EpiRetProj {
    static constexpr bool PERM = true;
    bf16_t* QD; bf16_t* KH; bf16_t* G; const float* tab;
    __device__ __forceinline__ void operator()(const f32x4 (&acc)[2][2][4][2], const Unit& u, int wr, int wc, int fr, int fq) const {
        const int row0 = u.pm * BM + wr * 64 + fr, cl = wc * 32 + 8 * fq;
        if (u.pn < 8) {
            const bool isq = u.pn < 4; const int h = u.pn & 3;
            const float lg = __builtin_amdgcn_logf(1.0f - __builtin_amdgcn_exp2f((float)(-5 - h)));
            bf16_t* base = (isq ? QD : KH) + h * 256 + cl;
#pragma unroll
            for (int ai = 0; ai < 2; ++ai)
#pragma unroll
                for (int m = 0; m < 4; ++m) { const int row = row0 + ai * HALF + m * 16, pos = row & 16383, ic = row & 127;
                    const float sc = isq ? __builtin_amdgcn_exp2f(lg * (float)(ic + 1)) : 0.0625f * __builtin_amdgcn_exp2f(-lg * (float)(ic + 1));
                    const f32x4* tp = (const f32x4*)(tab + ((size_t)pos * 128 + cl) * 2);
                    const f32x4 t0 = tp[0], t1 = tp[1], t2 = tp[2], t3 = tp[3];
                    const f32x4 a0 = acc[ai][0][m][0], a1 = acc[ai][0][m][1], b0 = acc[ai][1][m][0], b1 = acc[ai][1][m][1];
                    f32x4 o10, o11, o20, o21;
                    o10[0] = (a0[0] * t0[0] - b0[0] * t0[1]) * sc; o20[0] = (b0[0] * t0[0] + a0[0] * t0[1]) * sc;
                    o10[1] = (a0[1] * t0[2] - b0[1] * t0[3]) * sc; o20[1] = (b0[1] * t0[2] + a0[1] * t0[3]) * sc;
                    o10[2] = (a0[2] * t1[0] - b0[2] * t1[1]) * sc; o20[2] = (b0[2] * t1[0] + a0[2] * t1[1]) * sc;
                    o10[3] = (a0[3] * t1[2] - b0[3] * t1[3]) * sc; o20[3] = (b0[3] * t1[2] + a0[3] * t1[3]) * sc;
                    o11[0] = (a1[0] * t2[0] - b1[0] * t2[1]) * sc; o21[0] = (b1[0] * t2[0] + a1[0] * t2[1]) * sc;
                    o11[1] = (a1[1] * t2[2] - b1[1] * t2[3]) * sc; o21[1] = (b1[1] * t2[2] + a1[1] * t2[3]) * sc;
                    o11[2] = (a1[2] * t3[0] - b1[2] * t3[1]) * sc; o21[2] = (b1[2] * t3[0] + a1[2] * t3[1]) * sc;
                    o11[3] = (a1[3] * t3[2] - b1[3] * t3[3]) * sc; o21[3] = (b1[3] * t3[2] + a1[3] * t3[3]) * sc;
                    bf16_t* rp = base + (size_t)row * 1024;
                    *(u32x4*)rp = pack8v(o10, o11); *(u32x4*)(rp + 128) = pack8v(o20, o21); asm volatile("" ::: "memory"); }
        } else {
            bf16_t* base = G + (u.pn - 8) * 256 + cl;
#pragma unroll
            for (int ai = 0; ai < 2; ++ai)
#pragma unroll
                for (int m = 0; m < 4; ++m) { bf16_t* rp = base + (size_t)(row0 + ai * HALF + m * 16) * 2048;
#pragma unroll
                    for (int bj = 0; bj < 2; ++bj) { f32x4 v0 = acc[ai][bj][m][0], v1 = acc[ai][bj][m][1];
#pragma unroll
                        for (int j = 0; j < 4; ++j) { v0[j] = silu_f(v0[j]); v1[j] = silu_f(v1[j]); }
                        *(u32x4*)(rp + bj * HALF) = pack8v(v0, v1); } }
        }
    }
};
struct EpiVT {
    static constexpr bool PERM = true;
    bf16_t* VT;
    __device__ __forceinline__ void operator()(const f32x4 (&acc)[2][2][4][2], const Unit& u, int wr, int wc, int fr, int fq) const {
        const int row0 = u.pm * BM + wr * 64 + fr, c0 = u.pn * BM + wc * 32 + 8 * fq;
#pragma unroll
        for (int ai = 0; ai < 2; ++ai)
#pragma unroll
            for (int m = 0; m < 4; ++m) { const int R = row0 + ai * HALF + m * 16, h = R >> 9, e = R & 511;
#pragma unroll
                for (int bj = 0; bj < 2; ++bj) { const int c = c0 + bj * HALF, b = c >> 14, t = c & 16383, n = t >> 7, oct = (t & 127) >> 3;
                    const size_t off = ((size_t)((b * 4 + h) * 128 + n) << 16) + (size_t)(((((e >> 5) * 8 + (oct >> 1)) * 2 + (oct & 1)) * 32 + (e & 31)) * 8);
                    *(u32x4*)(VT + off) = pack8v(acc[ai][bj][m][0], acc[ai][bj][m][1]); } }
    }
};
struct EpiAddBf16 {
    static constexpr bool PERM = true;
    bf16_t* XB; float alpha;
    __device__ __forceinline__ void operator()(const f32x4 (&acc)[2][2][4][2], const Unit& u, int wr, int wc, int fr, int fq) const {
        const int row0 = u.pm * BM + wr * 64 + fr, col0 = u.pn * BM + wc * 32 + 8 * fq;
#pragma unroll
        for (int ai = 0; ai < 2; ++ai)
#pragma unroll
            for (int m = 0; m < 4; ++m) { bf16_t* rowp = XB + (size_t)(row0 + ai * HALF + m * 16) * 1024 + col0;
#pragma unroll
                for (int bj = 0; bj < 2; ++bj) { const u32x4 x = *(const u32x4*)(rowp + bj * HALF); f32x4 v0 = acc[ai][bj][m][0], v1 = acc[ai][bj][m][1];
                    v0[0] += alpha * __builtin_bit_cast(float, x.x << 16); v0[1] += alpha * __builtin_bit_cast(float, x.x & 0xffff0000u);
                    v0[2] += alpha * __builtin_bit_cast(float, x.y << 16); v0[3] += alpha * __builtin_bit_cast(float, x.y & 0xffff0000u);
                    v1[0] += alpha * __builtin_bit_cast(float, x.z << 16); v1[1] += alpha * __builtin_bit_cast(float, x.z & 0xffff0000u);
                    v1[2] += alpha * __builtin_bit_cast(float, x.w << 16); v1[3] += alpha * __builtin_bit_cast(float, x.w & 0xffff0000u);
                    *(u32x4*)(rowp + bj * HALF) = pack8v(v0, v1); } }
    }
};
struct EpiSwiGLU {
    static constexpr bool PERM = true;
    bf16_t* H;
    __device__ __forceinline__ void operator()(const f32x4 (&acc)[2][2][4][2], const Unit& u, int wr, int wc, int fr, int fq) const {
        const int row0 = u.pm * BM + wr * 64 + fr, col0 = u.pn * HALF + wc * 32 + 8 * fq;
#pragma unroll
        for (int ai = 0; ai < 2; ++ai)
#pragma unroll
            for (int m = 0; m < 4; ++m) { f32x4 v0 = acc[ai][0][m][0], v1 = acc[ai][0][m][1]; const f32x4 u0 = acc[ai][1][m][0], u1 = acc[ai][1][m][1];
#pragma unroll
                for (int j = 0; j < 4; ++j) { v0[j] = silu_f(v0[j]) * u0[j]; v1[j] = silu_f(v1[j]) * u1[j]; }
                *(u32x4*)(H + (size_t)(row0 + ai * HALF + m * 16) * 3584 + col0) = pack8v(v0, v1); }
    }
};
struct EpiQKV {
    static constexpr bool PERM = true;
    bf16_t* P;
    __device__ __forceinline__ void operator()(const f32x4 (&acc)[2][2][4][2], const Unit& u, int wr, int wc, int fr, int fq) const {
        const int row0 = u.pm * BM + wr * 64 + fr, cl = wc * 32 + 8 * fq;
        const int which = u.pn / 6, g = (u.pn % 6) >> 1, hp = u.pn & 1, sh = 2 * g;
#pragma unroll
        for (int ai = 0; ai < 2; ++ai)
#pragma unroll
            for (int m = 0; m < 4; ++m) { const int r = row0 + ai * HALF + m * 16, b = r >> 14, t = r & 16383;
                const int perm = (t & ((1 << sh) - 1)) * (16384 >> sh) + (t >> sh);
#pragma unroll
                for (int bj = 0; bj < 2; ++bj) { const int head = 2 * hp + bj;
                    bf16_t* dst = P + ((size_t)(((which * 3 + g) * 8 + b * 4 + head) * 16384 + perm) << 7) + cl;
                    *(u32x4*)dst = pack8v(acc[ai][bj][m][0], acc[ai][bj][m][1]); } }
    }
};
struct EpiBf16Y {
    static constexpr bool PERM = true;
    bf16_t* Y;
    __device__ __forceinline__ void operator()(const f32x4 (&acc)[2][2][4][2], const Unit& u, int wr, int wc, int fr, int fq) const {
        const int row0 = u.pm * BM + wr * 64 + fr, col0 = u.pn * BM + wc * 32 + 8 * fq;
#pragma unroll
        for (int ai = 0; ai < 2; ++ai)
#pragma unroll
            for (int m = 0; m < 4; ++m) { bf16_t* rp = Y + (size_t)(row0 + ai * HALF + m * 16) * 1024 + col0;
#pragma unroll
                for (int bj = 0; bj < 2; ++bj) *(u32x4*)(rp + bj * HALF) = pack8v(acc[ai][bj][m][0], acc[ai][bj][m][1]); }
    }
};
struct EpiF32Slab {
    static constexpr bool PERM = false;
    float* S;
    __device__ __forceinline__ void operator()(const f32x4 (&acc)[2][2][4][2], const Unit& u, int wr, int wc, int fr, int fq) const {
        float* base = S + ((size_t)u.ex << 16) + (size_t)(wr * 64 + fr) * 256 + wc * 32 + 4 * fq;
#pragma unroll
        for (int ai = 0; ai < 2; ++ai)
#pragma unroll
            for (int m = 0; m < 4; ++m) { float* rowp = base + (size_t)(ai * HALF + m * 16) * 256;
#pragma unroll
                for (int bj = 0; bj < 2; ++bj)
#pragma unroll
                    for (int n = 0; n < 2; ++n) *(f32x4*)(rowp + bj * HALF + n * 16) = acc[ai][bj][m][n]; }
    }
};
}
namespace swa {
constexpr int D = 128; constexpr float THR = 8.f; constexpr bool WSKIP = true; constexpr int LSE_LDS_OFF = 131072;
constexpr float SCALE = 0.08838834764831845f;
constexpr int NW = 8, QBLK = 32, KVBLK = 64, QB = NW * QBLK;
constexpr int SHM_V = KVBLK * D * 2, SHM_K = KVBLK * D * 2;
constexpr int LDS_BYTES = 2 * SHM_V + 2 * SHM_K + NW * 64 * 4;

using bf16 = __hip_bfloat16;
typedef short bf16x8 __attribute__((ext_vector_type(8)));
typedef short s16x4 __attribute__((ext_vector_type(4)));
typedef float f32x16 __attribute__((ext_vector_type(16)));
typedef float f32x4 __attribute__((ext_vector_type(4)));
typedef unsigned u32x4 __attribute__((ext_vector_type(4)));
template <class A, class Bt> struct same_t { static constexpr bool v = false; };
template <class A> struct same_t<A, A> { static constexpr bool v = true; };

#define KSWZ(row, colB) ((row) * 256 + ((colB) ^ (((row) & 7) << 4)))
#define SBAR() __builtin_amdgcn_sched_barrier(0)
__device__ __forceinline__ int v_st(int k, int c) { const int kk = (k & ~0xC) | ((k & 4) << 1) | ((k & 8) >> 1); return ((kk >> 3) * 4 + (c >> 5)) * 512 + ((kk & 7) * 32 + (c & 31)) * 2; }
__device__ __forceinline__ int v_rd_base(int lane) { return ((lane & 3) << 3) | (((lane >> 2) & 3) << 6) | (((lane >> 4) & 1) << 5) | (((lane >> 5) & 1) << 8); }
constexpr int v_rd_off(int d0, int ks, int half) { return d0 * 512 + ks * 4096 + half * 2048; }
__device__ __forceinline__ int crow(int r, int hi) { return (r & 3) + 8 * (r >> 2) + 4 * hi; }
__device__ __forceinline__ unsigned cvtpk(float lo, float hi) {
    unsigned r; asm volatile("v_cvt_pk_bf16_f32 %0, %1, %2" : "=v"(r) : "v"(lo), "v"(hi)); return r;
}
__device__ __forceinline__ bf16x8 pack8(f32x4 a, f32x4 b) {
    u32x4 w = {cvtpk(a[0], a[1]), cvtpk(a[2], a[3]), cvtpk(b[0], b[1]), cvtpk(b[2], b[3])};
    return *reinterpret_cast<bf16x8*>(&w);
}
template <class T> __device__ __forceinline__ bf16x8 load8(const T* p) {
    if constexpr (same_t<T, float>::v) { return pack8(*(const f32x4*)p, *(const f32x4*)(p + 4)); }
    else { return *reinterpret_cast<const bf16x8*>(p); }
}
__device__ __forceinline__ void mask_tile(f32x16& p0, f32x16& p1, int dq, unsigned W) {
    const float NEG = -__builtin_inff();
#pragma unroll
    for (int r = 0; r < 16; ++r) {
        const int c = (r & 3) + 8 * (r >> 2);
        if ((unsigned)(dq - c) >= W) p0[r] = NEG;
        if ((unsigned)(dq - c - 32) >= W) p1[r] = NEG;
    }
}
__device__ __forceinline__ void partialSM(f32x16& p0, f32x16& p1, float& m_reg, float& mn, float& alpha) {
    float pmax = p0[0]; for (int r = 1; r < 16; ++r) pmax = fmaxf(pmax, p0[r]); for (int r = 0; r < 16; ++r) pmax = fmaxf(pmax, p1[r]);
    { auto rr = __builtin_amdgcn_permlane32_swap(__float_as_uint(pmax), __float_as_uint(pmax), false, false);
      pmax = fmaxf(__uint_as_float(rr[0]), __uint_as_float(rr[1])); }
    constexpr float C2 = 1.4426950408889634f * SCALE;
    if (__builtin_expect(__all((pmax - m_reg) * SCALE <= THR), 1)) { mn = m_reg; alpha = 1.f; }
    else { mn = fmaxf(m_reg, pmax); alpha = __builtin_amdgcn_exp2f((m_reg - mn) * C2); m_reg = mn; }
    const float mnL = -mn * C2;
    for (int r = 0; r < 16; ++r) p0[r] = fmaf(p0[r], C2, mnL); for (int r = 0; r < 16; ++r) p1[r] = fmaf(p1[r], C2, mnL);
    for (int r = 0; r < 16; ++r) p0[r] = __builtin_amdgcn_exp2f(p0[r]);
}
__device__ __forceinline__ void finishSM(f32x16& p0, f32x16& p1, float alpha, float& l_reg, bf16x8& pa0, bf16x8& pa1, bf16x8& pa2, bf16x8& pa3) {
    for (int r = 0; r < 16; ++r) p1[r] = __builtin_amdgcn_exp2f(p1[r]);
    float ps = 0; for (int r = 0; r < 16; ++r) ps += p0[r]; for (int r = 0; r < 16; ++r) ps += p1[r];
    { auto rr = __builtin_amdgcn_permlane32_swap(__float_as_uint(ps), __float_as_uint(ps), false, false);
      ps = __uint_as_float(rr[0]) + __uint_as_float(rr[1]); }
    l_reg = l_reg * alpha + ps;
#define PK4(P, B_, OUT) do { unsigned a0 = cvtpk(P[B_+0], P[B_+1]), a1 = cvtpk(P[B_+2], P[B_+3]);                          \
        unsigned b0 = cvtpk(P[B_+4], P[B_+5]), b1 = cvtpk(P[B_+6], P[B_+7]);                                             \
        auto r0 = __builtin_amdgcn_permlane32_swap(a0, b0, false, false); auto r1 = __builtin_amdgcn_permlane32_swap(a1, b1, false, false); \
        u32x4 w = {r0[0], r1[0], r0[1], r1[1]}; OUT = *reinterpret_cast<bf16x8*>(&w); } while (0)
    PK4(p0, 0, pa0); PK4(p0, 8, pa1); PK4(p1, 0, pa2); PK4(p1, 8, pa3);
#undef PK4
}
template <int KB, bool SK>
__device__ __forceinline__ void qkt(f32x16& p0, f32x16& p1, const char* K_lds, int r32, int hi, const bf16x8* qr, bool act) {
    if (SK && !act) { const float NEG = -__builtin_inff();
#pragma unroll
        for (int r = 0; r < 16; ++r) { p0[r] = NEG; p1[r] = NEG; } return; }
    p0 = f32x16{}; p1 = f32x16{};
    const char* kb[4];
#pragma unroll
    for (int dd = 0; dd < 4; ++dd) kb[dd] = K_lds + KB * SHM_K + KSWZ(r32, (dd * 16 + hi * 8) * 2);
#pragma unroll
    for (int d0 = 0; d0 < 8; ++d0) { const char* a = kb[d0 & 3] + (d0 >> 2) * 128;
        bf16x8 b0 = *reinterpret_cast<const bf16x8*>(a);
        bf16x8 b1 = *reinterpret_cast<const bf16x8*>(a + 32 * 256);
        p0 = __builtin_amdgcn_mfma_f32_32x32x16_bf16(b0, qr[d0], p0, 0, 0, 0);
        p1 = __builtin_amdgcn_mfma_f32_32x32x16_bf16(b1, qr[d0], p1, 0, 0, 0); }
}
template <int VB, bool SK>
__device__ __forceinline__ void pv_tile(f32x16* o, int vb0, bf16x8 pa0, bf16x8 pa1, bf16x8 pa2, bf16x8 pa3, bool act) {
    if (SK && !act) return;
#define TRRD(dst, off) asm volatile("ds_read_b64_tr_b16 %0, %1 offset:%2" : "=&v"(dst) : "v"(vb0), "i"(off) : "memory")
#define PV_D0(d0) do { s16x4 l0, l1, l2, l3, h0, h1, h2, h3; constexpr int b_ = VB * SHM_V + v_rd_off(d0, 0, 0);     \
        TRRD(l0, b_); TRRD(h0, b_ + 2048); TRRD(l1, b_ + 4096); TRRD(h1, b_ + 6144); TRRD(l2, b_ + 8192); TRRD(h2, b_ + 10240); TRRD(l3, b_ + 12288); TRRD(h3, b_ + 14336); \
        asm volatile("s_waitcnt lgkmcnt(0)" ::: "memory"); SBAR();                 \
        o[d0] = __builtin_amdgcn_mfma_f32_32x32x16_bf16(pa0, (bf16x8){l0[0], l0[1], l0[2], l0[3], h0[0], h0[1], h0[2], h0[3]}, o[d0], 0, 0, 0);   \
        o[d0] = __builtin_amdgcn_mfma_f32_32x32x16_bf16(pa1, (bf16x8){l1[0], l1[1], l1[2], l1[3], h1[0], h1[1], h1[2], h1[3]}, o[d0], 0, 0, 0);   \
        o[d0] = __builtin_amdgcn_mfma_f32_32x32x16_bf16(pa2, (bf16x8){l2[0], l2[1], l2[2], l2[3], h2[0], h2[1], h2[2], h2[3]}, o[d0], 0, 0, 0);   \
        o[d0] = __builtin_amdgcn_mfma_f32_32x32x16_bf16(pa3, (bf16x8){l3[0], l3[1], l3[2], l3[3], h3[0], h3[1], h3[2], h3[3]}, o[d0], 0, 0, 0); } while (0)
    PV_D0(0); PV_D0(1); PV_D0(2); PV_D0(3);
#undef PV_D0
#undef TRRD
}

template <class TIn, class TOut> struct BlockRef { const TIn* Q; const TIn* K; const TIn* V; TOut* O; int P0; };
template <class TIn> struct Seam {
    int tid;
    bf16x8 qr[8];
    bf16x8 st_v0, st_v1, st_k0, st_k1; f32x4 sf0, sf1, sf2, sf3;
    f32x4 tq[16];
};
__device__ __forceinline__ int swa_jlo(int P0, int W) { const int lowk = P0 - W + 1; return lowk > 0 ? lowk / KVBLK : 0; }
#define ROW(p, k0, rr) ((p) + (size_t)((k0) + (rr)) * D + sc)
#define VMW() asm volatile("s_waitcnt vmcnt(0)" ::: "memory")
#define VMWN(n) asm volatile("s_waitcnt vmcnt(%0)" :: "i"(n) : "memory")
#define SLOAD_H(Kp, Vp, k0) do { S.st_v0 = load8<TIn>(ROW(Vp, k0, sr)); S.st_v1 = load8<TIn>(ROW(Vp, k0, 32 + sr));              \
                         S.st_k0 = load8<TIn>(ROW(Kp, k0, sr)); S.st_k1 = load8<TIn>(ROW(Kp, k0, 32 + sr)); } while (0)
#define SWRITE_HK(bf) do { *(bf16x8*)(K_lds + (bf) * SHM_K + kws) = S.st_k0; *(bf16x8*)(K_lds + (bf) * SHM_K + kws + 32 * 256) = S.st_k1; } while (0)
#define SWRITE_HV(bf) do { *(bf16x8*)(V_lds + (bf) * SHM_V + vst0) = S.st_v0; *(bf16x8*)(V_lds + (bf) * SHM_V + vst1) = S.st_v1; } while (0)
#define SWRITE_H(bf) do { SWRITE_HV(bf); SWRITE_HK(bf); } while (0)
#define SLOAD_F(p, k0) do { S.sf0 = *(const f32x4*)ROW(p, k0, sr); S.sf1 = *(const f32x4*)(ROW(p, k0, sr) + 4);                \
                            S.sf2 = *(const f32x4*)ROW(p, k0, 32 + sr); S.sf3 = *(const f32x4*)(ROW(p, k0, 32 + sr) + 4); } while (0)
#define SWRITE_KF(bf) do { *(bf16x8*)(K_lds + (bf) * SHM_K + kws) = pack8(S.sf0, S.sf1); *(bf16x8*)(K_lds + (bf) * SHM_K + kws + 32 * 256) = pack8(S.sf2, S.sf3); } while (0)
#define SWRITE_VF(bf) do { *(bf16x8*)(V_lds + (bf) * SHM_V + vst0) = pack8(S.sf0, S.sf1); *(bf16x8*)(V_lds + (bf) * SHM_V + vst1) = pack8(S.sf2, S.sf3); } while (0)
template <class TIn, class TOut>
__device__ __forceinline__ void causal_swa_prime(const BlockRef<TIn, TOut>& cur, int W, char* lds, Seam<TIn>& S) {
    constexpr bool F32 = same_t<TIn, float>::v;
    const int tid = S.tid, wid = __builtin_amdgcn_readfirstlane(tid >> 6), lane = tid & 63, r32 = lane & 31, hi = lane >> 5;
    const int sr = tid >> 4, sc = (tid & 15) * 8, kws = KSWZ(sr, sc * 2); char* K_lds = lds + 2 * SHM_V;
    const int kb0 = swa_jlo(cur.P0, W) * KVBLK;
    for (int d0 = 0; d0 < 8; ++d0) S.qr[d0] = load8<TIn>(cur.Q + (size_t)(wid * QBLK + r32) * D + d0 * 16 + hi * 8);
    if constexpr (F32) { SLOAD_F((const float*)cur.K, kb0); VMW(); SWRITE_KF(0); SBAR(); SLOAD_F((const float*)cur.V, kb0); }
    else { SLOAD_H(cur.K, cur.V, kb0); VMW(); SWRITE_HK(0); }
    __syncthreads();
}
template <class TIn, class TOut>
__device__ __forceinline__ void causal_swa_block(const BlockRef<TIn, TOut>& cur, const BlockRef<TIn, TOut>& nxt, int skv, int W, char* lds, Seam<TIn>& S) {
    constexpr bool F32 = same_t<TIn, float>::v;
    const int tid = S.tid, wid = __builtin_amdgcn_readfirstlane(tid >> 6), lane = tid & 63, r32 = lane & 31, hi = lane >> 5;
    const int j_lo = swa_jlo(cur.P0, W);
    int j_hi = (cur.P0 + QB - 1) / KVBLK + 1; if (j_hi > skv / KVBLK) j_hi = skv / KVBLK;
    const int NT = j_hi - j_lo;
    const int kbn = swa_jlo(nxt.P0, W) * KVBLK;
    const int qlo = cur.P0 + wid * QBLK, qm = qlo + r32 - 4 * hi;
    char* V_lds = lds; char* K_lds = lds + 2 * SHM_V;
    float* ws = (float*)(lds + 2 * SHM_V + 2 * SHM_K) + wid * 64; float* li_l = ws, * al_l = ws + 32;
    float m_reg = -1e30f, l_reg = 0; f32x16 o[4] = {};
    const int sr = tid >> 4, sc = (tid & 15) * 8, vst0 = v_st(sr, sc), vst1 = v_st(32 + sr, sc), kws = KSWZ(sr, sc * 2);
    const int vb0 = (int)(uintptr_t)V_lds + v_rd_base(lane);
    const TIn* Kh = cur.K; const TIn* Vh = cur.V;
#define RESC(a) do { if (__any((a) < 1.f)) { if (hi == 0) al_l[r32] = (a); asm volatile("s_waitcnt lgkmcnt(0)" ::: "memory");              \
                     for (int d_ = 0; d_ < 4; ++d_) for (int r = 0; r < 16; ++r) o[d_][r] *= al_l[crow(r, hi)]; } } while (0)
#define KBASE(t) ((j_lo + (t)) * KVBLK)
#define ACT(t) (KBASE(t) <= qlo + QBLK - 1 && KBASE(t) + KVBLK - 1 >= qlo - W + 1)
#define MASKT(P0_, P1_, t) do { const int kb_ = KBASE(t); if ((!SK || ACT(t)) && (kb_ + KVBLK - 1 > qlo || kb_ <= qlo + QBLK - 1 - W)) mask_tile(P0_, P1_, qm - kb_, (unsigned)W); } while (0)
    constexpr int NQL = F32 ? 16 : 8;
    constexpr bool SK = WSKIP && !F32;
#define SEAM_K0() do { VMWN(NQL); if constexpr (F32) { SWRITE_KF(0); SBAR(); SLOAD_F((const float*)nxt.V, kbn); } else { SWRITE_HK(0); } SBAR(); } while (0)
    f32x16 pA0, pA1, pB0, pB1; float mnA, mnB, alA, alB; bf16x8 pa0, pa1, pa2, pa3;
    if constexpr (F32) { VMW(); SWRITE_VF(0); SBAR(); } else { SWRITE_HV(0); SBAR(); }
    if (NT > 1) { if constexpr (F32) SLOAD_F((const float*)Kh, KBASE(1)); else SLOAD_H(Kh, Vh, KBASE(1)); }
    SBAR(); qkt<0, SK>(pA0, pA1, K_lds, r32, hi, S.qr, ACT(0));
    if constexpr (F32) { if (NT > 1) { VMW(); SWRITE_KF(1); SBAR(); SLOAD_F((const float*)Vh, KBASE(1)); } }
    MASKT(pA0, pA1, 0); partialSM(pA0, pA1, m_reg, mnA, alA);
    if (NT > 1) { VMW(); if constexpr (F32) { SWRITE_VF(1); SBAR(); if (NT > 2) SLOAD_F((const float*)Kh, KBASE(2)); } else SWRITE_H(1); }
    __syncthreads();
#define HALF_STEP(PX0, PX1, mnX, alX, PY0, PY1, alY, t, KB, VB, SB) do {                                                      \
        SBAR(); qkt<KB, SK>(PX0, PX1, K_lds, r32, hi, S.qr, ACT(t));                                             \
        finishSM(PY0, PY1, alY, l_reg, pa0, pa1, pa2, pa3); SBAR();                                                           \
        if ((t) + 1 < NT) { if constexpr (F32) { VMW(); SWRITE_KF(SB); SBAR(); SLOAD_F((const float*)Vh, KBASE((t) + 1)); }  \
                            else { SLOAD_H(Kh, Vh, KBASE((t) + 1)); } SBAR(); }                                               \
        pv_tile<VB, SK>(o, vb0, pa0, pa1, pa2, pa3, ACT((t) - 1)); MASKT(PX0, PX1, (t)); partialSM(PX0, PX1, m_reg, mnX, alX);                                        \
        __syncthreads();                                                                                                      \
        if ((t) + 1 < NT) { VMW(); if constexpr (F32) { SWRITE_VF(SB); SBAR(); if ((t) + 2 < NT) SLOAD_F((const float*)Kh, KBASE((t) + 2)); } \
                            else { SWRITE_H(SB); } }                                                                          \
        RESC(alX); __syncthreads(); } while (0)
    for (int t = 1; t + 1 < NT; t += 2) {
        HALF_STEP(pB0, pB1, mnB, alB, pA0, pA1, alA, t, 1, 0, 0);
        HALF_STEP(pA0, pA1, mnA, alA, pB0, pB1, alB, t + 1, 0, 1, 1);
    }
    const bool even = (NT & 1) == 0;
    if (even) { SBAR(); qkt<1, SK>(pB0, pB1, K_lds, r32, hi, S.qr, ACT(NT - 1)); SBAR(); }
#define QROW(e) (nxt.Q + (size_t)(wid * QBLK + r32) * D + ((e) >> 1) * 16 + hi * 8 + ((e) & 1) * 4)
    if constexpr (F32) { SLOAD_F((const float*)nxt.K, kbn); SBAR();
#pragma unroll
        for (int e = 0; e < 8; ++e) S.tq[e] = *(const f32x4*)QROW(e); }
    else { SLOAD_H(nxt.K, nxt.V, kbn); SBAR();
#pragma unroll
        for (int d0 = 0; d0 < 8; ++d0) S.qr[d0] = load8<TIn>(nxt.Q + (size_t)(wid * QBLK + r32) * D + d0 * 16 + hi * 8); }
    SBAR();
    finishSM(pA0, pA1, alA, l_reg, pa0, pa1, pa2, pa3); SBAR();
    if constexpr (F32) {
#pragma unroll
        for (int e = 8; e < 16; ++e) S.tq[e] = *(const f32x4*)QROW(e); SBAR(); }
#undef QROW
    pv_tile<0, SK>(o, vb0, pa0, pa1, pa2, pa3, ACT(even ? NT - 2 : NT - 1));
    if (even) { MASKT(pB0, pB1, NT - 1); partialSM(pB0, pB1, m_reg, mnB, alB); __syncthreads(); RESC(alB);
        finishSM(pB0, pB1, alB, l_reg, pa0, pa1, pa2, pa3); SBAR(); pv_tile<1, SK>(o, vb0, pa0, pa1, pa2, pa3, ACT(NT - 1)); }
    SBAR(); SEAM_K0();
    if (hi == 0) { li_l[r32] = l_reg; ((float*)(lds + LSE_LDS_OFF))[wid * QBLK + r32] = m_reg * SCALE + __logf(l_reg); } asm volatile("s_waitcnt lgkmcnt(0)" ::: "memory");
    float rli[16];
#pragma unroll
    for (int r = 0; r < 16; ++r) rli[r] = __builtin_amdgcn_rcpf(li_l[crow(r, hi)]);
    TOut* Ow = cur.O + (size_t)(wid * QBLK) * D + (size_t)(hi * 4) * D + r32;
#pragma unroll
    for (int r = 0; r < 16; ++r) { const int orow = (r & 3) + 8 * (r >> 2);
#pragma unroll
        for (int d0 = 0; d0 < 4; ++d0) { const float v = o[d0][r] * rli[r];
            if constexpr (same_t<TOut, float>::v) { Ow[orow * D + d0 * 32] = v; }
            else { const float vn = __shfl_xor(v, 1);
                   if ((r32 & 1) == 0) *(unsigned*)(Ow + orow * D + d0 * 32) = cvtpk(v, vn); } } }
    if constexpr (F32) {
#pragma unroll
        for (int d0 = 0; d0 < 8; ++d0) S.qr[d0] = pack8(S.tq[2 * d0], S.tq[2 * d0 + 1]); }
    __syncthreads();
#undef RESC
#undef KBASE
#undef ACT
#undef MASKT
#undef SEAM_K0
#undef HALF_STEP
}
#undef ROW
#undef VMW
#undef VMWN
#undef SLOAD_H
#undef SWRITE_HK
#undef SWRITE_HV
#undef SWRITE_H
#undef SLOAD_F
#undef SWRITE_KF
#undef SWRITE_VF
}
constexpr int T_TOK = 32768, DMODEL = 1024, SEQ = 16384, DFF = 3584, NEXP = 8;
constexpr float ALPHA = 1.6817928305074290f, LN_EPS = 1e-5f;
constexpr int NWAVES = 8;
constexpr size_t MiB = 1u << 20;
constexpr size_t WS_CTL = 0, CTL_ZERO_BYTES = 1 * MiB;
constexpr size_t WS_WIN = 2 * MiB, WS_WRO = 26 * MiB, WS_WQKV = 34 * MiB, WS_WAO = 52 * MiB, WS_WGU = 54 * MiB, WS_WDN = 82 * MiB;
constexpr size_t WS_TAB = 96 * MiB, WS_XB = 112 * MiB;
constexpr size_t WS_LIST = 176 * MiB, WS_TSLOT = 178 * MiB, WS_GATE = 178 * MiB + 256 * 1024, WS_LC = 178 * MiB + 512 * 1024;
constexpr size_t WS_BIG = 179 * MiB;
constexpr size_t BIG_QD = 0, BIG_KH = 64 * MiB, BIG_VT = 128 * MiB, BIG_G = 256 * MiB, BIG_RT = 384 * MiB;
constexpr size_t BIG_HID = 0;
constexpr size_t BIG_QKV = 0, BIG_OP = 288 * MiB, BIG_LSE = 384 * MiB, BIG_O = 386 * MiB;
constexpr size_t BIG_YP = 462 * MiB, BIG_WMGU = 594 * MiB, BIG_WMD = 706 * MiB;
constexpr size_t WS_SLAB = WS_BIG + 762 * MiB;
constexpr size_t WS_END = WS_SLAB + 32 * MiB;
constexpr int CW_TMO = 0, CW_BAR = 4096, CW_CNT = 8192;
constexpr int RING_OFF = 0, RING_BYTES = 131072, AUX_OFF = 131072, AUX_BYTES = 30720, MISC_OFF = AUX_OFF + AUX_BYTES, LDS_BYTES = MISC_OFF + 512;
static_assert(LDS_BYTES <= 163840, "LDS");

#define GAS __attribute__((address_space(1)))
#define LAS __attribute__((address_space(3)))
typedef unsigned short bf16;
typedef unsigned v4u __attribute__((ext_vector_type(4)));
typedef unsigned v2u __attribute__((ext_vector_type(2)));
typedef float f32x4 __attribute__((ext_vector_type(4)));
typedef float f32x16 __attribute__((ext_vector_type(16)));
typedef short bf16x8 __attribute__((ext_vector_type(8)));
typedef short s16x4 __attribute__((ext_vector_type(4)));
typedef GAS unsigned gu32;
#define RLX_AGENT __ATOMIC_RELAXED, __HIP_MEMORY_SCOPE_AGENT
#define LDS_WAIT() asm volatile("s_waitcnt lgkmcnt(0)" ::: "memory")
#define VM_WAIT() asm volatile("s_waitcnt vmcnt(0)" ::: "memory")
__device__ __forceinline__ unsigned f2bf(float f) { unsigned u = __builtin_bit_cast(unsigned, f); return (u + 0x7fffu + ((u >> 16) & 1u)) >> 16; }
__device__ __forceinline__ unsigned pk2(float lo, float hi) { return f2bf(lo) | (f2bf(hi) << 16); }
__device__ __forceinline__ float bflo(unsigned w) { return __builtin_bit_cast(float, w << 16); }
__device__ __forceinline__ float bfhi(unsigned w) { return __builtin_bit_cast(float, w & 0xffff0000u); }
#define XB_TMO      128
#define XB_XCNT(j)  (256  + 64 * (j))
#define XB_XSUB(j)  (1280 + 64 * (j))
#define XB_XGEN(j)  (2304 + 64 * (j))
#define XB_TOP      3328
#define XB_TOPGEN   3392
#define XCD_BAR_WORDS 3456
#define XB_SPIN_CAP (1u << 18)

__device__ __forceinline__ unsigned xb_ld(unsigned* p)              { return __hip_atomic_load(p, __ATOMIC_RELAXED, __HIP_MEMORY_SCOPE_AGENT); }
__device__ __forceinline__ unsigned xb_add(unsigned* p, unsigned v) { return __hip_atomic_fetch_add(p, v, __ATOMIC_RELAXED, __HIP_MEMORY_SCOPE_AGENT); }
__device__ __forceinline__ unsigned xb_xcc_id() { return (unsigned)__builtin_amdgcn_s_getreg((3 << 11) | 20) & 0xFu; }
#define XB_SPIN(cond, bar) do { unsigned _sp = 0; while (cond) { __builtin_amdgcn_s_sleep(1); \
    if ((++_sp & 255u) == 0u) { if (xb_ld(&(bar)[XB_TMO])) break; if (_sp > XB_SPIN_CAP) { atomicAdd(&(bar)[XB_TMO], 1u); break; } } } } while (0)

struct XcdBarrier {
    unsigned* bar; unsigned x;
    volatile LAS unsigned* st;
};

__device__ __forceinline__ XcdBarrier xcd_barrier_post(unsigned* bar, volatile LAS unsigned* st) {
    XcdBarrier b; b.bar = bar; b.x = xb_xcc_id(); b.st = st;
    if (threadIdx.x == 0) (void)xb_add(&bar[XB_XCNT(b.x)], 1u);
    return b;
}
__device__ __forceinline__ void xcd_barrier_complete(unsigned* bar, unsigned x, unsigned& nloc, unsigned& nx) {
    const unsigned G = gridDim.x * gridDim.y * gridDim.z;
    unsigned sum, cnt, mine, sp = 0u;
    for (;;) {
        sum = 0u; cnt = 0u; mine = 0u;
#pragma unroll
        for (unsigned j = 0; j < 16; ++j) { const unsigned c = xb_ld(&bar[XB_XCNT(j)]); sum += c; cnt += (c > 0u) ? 1u : 0u; mine = (j == x) ? c : mine; }
        if (sum == G) break;
        __builtin_amdgcn_s_sleep(1);
        if ((++sp & 255u) == 0u) { if (xb_ld(&bar[XB_TMO])) break; if (sp > XB_SPIN_CAP) { atomicAdd(&bar[XB_TMO], 1u); break; } }
    }
    nloc = mine > 0u ? mine : 1u; nx = cnt > 0u ? cnt : 1u;
}

__device__ __forceinline__ void xcd_barrier(const XcdBarrier& b) {
    asm volatile("s_waitcnt vmcnt(0)" ::: "memory");
    __syncthreads();
    if (threadIdx.x == 0) {
        unsigned* bar = b.bar;
        __builtin_amdgcn_s_waitcnt(0);
        unsigned nloc = b.st[0], nx = b.st[1];
        if (nloc == 0u) { xcd_barrier_complete(bar, b.x, nloc, nx); b.st[0] = nloc; b.st[1] = nx; }
        const unsigned old = xb_add(&bar[XB_XSUB(b.x)], 1u);
        const unsigned gen = old / nloc;
        if (old + 1u == (gen + 1u) * nloc) {
            __builtin_amdgcn_fence(__ATOMIC_RELEASE, "agent");
            asm volatile("s_waitcnt vmcnt(0)" ::: "memory");
            const unsigned og = xb_add(&bar[XB_TOP], 1u);
            const unsigned tg = og / nx;
            if (og + 1u == (tg + 1u) * nx) xb_add(&bar[XB_TOPGEN], 1u);
            else XB_SPIN(xb_ld(&bar[XB_TOPGEN]) == tg, bar);
            __builtin_amdgcn_fence(__ATOMIC_ACQUIRE, "agent");
            xb_add(&bar[XB_XGEN(b.x)], 1u);
            asm volatile("s_waitcnt vmcnt(0)" ::: "memory");
        } else {
            XB_SPIN(xb_ld(&bar[XB_XGEN(b.x)]) == gen, bar);
            __builtin_amdgcn_fence(__ATOMIC_ACQUIRE, "agent");
            asm volatile("s_waitcnt vmcnt(0)" ::: "memory");
        }
    }
    __syncthreads();
}
struct Args { const float* in[15]; float* out; unsigned char* ws; };
struct Frame {
    LAS unsigned char* lds;
    volatile LAS unsigned* MISC;
    int tid, lane, wave, G, c;
};
__device__ __forceinline__ unsigned long long arg_u64(const Frame& F, int k) { const unsigned long long v = ((const LAS unsigned long long*)(F.lds + MISC_OFF + 128))[k];
    return ((unsigned long long)(unsigned)__builtin_amdgcn_readfirstlane((int)(unsigned)(v >> 32)) << 32) | (unsigned long long)(unsigned)__builtin_amdgcn_readfirstlane((int)(unsigned)v); }
#define ARGI(F, k) ((const float*)(const GAS float*)arg_u64(F, (k)))
#define ARGX(F) ((float*)(GAS float*)arg_u64(F, 15))
#define ARGWS(F) ((unsigned char*)(GAS unsigned char*)arg_u64(F, 16))
#define F_CTL(F) ((gu32*)(ARGWS(F) + WS_CTL))
__device__ __forceinline__ void frame_refresh(Frame& F) { int t = F.tid; asm volatile("" : "+v"(t)); F.tid = t; F.lane = t & 63; F.wave = __builtin_amdgcn_readfirstlane(t >> 6); unsigned l = (unsigned)(uintptr_t)F.lds; int c_ = F.c, g_ = F.G; asm volatile("" : "+s"(l), "+s"(c_), "+s"(g_)); F.lds = (LAS unsigned char*)(uintptr_t)l; F.c = c_; F.G = g_; }
__device__ __forceinline__ float wave_sum(float v) {
#pragma unroll
    for (int o = 1; o < 64; o <<= 1) v += __shfl_xor(v, o);
    return v;
}
__device__ __forceinline__ s16x4 vtr(const LAS unsigned char* p) { return __builtin_bit_cast(s16x4, __builtin_amdgcn_ds_read_tr16_b64_v4i16((LAS s16x4*)p)); }
__device__ __forceinline__ int crow(int r, int hi) { return (r & 3) + 8 * (r >> 2) + 4 * hi; }

struct CvItem { const float* src; bf16* dst; int N, K; };
template <int MAP> __device__ __forceinline__ CvItem cv_make(const float* W, int K, int N, bf16* WT, int item) {
    const int nblk = N / 64, kb = item / nblk, nb = item - kb * nblk, n0 = 64 * nb; int dr = n0;
    if (MAP == 1) dr = n0 < 2048 ? n0 : (n0 < 4096 ? n0 + 2048 : n0 - 2048);
    if (MAP == 2) dr = (n0 >> 7) * 256 + (n0 & 127);
    if (MAP == 3) dr = (n0 >> 7) * 256 + 128 + (n0 & 127);
    CvItem c; c.src = W + (size_t)(64 * kb) * N + n0; c.dst = WT + (size_t)dr * K + 64 * kb; c.N = N; c.K = K; return c;
}
__device__ __forceinline__ void cv_load(const CvItem& c, f32x4 (&r)[16], int lane) {
    const float* p = c.src + (size_t)(lane >> 4) * c.N + 4 * (lane & 15);
#pragma unroll
    for (int i = 0; i < 16; ++i) r[i] = *(const GAS f32x4*)(p + (size_t)(4 * i) * c.N);
}
__device__ __forceinline__ void cv_store(const CvItem& c, const f32x4 (&r)[16], LAS float* scr, int lane) {
#pragma unroll
    for (int i = 0; i < 16; ++i) { LAS float* s = scr + (4 * i + (lane >> 4)) * 65 + 4 * (lane & 15); s[0] = r[i].x; s[1] = r[i].y; s[2] = r[i].z; s[3] = r[i].w; }
    LDS_WAIT(); asm volatile("" ::: "memory");
    const int ch = lane & 7;
#pragma unroll
    for (int jj = 0; jj < 8; ++jj) { const int n = (lane >> 3) + 8 * jj; const LAS float* s = scr + (8 * ch) * 65 + n;
        v4u o; o.x = pk2(s[0 * 65], s[1 * 65]); o.y = pk2(s[2 * 65], s[3 * 65]); o.z = pk2(s[4 * 65], s[5 * 65]); o.w = pk2(s[6 * 65], s[7 * 65]);
        *(GAS v4u*)(c.dst + (size_t)n * c.K + 8 * ch) = o; }
    LDS_WAIT(); asm volatile("" ::: "memory");
}
constexpr int CV_SCR_BYTES = 64 * 65 * 4;
__device__ __forceinline__ CvItem cv_dense(Frame& F, int it) {
    constexpr int I_WIN = 16 * 96, I_WRO = 32 * 16, I_QKV = 16 * 72, I_WAO = 8 * 16, I_GU = 16 * 56, I_DN = 56 * 16;
    constexpr int PERJ = I_WIN + I_WRO + I_QKV + I_WAO + 2 * I_GU + I_DN;
    const int j = it / PERJ; int r = it - j * PERJ;
    if (r < I_WIN) return cv_make<1>(ARGI(F, 3) + (size_t)j * 1024 * 6144, 1024, 6144, (bf16*)(ARGWS(F) + WS_WIN) + (size_t)j * 6144 * 1024, r); r -= I_WIN;
    if (r < I_WRO) return cv_make<0>(ARGI(F, 5) + (size_t)j * 2048 * 1024, 2048, 1024, (bf16*)(ARGWS(F) + WS_WRO) + (size_t)j * 1024 * 2048, r); r -= I_WRO;
    if (r < I_QKV) return cv_make<0>(ARGI(F, 6) + (size_t)j * 1024 * 4608, 1024, 4608, (bf16*)(ARGWS(F) + WS_WQKV) + (size_t)j * 4608 * 1024, r); r -= I_QKV;
    if (r < I_WAO) return cv_make<0>(ARGI(F, 7) + (size_t)j * 512 * 1024, 512, 1024, (bf16*)(ARGWS(F) + WS_WAO) + (size_t)j * 1024 * 512, r); r -= I_WAO;
    if (r < I_GU) return cv_make<2>(ARGI(F, 8) + (size_t)j * 1024 * 3584, 1024, 3584, (bf16*)(ARGWS(F) + WS_WGU) + (size_t)j * 7168 * 1024, r); r -= I_GU;
    if (r < I_GU) return cv_make<3>(ARGI(F, 9) + (size_t)j * 1024 * 3584, 1024, 3584, (bf16*)(ARGWS(F) + WS_WGU) + (size_t)j * 7168 * 1024, r); r -= I_GU;
    return cv_make<0>(ARGI(F, 10) + (size_t)j * 3584 * 1024, 3584, 1024, (bf16*)(ARGWS(F) + WS_WDN) + (size_t)j * 1024 * 3584, r);
}
constexpr int CV_DENSE_ITEMS = 2 * (16 * 96 + 32 * 16 + 16 * 72 + 8 * 16 + 2 * 16 * 56 + 56 * 16);
__device__ __forceinline__ CvItem cv_moe(Frame& F, int it, int j) {
    constexpr int I_GU = 16 * 56, I_DN = 56 * 16, PERE = 2 * I_GU + I_DN;
    bf16* WMGU = (bf16*)(ARGWS(F) + WS_BIG + BIG_WMGU); bf16* WMD = (bf16*)(ARGWS(F) + WS_BIG + BIG_WMD);
    const int e = it / PERE; int r = it - e * PERE; const size_t wofs = ((size_t)j * NEXP + e) * 1024 * 3584;
    if (r < I_GU) return cv_make<2>(ARGI(F, 12) + wofs, 1024, 3584, WMGU + (size_t)e * 7168 * 1024, r); r -= I_GU;
    if (r < I_GU) return cv_make<3>(ARGI(F, 13) + wofs, 1024, 3584, WMGU + (size_t)e * 7168 * 1024, r); r -= I_GU;
    return cv_make<0>(ARGI(F, 14) + wofs, 3584, 1024, WMD + (size_t)e * 1024 * 3584, r);
}
constexpr int CV_MOE_ITEMS = NEXP * (2 * 16 * 56 + 56 * 16);
template <bool MOE> __device__ __forceinline__ void cv_run(Frame& F, int first, int stride, int total, int j) {
    LAS float* scr = (LAS float*)(F.lds + RING_OFF + F.wave * CV_SCR_BYTES);
    if (first >= total) return;
    f32x4 ra[16], rb[16];
    CvItem ca = MOE ? cv_moe(F, first, j) : cv_dense(F, first), cb = ca;
    cv_load(ca, ra, F.lane);
    for (int it = first; it < total; it += 2 * stride) {
        const bool hb = it + stride < total;
        if (hb) { cb = MOE ? cv_moe(F, it + stride, j) : cv_dense(F, it + stride); cv_load(cb, rb, F.lane); }
        cv_store(ca, ra, scr, F.lane);
        if (!hb) break;
        const bool ha = it + 2 * stride < total;
        if (ha) { ca = MOE ? cv_moe(F, it + 2 * stride, j) : cv_dense(F, it + 2 * stride); cv_load(ca, ra, F.lane); }
        cv_store(cb, rb, scr, F.lane);
        if (!ha) break;
    }
}
__device__ __forceinline__ void p0_prologue(Frame& F) {
    const int gw = F.c * NWAVES + F.wave, NGW = F.G * NWAVES;
    cv_run<false>(F, gw, NGW, CV_DENSE_ITEMS, 0);
    { float* tab = (float*)(ARGWS(F) + WS_TAB); const int gt = F.c * 512 + F.tid, NT = F.G * 512;
      for (int e = gt; e < SEQ * 128; e += NT) { const int pos = e >> 7, cc = e & 127;
          const double ang = (double)pos * exp(-9.210340371976184 * (double)cc * (1.0 / 128.0)); double sn, cs; sincos(ang, &sn, &cs);
          typedef float f32x2t __attribute__((ext_vector_type(2))); *(GAS f32x2t*)(tab + (size_t)e * 2) = (f32x2t){(float)cs, (float)sn}; } }
    { const float* x = ARGI(F, 0); bf16* XB = (bf16*)(ARGWS(F) + WS_XB);
      for (int m = gw; m < T_TOK; m += NGW) { const GAS f32x4* xr = (const GAS f32x4*)(x + (size_t)m * DMODEL) + F.lane;
          GAS unsigned long long* o8 = (GAS unsigned long long*)(XB + (size_t)m * DMODEL) + F.lane;
#pragma unroll
          for (int jj = 0; jj < 4; ++jj) { const f32x4 v = xr[64 * jj]; o8[64 * jj] = (unsigned long long)pk2(v.x, v.y) | ((unsigned long long)pk2(v.z, v.w) << 32); } } }
}
template <bool SUB> __device__ __forceinline__ void moe_convert(Frame& F, int j) {
    if (SUB && ((F.c >> 3) & 3) != 0) return;
    const int gw = (SUB ? ((F.c >> 5) * 8 + (F.c & 7)) : F.c) * NWAVES + F.wave, NGW = (SUB ? 64 : F.G) * NWAVES;
    cv_run<true>(F, gw, NGW, CV_MOE_ITEMS, j);
}
__device__ __forceinline__ void moe_prefix_lds(Frame& F, LAS int* PB) {
    const int* LC = (const int*)(ARGWS(F) + WS_LC);
    for (int i = F.tid; i < 2048; i += 512) PB[i] = LC[i];
    __syncthreads();
    { const int e = F.wave, l = F.lane;
      const int v0 = PB[(4 * l) * 8 + e], v1 = PB[(4 * l + 1) * 8 + e], v2 = PB[(4 * l + 2) * 8 + e], v3 = PB[(4 * l + 3) * 8 + e];
      const int tot = v0 + v1 + v2 + v3; int inc = tot;
#pragma unroll
      for (int o = 1; o < 64; o <<= 1) { const int t = __shfl_up(inc, o); inc += (l >= o) ? t : 0; }
      const int ex = inc - tot;
      PB[(4 * l) * 8 + e] = ex; PB[(4 * l + 1) * 8 + e] = ex + v0; PB[(4 * l + 2) * 8 + e] = ex + v0 + v1; PB[(4 * l + 3) * 8 + e] = ex + v0 + v1 + v2;
      if (l == 63) PB[2048 + e] = inc; }
    __syncthreads();
}
__device__ __forceinline__ void unpack8(const v4u w, float (&v)[8]) { v[0] = bflo(w.x); v[1] = bfhi(w.x); v[2] = bflo(w.y); v[3] = bfhi(w.y); v[4] = bflo(w.z); v[5] = bfhi(w.z); v[6] = bflo(w.w); v[7] = bfhi(w.w); }
template <int MODE, bool FINAL> __device__ __forceinline__ void ln_pass(Frame& F, int li  , int sub  , int j) {
    const int gw = F.c * NWAVES + F.wave, NGW = F.G * NWAVES;
    const float* gain = ARGI(F, 1) + (size_t)(li * 2 + sub) * DMODEL; const float* bias = ARGI(F, 2) + (size_t)(li * 2 + sub) * DMODEL;
    float gv[2][8], bv[2][8];
#pragma unroll
    for (int q = 0; q < 2; ++q)
#pragma unroll
        for (int h2 = 0; h2 < 2; ++h2) { const f32x4 g4 = *(const GAS f32x4*)(gain + 512 * q + 8 * F.lane + 4 * h2), b4 = *(const GAS f32x4*)(bias + 512 * q + 8 * F.lane + 4 * h2);
#pragma unroll
            for (int k = 0; k < 4; ++k) { gv[q][4 * h2 + k] = g4[k]; bv[q][4 * h2 + k] = b4[k]; } }
    bf16* XB = (bf16*)(ARGWS(F) + WS_XB);
    int rtb[8]; LAS int* PB = (LAS int*)(F.lds + RING_OFF);
    if (MODE == 2) { moe_prefix_lds(F, PB); int acc = 0;
#pragma unroll
        for (int e = 0; e < 8; ++e) { rtb[e] = acc; acc += (PB[2048 + e] + 255) >> 8; } }
    const unsigned* tslot = (const unsigned*)(ARGWS(F) + WS_TSLOT); const float* gate = (const float*)(ARGWS(F) + WS_GATE); const bf16* YP = (const bf16*)(ARGWS(F) + WS_BIG + BIG_YP);
    for (int m = gw; m < T_TOK; m += NGW) {
        GAS v4u* xr = (GAS v4u*)(XB + (size_t)m * DMODEL) + F.lane;
        float v[2][8]; float s = 0.f;
#pragma unroll
        for (int q = 0; q < 2; ++q) unpack8(xr[64 * q], v[q]);
        if (MODE == 2) {
#pragma unroll
            for (int q = 0; q < 2; ++q)
#pragma unroll
                for (int k = 0; k < 8; ++k) v[q][k] *= ALPHA;
#pragma unroll
            for (int k2 = 0; k2 < 2; ++k2) { const unsigned ts = tslot[2 * m + k2]; const float gk = gate[2 * m + k2]; const int e = (int)(ts >> 20), slot = PB[(m >> 7) * 8 + e] + (int)(ts & 0xfffffu);
                int rb = 0;
#pragma unroll
                for (int q = 0; q < 8; ++q) rb = (q == e) ? rtb[q] : rb;
                const int yrow = rb * 256 + slot;
                if (yrow < 65536) { const GAS v4u* yr = (const GAS v4u*)(YP + (size_t)yrow * DMODEL) + F.lane;
#pragma unroll
                    for (int q = 0; q < 2; ++q) { float y[8]; unpack8(yr[64 * q], y);
#pragma unroll
                        for (int k = 0; k < 8; ++k) v[q][k] += gk * y[k]; } }
                else { const int lr = yrow - 65536, tl = lr >> 8, r = lr & 255;
                    const float* SL = (const float*)(ARGWS(F) + WS_SLAB);
#pragma unroll
                    for (int q = 0; q < 2; ++q) { const int col = 512 * q + 8 * F.lane, ct = col >> 8, cc = col & 255;
#pragma unroll
                        for (int kp = 0; kp < 4; ++kp) { const GAS f32x4* sp = (const GAS f32x4*)(SL + ((size_t)(kp * 32 + tl * 4 + ct) << 16) + (size_t)r * 256 + cc); const f32x4 a0 = sp[0], a1 = sp[1];
                            v[q][0] += gk * a0.x; v[q][1] += gk * a0.y; v[q][2] += gk * a0.z; v[q][3] += gk * a0.w; v[q][4] += gk * a1.x; v[q][5] += gk * a1.y; v[q][6] += gk * a1.z; v[q][7] += gk * a1.w; } } } }
        }
#pragma unroll
        for (int q = 0; q < 2; ++q)
#pragma unroll
            for (int k = 0; k < 8; ++k) s += v[q][k];
        const float mean = wave_sum(s) * (1.f / DMODEL); float s2 = 0.f;
#pragma unroll
        for (int q = 0; q < 2; ++q)
#pragma unroll
            for (int k = 0; k < 8; ++k) { v[q][k] -= mean; s2 += v[q][k] * v[q][k]; }
        const float rstd = 1.f / sqrtf(wave_sum(s2) * (1.f / DMODEL) + LN_EPS);
#pragma unroll
        for (int q = 0; q < 2; ++q) { float o[8];
#pragma unroll
            for (int k = 0; k < 8; ++k) o[k] = v[q][k] * rstd * gv[q][k] + bv[q][k];
            if (FINAL) { GAS f32x4* op = (GAS f32x4*)(ARGX(F) + (size_t)m * DMODEL + 512 * q + 8 * F.lane); op[0] = (f32x4){o[0], o[1], o[2], o[3]}; op[1] = (f32x4){o[4], o[5], o[6], o[7]}; }
            else { v4u w; w.x = pk2(o[0], o[1]); w.y = pk2(o[2], o[3]); w.z = pk2(o[4], o[5]); w.w = pk2(o[6], o[7]); xr[64 * q] = w; } }
    }
}
__device__ __forceinline__ void ln_route_pass(Frame& F, int li, int j) {
    const float* gain = ARGI(F, 1) + (size_t)(li * 2) * DMODEL; const float* bias = ARGI(F, 2) + (size_t)(li * 2) * DMODEL;
    LAS float* WRT = (LAS float*)(F.lds + RING_OFF);
    LAS float* SELG = (LAS float*)(F.lds + RING_OFF + 32768);
    LAS int* SELE = (LAS int*)(F.lds + RING_OFF + 32768 + 1024);
    const float* wr = ARGI(F, 11) + (size_t)j * DMODEL * NEXP;
    for (int i = F.tid; i < DMODEL * NEXP; i += 512) { const int d = i >> 3, e = i & 7; WRT[e * DMODEL + d] = wr[i]; }
    float gv[2][8], bv[2][8];
#pragma unroll
    for (int q = 0; q < 2; ++q)
#pragma unroll
        for (int h2 = 0; h2 < 2; ++h2) { const f32x4 g4 = *(const GAS f32x4*)(gain + 512 * q + 8 * F.lane + 4 * h2), b4 = *(const GAS f32x4*)(bias + 512 * q + 8 * F.lane + 4 * h2);
#pragma unroll
            for (int k = 0; k < 4; ++k) { gv[q][4 * h2 + k] = g4[k]; bv[q][4 * h2 + k] = b4[k]; } }
    bf16* XB = (bf16*)(ARGWS(F) + WS_XB);
    __syncthreads();
    const int ntok = T_TOK / F.G, tok0 = F.c * ntok;
    for (int tl = F.wave; tl < ntok; tl += NWAVES) { const int m = tok0 + tl;
        GAS v4u* xr = (GAS v4u*)(XB + (size_t)m * DMODEL) + F.lane;
        float v[2][8]; float s = 0.f;
#pragma unroll
        for (int q = 0; q < 2; ++q) unpack8(xr[64 * q], v[q]);
#pragma unroll
        for (int q = 0; q < 2; ++q)
#pragma unroll
            for (int k = 0; k < 8; ++k) s += v[q][k];
        const float mean = wave_sum(s) * (1.f / DMODEL); float s2 = 0.f;
#pragma unroll
        for (int q = 0; q < 2; ++q)
#pragma unroll
            for (int k = 0; k < 8; ++k) { v[q][k] -= mean; s2 += v[q][k] * v[q][k]; }
        const float rstd = 1.f / sqrtf(wave_sum(s2) * (1.f / DMODEL) + LN_EPS);
        float lg[8];
#pragma unroll
        for (int e = 0; e < 8; ++e) lg[e] = 0.f;
#pragma unroll
        for (int q = 0; q < 2; ++q) { float o[8];
#pragma unroll
            for (int k = 0; k < 8; ++k) o[k] = v[q][k] * rstd * gv[q][k] + bv[q][k];
            v4u w; w.x = pk2(o[0], o[1]); w.y = pk2(o[2], o[3]); w.z = pk2(o[4], o[5]); w.w = pk2(o[6], o[7]); xr[64 * q] = w;
#pragma unroll
            for (int e = 0; e < 8; ++e) { const f32x4 w0 = *(const LAS f32x4*)(WRT + e * DMODEL + 512 * q + 8 * F.lane), w1 = *(const LAS f32x4*)(WRT + e * DMODEL + 512 * q + 8 * F.lane + 4);
                lg[e] += ((o[0] * w0.x + o[1] * w0.y) + (o[2] * w0.z + o[3] * w0.w)) + ((o[4] * w1.x + o[5] * w1.y) + (o[6] * w1.z + o[7] * w1.w)); } }
#pragma unroll
        for (int e = 0; e < 8; ++e) lg[e] = wave_sum(lg[e]);
        int e1 = 0; float v1 = lg[0];
#pragma unroll
        for (int e = 1; e < 8; ++e) if (lg[e] > v1) { v1 = lg[e]; e1 = e; }
        int e2 = -1; float v2 = -3.0e38f;
#pragma unroll
        for (int e = 0; e < 8; ++e) if (e != e1 && lg[e] > v2) { v2 = lg[e]; e2 = e; }
        const float g1 = 1.f / (1.f + __expf(v2 - v1)), g2 = 1.f - g1;
        if (F.lane == 0) { SELE[2 * tl] = e1; SELE[2 * tl + 1] = e2; SELG[2 * tl] = g1; SELG[2 * tl + 1] = g2; }
    }
    __syncthreads();
    int myrank = 0, mye = 0;
    if (F.tid < 2 * ntok) { mye = SELE[F.tid];
        for (int i2 = 0; i2 < F.tid; ++i2) myrank += (SELE[i2] == mye) ? 1 : 0; }
    if (F.tid < 8) { int cnt = 0; for (int i2 = 0; i2 < 2 * ntok; ++i2) cnt += (SELE[i2] == F.tid) ? 1 : 0; ((int*)(ARGWS(F) + WS_LC))[F.c * 8 + F.tid] = cnt; }
    if (F.tid < 2 * ntok) { const int tok = tok0 + (F.tid >> 1);
        ((int*)(ARGWS(F) + WS_LIST))[(F.c * 8 + mye) * 256 + myrank] = tok;
        ((unsigned*)(ARGWS(F) + WS_TSLOT))[2 * tok + (F.tid & 1)] = ((unsigned)mye << 20) | (unsigned)myrank;
        ((float*)(ARGWS(F) + WS_GATE))[2 * tok + (F.tid & 1)] = SELG[F.tid]; }
    __syncthreads();
}
#define LDS_BAR() do { asm volatile("s_waitcnt lgkmcnt(0)" ::: "memory"); __builtin_amdgcn_s_barrier(); asm volatile("" ::: "memory"); } while (0)
__device__ __forceinline__ int off64(int row, int colbyte) { return row * 128 + (colbyte ^ ((((row >> 1) & 1) << 6) | (((row >> 3) & 1) << 5))); }
__device__ __forceinline__ float log2_gamma(int h) { return __builtin_amdgcn_logf(1.0f - __builtin_amdgcn_exp2f((float)(-5 - h))); }

__device__ __forceinline__ void ret_state_phase(Frame& F) {
    const int c = F.c; if (c >= 256) return;
    const int dt = c & 3, et = (c >> 2) & 7, h = (c >> 5) & 3, b = c >> 7;
    const int w = F.wave, lane = F.lane, dq = w & 3, eh = w >> 2, g = lane >> 4, l15 = lane & 15, q = l15 >> 2, p = l15 & 3;
    const bf16* KH = (const bf16*)(ARGWS(F) + WS_BIG + BIG_KH) + (size_t)b * SEQ * 1024 + h * 256 + dt * 64;
    const bf16* VT = (const bf16*)(ARGWS(F) + WS_BIG + BIG_VT) + ((size_t)((b * 4 + h) * 128) << 16);
    bf16* RT = (bf16*)(ARGWS(F) + WS_BIG + BIG_RT) + ((size_t)((b * 4 + h) * 128) << 17);
    const float dec = __builtin_amdgcn_exp2f(128.f * log2_gamma(h));
    const int r0 = F.tid >> 3, ch = F.tid & 7;
    const bf16* kp0 = KH + (size_t)r0 * 1024 + ch * 8; const bf16* kp1 = kp0 + (size_t)64 * 1024;
    const int lo0 = off64(r0, ch * 16), lo1 = off64(r0 + 64, ch * 16);
    int voff[4][2];
#pragma unroll
    for (int ks = 0; ks < 4; ++ks)
#pragma unroll
        for (int x = 0; x < 2; ++x) { const int e = 64 * et + 16 * (2 * eh + x) + l15, oct = 4 * ks + g; voff[ks][x] = ((((e >> 5) * 8 + (oct >> 1)) * 2 + (oct & 1)) * 32 + (e & 31)) * 8; }
    int roff[2];
#pragma unroll
    for (int x = 0; x < 2; ++x) { const int e = 64 * et + 16 * (2 * eh + x) + l15, d = 64 * dt + 16 * dq + 4 * g; roff[x] = ((((e >> 5) * 16 + (d >> 4)) * 2 + ((d >> 3) & 1)) * 32 + (e & 31)) * 8 + (d & 7); }
    float z0 = 0.f; asm volatile("" : "+v"(z0));
    f32x4 acc[2] = {(f32x4){z0, z0, z0, z0}, (f32x4){z0, z0, z0, z0}};
    v4u kq[4][2]; bf16x8 vq[4][4][2];
#define R2A_LOAD(st, nn) do { const int n_ = (nn) < 128 ? (nn) : 127; kq[st][0] = *(const GAS v4u*)(kp0 + (size_t)n_ * 128 * 1024); kq[st][1] = *(const GAS v4u*)(kp1 + (size_t)n_ * 128 * 1024); \
        _Pragma("unroll") for (int ks = 0; ks < 4; ++ks) _Pragma("unroll") for (int x = 0; x < 2; ++x) vq[st][ks][x] = *(const GAS bf16x8*)(VT + ((size_t)n_ << 16) + voff[ks][x]); } while (0)
    R2A_LOAD(0, 0); R2A_LOAD(1, 1); R2A_LOAD(2, 2);
    for (int n4 = 0; n4 < 128; n4 += 4) {
#pragma unroll
        for (int u4 = 0; u4 < 4; ++u4) { const int n = n4 + u4;
            LAS unsigned char* buf = F.lds + RING_OFF + (u4 & 1) * 16384;
            *(LAS v4u*)(buf + lo0) = kq[u4][0]; *(LAS v4u*)(buf + lo1) = kq[u4][1];
            R2A_LOAD((u4 + 3) & 3, n + 3);
            LDS_BAR();
            if (n > 0) {
#pragma unroll
                for (int x = 0; x < 2; ++x) { v2u o; o.x = pk2(acc[x][0], acc[x][1]); o.y = pk2(acc[x][2], acc[x][3]); *(GAS v2u*)(RT + ((size_t)n << 17) + roff[x]) = o; } }
#pragma unroll
            for (int ks = 0; ks < 4; ++ks) {
                const s16x4 t0 = vtr(buf + off64(32 * ks + 8 * g + q, 32 * dq + 8 * p)), t1 = vtr(buf + off64(32 * ks + 8 * g + 4 + q, 32 * dq + 8 * p));
                const bf16x8 a = (bf16x8){t0[0], t0[1], t0[2], t0[3], t1[0], t1[1], t1[2], t1[3]};
#pragma unroll
                for (int x = 0; x < 2; ++x) acc[x] = __builtin_amdgcn_mfma_f32_16x16x32_bf16(a, vq[u4][ks][x], acc[x], 0, 0, 0);
            }
#pragma unroll
            for (int x = 0; x < 2; ++x) acc[x] = acc[x] * dec;
        }
    }
#undef R2A_LOAD
    __syncthreads();
}

__device__ __forceinline__ void ret_out_phase(Frame& F, int j, bf16* YOUT) {
    const int w = F.wave, lane = F.lane, r32 = lane & 31, hi = lane >> 5, tid = F.tid;
    LAS unsigned char* QDI = F.lds + RING_OFF;
    LAS unsigned char* KHI = F.lds + RING_OFF + 65536;
    LAS unsigned char* PI = KHI;
    LAS float* STAT = (LAS float*)(F.lds + AUX_OFF);
    LAS unsigned char* YST = F.lds + RING_OFF;
    const bf16* QD = (const bf16*)(ARGWS(F) + WS_BIG + BIG_QD); const bf16* KH = (const bf16*)(ARGWS(F) + WS_BIG + BIG_KH);
    const bf16* VT = (const bf16*)(ARGWS(F) + WS_BIG + BIG_VT); const bf16* RT = (const bf16*)(ARGWS(F) + WS_BIG + BIG_RT);
    const bf16* GIN = (const bf16*)(ARGWS(F) + WS_BIG + BIG_G);
    const float* gn = ARGI(F, 4) + (size_t)j * 2048;
    const int ib = w & 3, jb0 = 2 * (w >> 2), jb1 = jb0 + 1;
    for (int U = F.c; U < 1024; U += F.G) {
        const int n = U & 127, h = (U >> 7) & 3, b = U >> 9;
        const size_t tok0 = (size_t)b * SEQ + (size_t)n * 128;
        { int tid1 = tid; asm volatile("" : "+v"(tid1)); v4u qv[8], kv[8];
#pragma unroll
          for (int k = 0; k < 8; ++k) { const int x = tid1 + 512 * k, row = x >> 5, chk = x & 31; const size_t go = (tok0 + row) * 1024 + h * 256 + chk * 8;
              qv[k] = *(const GAS v4u*)(QD + go); kv[k] = *(const GAS v4u*)(KH + go); }
#pragma unroll
          for (int k = 0; k < 8; ++k) { const int x = tid1 + 512 * k, row = x >> 5, chk = x & 31; const int lo = row * 512 + ((chk * 16) ^ ((row & 7) << 4));
              *(LAS v4u*)(QDI + lo) = qv[k]; *(LAS v4u*)(KHI + lo) = kv[k]; } }
        LDS_BAR();
        f32x16 s0 = {}, s1 = {};
        { const int qrow = 32 * ib + r32, k0row = 32 * jb0 + r32, k1row = 32 * jb1 + r32;
          if (jb0 <= ib) {
#pragma unroll
            for (int ks = 0; ks < 16; ++ks) { const int cb = (16 * ks + 8 * hi) * 2;
                const bf16x8 qf = *(const LAS bf16x8*)(QDI + qrow * 512 + (cb ^ ((qrow & 7) << 4)));
                const bf16x8 kf0 = *(const LAS bf16x8*)(KHI + k0row * 512 + (cb ^ ((k0row & 7) << 4)));
                s0 = __builtin_amdgcn_mfma_f32_32x32x16_bf16(kf0, qf, s0, 0, 0, 0);
                if (jb1 <= ib) { const bf16x8 kf1 = *(const LAS bf16x8*)(KHI + k1row * 512 + (cb ^ ((k1row & 7) << 4))); s1 = __builtin_amdgcn_mfma_f32_32x32x16_bf16(kf1, qf, s1, 0, 0, 0); } } } }
        LDS_BAR();
        { int r32p = r32, hip = hi; asm volatile("" : "+v"(r32p), "+v"(hip)); const int i = 32 * ib + r32p;
#pragma unroll
          for (int qq = 0; qq < 4; ++qq) {
              const int j0 = 32 * jb0 + 8 * qq + 4 * hip, j1 = j0 + 32;
              float a0 = s0[4 * qq], a1 = s0[4 * qq + 1], a2 = s0[4 * qq + 2], a3 = s0[4 * qq + 3];
              float c0 = s1[4 * qq], c1 = s1[4 * qq + 1], c2 = s1[4 * qq + 2], c3 = s1[4 * qq + 3];
              if (j0 + 0 > i) a0 = 0.f; if (j0 + 1 > i) a1 = 0.f; if (j0 + 2 > i) a2 = 0.f; if (j0 + 3 > i) a3 = 0.f;
              if (j1 + 0 > i) c0 = 0.f; if (j1 + 1 > i) c1 = 0.f; if (j1 + 2 > i) c2 = 0.f; if (j1 + 3 > i) c3 = 0.f;
              v2u o; o.x = pk2(a0, a1); o.y = pk2(a2, a3); *(LAS v2u*)(PI + i * 256 + ((j0 * 2) ^ ((i & 7) << 4))) = o;
              v2u o2; o2.x = pk2(c0, c1); o2.y = pk2(c2, c3); *(LAS v2u*)(PI + i * 256 + ((j1 * 2) ^ ((i & 7) << 4))) = o2; } }
        LDS_BAR();
        f32x16 acc[4][2];
#pragma unroll
        for (int rb = 0; rb < 4; ++rb) { acc[rb][0] = (f32x16){}; acc[rb][1] = (f32x16){}; }
        { const int nsteps = n > 0 ? 24 : 8;
          const bf16* vt = VT + ((size_t)((b * 4 + h) * 128 + n) << 16) + (size_t)(((2 * w) * 8 * 2 + hi) * 32 + r32) * 8;
          const bf16* rt = RT + ((size_t)((b * 4 + h) * 128 + n) << 17) + (size_t)(((2 * w) * 16 * 2 + hi) * 32 + r32) * 8;
          const int xr = (r32 & 7) << 4, rowp = r32 * 256;
#define R2B_LOAD(dst, sidx) do { int sp_ = (sidx); sp_ = sp_ < nsteps ? sp_ : nsteps - 1; const bf16* p_ = sp_ < 8 ? vt + sp_ * 512 : rt + (sp_ - 8) * 512; const int o1_ = sp_ < 8 ? 4096 : 8192; \
              dst[0] = *(const GAS bf16x8*)p_; dst[1] = *(const GAS bf16x8*)(p_ + o1_); } while (0)
          bf16x8 Bq[6][2];
          R2B_LOAD(Bq[0], 0); R2B_LOAD(Bq[1], 1); R2B_LOAD(Bq[2], 2); R2B_LOAD(Bq[3], 3); R2B_LOAD(Bq[4], 4);
          for (int s3 = 0; s3 < nsteps; s3 += 6) {
#pragma unroll
              for (int uu = 0; uu < 6; ++uu) { const int st = s3 + uu;
                  R2B_LOAD(Bq[(uu + 5) % 6], st + 5);
                  if (st < nsteps) { const bool pv = st < 8; const int ks = pv ? st : st - 8, cb = ((32 * ks + 16 * hi) ^ xr) + (pv ? 65536 : 0), sh = pv ? 0 : 1;
#pragma unroll
                      for (int rb = 0; rb < 4; ++rb) if (!pv || st <= 2 * rb + 1) {
                          const bf16x8 af = *(const LAS bf16x8*)(QDI + (((32 * 256) * rb + rowp) << sh) + cb);
                          acc[rb][0] = __builtin_amdgcn_mfma_f32_32x32x16_bf16(Bq[uu][0], af, acc[rb][0], 0, 0, 0);
                          acc[rb][1] = __builtin_amdgcn_mfma_f32_32x32x16_bf16(Bq[uu][1], af, acc[rb][1], 0, 0, 0); } } } }
#undef R2B_LOAD
        }
#pragma unroll
        for (int rb = 0; rb < 4; ++rb) { float s = 0.f, qs = 0.f;
#pragma unroll
            for (int et = 0; et < 2; ++et)
#pragma unroll
                for (int r = 0; r < 16; ++r) { const float v = acc[rb][et][r]; s += v; qs += v * v; }
            s += __shfl_xor(s, 32); qs += __shfl_xor(qs, 32);
            if (hi == 0) { STAT[((32 * rb + r32) * 8 + w) * 2] = s; STAT[((32 * rb + r32) * 8 + w) * 2 + 1] = qs; } }
        LDS_BAR();
        int r32b = r32, hib = hi; asm volatile("" : "+v"(r32b), "+v"(hib));
#pragma unroll
        for (int rb = 0; rb < 4; ++rb) { const int i = 32 * rb + r32b; float s = 0.f, qs = 0.f;
#pragma unroll
            for (int ww = 0; ww < 8; ++ww) { s += STAT[(i * 8 + ww) * 2]; qs += STAT[(i * 8 + ww) * 2 + 1]; }
            const float mean = s * (1.f / 512.f), var = qs * (1.f / 512.f) - mean * mean, rstd = 1.f / sqrtf(fmaxf(var, 0.f) + LN_EPS);
#pragma unroll
            for (int et = 0; et < 2; ++et)
#pragma unroll
                for (int qq = 0; qq < 4; ++qq) { const int e = 64 * w + 32 * et + 8 * qq + 4 * hib;
                    v2u o; o.x = pk2((acc[rb][et][4 * qq] - mean) * rstd, (acc[rb][et][4 * qq + 1] - mean) * rstd); o.y = pk2((acc[rb][et][4 * qq + 2] - mean) * rstd, (acc[rb][et][4 * qq + 3] - mean) * rstd);
                    *(LAS v2u*)(YST + i * 1024 + ((e * 2) ^ ((i & 63) << 4))) = o; } }
        LDS_BAR();
        { int tid6 = tid; asm volatile("" : "+v"(tid6)); const int chk = tid6 & 63; const f32x4 g0 = *(const GAS f32x4*)(gn + h * 512 + chk * 8), g1 = *(const GAS f32x4*)(gn + h * 512 + chk * 8 + 4);
#pragma unroll
          for (int k = 0; k < 16; ++k) { const int row = (tid6 >> 6) + 8 * k;
              const v4u y = *(const LAS v4u*)(YST + row * 1024 + ((chk * 16) ^ ((row & 63) << 4)));
              const size_t go6 = (tok0 + row) * 2048 + h * 512 + chk * 8; const v4u gg = *(const GAS v4u*)(GIN + go6);
              v4u o; o.x = pk2(bflo(y.x) * g0.x * bflo(gg.x), bfhi(y.x) * g0.y * bfhi(gg.x)); o.y = pk2(bflo(y.y) * g0.z * bflo(gg.y), bfhi(y.y) * g0.w * bfhi(gg.y));
              o.z = pk2(bflo(y.z) * g1.x * bflo(gg.z), bfhi(y.z) * g1.y * bfhi(gg.z)); o.w = pk2(bflo(y.w) * g1.z * bflo(gg.w), bfhi(y.w) * g1.w * bfhi(gg.w));
              *(GAS v4u*)(YOUT + go6) = o; } }
        __syncthreads();
    }
}
typedef swa::BlockRef<swa::bf16, swa::bf16> ABlk;
__device__ __forceinline__ float* att_lse(Frame& F, int L) {
    const int g = L >> 9, rem = L & 511, sh = 2 * g, seq = rem >> (6 - sh), qb = rem & ((64 >> sh) - 1);
    return (float*)(ARGWS(F) + WS_BIG + BIG_LSE) + (size_t)g * 131072 + (size_t)seq * (size_t)(SEQ >> sh) + (size_t)qb * 256;
}
__device__ __forceinline__ ABlk att_ref(Frame& F, int L) {
    const int g = L >> 9, rem = L & 511, sh = 2 * g, seq = rem >> (6 - sh), qb = rem & ((64 >> sh) - 1);
    const size_t base = (size_t)g * 131072 + (size_t)seq * (size_t)(SEQ >> sh);
    const swa::bf16* P = (const swa::bf16*)(ARGWS(F) + WS_BIG + BIG_QKV); constexpr size_t WH = (size_t)3 * 131072 * 128;
    ABlk r; r.Q = P + (base + (size_t)qb * 256) * 128; r.K = P + WH + base * 128; r.V = P + 2 * WH + base * 128;
    r.O = (swa::bf16*)(ARGWS(F) + WS_BIG + BIG_OP) + (base + (size_t)qb * 256) * 128; r.P0 = qb * 256;
    return r;
}
__device__ __forceinline__ void attn_phase(Frame& F) {
    extern __shared__ __attribute__((aligned(16))) unsigned char lds_dyn[];
    char* const ldsg = (char*)lds_dyn;
    int L = F.c; const int total = 1536, stride = F.G;
    if (L >= total) return;
    ABlk cur = att_ref(F, L);
    const int W = 129 + (F.G >> 20);
    swa::Seam<swa::bf16> S; S.tid = F.tid;
    swa::causal_swa_prime<swa::bf16, swa::bf16>(cur, W, ldsg, S);
    for (;;) {
        const bool last = L + stride >= total;
        const int Ln = last ? L : L + stride;
        const ABlk nxt = last ? cur : att_ref(F, Ln);
        const int skv = SEQ >> (2 * (L >> 9));
        swa::causal_swa_block<swa::bf16, swa::bf16>(cur, nxt, skv, W, ldsg, S);
        if (F.tid < 256) att_lse(F, L)[F.tid] = ((const LAS float*)(F.lds + swa::LSE_LDS_OFF))[F.tid];
        if (last) break;
        cur = nxt; L = Ln;
    }
}
__device__ __forceinline__ void attn_merge_phase(Frame& F) {
    const int gw = F.c * NWAVES + F.wave, NGW = F.G * NWAVES, hd = F.lane >> 4, chk = F.lane & 15;
    const bf16* OP = (const bf16*)(ARGWS(F) + WS_BIG + BIG_OP); const float* LSE = (const float*)(ARGWS(F) + WS_BIG + BIG_LSE); bf16* O = (bf16*)(ARGWS(F) + WS_BIG + BIG_O);
    for (int m = gw; m < T_TOK; m += NGW) { const int b = m >> 14, t = m & 16383;
        size_t row[3]; float ls[3];
#pragma unroll
        for (int g = 0; g < 3; ++g) { const int sh = 2 * g; row[g] = (size_t)g * 131072 + (size_t)(b * 4 + hd) * SEQ + (size_t)((t & ((1 << sh) - 1)) * (SEQ >> sh) + (t >> sh)); ls[g] = LSE[row[g]]; }
        const float mx = fmaxf(ls[0], fmaxf(ls[1], ls[2])); float wg[3]; float ws = 0.f;
#pragma unroll
        for (int g = 0; g < 3; ++g) { wg[g] = __expf(ls[g] - mx); ws += wg[g]; }
        const float inv = 1.f / ws; float o[8] = {0.f, 0.f, 0.f, 0.f, 0.f, 0.f, 0.f, 0.f};
#pragma unroll
        for (int g = 0; g < 3; ++g) { const v4u v = *(const GAS v4u*)(OP + row[g] * 128 + chk * 8); const float wt = wg[g] * inv;
            o[0] += wt * bflo(v.x); o[1] += wt * bfhi(v.x); o[2] += wt * bflo(v.y); o[3] += wt * bfhi(v.y); o[4] += wt * bflo(v.z); o[5] += wt * bfhi(v.z); o[6] += wt * bflo(v.w); o[7] += wt * bfhi(v.w); }
        v4u w; w.x = pk2(o[0], o[1]); w.y = pk2(o[2], o[3]); w.z = pk2(o[4], o[5]); w.w = pk2(o[6], o[7]);
        *(GAS v4u*)(O + (size_t)m * 512 + hd * 128 + chk * 8) = w; }
}
template <bool GATHER_, int NCT> struct MoeOrder {
    static constexpr bool GATHER = GATHER_;
    const char* A; const char* Bt; int K; size_t bstride; int G, c; int rtb[9]; const LAS int* idx;
    __device__ __forceinline__ bool next(int i, pg8::Unit& u) const {
        const int L = i * G + c; if (L >= rtb[8] * NCT) return false;
        const int rt = L / NCT; int e = 0;
#pragma unroll
        for (int k = 1; k < 8; ++k) e += (rtb[k] <= rt) ? 1 : 0;
        u.pm = rt; u.pn = L - rt * NCT; u.ex = e; return true;
    }
    __device__ __forceinline__ const char* a_ptr(const pg8::Unit& u) const { return GATHER ? A : A + (size_t)u.pm * ((size_t)256 * K * 2); }
    __device__ __forceinline__ const char* b_ptr(const pg8::Unit& u) const { return Bt + (size_t)u.ex * bstride + (size_t)u.pn * ((size_t)256 * K * 2); }
    __device__ __forceinline__ unsigned a_off(int ui, int row, int C, int) const { return (unsigned)idx[ui * 256 + row] * (unsigned)(K * 2) + (unsigned)(C * 2); }
    __device__ __forceinline__ int kt() const { return K / 64; }
};
struct MoeDownMain {
    static constexpr bool GATHER = false;
    const char* A; const char* Bt; int K; size_t bstride; int G, c; int rtb[9];
    __device__ __forceinline__ bool next(int i, pg8::Unit& u) const {
        if (G != 256) { const int L = i * G + c; if (L >= 1024) return false; u.pm = L >> 2; u.pn = L & 3; }
        else { if (i >= 4) return false; const int xcd = c & 7, k = c >> 3; u.pm = i * 64 + (xcd << 3) + (k >> 2); u.pn = k & 3; }
        int e = 0;
#pragma unroll
        for (int k2 = 1; k2 < 8; ++k2) e += (rtb[k2] <= u.pm) ? 1 : 0;
        u.ex = e; return true;
    }
    __device__ __forceinline__ const char* a_ptr(const pg8::Unit& u) const { return A + (size_t)u.pm * ((size_t)256 * K * 2); }
    __device__ __forceinline__ const char* b_ptr(const pg8::Unit& u) const { return Bt + (size_t)u.ex * bstride + (size_t)u.pn * ((size_t)256 * K * 2); }
    __device__ __forceinline__ unsigned a_off(int, int, int, int) const { return 0u; }
    __device__ __forceinline__ int kt() const { return K / 64; }
};
struct MoeDownTail {
    static constexpr bool GATHER = false;
    const char* A; const char* Bt; int K; size_t bstride; int G, c; int rtb[9];
    __device__ __forceinline__ bool next(int i, pg8::Unit& u) const {
        const int nl = rtb[8] - 256; if (i > 0 || c >= nl * 16) return false;
        const int t = c >> 2; u.pm = 256 + (t >> 2); u.pn = t & 3; u.ex = (c & 3) * 32 + t; return true;
    }
    __device__ __forceinline__ int expert(const pg8::Unit& u) const { int e = 0;
#pragma unroll
        for (int k2 = 1; k2 < 8; ++k2) e += (rtb[k2] <= u.pm) ? 1 : 0;
        return e; }
    __device__ __forceinline__ const char* a_ptr(const pg8::Unit& u) const { return A + (size_t)u.pm * ((size_t)256 * K * 2) + (size_t)(c & 3) * (896 * 2); }
    __device__ __forceinline__ const char* b_ptr(const pg8::Unit& u) const { return Bt + (size_t)expert(u) * bstride + (size_t)u.pn * ((size_t)256 * K * 2) + (size_t)(c & 3) * (896 * 2); }
    __device__ __forceinline__ unsigned a_off(int, int, int, int) const { return 0u; }
    __device__ __forceinline__ int kt() const { return 14; }
};
__device__ __forceinline__ void moe_rtb(const LAS int* PB, int (&rtb)[9], int (&cnt)[8]) {
    int acc = 0;
#pragma unroll
    for (int e = 0; e < 8; ++e) { rtb[e] = acc; cnt[e] = __builtin_amdgcn_readfirstlane(PB[2048 + e]); acc += (cnt[e] + 255) >> 8; }
    rtb[8] = acc;
}
__global__ void __launch_bounds__(NWAVES * 64, 2) fwd_kernel(Args args) {
    extern __shared__ __attribute__((aligned(16))) unsigned char lds[];
    Frame F;
    F.lds = (LAS unsigned char*)lds;
    F.MISC = (volatile LAS unsigned*)(F.lds + MISC_OFF);
    F.tid = threadIdx.x; F.lane = F.tid & 63; F.wave = __builtin_amdgcn_readfirstlane(F.tid >> 6);
    F.G = gridDim.x; F.c = blockIdx.x;
    for (int u = F.tid; u < 32; u += NWAVES * 64) ((LAS unsigned*)(F.lds + MISC_OFF))[u] = 0u;
    if (F.tid == 0) { LAS unsigned long long* tb = (LAS unsigned long long*)(F.lds + MISC_OFF + 128);
#pragma unroll
        for (int i = 0; i < 15; ++i) tb[i] = (unsigned long long)args.in[i];
        tb[15] = (unsigned long long)args.out; tb[16] = (unsigned long long)args.ws; }
    __syncthreads();
    XcdBarrier bar = xcd_barrier_post((unsigned*)(F_CTL(F) + CW_BAR), F.MISC + 8);
#ifdef STAMP_A
#define STAMP_HERE(idx) do { if (threadIdx.x == 0) ((volatile LAS unsigned long long*)(F.lds + AUX_OFF + 16384))[(idx)] = wall_clock64(); } while (0)
#else
#define STAMP_HERE(idx) do { } while (0)
#endif
#define GRID_BAR(idx) do { XcdBarrier bb_ = bar; asm volatile("" : "+s"(bb_.bar), "+s"(bb_.x)); xcd_barrier(bb_); STAMP_HERE(idx); } while (0)
#define WSP ARGWS(F)
#define BIGP (ARGWS(F) + WS_BIG)
#define XBP ((bf16*)(ARGWS(F) + WS_XB))

#ifndef ONLY
#define ONLY -1
#endif
#define RUN(n) (ONLY < 0 || ONLY == (n))
    STAMP_HERE(0);
#ifndef DBL
#define DBL 0
#endif
    if (DBL & 1) { frame_refresh(F); p0_prologue(F); }
    if (RUN(0)) { frame_refresh(F); p0_prologue(F); }
    GRID_BAR(1);

#pragma unroll
    for (int j = 0; j < 2; ++j) {
        for (int rep_ = 0; rep_ < ((DBL & 256) ? 2 : 1); ++rep_) if (RUN(1)) { frame_refresh(F);
            const bf16* Win = (const bf16*)(WSP + WS_WIN) + (size_t)j * 6144 * 1024;
#ifndef SKIP_RP
            { pg8::StaticOrder S; S.init(XBP, Win, T_TOK, 4096, 1024, F.G, F.c);
              pg8::EpiRetProj E{(bf16*)(BIGP + BIG_QD), (bf16*)(BIGP + BIG_KH), (bf16*)(BIGP + BIG_G), (const float*)(WSP + WS_TAB)};
              pg8::gemm_phase<pg8::EpiRetProj, pg8::StaticOrder, true>(F.lds + RING_OFF, S, E, F.tid); }
#endif
#ifndef SKIP_VT
            { pg8::StaticOrder S; S.init(Win + (size_t)4096 * 1024, XBP, 2048, T_TOK, 1024, F.G, F.c);
              pg8::EpiVT E{(bf16*)(BIGP + BIG_VT)};
              pg8::gemm_phase<pg8::EpiVT, pg8::StaticOrder, true>(F.lds + RING_OFF, S, E, F.tid); }
#endif
        }
        GRID_BAR(1 + 16 * j + 1);
        if (DBL & 4) { frame_refresh(F); ret_state_phase(F); }
        if (RUN(2)) { frame_refresh(F); ret_state_phase(F); }
        GRID_BAR(1 + 16 * j + 2);
        if (DBL & 8) { frame_refresh(F); ret_out_phase(F, j, (bf16*)(BIGP + 640 * MiB)); }
        if (RUN(3)) { frame_refresh(F); ret_out_phase(F, j, (bf16*)(BIGP + BIG_G)); }
        GRID_BAR(1 + 16 * j + 3);
        if (RUN(4)) { frame_refresh(F);
            pg8::StaticOrder S; S.init(BIGP + BIG_G, (const bf16*)(WSP + WS_WRO) + (size_t)j * 1024 * 2048, T_TOK, 1024, 2048, F.G, F.c);
            pg8::EpiAddBf16 E{XBP, ALPHA};
            pg8::gemm_phase<pg8::EpiAddBf16, pg8::StaticOrder, true>(F.lds + RING_OFF, S, E, F.tid);
        }
        GRID_BAR(1 + 16 * j + 4);
        if (RUN(5)) { frame_refresh(F); ln_pass<0, false>(F, 2 * j, 0, j); }
        if (DBL & 2) { frame_refresh(F); moe_convert<false>(F, j); }
        if (RUN(6)) { frame_refresh(F); if (DBL & 1024) moe_convert<true>(F, j); else moe_convert<false>(F, j); }
        GRID_BAR(1 + 16 * j + 5);
        for (int rep_ = 0; rep_ < ((DBL & 64) ? 2 : 1); ++rep_) if (RUN(7)) { frame_refresh(F);
            pg8::StaticOrder S; S.init(XBP, (const bf16*)(WSP + WS_WGU) + (size_t)j * 7168 * 1024, T_TOK, 7168, 1024, F.G, F.c);
            pg8::EpiSwiGLU E{(bf16*)(BIGP + BIG_HID)};
            pg8::gemm_phase<pg8::EpiSwiGLU, pg8::StaticOrder, true>(F.lds + RING_OFF, S, E, F.tid);
        }
        GRID_BAR(1 + 16 * j + 6);
        if (RUN(8)) { frame_refresh(F);
            pg8::StaticOrder S; S.init(BIGP + BIG_HID, (const bf16*)(WSP + WS_WDN) + (size_t)j * 1024 * 3584, T_TOK, 1024, 3584, F.G, F.c);
            pg8::EpiAddBf16 E{XBP, ALPHA};
            pg8::gemm_phase<pg8::EpiAddBf16, pg8::StaticOrder, true>(F.lds + RING_OFF, S, E, F.tid);
        }
        GRID_BAR(1 + 16 * j + 7);
        if (RUN(5)) { frame_refresh(F); ln_pass<0, false>(F, 2 * j, 1, j); }
        GRID_BAR(1 + 16 * j + 8);
        if (RUN(9)) { frame_refresh(F);
            pg8::StaticOrder S; S.init(XBP, (const bf16*)(WSP + WS_WQKV) + (size_t)j * 4608 * 1024, T_TOK, 4608, 1024, F.G, F.c);
            pg8::EpiQKV E{(bf16*)(BIGP + BIG_QKV)};
            pg8::gemm_phase<pg8::EpiQKV, pg8::StaticOrder, true>(F.lds + RING_OFF, S, E, F.tid);
        }
        GRID_BAR(1 + 16 * j + 9);
        if (DBL & 16) { frame_refresh(F); attn_phase(F); }
        if (RUN(10)) { frame_refresh(F); attn_phase(F); }
        GRID_BAR(1 + 16 * j + 10);
        if (DBL & 32) { frame_refresh(F); attn_merge_phase(F); }
        if (RUN(11)) { frame_refresh(F); attn_merge_phase(F); }
        GRID_BAR(1 + 16 * j + 11);
        if (RUN(12)) { frame_refresh(F);
            pg8::StaticOrder S; S.init(BIGP + BIG_O, (const bf16*)(WSP + WS_WAO) + (size_t)j * 1024 * 512, T_TOK, 1024, 512, F.G, F.c);
            pg8::EpiAddBf16 E{XBP, ALPHA};
            pg8::gemm_phase<pg8::EpiAddBf16, pg8::StaticOrder, true>(F.lds + RING_OFF, S, E, F.tid);
        }
        GRID_BAR(1 + 16 * j + 12);
        if (RUN(13)) { frame_refresh(F); ln_route_pass(F, 2 * j + 1, j); }
        GRID_BAR(1 + 16 * j + 13);
        for (int rep_ = 0; rep_ < ((DBL & 512) ? 2 : 1); ++rep_) if (RUN(14)) {
            frame_refresh(F); MoeOrder<true, 28> S; int cnt[8];
            LAS int* PB = (LAS int*)(F.lds + RING_OFF); moe_prefix_lds(F, PB); moe_rtb(PB, S.rtb, cnt);
            S.G = F.G; S.c = F.c; S.idx = (const LAS int*)(F.lds + AUX_OFF);
            S.A = (const char*)XBP; S.Bt = (const char*)(BIGP + BIG_WMGU); S.K = 1024; S.bstride = (size_t)7168 * 1024 * 2;
            const int* BL = (const int*)(WSP + WS_LIST); LAS int* idx = (LAS int*)(F.lds + AUX_OFF);
            pg8::Unit u; int nun = 0;
            for (int ui = 0; S.next(ui, u) && ui < 30; ++ui) { nun = ui + 1;
                if (F.tid < 256) { const int e = u.ex; int rb = 0, ce = 0;
#pragma unroll
                    for (int q = 0; q < 8; ++q) { rb = (q == e) ? S.rtb[q] : rb; ce = (q == e) ? cnt[q] : ce; }
                    int slot = (u.pm - rb) * 256 + F.tid; slot = slot < ce ? slot : 0;
                    int lo = 0;
#pragma unroll
                    for (int st = 128; st > 0; st >>= 1) lo = (PB[(lo + st) * 8 + e] <= slot) ? lo + st : lo;
                    idx[ui * 256 + F.tid] = (lo * 8 + e) * 256 + (slot - PB[lo * 8 + e]); } }
            if (F.tid < 256) {
#pragma unroll 10
                for (int ui = 0; ui < 30; ++ui) if (ui < nun) idx[ui * 256 + F.tid] = BL[idx[ui * 256 + F.tid]]; }
            __syncthreads();
            pg8::EpiSwiGLU E{(bf16*)(BIGP + BIG_HID)};
            pg8::gemm_phase<pg8::EpiSwiGLU, MoeOrder<true, 28>, true>(F.lds + RING_OFF, S, E, F.tid);
        }
        GRID_BAR(1 + 16 * j + 14);
        for (int rep_ = 0; rep_ < ((DBL & 128) ? 2 : 1); ++rep_) if (RUN(15)) {
            frame_refresh(F);
            int rtb5[9], cnt5[8]; { LAS int* PB = (LAS int*)(F.lds + RING_OFF); moe_prefix_lds(F, PB); moe_rtb(PB, rtb5, cnt5); __syncthreads(); }
            { MoeDownMain S;
#pragma unroll
              for (int e = 0; e < 9; ++e) S.rtb[e] = rtb5[e];
              S.G = F.G; S.c = F.c; S.A = (const char*)(BIGP + BIG_HID); S.Bt = (const char*)(BIGP + BIG_WMD); S.K = 3584; S.bstride = (size_t)1024 * 3584 * 2;
              pg8::EpiBf16Y E{(bf16*)(BIGP + BIG_YP)};
              pg8::gemm_phase<pg8::EpiBf16Y, MoeDownMain, true>(F.lds + RING_OFF, S, E, F.tid); }
            frame_refresh(F);
            { MoeDownTail S;
#pragma unroll
              for (int e = 0; e < 9; ++e) S.rtb[e] = rtb5[e];
              S.G = F.G; S.c = F.c; S.A = (const char*)(BIGP + BIG_HID); S.Bt = (const char*)(BIGP + BIG_WMD); S.K = 3584; S.bstride = (size_t)1024 * 3584 * 2;
              pg8::EpiF32Slab E{(float*)(WSP + WS_SLAB)};
              pg8::gemm_phase<pg8::EpiF32Slab, MoeDownTail, false>(F.lds + RING_OFF, S, E, F.tid); }
        }
        GRID_BAR(1 + 16 * j + 15);
        if (RUN(16)) { frame_refresh(F); if (j == 0) ln_pass<2, false>(F, 1, 1, 0); else ln_pass<2, true>(F, 3, 1, 1); }
        if (j == 0) GRID_BAR(1 + 16 * j + 16);
    }
#ifdef STAMP_A
    GRID_BAR(34);
    { if (blockIdx.x == 0 && threadIdx.x == 0) { volatile LAS unsigned long long* ts = (volatile LAS unsigned long long*)(F.lds + AUX_OFF + 16384);
          float* vv = (float*)(ARGWS(F) + 65536); vv[0] = (float)(ts[STAMP_A + STAMP_AN] - ts[STAMP_A]) * 0.01f; vv[1] = (float)(ts[STAMP_B + STAMP_BN] - ts[STAMP_B]) * 0.01f; } }
    GRID_BAR(35);
    { const float* vv = (const float*)(ARGWS(F) + 65536); const float va = vv[0], vb = vv[1];
      float* out = ARGX(F); const float c = sqrtf(va);
      for (size_t i = (size_t)blockIdx.x * 512 + threadIdx.x; i < (size_t)T_TOK * DMODEL; i += (size_t)gridDim.x * 512) out[i] = (i == 0) ? vb : c; }
#endif
}

extern "C" void kernel_launch(void* const* d_in, const int* in_sizes, int n_in, void* d_out, int out_size, void* d_ws, size_t ws_size, hipStream_t stream) {
    static int grid = 0;
    if (grid == 0) {
        if (n_in != 15 || out_size != T_TOK * DMODEL || ws_size < WS_END) { fprintf(stderr, "kernel_launch: unexpected shapes / workspace (n_in %d, out %d, ws %zu < %zu)\n", n_in, out_size, ws_size, (size_t)WS_END); grid = -1; return; }
        int dev = 0, cus = 0, per_cu = 0;
        if (hipGetDevice(&dev) != hipSuccess || hipDeviceGetAttribute(&cus, hipDeviceAttributeMultiprocessorCount, dev) != hipSuccess) { grid = -1; return; }
        if (hipFuncSetAttribute((const void*)fwd_kernel, hipFuncAttributeMaxDynamicSharedMemorySize, LDS_BYTES) != hipSuccess) { fprintf(stderr, "kernel_launch: hipFuncSetAttribute failed\n"); grid = -1; return; }
        if (hipOccupancyMaxActiveBlocksPerMultiprocessor(&per_cu, (const void*)fwd_kernel, NWAVES * 64, LDS_BYTES) != hipSuccess || per_cu < 1) { fprintf(stderr, "kernel_launch: occupancy query says %d\n", per_cu); }
        (void)hipGetLastError();
        if (cus < 256) { fprintf(stderr, "kernel_launch: this kernel needs 256 CUs (found %d)\n", cus); grid = -1; return; }
        grid = 256;
    }
    if (grid < 0) return;
    if (hipMemsetAsync((char*)d_ws + WS_CTL, 0, CTL_ZERO_BYTES, stream) != hipSuccess) return;
    Args a{};
    for (int i = 0; i < 15; ++i) a.in[i] = (const float*)d_in[i];
    a.out = (float*)d_out; a.ws = (unsigned char*)d_ws;
    hipLaunchKernelGGL(fwd_kernel, dim3(grid), dim3(NWAVES * 64), LDS_BYTES, stream, a);
}
```

```cpp
#include <hip/hip_runtime.h>
#include <hip/hip_bf16.h>
#include <cstdio>
#include <cstdint>
#include <cmath>
namespace pg8 {
#define PG8_LAS __attribute__((address_space(3)))
typedef unsigned short bf16_t;
typedef short bf16x8 __attribute__((ext_vector_type(8)));
typedef float f32x4 __attribute__((ext_vector_type(4)));
typedef float f32x2 __attribute__((ext_vector_type(2)));
typedef unsigned u32x4 __attribute__((ext_vector_type(4)));
constexpr int BM = 256, BK = 64, HALF = 128, HTB = HALF * BK * 2  , STAGE_BYTES = 8 * HTB, NXCD = 8, WGM = 8;

__host__ __device__ __forceinline__ int lds_byte(int r, int c) { const int st = (r >> 4) * 2 + (c >> 5), rr = r & 15, cc = c & 31, ob = rr * 64 + cc * 2; return st * 1024 + (ob ^ (((ob >> 9) & 1) << 5)); }
__host__ __device__ __forceinline__ void stage_rc(int b, int& R, int& C) { const int st = b / 1024, sb = b % 1024, swz = sb ^ (((sb >> 9) & 1) << 5); R = (st >> 1) * 16 + swz / 64; C = (st & 1) * 32 + (swz % 64) / 2; }
__host__ __device__ __forceinline__ int perm32(int rho) { const int n = rho >> 4, i = rho & 15; return 8 * (i >> 2) + 4 * n + (i & 3); }

struct Unit { int pm, pn, ex; };

struct StaticOrder {
    static constexpr bool GATHER = false;
    const char* A; const char* Bt; int K;
    int nM, nN, nwg, G, c;
    __device__ void init(const void* A_, const void* Bt_, int M, int N, int K_, int G_, int c_) { A = (const char*)A_; Bt = (const char*)Bt_; K = K_; nM = M / BM; nN = N / BM; nwg = nM * nN; G = G_; c = c_; }
    __device__ bool next(int i, Unit& u) const {
        const long L = (long)i * G + c; if (L >= nwg) return false;
        int wgid = (int)L; { const int q = nwg / NXCD, r = nwg % NXCD, xcd = wgid % NXCD, off = wgid / NXCD; wgid = (xcd < r ? xcd * (q + 1) : r * (q + 1) + (xcd - r) * q) + off; }
        const int nig = WGM * nN, gid = wgid / nig, fm = gid * WGM, gsz = (nM - fm) < WGM ? (nM - fm) : WGM;
        u.pm = fm + ((wgid % nig) % gsz); u.pn = (wgid % nig) / gsz; u.ex = 0; return true;
    }
    __device__ __forceinline__ const char* a_ptr(const Unit& u) const { return A + (size_t)u.pm * ((size_t)BM * K * 2); }
    __device__ __forceinline__ const char* b_ptr(const Unit& u) const { return Bt + (size_t)u.pn * ((size_t)BM * K * 2); }
    __device__ __forceinline__ unsigned a_off(int, int, int, int) const { return 0u; }
    __device__ __forceinline__ int kt() const { return K / BK; }
};

__device__ __forceinline__ unsigned cvt_pk_bf16(float lo, float hi) { unsigned r; asm volatile("v_cvt_pk_bf16_f32 %0, %1, %2" : "=v"(r) : "v"(lo), "v"(hi)); return r; }

template <class Epi, class Sched, bool ALIGN_EPI>
__device__ __forceinline__ void gemm_phase(PG8_LAS unsigned char* lds, const Sched& S, const Epi& E, const int tid) {
    constexpr bool GATHER = Sched::GATHER;
    const int wid = __builtin_amdgcn_readfirstlane(tid >> 6), lane = tid & 63, wr = wid >> 2, wc = wid & 3, fr = lane & 15, fq = lane >> 4;
    const int K = S.K, nt = S.kt();
    unsigned voffA[2][2], nvoffA[2][2], voffB[2]; int sR[2], sC[2];
#pragma unroll
    for (int i = 0; i < 2; ++i) { int R, C; stage_rc(tid * 16 + i * 8192, R, C); sR[i] = R; sC[i] = C; const int Rb = Epi::PERM ? ((R & ~31) + perm32(R & 31)) : R;
        voffA[0][i] = (unsigned)(R * K + C) * 2u; voffA[1][i] = voffA[0][i]; nvoffA[0][i] = voffA[0][i]; nvoffA[1][i] = voffA[0][i]; voffB[i] = (unsigned)(Rb * K + C) * 2u; }
    const size_t kstep = (size_t)(BK * 2);
    const size_t hstep = (size_t)HALF * K * 2;
    const size_t ahstep = GATHER ? (size_t)0 : hstep;
    const unsigned ldsw = (unsigned)wid * 1024u;
    const int aoff = lds_byte(wr * 64 + fr, fq * 8), boff = lds_byte(wc * 32 + fr, fq * 8);
#define PG8_SA(b, h) (((b) * 2 + (h)) * HTB)
#define PG8_SB(b, h) ((4 + (b) * 2 + (h)) * HTB)
#define PG8_STAGE(bufoff, gbase, voff) do { _Pragma("unroll") for (int _i = 0; _i < 2; ++_i) \
        __builtin_amdgcn_global_load_lds((const unsigned*)((const char*)(gbase) + (voff)[_i]), (PG8_LAS unsigned*)(lds + (bufoff) + ldsw + _i * 8192), 16, 0, 0); } while (0)
#define PG8_STAGE_A(bufoff, gbase, h, VO) PG8_STAGE(bufoff, (gbase) + (h) * ahstep, (VO)[GATHER ? (h) : 0])
#define PG8_LDA(dst, b, h) do { _Pragma("unroll") for (int m = 0; m < 4; ++m) _Pragma("unroll") for (int k = 0; k < 2; ++k) dst[m][k] = *(const PG8_LAS bf16x8*)(lds + PG8_SA(b, h) + aoff + m * 2048 + k * 1024); } while (0)
#define PG8_LDB(dst, b, h) do { _Pragma("unroll") for (int n = 0; n < 2; ++n) _Pragma("unroll") for (int k = 0; k < 2; ++k) dst[n][k] = *(const PG8_LAS bf16x8*)(lds + PG8_SB(b, h) + boff + n * 2048 + k * 1024); } while (0)
#define PG8_MMA(ai, bj, At, Bt) do { __builtin_amdgcn_s_setprio(1); _Pragma("unroll") for (int m = 0; m < 4; ++m) _Pragma("unroll") for (int n = 0; n < 2; ++n) _Pragma("unroll") for (int k = 0; k < 2; ++k) \
        acc[ai][bj][m][n] = __builtin_amdgcn_mfma_f32_16x16x32_bf16(Bt[n][k], At[m][k], acc[ai][bj][m][n], 0, 0, 0); __builtin_amdgcn_s_setprio(0); } while (0)
#define PG8_WAIT_V(n) asm volatile("s_waitcnt vmcnt(" #n ")" ::: "memory")
#define PG8_WAIT_L(n) asm volatile("s_waitcnt lgkmcnt(" #n ")" ::: "memory")
#define PG8_BAR __builtin_amdgcn_s_barrier()
#define PG8_SCHED __builtin_amdgcn_sched_barrier(0)
    Unit cur, nxt; int ui = 0;
    if (!S.next(0, cur)) return;
    f32x4 acc[2][2][4][2];
#pragma unroll
    for (int a = 0; a < 2; ++a)
#pragma unroll
        for (int b = 0; b < 2; ++b)
#pragma unroll
            for (int m = 0; m < 4; ++m)
#pragma unroll
                for (int n = 0; n < 2; ++n) acc[a][b][m][n] = (f32x4){0.f, 0.f, 0.f, 0.f};
    bf16x8 At[4][2], B0[2][2], B1[2][2];
    const char* cA = S.a_ptr(cur); const char* cB = S.b_ptr(cur);
    if constexpr (GATHER) {
#pragma unroll
        for (int h = 0; h < 2; ++h)
#pragma unroll
            for (int i = 0; i < 2; ++i) voffA[h][i] = S.a_off(0, h * HALF + sR[i], sC[i], 0);
    }
    PG8_STAGE(PG8_SB(0, 0), cB, voffB); PG8_STAGE(PG8_SB(0, 1), cB + hstep, voffB); PG8_STAGE_A(PG8_SA(0, 0), cA, 0, voffA); PG8_STAGE_A(PG8_SA(0, 1), cA, 1, voffA);
    if (wr == 1) PG8_BAR;
    PG8_WAIT_V(2); PG8_BAR;
    PG8_STAGE(PG8_SB(1, 0), cB + kstep, voffB); PG8_STAGE_A(PG8_SA(1, 0), cA + kstep, 0, voffA); PG8_STAGE(PG8_SB(1, 1), cB + hstep + kstep, voffB);
    PG8_WAIT_V(6); PG8_BAR;
    for (;;) {
        const bool has_next = S.next(ui + 1, nxt);
        const char* nA = has_next ? S.a_ptr(nxt) : cA; const char* nB = has_next ? S.b_ptr(nxt) : cB;
        if constexpr (GATHER) {
#pragma unroll
            for (int h = 0; h < 2; ++h)
#pragma unroll
                for (int i = 0; i < 2; ++i) nvoffA[h][i] = has_next ? S.a_off(ui + 1, h * HALF + sR[i], sC[i], 0) : voffA[h][i];
        }
        for (int t = 0; t < nt; t += 2) {
            const bool last = (t == nt - 2);
            const char* a1 = cA + (size_t)(t + 1) * kstep;
            const char* a2 = last ? nA : cA + (size_t)(t + 2) * kstep; const char* b2 = last ? nB : cB + (size_t)(t + 2) * kstep;
            const char* a3 = a2 + kstep; const char* b3 = b2 + kstep;
            unsigned vo2[2][2];
#pragma unroll
            for (int h = 0; h < 2; ++h)
#pragma unroll
                for (int i = 0; i < 2; ++i) vo2[h][i] = (GATHER && last) ? nvoffA[h][i] : voffA[h][i];
            PG8_LDB(B0, 0, 0); PG8_LDB(B1, 0, 1); PG8_SCHED; PG8_LDA(At, 0, 0); PG8_STAGE_A(PG8_SA(1, 1), a1, 1, voffA);
            PG8_WAIT_V(8); PG8_WAIT_L(0); PG8_BAR; PG8_MMA(0, 0, At, B0); PG8_MMA(0, 1, At, B1); PG8_BAR; PG8_SCHED;
            PG8_LDA(At, 0, 1); PG8_STAGE(PG8_SB(0, 0), b2, voffB); PG8_STAGE(PG8_SB(0, 1), b2 + hstep, voffB); PG8_STAGE_A(PG8_SA(0, 0), a2, 0, vo2);
            PG8_WAIT_V(8); PG8_WAIT_L(0); PG8_BAR; PG8_MMA(1, 0, At, B0); PG8_MMA(1, 1, At, B1); PG8_BAR; PG8_SCHED;
            PG8_LDB(B0, 1, 0); PG8_LDB(B1, 1, 1); PG8_SCHED; PG8_LDA(At, 1, 0); PG8_STAGE_A(PG8_SA(0, 1), a2, 1, vo2);
            PG8_WAIT_V(8); PG8_WAIT_L(0); PG8_BAR; PG8_MMA(0, 0, At, B0); PG8_MMA(0, 1, At, B1); PG8_BAR; PG8_SCHED;
            PG8_LDA(At, 1, 1); PG8_STAGE(PG8_SB(1, 0), b3, voffB); PG8_STAGE(PG8_SB(1, 1), b3 + hstep, voffB); PG8_STAGE_A(PG8_SA(1, 0), a3, 0, vo2);
            PG8_WAIT_V(8); PG8_WAIT_L(0); PG8_BAR; PG8_MMA(1, 0, At, B0); PG8_MMA(1, 1, At, B1); PG8_BAR; PG8_SCHED;
        }
        if constexpr (ALIGN_EPI) { if (wr == 0) PG8_BAR; }
        E(acc, cur, wr, wc, fr, fq);
        if (!has_next) break;
#pragma unroll
        for (int a = 0; a < 2; ++a)
#pragma unroll
            for (int b = 0; b < 2; ++b)
#pragma unroll
                for (int m = 0; m < 4; ++m)
#pragma unroll
                    for (int n = 0; n < 2; ++n) acc[a][b][m][n] = (f32x4){0.f, 0.f, 0.f, 0.f};
        cur = nxt; cA = nA; cB = nB; ++ui;
        if constexpr (GATHER) {
#pragma unroll
            for (int h = 0; h < 2; ++h)
#pragma unroll
                for (int i = 0; i < 2; ++i) voffA[h][i] = nvoffA[h][i];
        }
        if constexpr (ALIGN_EPI) { if (wr == 1) PG8_BAR; }
    }
    PG8_WAIT_V(0);
    if constexpr (!ALIGN_EPI) { if (wr == 0) PG8_BAR; }
    PG8_BAR;
#undef PG8_SA
#undef PG8_SB
#undef PG8_STAGE
#undef PG8_STAGE_A
#undef PG8_LDA
#undef PG8_LDB
#undef PG8_MMA
#undef PG8_WAIT_V
#undef PG8_WAIT_L
#undef PG8_BAR
#undef PG8_SCHED
}
__device__ __forceinline__ float silu_f(float x) { return x * __builtin_amdgcn_rcpf(1.0f + __builtin_amdgcn_exp2f(-1.4426950408889634f * x)); }
__device__ __forceinline__ u32x4 pack8v(const f32x4& v0, const f32x4& v1) { u32x4 w; w.x = cvt_pk_bf16(v0[0], v0[1]); w.y = cvt_pk_bf16(v0[2], v0[3]); w.z = cvt_pk_bf16(v1[0], v1[1]); w.w = cvt_pk_bf16(v1[2], v1[3]); return w; }

struct EpiRetProj {
    static constexpr bool PERM = true;
    bf16_t* QD; bf16_t* KH; bf16_t* G; const float* tab;
    __device__ __forceinline__ void operator()(const f32x4 (&acc)[2][2][4][2], const Unit& u, int wr, int wc, int fr, int fq) const {
        const int row0 = u.pm * BM + wr * 64 + fr, cl = wc * 32 + 8 * fq;
        if (u.pn < 8) {
            const bool isq = u.pn < 4; const int h = u.pn & 3;
            const float lg = __builtin_amdgcn_logf(1.0f - __builtin_amdgcn_exp2f((float)(-5 - h)));
            bf16_t* base = (isq ? QD : KH) + h * 256 + cl;
#pragma unroll
            for (int ai = 0; ai < 2; ++ai)
#pragma unroll
                for (int m = 0; m < 4; ++m) { const int row = row0 + ai * HALF + m * 16, pos = row & 16383, ic = row & 127;
                    const float sc = isq ? __builtin_amdgcn_exp2f(lg * (float)(ic + 1)) : 0.0625f * __builtin_amdgcn_exp2f(-lg * (float)(ic + 1));
                    const f32x4* tp = (const f32x4*)(tab + ((size_t)pos * 128 + cl) * 2);
                    const f32x4 t0 = tp[0], t1 = tp[1], t2 = tp[2], t3 = tp[3];
                    const f32x4 a0 = acc[ai][0][m][0], a1 = acc[ai][0][m][1], b0 = acc[ai][1][m][0], b1 = acc[ai][1][m][1];
                    f32x4 o10, o11, o20, o21;
                    o10[0] = (a0[0] * t0[0] - b0[0] * t0[1]) * sc; o20[0] = (b0[0] * t0[0] + a0[0] * t0[1]) * sc;
                    o10[1] = (a0[1] * t0[2] - b0[1] * t0[3]) * sc; o20[1] = (b0[1] * t0[2] + a0[1] * t0[3]) * sc;
                    o10[2] = (a0[2] * t1[0] - b0[2] * t1[1]) * sc; o20[2] = (b0[2] * t1[0] + a0[2] * t1[1]) * sc;
                    o10[3] = (a0[3] * t1[2] - b0[3] * t1[3]) * sc; o20[3] = (b0[3] * t1[2] + a0[3] * t1[3]) * sc;
                    o11[0] = (a1[0] * t2[0] - b1[0] * t2[1]) * sc; o21[0] = (b1[0] * t2[0] + a1[0] * t2[1]) * sc;
                    o11[1] = (a1[1] * t2[2] - b1[1] * t2[3]) * sc; o21[1] = (b1[1] * t2[2] + a1[1] * t2[3]) * sc;
                    o11[2] = (a1[2] * t3[0] - b1[2] * t3[1]) * sc; o21[2] = (b1[2] * t3[0] + a1[2] * t3[1]) * sc;
                    o11[3] = (a1[3] * t3[2] - b1[3] * t3[3]) * sc; o21[3] = (b1[3] * t3[2] + a1[3] * t3[3]) * sc;
                    bf16_t* rp = base + (size_t)row * 1024;
                    *(u32x4*)rp = pack8v(o10, o11); *(u32x4*)(rp + 128) = pack8v(o20, o21); asm volatile("" ::: "memory"); }
        } else {
            bf16_t* base = G + (u.pn - 8) * 256 + cl;
#pragma unroll
            for (int ai = 0; ai < 2; ++ai)
#pragma unroll
                for (int m = 0; m < 4; ++m) { bf16_t* rp = base + (size_t)(row0 + ai * HALF + m * 16) * 2048;
#pragma unroll
                    for (int bj = 0; bj < 2; ++bj) { f32x4 v0 = acc[ai][bj][m][0], v1 = acc[ai][bj][m][1];
#pragma unroll
                        for (int j = 0; j < 4; ++j) { v0[j] = silu_f(v0[j]); v1[j] = silu_f(v1[j]); }
                        *(u32x4*)(rp + bj * HALF) = pack8v(v0, v1); } }
        }
    }
};
struct EpiVT {
    static constexpr bool PERM = true;
    bf16_t* VT;
    __device__ __forceinline__ void operator()(const f32x4 (&acc)[2][2][4][2], const Unit& u, int wr, int wc, int fr, int fq) const {
        const int row0 = u.pm * BM + wr * 64 + fr, c0 = u.pn * BM + wc * 32 + 8 * fq;
#pragma unroll
        for (int ai = 0; ai < 2; ++ai)
#pragma unroll
            for (int m = 0; m < 4; ++m) { const int R = row0 + ai * HALF + m * 16, h = R >> 9, e = R & 511;
#pragma unroll
                for (int bj = 0; bj < 2; ++bj) { const int c = c0 + bj * HALF, b = c >> 14, t = c & 16383, n = t >> 7, oct = (t & 127) >> 3;
                    const size_t off = ((size_t)((b * 4 + h) * 128 + n) << 16) + (size_t)(((((e >> 5) * 8 + (oct >> 1)) * 2 + (oct & 1)) * 32 + (e & 31)) * 8);
                    *(u32x4*)(VT + off) = pack8v(acc[ai][bj][m][0], acc[ai][bj][m][1]); } }
    }
};
struct EpiAddBf16 {
    static constexpr bool PERM = true;
    bf16_t* XB; float alpha;
    __device__ __forceinline__ void operator()(const f32x4 (&acc)[2][2][4][2], const Unit& u, int wr, int wc, int fr, int fq) const {
        const int row0 = u.pm * BM + wr * 64 + fr, col0 = u.pn * BM + wc * 32 + 8 * fq;
#pragma unroll
        for (int ai = 0; ai < 2; ++ai)
#pragma unroll
            for (int m = 0; m < 4; ++m) { bf16_t* rowp = XB + (size_t)(row0 + ai * HALF + m * 16) * 1024 + col0;
#pragma unroll
                for (int bj = 0; bj < 2; ++bj) { const u32x4 x = *(const u32x4*)(rowp + bj * HALF); f32x4 v0 = acc[ai][bj][m][0], v1 = acc[ai][bj][m][1];
                    v0[0] += alpha * __builtin_bit_cast(float, x.x << 16); v0[1] += alpha * __builtin_bit_cast(float, x.x & 0xffff0000u);
                    v0[2] += alpha * __builtin_bit_cast(float, x.y << 16); v0[3] += alpha * __builtin_bit_cast(float, x.y & 0xffff0000u);
                    v1[0] += alpha * __builtin_bit_cast(float, x.z << 16); v1[1] += alpha * __builtin_bit_cast(float, x.z & 0xffff0000u);
                    v1[2] += alpha * __builtin_bit_cast(float, x.w << 16); v1[3] += alpha * __builtin_bit_cast(float, x.w & 0xffff0000u);
                    *(u32x4*)(rowp + bj * HALF) = pack8v(v0, v1); } }
    }
};
struct EpiSwiGLU {
    static constexpr bool PERM = true;
    bf16_t* H;
    __device__ __forceinline__ void operator()(const f32x4 (&acc)[2][2][4][2], const Unit& u, int wr, int wc, int fr, int fq) const {
        const int row0 = u.pm * BM + wr * 64 + fr, col0 = u.pn * HALF + wc * 32 + 8 * fq;
#pragma unroll
        for (int ai = 0; ai < 2; ++ai)
#pragma unroll
            for (int m = 0; m < 4; ++m) { f32x4 v0 = acc[ai][0][m][0], v1 = acc[ai][0][m][1]; const f32x4 u0 = acc[ai][1][m][0], u1 = acc[ai][1][m][1];
#pragma unroll
                for (int j = 0; j < 4; ++j) { v0[j] = silu_f(v0[j]) * u0[j]; v1[j] = silu_f(v1[j]) * u1[j]; }
                *(u32x4*)(H + (size_t)(row0 + ai * HALF + m * 16) * 3584 + col0) = pack8v(v0, v1); }
    }
};
struct EpiQKV {
    static constexpr bool PERM = true;
    bf16_t* P;
    __device__ __forceinline__ void operator()(const f32x4 (&acc)[2][2][4][2], const Unit& u, int wr, int wc, int fr, int fq) const {
        const int row0 = u.pm * BM + wr * 64 + fr, cl = wc * 32 + 8 * fq;
        const int which = u.pn / 6, g = (u.pn % 6) >> 1, hp = u.pn & 1, sh = 2 * g;
#pragma unroll
        for (int ai = 0; ai < 2; ++ai)
#pragma unroll
            for (int m = 0; m < 4; ++m) { const int r = row0 + ai * HALF + m * 16, b = r >> 14, t = r & 16383;
                const int perm = (t & ((1 << sh) - 1)) * (16384 >> sh) + (t >> sh);
#pragma unroll
                for (int bj = 0; bj < 2; ++bj) { const int head = 2 * hp + bj;
                    bf16_t* dst = P + ((size_t)(((which * 3 + g) * 8 + b * 4 + head) * 16384 + perm) << 7) + cl;
                    *(u32x4*)dst = pack8v(acc[ai][bj][m][0], acc[ai][bj][m][1]); } }
    }
};
struct EpiBf16Y {
    static constexpr bool PERM = true;
    bf16_t* Y;
    __device__ __forceinline__ void operator()(const f32x4 (&acc)[2][2][4][2], const Unit& u, int wr, int wc, int fr, int fq) const {
        const int row0 = u.pm * BM + wr * 64 + fr, col0 = u.pn * BM + wc * 32 + 8 * fq;
#pragma unroll
        for (int ai = 0; ai < 2; ++ai)
#pragma unroll
            for (int m = 0; m < 4; ++m) { bf16_t* rp = Y + (size_t)(row0 + ai * HALF + m * 16) * 1024 + col0;
#pragma unroll
                for (int bj = 0; bj < 2; ++bj) *(u32x4*)(rp + bj * HALF) = pack8v(acc[ai][bj][m][0], acc[ai][bj][m][1]); }
    }
};
struct EpiF32Slab {
    static constexpr bool PERM = false;
    float* S;
    __device__ __forceinline__ void operator()(const f32x4 (&acc)[2][2][4][2], const Unit& u, int wr, int wc, int fr, int fq) const {
        float* base = S + ((size_t)u.ex << 16) + (size_t)(wr * 64 + fr) * 256 + wc * 32 + 4 * fq;
#pragma unroll
        for (int ai = 0; ai < 2; ++ai)
#pragma unroll
            for (int m = 0; m < 4; ++m) { float* rowp = base + (size_t)(ai * HALF + m * 16) * 256;
#pragma unroll
                for (int bj = 0; bj < 2; ++bj)
#pragma unroll
                    for (int n = 0; n < 2; ++n) *(f32x4*)(rowp + bj * HALF + n * 16) = acc[ai][bj][m][n]; }
    }
};
}
namespace swa {
constexpr int D = 128; constexpr float THR = 8.f; constexpr bool WSKIP = true; constexpr int LSE_LDS_OFF = 131072;
constexpr float SCALE = 0.08838834764831845f;
constexpr int NW = 8, QBLK = 32, KVBLK = 64, QB = NW * QBLK;
constexpr int SHM_V = KVBLK * D * 2, SHM_K = KVBLK * D * 2;
constexpr int LDS_BYTES = 2 * SHM_V + 2 * SHM_K + NW * 64 * 4;

using bf16 = __hip_bfloat16;
typedef short bf16x8 __attribute__((ext_vector_type(8)));
typedef short s16x4 __attribute__((ext_vector_type(4)));
typedef float f32x16 __attribute__((ext_vector_type(16)));
typedef float f32x4 __attribute__((ext_vector_type(4)));
typedef unsigned u32x4 __attribute__((ext_vector_type(4)));
template <class A, class Bt> struct same_t { static constexpr bool v = false; };
template <class A> struct same_t<A, A> { static constexpr bool v = true; };

#define KSWZ(row, colB) ((row) * 256 + ((colB) ^ (((row) & 7) << 4)))
#define SBAR() __builtin_amdgcn_sched_barrier(0)
__device__ __forceinline__ int v_st(int k, int c) { const int kk = (k & ~0xC) | ((k & 4) << 1) | ((k & 8) >> 1); return ((kk >> 3) * 4 + (c >> 5)) * 512 + ((kk & 7) * 32 + (c & 31)) * 2; }
__device__ __forceinline__ int v_rd_base(int lane) { return ((lane & 3) << 3) | (((lane >> 2) & 3) << 6) | (((lane >> 4) & 1) << 5) | (((lane >> 5) & 1) << 8); }
constexpr int v_rd_off(int d0, int ks, int half) { return d0 * 512 + ks * 4096 + half * 2048; }
__device__ __forceinline__ int crow(int r, int hi) { return (r & 3) + 8 * (r >> 2) + 4 * hi; }
__device__ __forceinline__ unsigned cvtpk(float lo, float hi) {
    unsigned r; asm volatile("v_cvt_pk_bf16_f32 %0, %1, %2" : "=v"(r) : "v"(lo), "v"(hi)); return r;
}
__device__ __forceinline__ bf16x8 pack8(f32x4 a, f32x4 b) {
    u32x4 w = {cvtpk(a[0], a[1]), cvtpk(a[2], a[3]), cvtpk(b[0], b[1]), cvtpk(b[2], b[3])};
    return *reinterpret_cast<bf16x8*>(&w);
}
template <class T> __device__ __forceinline__ bf16x8 load8(const T* p) {
    if constexpr (same_t<T, float>::v) { return pack8(*(const f32x4*)p, *(const f32x4*)(p + 4)); }
    else { return *reinterpret_cast<const bf16x8*>(p); }
}
__device__ __forceinline__ void mask_tile(f32x16& p0, f32x16& p1, int dq, unsigned W) {
    const float NEG = -__builtin_inff();
#pragma unroll
    for (int r = 0; r < 16; ++r) {
        const int c = (r & 3) + 8 * (r >> 2);
        if ((unsigned)(dq - c) >= W) p0[r] = NEG;
        if ((unsigned)(dq - c - 32) >= W) p1[r] = NEG;
    }
}
__device__ __forceinline__ void partialSM(f32x16& p0, f32x16& p1, float& m_reg, float& mn, float& alpha) {
    float pmax = p0[0]; for (int r = 1; r < 16; ++r) pmax = fmaxf(pmax, p0[r]); for (int r = 0; r < 16; ++r) pmax = fmaxf(pmax, p1[r]);
    { auto rr = __builtin_amdgcn_permlane32_swap(__float_as_uint(pmax), __float_as_uint(pmax), false, false);
      pmax = fmaxf(__uint_as_float(rr[0]), __uint_as_float(rr[1])); }
    constexpr float C2 = 1.4426950408889634f * SCALE;
    if (__builtin_expect(__all((pmax - m_reg) * SCALE <= THR), 1)) { mn = m_reg; alpha = 1.f; }
    else { mn = fmaxf(m_reg, pmax); alpha = __builtin_amdgcn_exp2f((m_reg - mn) * C2); m_reg = mn; }
    const float mnL = -mn * C2;
    for (int r = 0; r < 16; ++r) p0[r] = fmaf(p0[r], C2, mnL); for (int r = 0; r < 16; ++r) p1[r] = fmaf(p1[r], C2, mnL);
    for (int r = 0; r < 16; ++r) p0[r] = __builtin_amdgcn_exp2f(p0[r]);
}
__device__ __forceinline__ void finishSM(f32x16& p0, f32x16& p1, float alpha, float& l_reg, bf16x8& pa0, bf16x8& pa1, bf16x8& pa2, bf16x8& pa3) {
    for (int r = 0; r < 16; ++r) p1[r] = __builtin_amdgcn_exp2f(p1[r]);
    float ps = 0; for (int r = 0; r < 16; ++r) ps += p0[r]; for (int r = 0; r < 16; ++r) ps += p1[r];
    { auto rr = __builtin_amdgcn_permlane32_swap(__float_as_uint(ps), __float_as_uint(ps), false, false);
      ps = __uint_as_float(rr[0]) + __uint_as_float(rr[1]); }
    l_reg = l_reg * alpha + ps;
#define PK4(P, B_, OUT) do { unsigned a0 = cvtpk(P[B_+0], P[B_+1]), a1 = cvtpk(P[B_+2], P[B_+3]);                          \
        unsigned b0 = cvtpk(P[B_+4], P[B_+5]), b1 = cvtpk(P[B_+6], P[B_+7]);                                             \
        auto r0 = __builtin_amdgcn_permlane32_swap(a0, b0, false, false); auto r1 = __builtin_amdgcn_permlane32_swap(a1, b1, false, false); \
        u32x4 w = {r0[0], r1[0], r0[1], r1[1]}; OUT = *reinterpret_cast<bf16x8*>(&w); } while (0)
    PK4(p0, 0, pa0); PK4(p0, 8, pa1); PK4(p1, 0, pa2); PK4(p1, 8, pa3);
#undef PK4
}
template <int KB, bool SK>
__device__ __forceinline__ void qkt(f32x16& p0, f32x16& p1, const char* K_lds, int r32, int hi, const bf16x8* qr, bool act) {
    if (SK && !act) { const float NEG = -__builtin_inff();
#pragma unroll
        for (int r = 0; r < 16; ++r) { p0[r] = NEG; p1[r] = NEG; } return; }
    p0 = f32x16{}; p1 = f32x16{};
    const char* kb[4];
#pragma unroll
    for (int dd = 0; dd < 4; ++dd) kb[dd] = K_lds + KB * SHM_K + KSWZ(r32, (dd * 16 + hi * 8) * 2);
#pragma unroll
    for (int d0 = 0; d0 < 8; ++d0) { const char* a = kb[d0 & 3] + (d0 >> 2) * 128;
        bf16x8 b0 = *reinterpret_cast<const bf16x8*>(a);
        bf16x8 b1 = *reinterpret_cast<const bf16x8*>(a + 32 * 256);
        p0 = __builtin_amdgcn_mfma_f32_32x32x16_bf16(b0, qr[d0], p0, 0, 0, 0);
        p1 = __builtin_amdgcn_mfma_f32_32x32x16_bf16(b1, qr[d0], p1, 0, 0, 0); }
}
template <int VB, bool SK>
__device__ __forceinline__ void pv_tile(f32x16* o, int vb0, bf16x8 pa0, bf16x8 pa1, bf16x8 pa2, bf16x8 pa3, bool act) {
    if (SK && !act) return;
#define TRRD(dst, off) asm volatile("ds_read_b64_tr_b16 %0, %1 offset:%2" : "=&v"(dst) : "v"(vb0), "i"(off) : "memory")
#define PV_D0(d0) do { s16x4 l0, l1, l2, l3, h0, h1, h2, h3; constexpr int b_ = VB * SHM_V + v_rd_off(d0, 0, 0);     \
        TRRD(l0, b_); TRRD(h0, b_ + 2048); TRRD(l1, b_ + 4096); TRRD(h1, b_ + 6144); TRRD(l2, b_ + 8192); TRRD(h2, b_ + 10240); TRRD(l3, b_ + 12288); TRRD(h3, b_ + 14336); \
        asm volatile("s_waitcnt lgkmcnt(0)" ::: "memory"); SBAR();                 \
        o[d0] = __builtin_amdgcn_mfma_f32_32x32x16_bf16(pa0, (bf16x8){l0[0], l0[1], l0[2], l0[3], h0[0], h0[1], h0[2], h0[3]}, o[d0], 0, 0, 0);   \
        o[d0] = __builtin_amdgcn_mfma_f32_32x32x16_bf16(pa1, (bf16x8){l1[0], l1[1], l1[2], l1[3], h1[0], h1[1], h1[2], h1[3]}, o[d0], 0, 0, 0);   \
        o[d0] = __builtin_amdgcn_mfma_f32_32x32x16_bf16(pa2, (bf16x8){l2[0], l2[1], l2[2], l2[3], h2[0], h2[1], h2[2], h2[3]}, o[d0], 0, 0, 0);   \
        o[d0] = __builtin_amdgcn_mfma_f32_32x32x16_bf16(pa3, (bf16x8){l3[0], l3[1], l3[2], l3[3], h3[0], h3[1], h3[2], h3[3]}, o[d0], 0, 0, 0); } while (0)
    PV_D0(0); PV_D0(1); PV_D0(2); PV_D0(3);
#undef PV_D0
#undef TRRD
}

template <class TIn, class TOut> struct BlockRef { const TIn* Q; const TIn* K; const TIn* V; TOut* O; int P0; };
template <class TIn> struct Seam {
    int tid;
    bf16x8 qr[8];
    bf16x8 st_v0, st_v1, st_k0, st_k1; f32x4 sf0, sf1, sf2, sf3;
    f32x4 tq[16];
};
__device__ __forceinline__ int swa_jlo(int P0, int W) { const int lowk = P0 - W + 1; return lowk > 0 ? lowk / KVBLK : 0; }
#define ROW(p, k0, rr) ((p) + (size_t)((k0) + (rr)) * D + sc)
#define VMW() asm volatile("s_waitcnt vmcnt(0)" ::: "memory")
#define VMWN(n) asm volatile("s_waitcnt vmcnt(%0)" :: "i"(n) : "memory")
#define SLOAD_H(Kp, Vp, k0) do { S.st_v0 = load8<TIn>(ROW(Vp, k0, sr)); S.st_v1 = load8<TIn>(ROW(Vp, k0, 32 + sr));              \
                         S.st_k0 = load8<TIn>(ROW(Kp, k0, sr)); S.st_k1 = load8<TIn>(ROW(Kp, k0, 32 + sr)); } while (0)
#define SWRITE_HK(bf) do { *(bf16x8*)(K_lds + (bf) * SHM_K + kws) = S.st_k0; *(bf16x8*)(K_lds + (bf) * SHM_K + kws + 32 * 256) = S.st_k1; } while (0)
#define SWRITE_HV(bf) do { *(bf16x8*)(V_lds + (bf) * SHM_V + vst0) = S.st_v0; *(bf16x8*)(V_lds + (bf) * SHM_V + vst1) = S.st_v1; } while (0)
#define SWRITE_H(bf) do { SWRITE_HV(bf); SWRITE_HK(bf); } while (0)
#define SLOAD_F(p, k0) do { S.sf0 = *(const f32x4*)ROW(p, k0, sr); S.sf1 = *(const f32x4*)(ROW(p, k0, sr) + 4);                \
                            S.sf2 = *(const f32x4*)ROW(p, k0, 32 + sr); S.sf3 = *(const f32x4*)(ROW(p, k0, 32 + sr) + 4); } while (0)
#define SWRITE_KF(bf) do { *(bf16x8*)(K_lds + (bf) * SHM_K + kws) = pack8(S.sf0, S.sf1); *(bf16x8*)(K_lds + (bf) * SHM_K + kws + 32 * 256) = pack8(S.sf2, S.sf3); } while (0)
#define SWRITE_VF(bf) do { *(bf16x8*)(V_lds + (bf) * SHM_V + vst0) = pack8(S.sf0, S.sf1); *(bf16x8*)(V_lds + (bf) * SHM_V + vst1) = pack8(S.sf2, S.sf3); } while (0)
template <class TIn, class TOut>
__device__ __forceinline__ void causal_swa_prime(const BlockRef<TIn, TOut>& cur, int W, char* lds, Seam<TIn>& S) {
    constexpr bool F32 = same_t<TIn, float>::v;
    const int tid = S.tid, wid = __builtin_amdgcn_readfirstlane(tid >> 6), lane = tid & 63, r32 = lane & 31, hi = lane >> 5;
    const int sr = tid >> 4, sc = (tid & 15) * 8, kws = KSWZ(sr, sc * 2); char* K_lds = lds + 2 * SHM_V;
    const int kb0 = swa_jlo(cur.P0, W) * KVBLK;
    for (int d0 = 0; d0 < 8; ++d0) S.qr[d0] = load8<TIn>(cur.Q + (size_t)(wid * QBLK + r32) * D + d0 * 16 + hi * 8);
    if constexpr (F32) { SLOAD_F((const float*)cur.K, kb0); VMW(); SWRITE_KF(0); SBAR(); SLOAD_F((const float*)cur.V, kb0); }
    else { SLOAD_H(cur.K, cur.V, kb0); VMW(); SWRITE_HK(0); }
    __syncthreads();
}
template <class TIn, class TOut>
__device__ __forceinline__ void causal_swa_block(const BlockRef<TIn, TOut>& cur, const BlockRef<TIn, TOut>& nxt, int skv, int W, char* lds, Seam<TIn>& S) {
    constexpr bool F32 = same_t<TIn, float>::v;
    const int tid = S.tid, wid = __builtin_amdgcn_readfirstlane(tid >> 6), lane = tid & 63, r32 = lane & 31, hi = lane >> 5;
    const int j_lo = swa_jlo(cur.P0, W);
    int j_hi = (cur.P0 + QB - 1) / KVBLK + 1; if (j_hi > skv / KVBLK) j_hi = skv / KVBLK;
    const int NT = j_hi - j_lo;
    const int kbn = swa_jlo(nxt.P0, W) * KVBLK;
    const int qlo = cur.P0 + wid * QBLK, qm = qlo + r32 - 4 * hi;
    char* V_lds = lds; char* K_lds = lds + 2 * SHM_V;
    float* ws = (float*)(lds + 2 * SHM_V + 2 * SHM_K) + wid * 64; float* li_l = ws, * al_l = ws + 32;
    float m_reg = -1e30f, l_reg = 0; f32x16 o[4] = {};
    const int sr = tid >> 4, sc = (tid & 15) * 8, vst0 = v_st(sr, sc), vst1 = v_st(32 + sr, sc), kws = KSWZ(sr, sc * 2);
    const int vb0 = (int)(uintptr_t)V_lds + v_rd_base(lane);
    const TIn* Kh = cur.K; const TIn* Vh = cur.V;
#define RESC(a) do { if (__any((a) < 1.f)) { if (hi == 0) al_l[r32] = (a); asm volatile("s_waitcnt lgkmcnt(0)" ::: "memory");              \
                     for (int d_ = 0; d_ < 4; ++d_) for (int r = 0; r < 16; ++r) o[d_][r] *= al_l[crow(r, hi)]; } } while (0)
#define KBASE(t) ((j_lo + (t)) * KVBLK)
#define ACT(t) (KBASE(t) <= qlo + QBLK - 1 && KBASE(t) + KVBLK - 1 >= qlo - W + 1)
#define MASKT(P0_, P1_, t) do { const int kb_ = KBASE(t); if ((!SK || ACT(t)) && (kb_ + KVBLK - 1 > qlo || kb_ <= qlo + QBLK - 1 - W)) mask_tile(P0_, P1_, qm - kb_, (unsigned)W); } while (0)
    constexpr int NQL = F32 ? 16 : 8;
    constexpr bool SK = WSKIP && !F32;
#define SEAM_K0() do { VMWN(NQL); if constexpr (F32) { SWRITE_KF(0); SBAR(); SLOAD_F((const float*)nxt.V, kbn); } else { SWRITE_HK(0); } SBAR(); } while (0)
    f32x16 pA0, pA1, pB0, pB1; float mnA, mnB, alA, alB; bf16x8 pa0, pa1, pa2, pa3;
    if constexpr (F32) { VMW(); SWRITE_VF(0); SBAR(); } else { SWRITE_HV(0); SBAR(); }
    if (NT > 1) { if constexpr (F32) SLOAD_F((const float*)Kh, KBASE(1)); else SLOAD_H(Kh, Vh, KBASE(1)); }
    SBAR(); qkt<0, SK>(pA0, pA1, K_lds, r32, hi, S.qr, ACT(0));
    if constexpr (F32) { if (NT > 1) { VMW(); SWRITE_KF(1); SBAR(); SLOAD_F((const float*)Vh, KBASE(1)); } }
    MASKT(pA0, pA1, 0); partialSM(pA0, pA1, m_reg, mnA, alA);
    if (NT > 1) { VMW(); if constexpr (F32) { SWRITE_VF(1); SBAR(); if (NT > 2) SLOAD_F((const float*)Kh, KBASE(2)); } else SWRITE_H(1); }
    __syncthreads();
#define HALF_STEP(PX0, PX1, mnX, alX, PY0, PY1, alY, t, KB, VB, SB) do {                                                      \
        SBAR(); qkt<KB, SK>(PX0, PX1, K_lds, r32, hi, S.qr, ACT(t));                                             \
        finishSM(PY0, PY1, alY, l_reg, pa0, pa1, pa2, pa3); SBAR();                                                           \
        if ((t) + 1 < NT) { if constexpr (F32) { VMW(); SWRITE_KF(SB); SBAR(); SLOAD_F((const float*)Vh, KBASE((t) + 1)); }  \
                            else { SLOAD_H(Kh, Vh, KBASE((t) + 1)); } SBAR(); }                                               \
        pv_tile<VB, SK>(o, vb0, pa0, pa1, pa2, pa3, ACT((t) - 1)); MASKT(PX0, PX1, (t)); partialSM(PX0, PX1, m_reg, mnX, alX);                                        \
        __syncthreads();                                                                                                      \
        if ((t) + 1 < NT) { VMW(); if constexpr (F32) { SWRITE_VF(SB); SBAR(); if ((t) + 2 < NT) SLOAD_F((const float*)Kh, KBASE((t) + 2)); } \
                            else { SWRITE_H(SB); } }                                                                          \
        RESC(alX); __syncthreads(); } while (0)
    for (int t = 1; t + 1 < NT; t += 2) {
        HALF_STEP(pB0, pB1, mnB, alB, pA0, pA1, alA, t, 1, 0, 0);
        HALF_STEP(pA0, pA1, mnA, alA, pB0, pB1, alB, t + 1, 0, 1, 1);
    }
    const bool even = (NT & 1) == 0;
    if (even) { SBAR(); qkt<1, SK>(pB0, pB1, K_lds, r32, hi, S.qr, ACT(NT - 1)); SBAR(); }
#define QROW(e) (nxt.Q + (size_t)(wid * QBLK + r32) * D + ((e) >> 1) * 16 + hi * 8 + ((e) & 1) * 4)
    if constexpr (F32) { SLOAD_F((const float*)nxt.K, kbn); SBAR();
#pragma unroll
        for (int e = 0; e < 8; ++e) S.tq[e] = *(const f32x4*)QROW(e); }
    else { SLOAD_H(nxt.K, nxt.V, kbn); SBAR();
#pragma unroll
        for (int d0 = 0; d0 < 8; ++d0) S.qr[d0] = load8<TIn>(nxt.Q + (size_t)(wid * QBLK + r32) * D + d0 * 16 + hi * 8); }
    SBAR();
    finishSM(pA0, pA1, alA, l_reg, pa0, pa1, pa2, pa3); SBAR();
    if constexpr (F32) {
#pragma unroll
        for (int e = 8; e < 16; ++e) S.tq[e] = *(const f32x4*)QROW(e); SBAR(); }
#undef QROW
    pv_tile<0, SK>(o, vb0, pa0, pa1, pa2, pa3, ACT(even ? NT - 2 : NT - 1));
    if (even) { MASKT(pB0, pB1, NT - 1); partialSM(pB0, pB1, m_reg, mnB, alB); __syncthreads(); RESC(alB);
        finishSM(pB0, pB1, alB, l_reg, pa0, pa1, pa2, pa3); SBAR(); pv_tile<1, SK>(o, vb0, pa0, pa1, pa2, pa3, ACT(NT - 1)); }
    SBAR(); SEAM_K0();
    if (hi == 0) { li_l[r32] = l_reg; ((float*)(lds + LSE_LDS_OFF))[wid * QBLK + r32] = m_reg * SCALE + __logf(l_reg); } asm volatile("s_waitcnt lgkmcnt(0)" ::: "memory");
    float rli[16];
#pragma unroll
    for (int r = 0; r < 16; ++r) rli[r] = __builtin_amdgcn_rcpf(li_l[crow(r, hi)]);
    TOut* Ow = cur.O + (size_t)(wid * QBLK) * D + (size_t)(hi * 4) * D + r32;
#pragma unroll
    for (int r = 0; r < 16; ++r) { const int orow = (r & 3) + 8 * (r >> 2);
#pragma unroll
        for (int d0 = 0; d0 < 4; ++d0) { const float v = o[d0][r] * rli[r];
            if constexpr (same_t<TOut, float>::v) { Ow[orow * D + d0 * 32] = v; }
            else { const float vn = __shfl_xor(v, 1);
                   if ((r32 & 1) == 0) *(unsigned*)(Ow + orow * D + d0 * 32) = cvtpk(v, vn); } } }
    if constexpr (F32) {
#pragma unroll
        for (int d0 = 0; d0 < 8; ++d0) S.qr[d0] = pack8(S.tq[2 * d0], S.tq[2 * d0 + 1]); }
    __syncthreads();
#undef RESC
#undef KBASE
#undef ACT
#undef MASKT
#undef SEAM_K0
#undef HALF_STEP
}
#undef ROW
#undef VMW
#undef VMWN
#undef SLOAD_H
#undef SWRITE_HK
#undef SWRITE_HV
#undef SWRITE_H
#undef SLOAD_F
#undef SWRITE_KF
#undef SWRITE_VF
}
constexpr int T_TOK = 32768, DMODEL = 1024, SEQ = 16384, DFF = 3584, NEXP = 8;
constexpr float ALPHA = 1.6817928305074290f, LN_EPS = 1e-5f;
constexpr int NWAVES = 8;
constexpr size_t MiB = 1u << 20;
constexpr size_t WS_CTL = 0, CTL_ZERO_BYTES = 1 * MiB;
constexpr size_t WS_WIN = 2 * MiB, WS_WRO = 26 * MiB, WS_WQKV = 34 * MiB, WS_WAO = 52 * MiB, WS_WGU = 54 * MiB, WS_WDN = 82 * MiB;
constexpr size_t WS_TAB = 96 * MiB, WS_XB = 112 * MiB;
constexpr size_t WS_LIST = 176 * MiB, WS_TSLOT = 178 * MiB, WS_GATE = 178 * MiB + 256 * 1024, WS_LC = 178 * MiB + 512 * 1024;
constexpr size_t WS_BIG = 179 * MiB;
constexpr size_t BIG_QD = 0, BIG_KH = 64 * MiB, BIG_VT = 128 * MiB, BIG_G = 256 * MiB, BIG_RT = 384 * MiB;
constexpr size_t BIG_HID = 0;
constexpr size_t BIG_QKV = 0, BIG_OP = 288 * MiB, BIG_LSE = 384 * MiB, BIG_O = 386 * MiB;
constexpr size_t BIG_YP = 462 * MiB, BIG_WMGU = 594 * MiB, BIG_WMD = 706 * MiB;
constexpr size_t WS_SLAB = WS_BIG + 762 * MiB;
constexpr size_t WS_END = WS_SLAB + 32 * MiB;
constexpr int CW_TMO = 0, CW_BAR = 4096, CW_CNT = 8192;
constexpr int RING_OFF = 0, RING_BYTES = 131072, AUX_OFF = 131072, AUX_BYTES = 30720, MISC_OFF = AUX_OFF + AUX_BYTES, LDS_BYTES = MISC_OFF + 512;
static_assert(LDS_BYTES <= 163840, "LDS");

#define GAS __attribute__((address_space(1)))
#define LAS __attribute__((address_space(3)))
typedef unsigned short bf16;
typedef unsigned v4u __attribute__((ext_vector_type(4)));
typedef unsigned v2u __attribute__((ext_vector_type(2)));
typedef float f32x4 __attribute__((ext_vector_type(4)));
typedef float f32x16 __attribute__((ext_vector_type(16)));
typedef short bf16x8 __attribute__((ext_vector_type(8)));
typedef short s16x4 __attribute__((ext_vector_type(4)));
typedef GAS unsigned gu32;
#define RLX_AGENT __ATOMIC_RELAXED, __HIP_MEMORY_SCOPE_AGENT
#define LDS_WAIT() asm volatile("s_waitcnt lgkmcnt(0)" ::: "memory")
#define VM_WAIT() asm volatile("s_waitcnt vmcnt(0)" ::: "memory")
__device__ __forceinline__ unsigned f2bf(float f) { unsigned u = __builtin_bit_cast(unsigned, f); return (u + 0x7fffu + ((u >> 16) & 1u)) >> 16; }
__device__ __forceinline__ unsigned pk2(float lo, float hi) { return f2bf(lo) | (f2bf(hi) << 16); }
__device__ __forceinline__ float bflo(unsigned w) { return __builtin_bit_cast(float, w << 16); }
__device__ __forceinline__ float bfhi(unsigned w) { return __builtin_bit_cast(float, w & 0xffff0000u); }
#define XB_TMO      128
#define XB_XCNT(j)  (256  + 64 * (j))
#define XB_XSUB(j)  (1280 + 64 * (j))
#define XB_XGEN(j)  (2304 + 64 * (j))
#define XB_TOP      3328
#define XB_TOPGEN   3392
#define XCD_BAR_WORDS 3456
#define XB_SPIN_CAP (1u << 18)

__device__ __forceinline__ unsigned xb_ld(unsigned* p)              { return __hip_atomic_load(p, __ATOMIC_RELAXED, __HIP_MEMORY_SCOPE_AGENT); }
__device__ __forceinline__ unsigned xb_add(unsigned* p, unsigned v) { return __hip_atomic_fetch_add(p, v, __ATOMIC_RELAXED, __HIP_MEMORY_SCOPE_AGENT); }
__device__ __forceinline__ unsigned xb_xcc_id() { return (unsigned)__builtin_amdgcn_s_getreg((3 << 11) | 20) & 0xFu; }
#define XB_SPIN(cond, bar) do { unsigned _sp = 0; while (cond) { __builtin_amdgcn_s_sleep(1); \
    if ((++_sp & 255u) == 0u) { if (xb_ld(&(bar)[XB_TMO])) break; if (_sp > XB_SPIN_CAP) { atomicAdd(&(bar)[XB_TMO], 1u); break; } } } } while (0)

struct XcdBarrier {
    unsigned* bar; unsigned x;
    volatile LAS unsigned* st;
};

__device__ __forceinline__ XcdBarrier xcd_barrier_post(unsigned* bar, volatile LAS unsigned* st) {
    XcdBarrier b; b.bar = bar; b.x = xb_xcc_id(); b.st = st;
    if (threadIdx.x == 0) (void)xb_add(&bar[XB_XCNT(b.x)], 1u);
    return b;
}
__device__ __forceinline__ void xcd_barrier_complete(unsigned* bar, unsigned x, unsigned& nloc, unsigned& nx) {
    const unsigned G = gridDim.x * gridDim.y * gridDim.z;
    unsigned sum, cnt, mine, sp = 0u;
    for (;;) {
        sum = 0u; cnt = 0u; mine = 0u;
#pragma unroll
        for (unsigned j = 0; j < 16; ++j) { const unsigned c = xb_ld(&bar[XB_XCNT(j)]); sum += c; cnt += (c > 0u) ? 1u : 0u; mine = (j == x) ? c : mine; }
        if (sum == G) break;
        __builtin_amdgcn_s_sleep(1);
        if ((++sp & 255u) == 0u) { if (xb_ld(&bar[XB_TMO])) break; if (sp > XB_SPIN_CAP) { atomicAdd(&bar[XB_TMO], 1u); break; } }
    }
    nloc = mine > 0u ? mine : 1u; nx = cnt > 0u ? cnt : 1u;
}

__device__ __forceinline__ void xcd_barrier(const XcdBarrier& b) {
    asm volatile("s_waitcnt vmcnt(0)" ::: "memory");
    __syncthreads();
    if (threadIdx.x == 0) {
        unsigned* bar = b.bar;
        __builtin_amdgcn_s_waitcnt(0);
        unsigned nloc = b.st[0], nx = b.st[1];
        if (nloc == 0u) { xcd_barrier_complete(bar, b.x, nloc, nx); b.st[0] = nloc; b.st[1] = nx; }
        const unsigned old = xb_add(&bar[XB_XSUB(b.x)], 1u);
        const unsigned gen = old / nloc;
        if (old + 1u == (gen + 1u) * nloc) {
            __builtin_amdgcn_fence(__ATOMIC_RELEASE, "agent");
            asm volatile("s_waitcnt vmcnt(0)" ::: "memory");
            const unsigned og = xb_add(&bar[XB_TOP], 1u);
            const unsigned tg = og / nx;
            if (og + 1u == (tg + 1u) * nx) xb_add(&bar[XB_TOPGEN], 1u);
            else XB_SPIN(xb_ld(&bar[XB_TOPGEN]) == tg, bar);
            __builtin_amdgcn_fence(__ATOMIC_ACQUIRE, "agent");
            xb_add(&bar[XB_XGEN(b.x)], 1u);
            asm volatile("s_waitcnt vmcnt(0)" ::: "memory");
        } else {
            XB_SPIN(xb_ld(&bar[XB_XGEN(b.x)]) == gen, bar);
            __builtin_amdgcn_fence(__ATOMIC_ACQUIRE, "agent");
            asm volatile("s_waitcnt vmcnt(0)" ::: "memory");
        }
    }
    __syncthreads();
}
struct Args { const float* in[15]; float* out; unsigned char* ws; };
struct Frame {
    LAS unsigned char* lds;
    volatile LAS unsigned* MISC;
    int tid, lane, wave, G, c;
};
__device__ __forceinline__ unsigned long long arg_u64(const Frame& F, int k) { const unsigned long long v = ((const LAS unsigned long long*)(F.lds + MISC_OFF + 128))[k];
    return ((unsigned long long)(unsigned)__builtin_amdgcn_readfirstlane((int)(unsigned)(v >> 32)) << 32) | (unsigned long long)(unsigned)__builtin_amdgcn_readfirstlane((int)(unsigned)v); }
#define ARGI(F, k) ((const float*)(const GAS float*)arg_u64(F, (k)))
#define ARGX(F) ((float*)(GAS float*)arg_u64(F, 15))
#define ARGWS(F) ((unsigned char*)(GAS unsigned char*)arg_u64(F, 16))
#define F_CTL(F) ((gu32*)(ARGWS(F) + WS_CTL))
__device__ __forceinline__ void frame_refresh(Frame& F) { int t = F.tid; asm volatile("" : "+v"(t)); F.tid = t; F.lane = t & 63; F.wave = __builtin_amdgcn_readfirstlane(t >> 6); unsigned l = (unsigned)(uintptr_t)F.lds; int c_ = F.c, g_ = F.G; asm volatile("" : "+s"(l), "+s"(c_), "+s"(g_)); F.lds = (LAS unsigned char*)(uintptr_t)l; F.c = c_; F.G = g_; }
__device__ __forceinline__ float wave_sum(float v) {
#pragma unroll
    for (int o = 1; o < 64; o <<= 1) v += __shfl_xor(v, o);
    return v;
}
__device__ __forceinline__ s16x4 vtr(const LAS unsigned char* p) { return __builtin_bit_cast(s16x4, __builtin_amdgcn_ds_read_tr16_b64_v4i16((LAS s16x4*)p)); }
__device__ __forceinline__ int crow(int r, int hi) { return (r & 3) + 8 * (r >> 2) + 4 * hi; }

struct CvItem { const float* src; bf16* dst; int N, K; };
template <int MAP> __device__ __forceinline__ CvItem cv_make(const float* W, int K, int N, bf16* WT, int item) {
    const int nblk = N / 64, kb = item / nblk, nb = item - kb * nblk, n0 = 64 * nb; int dr = n0;
    if (MAP == 1) dr = n0 < 2048 ? n0 : (n0 < 4096 ? n0 + 2048 : n0 - 2048);
    if (MAP == 2) dr = (n0 >> 7) * 256 + (n0 & 127);
    if (MAP == 3) dr = (n0 >> 7) * 256 + 128 + (n0 & 127);
    CvItem c; c.src = W + (size_t)(64 * kb) * N + n0; c.dst = WT + (size_t)dr * K + 64 * kb; c.N = N; c.K = K; return c;
}
__device__ __forceinline__ void cv_load(const CvItem& c, f32x4 (&r)[16], int lane) {
    const float* p = c.src + (size_t)(lane >> 4) * c.N + 4 * (lane & 15);
#pragma unroll
    for (int i = 0; i < 16; ++i) r[i] = *(const GAS f32x4*)(p + (size_t)(4 * i) * c.N);
}
__device__ __forceinline__ void cv_store(const CvItem& c, const f32x4 (&r)[16], LAS float* scr, int lane) {
#pragma unroll
    for (int i = 0; i < 16; ++i) { LAS float* s = scr + (4 * i + (lane >> 4)) * 65 + 4 * (lane & 15); s[0] = r[i].x; s[1] = r[i].y; s[2] = r[i].z; s[3] = r[i].w; }
    LDS_WAIT(); asm volatile("" ::: "memory");
    const int ch = lane & 7;
#pragma unroll
    for (int jj = 0; jj < 8; ++jj) { const int n = (lane >> 3) + 8 * jj; const LAS float* s = scr + (8 * ch) * 65 + n;
        v4u o; o.x = pk2(s[0 * 65], s[1 * 65]); o.y = pk2(s[2 * 65], s[3 * 65]); o.z = pk2(s[4 * 65], s[5 * 65]); o.w = pk2(s[6 * 65], s[7 * 65]);
        *(GAS v4u*)(c.dst + (size_t)n * c.K + 8 * ch) = o; }
    LDS_WAIT(); asm volatile("" ::: "memory");
}
constexpr int CV_SCR_BYTES = 64 * 65 * 4;
__device__ __forceinline__ CvItem cv_dense(Frame& F, int it) {
    constexpr int I_WIN = 16 * 96, I_WRO = 32 * 16, I_QKV = 16 * 72, I_WAO = 8 * 16, I_GU = 16 * 56, I_DN = 56 * 16;
    constexpr int PERJ = I_WIN + I_WRO + I_QKV + I_WAO + 2 * I_GU + I_DN;
    const int j = it / PERJ; int r = it - j * PERJ;
    if (r < I_WIN) return cv_make<1>(ARGI(F, 3) + (size_t)j * 1024 * 6144, 1024, 6144, (bf16*)(ARGWS(F) + WS_WIN) + (size_t)j * 6144 * 1024, r); r -= I_WIN;
    if (r < I_WRO) return cv_make<0>(ARGI(F, 5) + (size_t)j * 2048 * 1024, 2048, 1024, (bf16*)(ARGWS(F) + WS_WRO) + (size_t)j * 1024 * 2048, r); r -= I_WRO;
    if (r < I_QKV) return cv_make<0>(ARGI(F, 6) + (size_t)j * 1024 * 4608, 1024, 4608, (bf16*)(ARGWS(F) + WS_WQKV) + (size_t)j * 4608 * 1024, r); r -= I_QKV;
    if (r < I_WAO) return cv_make<0>(ARGI(F, 7) + (size_t)j * 512 * 1024, 512, 1024, (bf16*)(ARGWS(F) + WS_WAO) + (size_t)j * 1024 * 512, r); r -= I_WAO;
    if (r < I_GU) return cv_make<2>(ARGI(F, 8) + (size_t)j * 1024 * 3584, 1024, 3584, (bf16*)(ARGWS(F) + WS_WGU) + (size_t)j * 7168 * 1024, r); r -= I_GU;
    if (r < I_GU) return cv_make<3>(ARGI(F, 9) + (size_t)j * 1024 * 3584, 1024, 3584, (bf16*)(ARGWS(F) + WS_WGU) + (size_t)j * 7168 * 1024, r); r -= I_GU;
    return cv_make<0>(ARGI(F, 10) + (size_t)j * 3584 * 1024, 3584, 1024, (bf16*)(ARGWS(F) + WS_WDN) + (size_t)j * 1024 * 3584, r);
}
constexpr int CV_DENSE_ITEMS = 2 * (16 * 96 + 32 * 16 + 16 * 72 + 8 * 16 + 2 * 16 * 56 + 56 * 16);
__device__ __forceinline__ CvItem cv_moe(Frame& F, int it, int j) {
    constexpr int I_GU = 16 * 56, I_DN = 56 * 16, PERE = 2 * I_GU + I_DN;
    bf16* WMGU = (bf16*)(ARGWS(F) + WS_BIG + BIG_WMGU); bf16* WMD = (bf16*)(ARGWS(F) + WS_BIG + BIG_WMD);
    const int e = it / PERE; int r = it - e * PERE; const size_t wofs = ((size_t)j * NEXP + e) * 1024 * 3584;
    if (r < I_GU) return cv_make<2>(ARGI(F, 12) + wofs, 1024, 3584, WMGU + (size_t)e * 7168 * 1024, r); r -= I_GU;
    if (r < I_GU) return cv_make<3>(ARGI(F, 13) + wofs, 1024, 3584, WMGU + (size_t)e * 7168 * 1024, r); r -= I_GU;
    return cv_make<0>(ARGI(F, 14) + wofs, 3584, 1024, WMD + (size_t)e * 1024 * 3584, r);
}
constexpr int CV_MOE_ITEMS = NEXP * (2 * 16 * 56 + 56 * 16);
template <bool MOE> __device__ __forceinline__ void cv_run(Frame& F, int first, int stride, int total, int j) {
    LAS float* scr = (LAS float*)(F.lds + RING_OFF + F.wave * CV_SCR_BYTES);
    if (first >= total) return;
    f32x4 ra[16], rb[16];
    CvItem ca = MOE ? cv_moe(F, first, j) : cv_dense(F, first), cb = ca;
    cv_load(ca, ra, F.lane);
    for (int it = first; it < total; it += 2 * stride) {
        const bool hb = it + stride < total;
        if (hb) { cb = MOE ? cv_moe(F, it + stride, j) : cv_dense(F, it + stride); cv_load(cb, rb, F.lane); }
        cv_store(ca, ra, scr, F.lane);
        if (!hb) break;
        const bool ha = it + 2 * stride < total;
        if (ha) { ca = MOE ? cv_moe(F, it + 2 * stride, j) : cv_dense(F, it + 2 * stride); cv_load(ca, ra, F.lane); }
        cv_store(cb, rb, scr, F.lane);
        if (!ha) break;
    }
}
__device__ __forceinline__ void p0_prologue(Frame& F) {
    const int gw = F.c * NWAVES + F.wave, NGW = F.G * NWAVES;
    cv_run<false>(F, gw, NGW, CV_DENSE_ITEMS, 0);
    { float* tab = (float*)(ARGWS(F) + WS_TAB); const int gt = F.c * 512 + F.tid, NT = F.G * 512;
      for (int e = gt; e < SEQ * 128; e += NT) { const int pos = e >> 7, cc = e & 127;
          const double ang = (double)pos * exp(-9.210340371976184 * (double)cc * (1.0 / 128.0)); double sn, cs; sincos(ang, &sn, &cs);
          typedef float f32x2t __attribute__((ext_vector_type(2))); *(GAS f32x2t*)(tab + (size_t)e * 2) = (f32x2t){(float)cs, (float)sn}; } }
    { const float* x = ARGI(F, 0); bf16* XB = (bf16*)(ARGWS(F) + WS_XB);
      for (int m0 = gw; m0 < T_TOK; m0 += 4 * NGW) { f32x4 xv[4][4];
#pragma unroll
          for (int r = 0; r < 4; ++r) { const int m = m0 + r * NGW < T_TOK ? m0 + r * NGW : gw; const GAS f32x4* xr = (const GAS f32x4*)(x + (size_t)m * DMODEL) + F.lane;
#pragma unroll
              for (int jj = 0; jj < 4; ++jj) xv[r][jj] = xr[64 * jj]; }
#pragma unroll
          for (int r = 0; r < 4; ++r) { const int m = m0 + r * NGW; if (m >= T_TOK) break; GAS unsigned long long* o8 = (GAS unsigned long long*)(XB + (size_t)m * DMODEL) + F.lane;
#pragma unroll
              for (int jj = 0; jj < 4; ++jj) { const f32x4 v = xv[r][jj]; o8[64 * jj] = (unsigned long long)pk2(v.x, v.y) | ((unsigned long long)pk2(v.z, v.w) << 32); } } } }
}
template <bool SUB> __device__ __forceinline__ void moe_convert(Frame& F, int j) {
    if (SUB && ((F.c >> 3) & 3) != 0) return;
    const int gw = (SUB ? ((F.c >> 5) * 8 + (F.c & 7)) : F.c) * NWAVES + F.wave, NGW = (SUB ? 64 : F.G) * NWAVES;
    cv_run<true>(F, gw, NGW, CV_MOE_ITEMS, j);
}
__device__ __forceinline__ void moe_prefix_lds(Frame& F, LAS int* PB) {
    const int* LC = (const int*)(ARGWS(F) + WS_LC);
    for (int i = F.tid; i < 2048; i += 512) PB[i] = LC[i];
    __syncthreads();
    { const int e = F.wave, l = F.lane;
      const int v0 = PB[(4 * l) * 8 + e], v1 = PB[(4 * l + 1) * 8 + e], v2 = PB[(4 * l + 2) * 8 + e], v3 = PB[(4 * l + 3) * 8 + e];
      const int tot = v0 + v1 + v2 + v3; int inc = tot;
#pragma unroll
      for (int o = 1; o < 64; o <<= 1) { const int t = __shfl_up(inc, o); inc += (l >= o) ? t : 0; }
      const int ex = inc - tot;
      PB[(4 * l) * 8 + e] = ex; PB[(4 * l + 1) * 8 + e] = ex + v0; PB[(4 * l + 2) * 8 + e] = ex + v0 + v1; PB[(4 * l + 3) * 8 + e] = ex + v0 + v1 + v2;
      if (l == 63) PB[2048 + e] = inc; }
    __syncthreads();
}
__device__ __forceinline__ void unpack8(const v4u w, float (&v)[8]) { v[0] = bflo(w.x); v[1] = bfhi(w.x); v[2] = bflo(w.y); v[3] = bfhi(w.y); v[4] = bflo(w.z); v[5] = bfhi(w.z); v[6] = bflo(w.w); v[7] = bfhi(w.w); }
template <int MODE, bool FINAL> __device__ __forceinline__ void ln_pass(Frame& F, int li  , int sub  , int j) {
    const int gw = F.c * NWAVES + F.wave, NGW = F.G * NWAVES;
    const float* gain = ARGI(F, 1) + (size_t)(li * 2 + sub) * DMODEL; const float* bias = ARGI(F, 2) + (size_t)(li * 2 + sub) * DMODEL;
    float gv[2][8], bv[2][8];
#pragma unroll
    for (int q = 0; q < 2; ++q)
#pragma unroll
        for (int h2 = 0; h2 < 2; ++h2) { const f32x4 g4 = *(const GAS f32x4*)(gain + 512 * q + 8 * F.lane + 4 * h2), b4 = *(const GAS f32x4*)(bias + 512 * q + 8 * F.lane + 4 * h2);
#pragma unroll
            for (int k = 0; k < 4; ++k) { gv[q][4 * h2 + k] = g4[k]; bv[q][4 * h2 + k] = b4[k]; } }
    bf16* XB = (bf16*)(ARGWS(F) + WS_XB);
    int rtb[8]; LAS int* PB = (LAS int*)(F.lds + RING_OFF);
    if (MODE == 2) { moe_prefix_lds(F, PB); int acc = 0;
#pragma unroll
        for (int e = 0; e < 8; ++e) { rtb[e] = acc; acc += (PB[2048 + e] + 255) >> 8; } }
    const unsigned* tslot = (const unsigned*)(ARGWS(F) + WS_TSLOT); const float* gate = (const float*)(ARGWS(F) + WS_GATE); const bf16* YP = (const bf16*)(ARGWS(F) + WS_BIG + BIG_YP);
    for (int m0 = gw; m0 < T_TOK; m0 += 4 * NGW) {
        v4u zr[4][2]; unsigned ts[4][2]; float gk[4][2]; v4u yv[4][2][2]; int yrow[4][2];
#pragma unroll
        for (int r = 0; r < 4; ++r) { const int m = m0 + r * NGW; const bool ok = m < T_TOK; const int mm = ok ? m : gw;
            const GAS v4u* xr = (const GAS v4u*)(XB + (size_t)mm * DMODEL) + F.lane; zr[r][0] = xr[0]; zr[r][1] = xr[64];
            if (MODE == 2) { ts[r][0] = tslot[2 * mm]; ts[r][1] = tslot[2 * mm + 1]; gk[r][0] = gate[2 * mm]; gk[r][1] = gate[2 * mm + 1]; } }
        if (MODE == 2) {
#pragma unroll
            for (int r = 0; r < 4; ++r) { const int m = m0 + r * NGW; const int mm = m < T_TOK ? m : gw;
#pragma unroll
                for (int k2 = 0; k2 < 2; ++k2) { const int e = (int)(ts[r][k2] >> 20), slot = PB[(mm >> 7) * 8 + e] + (int)(ts[r][k2] & 0xfffffu);
                    int rb = 0;
#pragma unroll
                    for (int q = 0; q < 8; ++q) rb = (q == e) ? rtb[q] : rb;
                    yrow[r][k2] = rb * 256 + slot;
                    const GAS v4u* yr = (const GAS v4u*)(YP + (size_t)(yrow[r][k2] < 65536 ? yrow[r][k2] : 0) * DMODEL) + F.lane; yv[r][k2][0] = yr[0]; yv[r][k2][1] = yr[64]; } } }
#pragma unroll
        for (int r = 0; r < 4; ++r) { const int m = m0 + r * NGW; if (m >= T_TOK) break;
            float v[2][8]; float s = 0.f;
#pragma unroll
            for (int q = 0; q < 2; ++q) unpack8(zr[r][q], v[q]);
            if (MODE == 2) {
#pragma unroll
                for (int q = 0; q < 2; ++q)
#pragma unroll
                    for (int k = 0; k < 8; ++k) v[q][k] *= ALPHA;
#pragma unroll
                for (int k2 = 0; k2 < 2; ++k2) { const float g_ = gk[r][k2];
                    if (yrow[r][k2] < 65536) {
#pragma unroll
                        for (int q = 0; q < 2; ++q) { float y[8]; unpack8(yv[r][k2][q], y);
#pragma unroll
                            for (int k = 0; k < 8; ++k) v[q][k] += g_ * y[k]; } }
                    else { const int lr = yrow[r][k2] - 65536, tl = lr >> 8, rr = lr & 255;
                        const float* SL = (const float*)(ARGWS(F) + WS_SLAB);
#pragma unroll
                        for (int q = 0; q < 2; ++q) { const int col = 512 * q + 8 * F.lane, ct = col >> 8, cc = col & 255;
#pragma unroll
                            for (int kp = 0; kp < 4; ++kp) { const GAS f32x4* sp = (const GAS f32x4*)(SL + ((size_t)(kp * 32 + tl * 4 + ct) << 16) + (size_t)rr * 256 + cc); const f32x4 a0 = sp[0], a1 = sp[1];
                                v[q][0] += g_ * a0.x; v[q][1] += g_ * a0.y; v[q][2] += g_ * a0.z; v[q][3] += g_ * a0.w; v[q][4] += g_ * a1.x; v[q][5] += g_ * a1.y; v[q][6] += g_ * a1.z; v[q][7] += g_ * a1.w; } } } }
            }
#pragma unroll
            for (int q = 0; q < 2; ++q)
#pragma unroll
                for (int k = 0; k < 8; ++k) s += v[q][k];
            const float mean = wave_sum(s) * (1.f / DMODEL); float s2 = 0.f;
#pragma unroll
            for (int q = 0; q < 2; ++q)
#pragma unroll
                for (int k = 0; k < 8; ++k) { v[q][k] -= mean; s2 += v[q][k] * v[q][k]; }
            const float rstd = 1.f / sqrtf(wave_sum(s2) * (1.f / DMODEL) + LN_EPS);
            GAS v4u* xw = (GAS v4u*)(XB + (size_t)m * DMODEL) + F.lane;
#pragma unroll
            for (int q = 0; q < 2; ++q) { float o[8];
#pragma unroll
                for (int k = 0; k < 8; ++k) o[k] = v[q][k] * rstd * gv[q][k] + bv[q][k];
                if (FINAL) { GAS f32x4* op = (GAS f32x4*)(ARGX(F) + (size_t)m * DMODEL + 512 * q + 8 * F.lane); op[0] = (f32x4){o[0], o[1], o[2], o[3]}; op[1] = (f32x4){o[4], o[5], o[6], o[7]}; }
                else { v4u w; w.x = pk2(o[0], o[1]); w.y = pk2(o[2], o[3]); w.z = pk2(o[4], o[5]); w.w = pk2(o[6], o[7]); xw[64 * q] = w; } }
        }
    }
}
__device__ __forceinline__ void ln_route_pass(Frame& F, int li, int j) {
    const float* gain = ARGI(F, 1) + (size_t)(li * 2) * DMODEL; const float* bias = ARGI(F, 2) + (size_t)(li * 2) * DMODEL;
    LAS float* WRT = (LAS float*)(F.lds + RING_OFF);
    LAS float* SELG = (LAS float*)(F.lds + RING_OFF + 32768);
    LAS int* SELE = (LAS int*)(F.lds + RING_OFF + 32768 + 1024);
    const float* wr = ARGI(F, 11) + (size_t)j * DMODEL * NEXP;
    for (int i = F.tid; i < DMODEL * NEXP; i += 512) { const int d = i >> 3, e = i & 7; WRT[e * DMODEL + d] = wr[i]; }
    float gv[2][8], bv[2][8];
#pragma unroll
    for (int q = 0; q < 2; ++q)
#pragma unroll
        for (int h2 = 0; h2 < 2; ++h2) { const f32x4 g4 = *(const GAS f32x4*)(gain + 512 * q + 8 * F.lane + 4 * h2), b4 = *(const GAS f32x4*)(bias + 512 * q + 8 * F.lane + 4 * h2);
#pragma unroll
            for (int k = 0; k < 4; ++k) { gv[q][4 * h2 + k] = g4[k]; bv[q][4 * h2 + k] = b4[k]; } }
    bf16* XB = (bf16*)(ARGWS(F) + WS_XB);
    __syncthreads();
    const int ntok = T_TOK / F.G, tok0 = F.c * ntok;
    v4u znx[2]; { const GAS v4u* x0 = (const GAS v4u*)(XB + (size_t)(tok0 + F.wave) * DMODEL) + F.lane; znx[0] = x0[0]; znx[1] = x0[64]; }
    for (int tl = F.wave; tl < ntok; tl += NWAVES) { const int m = tok0 + tl;
        GAS v4u* xr = (GAS v4u*)(XB + (size_t)m * DMODEL) + F.lane;
        float v[2][8]; float s = 0.f;
        const v4u zc0 = znx[0], zc1 = znx[1];
        if (tl + NWAVES < ntok) { const GAS v4u* xn_ = (const GAS v4u*)(XB + (size_t)(m + NWAVES) * DMODEL) + F.lane; znx[0] = xn_[0]; znx[1] = xn_[64]; }
        unpack8(zc0, v[0]); unpack8(zc1, v[1]);
#pragma unroll
        for (int q = 0; q < 2; ++q)
#pragma unroll
            for (int k = 0; k < 8; ++k) s += v[q][k];
        const float mean = wave_sum(s) * (1.f / DMODEL); float s2 = 0.f;
#pragma unroll
        for (int q = 0; q < 2; ++q)
#pragma unroll
            for (int k = 0; k < 8; ++k) { v[q][k] -= mean; s2 += v[q][k] * v[q][k]; }
        const float rstd = 1.f / sqrtf(wave_sum(s2) * (1.f / DMODEL) + LN_EPS);
        float lg[8];
#pragma unroll
        for (int e = 0; e < 8; ++e) lg[e] = 0.f;
#pragma unroll
        for (int q = 0; q < 2; ++q) { float o[8];
#pragma unroll
            for (int k = 0; k < 8; ++k) o[k] = v[q][k] * rstd * gv[q][k] + bv[q][k];
            v4u w; w.x = pk2(o[0], o[1]); w.y = pk2(o[2], o[3]); w.z = pk2(o[4], o[5]); w.w = pk2(o[6], o[7]); xr[64 * q] = w;
#pragma unroll
            for (int e = 0; e < 8; ++e) { const f32x4 w0 = *(const LAS f32x4*)(WRT + e * DMODEL + 512 * q + 8 * F.lane), w1 = *(const LAS f32x4*)(WRT + e * DMODEL + 512 * q + 8 * F.lane + 4);
                lg[e] += ((o[0] * w0.x + o[1] * w0.y) + (o[2] * w0.z + o[3] * w0.w)) + ((o[4] * w1.x + o[5] * w1.y) + (o[6] * w1.z + o[7] * w1.w)); } }
#pragma unroll
        for (int e = 0; e < 8; ++e) lg[e] = wave_sum(lg[e]);
        int e1 = 0; float v1 = lg[0];
#pragma unroll
        for (int e = 1; e < 8; ++e) if (lg[e] > v1) { v1 = lg[e]; e1 = e; }
        int e2 = -1; float v2 = -3.0e38f;
#pragma unroll
        for (int e = 0; e < 8; ++e) if (e != e1 && lg[e] > v2) { v2 = lg[e]; e2 = e; }
        const float g1 = 1.f / (1.f + __expf(v2 - v1)), g2 = 1.f - g1;
        if (F.lane == 0) { SELE[2 * tl] = e1; SELE[2 * tl + 1] = e2; SELG[2 * tl] = g1; SELG[2 * tl + 1] = g2; }
    }
    __syncthreads();
    int myrank = 0, mye = 0;
    if (F.tid < 2 * ntok) { mye = SELE[F.tid];
        for (int i2 = 0; i2 < F.tid; ++i2) myrank += (SELE[i2] == mye) ? 1 : 0; }
    if (F.tid < 8) { int cnt = 0; for (int i2 = 0; i2 < 2 * ntok; ++i2) cnt += (SELE[i2] == F.tid) ? 1 : 0; ((int*)(ARGWS(F) + WS_LC))[F.c * 8 + F.tid] = cnt; }
    if (F.tid < 2 * ntok) { const int tok = tok0 + (F.tid >> 1);
        ((int*)(ARGWS(F) + WS_LIST))[(F.c * 8 + mye) * 256 + myrank] = tok;
        ((unsigned*)(ARGWS(F) + WS_TSLOT))[2 * tok + (F.tid & 1)] = ((unsigned)mye << 20) | (unsigned)myrank;
        ((float*)(ARGWS(F) + WS_GATE))[2 * tok + (F.tid & 1)] = SELG[F.tid]; }
    __syncthreads();
}
#define LDS_BAR() do { asm volatile("s_waitcnt lgkmcnt(0)" ::: "memory"); __builtin_amdgcn_s_barrier(); asm volatile("" ::: "memory"); } while (0)
__device__ __forceinline__ int off64(int row, int colbyte) { return row * 128 + (colbyte ^ ((((row >> 1) & 1) << 6) | (((row >> 3) & 1) << 5))); }
__device__ __forceinline__ float log2_gamma(int h) { return __builtin_amdgcn_logf(1.0f - __builtin_amdgcn_exp2f((float)(-5 - h))); }

__device__ __forceinline__ void ret_state_phase(Frame& F) {
    const int c = F.c; if (c >= 256) return;
    const int dt = c & 3, et = (c >> 2) & 7, h = (c >> 5) & 3, b = c >> 7;
    const int w = F.wave, lane = F.lane, dq = w & 3, eh = w >> 2, g = lane >> 4, l15 = lane & 15, q = l15 >> 2, p = l15 & 3;
    const bf16* KH = (const bf16*)(ARGWS(F) + WS_BIG + BIG_KH) + (size_t)b * SEQ * 1024 + h * 256 + dt * 64;
    const bf16* VT = (const bf16*)(ARGWS(F) + WS_BIG + BIG_VT) + ((size_t)((b * 4 + h) * 128) << 16);
    bf16* RT = (bf16*)(ARGWS(F) + WS_BIG + BIG_RT) + ((size_t)((b * 4 + h) * 128) << 17);
    const float dec = __builtin_amdgcn_exp2f(128.f * log2_gamma(h));
    const int r0 = F.tid >> 3, ch = F.tid & 7;
    const bf16* kp0 = KH + (size_t)r0 * 1024 + ch * 8; const bf16* kp1 = kp0 + (size_t)64 * 1024;
    const int lo0 = off64(r0, ch * 16), lo1 = off64(r0 + 64, ch * 16);
    int voff[4][2];
#pragma unroll
    for (int ks = 0; ks < 4; ++ks)
#pragma unroll
        for (int x = 0; x < 2; ++x) { const int e = 64 * et + 16 * (2 * eh + x) + l15, oct = 4 * ks + g; voff[ks][x] = ((((e >> 5) * 8 + (oct >> 1)) * 2 + (oct & 1)) * 32 + (e & 31)) * 8; }
    int roff[2];
#pragma unroll
    for (int x = 0; x < 2; ++x) { const int e = 64 * et + 16 * (2 * eh + x) + l15, d = 64 * dt + 16 * dq + 4 * g; roff[x] = ((((e >> 5) * 16 + (d >> 4)) * 2 + ((d >> 3) & 1)) * 32 + (e & 31)) * 8 + (d & 7); }
    float z0 = 0.f; asm volatile("" : "+v"(z0));
    f32x4 acc[2] = {(f32x4){z0, z0, z0, z0}, (f32x4){z0, z0, z0, z0}};
    v4u kq[4][2]; bf16x8 vq[4][4][2];
#define R2A_LOAD(st, nn) do { const int n_ = (nn) < 128 ? (nn) : 127; kq[st][0] = *(const GAS v4u*)(kp0 + (size_t)n_ * 128 * 1024); kq[st][1] = *(const GAS v4u*)(kp1 + (size_t)n_ * 128 * 1024); \
        _Pragma("unroll") for (int ks = 0; ks < 4; ++ks) _Pragma("unroll") for (int x = 0; x < 2; ++x) vq[st][ks][x] = *(const GAS bf16x8*)(VT + ((size_t)n_ << 16) + voff[ks][x]); } while (0)
    R2A_LOAD(0, 0); R2A_LOAD(1, 1); R2A_LOAD(2, 2);
    for (int n4 = 0; n4 < 128; n4 += 4) {
#pragma unroll
        for (int u4 = 0; u4 < 4; ++u4) { const int n = n4 + u4;
            LAS unsigned char* buf = F.lds + RING_OFF + (u4 & 1) * 16384;
            *(LAS v4u*)(buf + lo0) = kq[u4][0]; *(LAS v4u*)(buf + lo1) = kq[u4][1];
            R2A_LOAD((u4 + 3) & 3, n + 3);
            LDS_BAR();
            if (n > 0) {
#pragma unroll
                for (int x = 0; x < 2; ++x) { v2u o; o.x = pk2(acc[x][0], acc[x][1]); o.y = pk2(acc[x][2], acc[x][3]); *(GAS v2u*)(RT + ((size_t)n << 17) + roff[x]) = o; } }
#pragma unroll
            for (int ks = 0; ks < 4; ++ks) {
                const s16x4 t0 = vtr(buf + off64(32 * ks + 8 * g + q, 32 * dq + 8 * p)), t1 = vtr(buf + off64(32 * ks + 8 * g + 4 + q, 32 * dq + 8 * p));
                const bf16x8 a = (bf16x8){t0[0], t0[1], t0[2], t0[3], t1[0], t1[1], t1[2], t1[3]};
#pragma unroll
                for (int x = 0; x < 2; ++x) acc[x] = __builtin_amdgcn_mfma_f32_16x16x32_bf16(a, vq[u4][ks][x], acc[x], 0, 0, 0);
            }
#pragma unroll
            for (int x = 0; x < 2; ++x) acc[x] = acc[x] * dec;
        }
    }
#undef R2A_LOAD
    __syncthreads();
}

__device__ __forceinline__ void ret_out_phase(Frame& F, int j, bf16* YOUT) {
    const int w = F.wave, lane = F.lane, r32 = lane & 31, hi = lane >> 5, tid = F.tid;
    LAS unsigned char* QDI = F.lds + RING_OFF;
    LAS unsigned char* KHI = F.lds + RING_OFF + 65536;
    LAS unsigned char* PI = KHI;
    LAS float* STAT = (LAS float*)(F.lds + AUX_OFF);
    LAS unsigned char* YST = F.lds + RING_OFF;
    const bf16* QD = (const bf16*)(ARGWS(F) + WS_BIG + BIG_QD); const bf16* KH = (const bf16*)(ARGWS(F) + WS_BIG + BIG_KH);
    const bf16* VT = (const bf16*)(ARGWS(F) + WS_BIG + BIG_VT); const bf16* RT = (const bf16*)(ARGWS(F) + WS_BIG + BIG_RT);
    const bf16* GIN = (const bf16*)(ARGWS(F) + WS_BIG + BIG_G);
    const float* gn = ARGI(F, 4) + (size_t)j * 2048;
    const int ib = w & 3, jb0 = 2 * (w >> 2), jb1 = jb0 + 1;
    for (int U = F.c; U < 1024; U += F.G) {
        const int n = U & 127, h = (U >> 7) & 3, b = U >> 9;
        const size_t tok0 = (size_t)b * SEQ + (size_t)n * 128;
        { int tid1 = tid; asm volatile("" : "+v"(tid1)); v4u qv[8], kv[8];
#pragma unroll
          for (int k = 0; k < 8; ++k) { const int x = tid1 + 512 * k, row = x >> 5, chk = x & 31; const size_t go = (tok0 + row) * 1024 + h * 256 + chk * 8;
              qv[k] = *(const GAS v4u*)(QD + go); kv[k] = *(const GAS v4u*)(KH + go); }
#pragma unroll
          for (int k = 0; k < 8; ++k) { const int x = tid1 + 512 * k, row = x >> 5, chk = x & 31; const int lo = row * 512 + ((chk * 16) ^ ((row & 7) << 4));
              *(LAS v4u*)(QDI + lo) = qv[k]; *(LAS v4u*)(KHI + lo) = kv[k]; } }
        LDS_BAR();
        f32x16 s0 = {}, s1 = {};
        { const int qrow = 32 * ib + r32, k0row = 32 * jb0 + r32, k1row = 32 * jb1 + r32;
          if (jb0 <= ib) {
#pragma unroll
            for (int ks = 0; ks < 16; ++ks) { const int cb = (16 * ks + 8 * hi) * 2;
                const bf16x8 qf = *(const LAS bf16x8*)(QDI + qrow * 512 + (cb ^ ((qrow & 7) << 4)));
                const bf16x8 kf0 = *(const LAS bf16x8*)(KHI + k0row * 512 + (cb ^ ((k0row & 7) << 4)));
                s0 = __builtin_amdgcn_mfma_f32_32x32x16_bf16(kf0, qf, s0, 0, 0, 0);
                if (jb1 <= ib) { const bf16x8 kf1 = *(const LAS bf16x8*)(KHI + k1row * 512 + (cb ^ ((k1row & 7) << 4))); s1 = __builtin_amdgcn_mfma_f32_32x32x16_bf16(kf1, qf, s1, 0, 0, 0); } } } }
        LDS_BAR();
        { int r32p = r32, hip = hi; asm volatile("" : "+v"(r32p), "+v"(hip)); const int i = 32 * ib + r32p;
#pragma unroll
          for (int qq = 0; qq < 4; ++qq) {
              const int j0 = 32 * jb0 + 8 * qq + 4 * hip, j1 = j0 + 32;
              float a0 = s0[4 * qq], a1 = s0[4 * qq + 1], a2 = s0[4 * qq + 2], a3 = s0[4 * qq + 3];
              float c0 = s1[4 * qq], c1 = s1[4 * qq + 1], c2 = s1[4 * qq + 2], c3 = s1[4 * qq + 3];
              if (j0 + 0 > i) a0 = 0.f; if (j0 + 1 > i) a1 = 0.f; if (j0 + 2 > i) a2 = 0.f; if (j0 + 3 > i) a3 = 0.f;
              if (j1 + 0 > i) c0 = 0.f; if (j1 + 1 > i) c1 = 0.f; if (j1 + 2 > i) c2 = 0.f; if (j1 + 3 > i) c3 = 0.f;
              v2u o; o.x = pk2(a0, a1); o.y = pk2(a2, a3); *(LAS v2u*)(PI + i * 256 + ((j0 * 2) ^ ((i & 7) << 4))) = o;
              v2u o2; o2.x = pk2(c0, c1); o2.y = pk2(c2, c3); *(LAS v2u*)(PI + i * 256 + ((j1 * 2) ^ ((i & 7) << 4))) = o2; } }
        LDS_BAR();
        f32x16 acc[4][2];
#pragma unroll
        for (int rb = 0; rb < 4; ++rb) { acc[rb][0] = (f32x16){}; acc[rb][1] = (f32x16){}; }
        { const int nsteps = n > 0 ? 24 : 8;
          const bf16* vt = VT + ((size_t)((b * 4 + h) * 128 + n) << 16) + (size_t)(((2 * w) * 8 * 2 + hi) * 32 + r32) * 8;
          const bf16* rt = RT + ((size_t)((b * 4 + h) * 128 + n) << 17) + (size_t)(((2 * w) * 16 * 2 + hi) * 32 + r32) * 8;
          const int xr = (r32 & 7) << 4, rowp = r32 * 256;
#define R2B_LOAD(dst, sidx) do { int sp_ = (sidx); sp_ = sp_ < nsteps ? sp_ : nsteps - 1; const bf16* p_ = sp_ < 8 ? vt + sp_ * 512 : rt + (sp_ - 8) * 512; const int o1_ = sp_ < 8 ? 4096 : 8192; \
              dst[0] = *(const GAS bf16x8*)p_; dst[1] = *(const GAS bf16x8*)(p_ + o1_); } while (0)
          bf16x8 Bq[6][2];
          R2B_LOAD(Bq[0], 0); R2B_LOAD(Bq[1], 1); R2B_LOAD(Bq[2], 2); R2B_LOAD(Bq[3], 3); R2B_LOAD(Bq[4], 4);
          for (int s3 = 0; s3 < nsteps; s3 += 6) {
#pragma unroll
              for (int uu = 0; uu < 6; ++uu) { const int st = s3 + uu;
                  R2B_LOAD(Bq[(uu + 5) % 6], st + 5);
                  if (st < nsteps) { const bool pv = st < 8; const int ks = pv ? st : st - 8, cb = ((32 * ks + 16 * hi) ^ xr) + (pv ? 65536 : 0), sh = pv ? 0 : 1;
#pragma unroll
                      for (int rb = 0; rb < 4; ++rb) if (!pv || st <= 2 * rb + 1) {
                          const bf16x8 af = *(const LAS bf16x8*)(QDI + (((32 * 256) * rb + rowp) << sh) + cb);
                          acc[rb][0] = __builtin_amdgcn_mfma_f32_32x32x16_bf16(Bq[uu][0], af, acc[rb][0], 0, 0, 0);
                          acc[rb][1] = __builtin_amdgcn_mfma_f32_32x32x16_bf16(Bq[uu][1], af, acc[rb][1], 0, 0, 0); } } } }
#undef R2B_LOAD
        }
#pragma unroll
        for (int rb = 0; rb < 4; ++rb) { float s = 0.f, qs = 0.f;
#pragma unroll
            for (int et = 0; et < 2; ++et)
#pragma unroll
                for (int r = 0; r < 16; ++r) { const float v = acc[rb][et][r]; s += v; qs += v * v; }
            s += __shfl_xor(s, 32); qs += __shfl_xor(qs, 32);
            if (hi == 0) { STAT[((32 * rb + r32) * 8 + w) * 2] = s; STAT[((32 * rb + r32) * 8 + w) * 2 + 1] = qs; } }
        LDS_BAR();
        int r32b = r32, hib = hi; asm volatile("" : "+v"(r32b), "+v"(hib));
#pragma unroll
        for (int rb = 0; rb < 4; ++rb) { const int i = 32 * rb + r32b; float s = 0.f, qs = 0.f;
#pragma unroll
            for (int ww = 0; ww < 8; ++ww) { s += STAT[(i * 8 + ww) * 2]; qs += STAT[(i * 8 + ww) * 2 + 1]; }
            const float mean = s * (1.f / 512.f), var = qs * (1.f / 512.f) - mean * mean, rstd = 1.f / sqrtf(fmaxf(var, 0.f) + LN_EPS);
#pragma unroll
            for (int et = 0; et < 2; ++et)
#pragma unroll
                for (int qq = 0; qq < 4; ++qq) { const int e = 64 * w + 32 * et + 8 * qq + 4 * hib;
                    v2u o; o.x = pk2((acc[rb][et][4 * qq] - mean) * rstd, (acc[rb][et][4 * qq + 1] - mean) * rstd); o.y = pk2((acc[rb][et][4 * qq + 2] - mean) * rstd, (acc[rb][et][4 * qq + 3] - mean) * rstd);
                    *(LAS v2u*)(YST + i * 1024 + ((e * 2) ^ ((i & 63) << 4))) = o; } }
        LDS_BAR();
        { int tid6 = tid; asm volatile("" : "+v"(tid6)); const int chk = tid6 & 63; const f32x4 g0 = *(const GAS f32x4*)(gn + h * 512 + chk * 8), g1 = *(const GAS f32x4*)(gn + h * 512 + chk * 8 + 4);
#pragma unroll
          for (int k = 0; k < 16; ++k) { const int row = (tid6 >> 6) + 8 * k;
              const v4u y = *(const LAS v4u*)(YST + row * 1024 + ((chk * 16) ^ ((row & 63) << 4)));
              const size_t go6 = (tok0 + row) * 2048 + h * 512 + chk * 8; const v4u gg = *(const GAS v4u*)(GIN + go6);
              v4u o; o.x = pk2(bflo(y.x) * g0.x * bflo(gg.x), bfhi(y.x) * g0.y * bfhi(gg.x)); o.y = pk2(bflo(y.y) * g0.z * bflo(gg.y), bfhi(y.y) * g0.w * bfhi(gg.y));
              o.z = pk2(bflo(y.z) * g1.x * bflo(gg.z), bfhi(y.z) * g1.y * bfhi(gg.z)); o.w = pk2(bflo(y.w) * g1.z * bflo(gg.w), bfhi(y.w) * g1.w * bfhi(gg.w));
              *(GAS v4u*)(YOUT + go6) = o; } }
        __syncthreads();
    }
}
typedef swa::BlockRef<swa::bf16, swa::bf16> ABlk;
__device__ __forceinline__ float* att_lse(Frame& F, int L) {
    const int g = L >> 9, rem = L & 511, sh = 2 * g, seq = rem >> (6 - sh), qb = rem & ((64 >> sh) - 1);
    return (float*)(ARGWS(F) + WS_BIG + BIG_LSE) + (size_t)g * 131072 + (size_t)seq * (size_t)(SEQ >> sh) + (size_t)qb * 256;
}
__device__ __forceinline__ ABlk att_ref(Frame& F, int L) {
    const int g = L >> 9, rem = L & 511, sh = 2 * g, seq = rem >> (6 - sh), qb = rem & ((64 >> sh) - 1);
    const size_t base = (size_t)g * 131072 + (size_t)seq * (size_t)(SEQ >> sh);
    const swa::bf16* P = (const swa::bf16*)(ARGWS(F) + WS_BIG + BIG_QKV); constexpr size_t WH = (size_t)3 * 131072 * 128;
    ABlk r; r.Q = P + (base + (size_t)qb * 256) * 128; r.K = P + WH + base * 128; r.V = P + 2 * WH + base * 128;
    r.O = (swa::bf16*)(ARGWS(F) + WS_BIG + BIG_OP) + (base + (size_t)qb * 256) * 128; r.P0 = qb * 256;
    return r;
}
__device__ __forceinline__ void attn_phase(Frame& F) {
    extern __shared__ __attribute__((aligned(16))) unsigned char lds_dyn[];
    char* const ldsg = (char*)lds_dyn;
    int L = F.c; const int total = 1536, stride = F.G;
    if (L >= total) return;
    ABlk cur = att_ref(F, L);
    const int W = 129 + (F.G >> 20);
    swa::Seam<swa::bf16> S; S.tid = F.tid;
    swa::causal_swa_prime<swa::bf16, swa::bf16>(cur, W, ldsg, S);
    for (;;) {
        const bool last = L + stride >= total;
        const int Ln = last ? L : L + stride;
        const ABlk nxt = last ? cur : att_ref(F, Ln);
        const int skv = SEQ >> (2 * (L >> 9));
        swa::causal_swa_block<swa::bf16, swa::bf16>(cur, nxt, skv, W, ldsg, S);
        if (F.tid < 256) att_lse(F, L)[F.tid] = ((const LAS float*)(F.lds + swa::LSE_LDS_OFF))[F.tid];
        if (last) break;
        cur = nxt; L = Ln;
    }
}
__device__ __forceinline__ void attn_merge_phase(Frame& F) {
    const int gw = F.c * NWAVES + F.wave, NGW = F.G * NWAVES, hd = F.lane >> 4, chk = F.lane & 15;
    const bf16* OP = (const bf16*)(ARGWS(F) + WS_BIG + BIG_OP); const float* LSE = (const float*)(ARGWS(F) + WS_BIG + BIG_LSE); bf16* O = (bf16*)(ARGWS(F) + WS_BIG + BIG_O);
    for (int m0 = gw; m0 < T_TOK; m0 += 4 * NGW) {
        size_t row[4][3]; float ls[4][3]; v4u ov[4][3];
#pragma unroll
        for (int r = 0; r < 4; ++r) { const int m = m0 + r * NGW < T_TOK ? m0 + r * NGW : gw; const int b = m >> 14, t = m & 16383;
#pragma unroll
            for (int g = 0; g < 3; ++g) { const int sh = 2 * g; row[r][g] = (size_t)g * 131072 + (size_t)(b * 4 + hd) * SEQ + (size_t)((t & ((1 << sh) - 1)) * (SEQ >> sh) + (t >> sh));
                ls[r][g] = LSE[row[r][g]]; ov[r][g] = *(const GAS v4u*)(OP + row[r][g] * 128 + chk * 8); } }
#pragma unroll
        for (int r = 0; r < 4; ++r) { const int m = m0 + r * NGW; if (m >= T_TOK) break;
            const float mx = fmaxf(ls[r][0], fmaxf(ls[r][1], ls[r][2])); float wg[3]; float ws = 0.f;
#pragma unroll
            for (int g = 0; g < 3; ++g) { wg[g] = __expf(ls[r][g] - mx); ws += wg[g]; }
            const float inv = 1.f / ws; float o[8] = {0.f, 0.f, 0.f, 0.f, 0.f, 0.f, 0.f, 0.f};
#pragma unroll
            for (int g = 0; g < 3; ++g) { const v4u v = ov[r][g]; const float wt = wg[g] * inv;
                o[0] += wt * bflo(v.x); o[1] += wt * bfhi(v.x); o[2] += wt * bflo(v.y); o[3] += wt * bfhi(v.y); o[4] += wt * bflo(v.z); o[5] += wt * bfhi(v.z); o[6] += wt * bflo(v.w); o[7] += wt * bfhi(v.w); }
            v4u w; w.x = pk2(o[0], o[1]); w.y = pk2(o[2], o[3]); w.z = pk2(o[4], o[5]); w.w = pk2(o[6], o[7]);
            *(GAS v4u*)(O + (size_t)m * 512 + hd * 128 + chk * 8) = w; } }
}
template <bool GATHER_, int NCT> struct MoeOrder {
    static constexpr bool GATHER = GATHER_;
    const char* A; const char* Bt; int K; size_t bstride; int G, c; int rtb[9]; const LAS int* idx;
    __device__ __forceinline__ bool next(int i, pg8::Unit& u) const {
        const int L = i * G + c; if (L >= rtb[8] * NCT) return false;
        const int rt = L / NCT; int e = 0;
#pragma unroll
        for (int k = 1; k < 8; ++k) e += (rtb[k] <= rt) ? 1 : 0;
        u.pm = rt; u.pn = L - rt * NCT; u.ex = e; return true;
    }
    __device__ __forceinline__ const char* a_ptr(const pg8::Unit& u) const { return GATHER ? A : A + (size_t)u.pm * ((size_t)256 * K * 2); }
    __device__ __forceinline__ const char* b_ptr(const pg8::Unit& u) const { return Bt + (size_t)u.ex * bstride + (size_t)u.pn * ((size_t)256 * K * 2); }
    __device__ __forceinline__ unsigned a_off(int ui, int row, int C, int) const { return (unsigned)idx[ui * 256 + row] * (unsigned)(K * 2) + (unsigned)(C * 2); }
    __device__ __forceinline__ int kt() const { return K / 64; }
};
struct MoeDownMain {
    static constexpr bool GATHER = false;
    const char* A; const char* Bt; int K; size_t bstride; int G, c; int rtb[9];
    __device__ __forceinline__ bool next(int i, pg8::Unit& u) const {
        if (G != 256) { const int L = i * G + c; if (L >= 1024) return false; u.pm = L >> 2; u.pn = L & 3; }
        else { if (i >= 4) return false; const int xcd = c & 7, k = c >> 3; u.pm = i * 64 + (xcd << 3) + (k >> 2); u.pn = k & 3; }
        int e = 0;
#pragma unroll
        for (int k2 = 1; k2 < 8; ++k2) e += (rtb[k2] <= u.pm) ? 1 : 0;
        u.ex = e; return true;
    }
    __device__ __forceinline__ const char* a_ptr(const pg8::Unit& u) const { return A + (size_t)u.pm * ((size_t)256 * K * 2); }
    __device__ __forceinline__ const char* b_ptr(const pg8::Unit& u) const { return Bt + (size_t)u.ex * bstride + (size_t)u.pn * ((size_t)256 * K * 2); }
    __device__ __forceinline__ unsigned a_off(int, int, int, int) const { return 0u; }
    __device__ __forceinline__ int kt() const { return K / 64; }
};
struct MoeDownTail {
    static constexpr bool GATHER = false;
    const char* A; const char* Bt; int K; size_t bstride; int G, c; int rtb[9];
    __device__ __forceinline__ bool next(int i, pg8::Unit& u) const {
        const int nl = rtb[8] - 256; if (i > 0 || c >= nl * 16) return false;
        const int t = c >> 2; u.pm = 256 + (t >> 2); u.pn = t & 3; u.ex = (c & 3) * 32 + t; return true;
    }
    __device__ __forceinline__ int expert(const pg8::Unit& u) const { int e = 0;
#pragma unroll
        for (int k2 = 1; k2 < 8; ++k2) e += (rtb[k2] <= u.pm) ? 1 : 0;
        return e; }
    __device__ __forceinline__ const char* a_ptr(const pg8::Unit& u) const { return A + (size_t)u.pm * ((size_t)256 * K * 2) + (size_t)(c & 3) * (896 * 2); }
    __device__ __forceinline__ const char* b_ptr(const pg8::Unit& u) const { return Bt + (size_t)expert(u) * bstride + (size_t)u.pn * ((size_t)256 * K * 2) + (size_t)(c & 3) * (896 * 2); }
    __device__ __forceinline__ unsigned a_off(int, int, int, int) const { return 0u; }
    __device__ __forceinline__ int kt() const { return 14; }
};
__device__ __forceinline__ void moe_rtb(const LAS int* PB, int (&rtb)[9], int (&cnt)[8]) {
    int acc = 0;
#pragma unroll
    for (int e = 0; e < 8; ++e) { rtb[e] = acc; cnt[e] = __builtin_amdgcn_readfirstlane(PB[2048 + e]); acc += (cnt[e] + 255) >> 8; }
    rtb[8] = acc;
}
__global__ void __launch_bounds__(NWAVES * 64, 2) fwd_kernel(Args args) {
    extern __shared__ __attribute__((aligned(16))) unsigned char lds[];
    Frame F;
    F.lds = (LAS unsigned char*)lds;
    F.MISC = (volatile LAS unsigned*)(F.lds + MISC_OFF);
    F.tid = threadIdx.x; F.lane = F.tid & 63; F.wave = __builtin_amdgcn_readfirstlane(F.tid >> 6);
    F.G = gridDim.x; F.c = blockIdx.x;
    for (int u = F.tid; u < 32; u += NWAVES * 64) ((LAS unsigned*)(F.lds + MISC_OFF))[u] = 0u;
    if (F.tid == 0) { LAS unsigned long long* tb = (LAS unsigned long long*)(F.lds + MISC_OFF + 128);
#pragma unroll
        for (int i = 0; i < 15; ++i) tb[i] = (unsigned long long)args.in[i];
        tb[15] = (unsigned long long)args.out; tb[16] = (unsigned long long)args.ws; }
    __syncthreads();
    XcdBarrier bar = xcd_barrier_post((unsigned*)(F_CTL(F) + CW_BAR), F.MISC + 8);
#ifdef STAMP_A
#define STAMP_HERE(idx) do { if (threadIdx.x == 0) ((volatile LAS unsigned long long*)(F.lds + AUX_OFF + 16384))[(idx)] = wall_clock64(); } while (0)
#else
#define STAMP_HERE(idx) do { } while (0)
#endif
#define GRID_BAR(idx) do { XcdBarrier bb_ = bar; asm volatile("" : "+s"(bb_.bar), "+s"(bb_.x)); xcd_barrier(bb_); STAMP_HERE(idx); } while (0)
#define WSP ARGWS(F)
#define BIGP (ARGWS(F) + WS_BIG)
#define XBP ((bf16*)(ARGWS(F) + WS_XB))

#ifndef ONLY
#define ONLY -1
#endif
#define RUN(n) (ONLY < 0 || ONLY == (n))
    STAMP_HERE(0);
#ifndef DBL
#define DBL 0
#endif
    if (DBL & 1) { frame_refresh(F); p0_prologue(F); }
    if (RUN(0)) { frame_refresh(F); p0_prologue(F); }
    GRID_BAR(1);

#pragma unroll
    for (int j = 0; j < 2; ++j) {
        for (int rep_ = 0; rep_ < ((DBL & 256) ? 2 : 1); ++rep_) if (RUN(1)) { frame_refresh(F);
            const bf16* Win = (const bf16*)(WSP + WS_WIN) + (size_t)j * 6144 * 1024;
#ifndef SKIP_RP
            { pg8::StaticOrder S; S.init(XBP, Win, T_TOK, 4096, 1024, F.G, F.c);
              pg8::EpiRetProj E{(bf16*)(BIGP + BIG_QD), (bf16*)(BIGP + BIG_KH), (bf16*)(BIGP + BIG_G), (const float*)(WSP + WS_TAB)};
              pg8::gemm_phase<pg8::EpiRetProj, pg8::StaticOrder, true>(F.lds + RING_OFF, S, E, F.tid); }
#endif
#ifndef SKIP_VT
            { pg8::StaticOrder S; S.init(Win + (size_t)4096 * 1024, XBP, 2048, T_TOK, 1024, F.G, F.c);
              pg8::EpiVT E{(bf16*)(BIGP + BIG_VT)};
              pg8::gemm_phase<pg8::EpiVT, pg8::StaticOrder, true>(F.lds + RING_OFF, S, E, F.tid); }
#endif
        }
        GRID_BAR(1 + 16 * j + 1);
        if (DBL & 4) { frame_refresh(F); ret_state_phase(F); }
        if (RUN(2)) { frame_refresh(F); ret_state_phase(F); }
        GRID_BAR(1 + 16 * j + 2);
        if (DBL & 8) { frame_refresh(F); ret_out_phase(F, j, (bf16*)(BIGP + 640 * MiB)); }
        if (RUN(3)) { frame_refresh(F); ret_out_phase(F, j, (bf16*)(BIGP + BIG_G)); }
        GRID_BAR(1 + 16 * j + 3);
        if (RUN(4)) { frame_refresh(F);
            pg8::StaticOrder S; S.init(BIGP + BIG_G, (const bf16*)(WSP + WS_WRO) + (size_t)j * 1024 * 2048, T_TOK, 1024, 2048, F.G, F.c);
            pg8::EpiAddBf16 E{XBP, ALPHA};
            pg8::gemm_phase<pg8::EpiAddBf16, pg8::StaticOrder, true>(F.lds + RING_OFF, S, E, F.tid);
        }
        GRID_BAR(1 + 16 * j + 4);
        if (RUN(5)) { frame_refresh(F); ln_pass<0, false>(F, 2 * j, 0, j); }
        if (DBL & 2) { frame_refresh(F); moe_convert<false>(F, j); }
        if (RUN(6)) { frame_refresh(F); if (DBL & 1024) moe_convert<true>(F, j); else moe_convert<false>(F, j); }
        GRID_BAR(1 + 16 * j + 5);
        for (int rep_ = 0; rep_ < ((DBL & 64) ? 2 : 1); ++rep_) if (RUN(7)) { frame_refresh(F);
            pg8::StaticOrder S; S.init(XBP, (const bf16*)(WSP + WS_WGU) + (size_t)j * 7168 * 1024, T_TOK, 7168, 1024, F.G, F.c);
            pg8::EpiSwiGLU E{(bf16*)(BIGP + BIG_HID)};
            pg8::gemm_phase<pg8::EpiSwiGLU, pg8::StaticOrder, true>(F.lds + RING_OFF, S, E, F.tid);
        }
        GRID_BAR(1 + 16 * j + 6);
        if (RUN(8)) { frame_refresh(F);
            pg8::StaticOrder S; S.init(BIGP + BIG_HID, (const bf16*)(WSP + WS_WDN) + (size_t)j * 1024 * 3584, T_TOK, 1024, 3584, F.G, F.c);
            pg8::EpiAddBf16 E{XBP, ALPHA};
            pg8::gemm_phase<pg8::EpiAddBf16, pg8::StaticOrder, true>(F.lds + RING_OFF, S, E, F.tid);
        }
        GRID_BAR(1 + 16 * j + 7);
        if (RUN(5)) { frame_refresh(F); ln_pass<0, false>(F, 2 * j, 1, j); }
        GRID_BAR(1 + 16 * j + 8);
        if (RUN(9)) { frame_refresh(F);
            pg8::StaticOrder S; S.init(XBP, (const bf16*)(WSP + WS_WQKV) + (size_t)j * 4608 * 1024, T_TOK, 4608, 1024, F.G, F.c);
            pg8::EpiQKV E{(bf16*)(BIGP + BIG_QKV)};
            pg8::gemm_phase<pg8::EpiQKV, pg8::StaticOrder, true>(F.lds + RING_OFF, S, E, F.tid);
        }
        GRID_BAR(1 + 16 * j + 9);
        if (DBL & 16) { frame_refresh(F); attn_phase(F); }
        if (RUN(10)) { frame_refresh(F); attn_phase(F); }
        GRID_BAR(1 + 16 * j + 10);
        if (DBL & 32) { frame_refresh(F); attn_merge_phase(F); }
        if (RUN(11)) { frame_refresh(F); attn_merge_phase(F); }
        GRID_BAR(1 + 16 * j + 11);
        if (RUN(12)) { frame_refresh(F);
            pg8::StaticOrder S; S.init(BIGP + BIG_O, (const bf16*)(WSP + WS_WAO) + (size_t)j * 1024 * 512, T_TOK, 1024, 512, F.G, F.c);
            pg8::EpiAddBf16 E{XBP, ALPHA};
            pg8::gemm_phase<pg8::EpiAddBf16, pg8::StaticOrder, true>(F.lds + RING_OFF, S, E, F.tid);
        }
        GRID_BAR(1 + 16 * j + 12);
        if (RUN(13)) { frame_refresh(F); ln_route_pass(F, 2 * j + 1, j); }
        GRID_BAR(1 + 16 * j + 13);
        for (int rep_ = 0; rep_ < ((DBL & 512) ? 2 : 1); ++rep_) if (RUN(14)) {
            frame_refresh(F); MoeOrder<true, 28> S; int cnt[8];
            LAS int* PB = (LAS int*)(F.lds + RING_OFF); moe_prefix_lds(F, PB); moe_rtb(PB, S.rtb, cnt);
            S.G = F.G; S.c = F.c; S.idx = (const LAS int*)(F.lds + AUX_OFF);
            S.A = (const char*)XBP; S.Bt = (const char*)(BIGP + BIG_WMGU); S.K = 1024; S.bstride = (size_t)7168 * 1024 * 2;
            const int* BL = (const int*)(WSP + WS_LIST); LAS int* idx = (LAS int*)(F.lds + AUX_OFF);
            pg8::Unit u; int nun = 0;
            for (int ui = 0; S.next(ui, u) && ui < 30; ++ui) { nun = ui + 1;
                if (F.tid < 256) { const int e = u.ex; int rb = 0, ce = 0;
#pragma unroll
                    for (int q = 0; q < 8; ++q) { rb = (q == e) ? S.rtb[q] : rb; ce = (q == e) ? cnt[q] : ce; }
                    int slot = (u.pm - rb) * 256 + F.tid; slot = slot < ce ? slot : 0;
                    int lo = 0;
#pragma unroll
                    for (int st = 128; st > 0; st >>= 1) lo = (PB[(lo + st) * 8 + e] <= slot) ? lo + st : lo;
                    idx[ui * 256 + F.tid] = (lo * 8 + e) * 256 + (slot - PB[lo * 8 + e]); } }
            if (F.tid < 256) {
#pragma unroll 10
                for (int ui = 0; ui < 30; ++ui) if (ui < nun) idx[ui * 256 + F.tid] = BL[idx[ui * 256 + F.tid]]; }
            __syncthreads();
            pg8::EpiSwiGLU E{(bf16*)(BIGP + BIG_HID)};
            pg8::gemm_phase<pg8::EpiSwiGLU, MoeOrder<true, 28>, true>(F.lds + RING_OFF, S, E, F.tid);
        }
        GRID_BAR(1 + 16 * j + 14);
        for (int rep_ = 0; rep_ < ((DBL & 128) ? 2 : 1); ++rep_) if (RUN(15)) {
            frame_refresh(F);
            int rtb5[9], cnt5[8]; { LAS int* PB = (LAS int*)(F.lds + RING_OFF); moe_prefix_lds(F, PB); moe_rtb(PB, rtb5, cnt5); __syncthreads(); }
            { MoeDownMain S;
#pragma unroll
              for (int e = 0; e < 9; ++e) S.rtb[e] = rtb5[e];
              S.G = F.G; S.c = F.c; S.A = (const char*)(BIGP + BIG_HID); S.Bt = (const char*)(BIGP + BIG_WMD); S.K = 3584; S.bstride = (size_t)1024 * 3584 * 2;
              pg8::EpiBf16Y E{(bf16*)(BIGP + BIG_YP)};
              pg8::gemm_phase<pg8::EpiBf16Y, MoeDownMain, true>(F.lds + RING_OFF, S, E, F.tid); }
            frame_refresh(F);
            { MoeDownTail S;
#pragma unroll
              for (int e = 0; e < 9; ++e) S.rtb[e] = rtb5[e];
              S.G = F.G; S.c = F.c; S.A = (const char*)(BIGP + BIG_HID); S.Bt = (const char*)(BIGP + BIG_WMD); S.K = 3584; S.bstride = (size_t)1024 * 3584 * 2;
              pg8::EpiF32Slab E{(float*)(WSP + WS_SLAB)};
              pg8::gemm_phase<pg8::EpiF32Slab, MoeDownTail, false>(F.lds + RING_OFF, S, E, F.tid); }
        }
        GRID_BAR(1 + 16 * j + 15);
        if (RUN(16)) { frame_refresh(F); if (j == 0) ln_pass<2, false>(F, 1, 1, 0); else ln_pass<2, true>(F, 3, 1, 1); }
        if (j == 0) GRID_BAR(1 + 16 * j + 16);
    }
#ifdef STAMP_A
    GRID_BAR(34);
    { if (blockIdx.x == 0 && threadIdx.x == 0) { volatile LAS unsigned long long* ts = (volatile LAS unsigned long long*)(F.lds + AUX_OFF + 16384);
          float* vv = (float*)(ARGWS(F) + 65536); vv[0] = (float)(ts[STAMP_A + STAMP_AN] - ts[STAMP_A]) * 0.01f; vv[1] = (float)(ts[STAMP_B + STAMP_BN] - ts[STAMP_B]) * 0.01f; } }
    GRID_BAR(35);
    { const float* vv = (const float*)(ARGWS(F) + 65536); const float va = vv[0], vb = vv[1];
      float* out = ARGX(F); const float c = sqrtf(va);
      for (size_t i = (size_t)blockIdx.x * 512 + threadIdx.x; i < (size_t)T_TOK * DMODEL; i += (size_t)gridDim.x * 512) out[i] = (i == 0) ? vb : c; }
#endif
}

extern "C" void kernel_launch(void* const* d_in, const int* in_sizes, int n_in, void* d_out, int out_size, void* d_ws, size_t ws_size, hipStream_t stream) {
    static int grid = 0;
    if (grid == 0) {
        if (n_in != 15 || out_size != T_TOK * DMODEL || ws_size < WS_END) { fprintf(stderr, "kernel_launch: unexpected shapes / workspace (n_in %d, out %d, ws %zu < %zu)\n", n_in, out_size, ws_size, (size_t)WS_END); grid = -1; return; }
        int dev = 0, cus = 0, per_cu = 0;
        if (hipGetDevice(&dev) != hipSuccess || hipDeviceGetAttribute(&cus, hipDeviceAttributeMultiprocessorCount, dev) != hipSuccess) { grid = -1; return; }
        if (hipFuncSetAttribute((const void*)fwd_kernel, hipFuncAttributeMaxDynamicSharedMemorySize, LDS_BYTES) != hipSuccess) { fprintf(stderr, "kernel_launch: hipFuncSetAttribute failed\n"); grid = -1; return; }
        if (hipOccupancyMaxActiveBlocksPerMultiprocessor(&per_cu, (const void*)fwd_kernel, NWAVES * 64, LDS_BYTES) != hipSuccess || per_cu < 1) { fprintf(stderr, "kernel_launch: occupancy query says %d\n", per_cu); }
        (void)hipGetLastError();
        if (cus < 256) { fprintf(stderr, "kernel_launch: this kernel needs 256 CUs (found %d)\n", cus); grid = -1; return; }
        grid = 256;
    }
    if (grid < 0) return;
    if (hipMemsetAsync((char*)d_ws + WS_CTL, 0, CTL_ZERO_BYTES, stream) != hipSuccess) return;
    Args a{};
    for (int i = 0; i < 15; ++i) a.in[i] = (const float*)d_in[i];
    a.out = (float*)d_out; a.ws = (unsigned char*)d_ws;
    hipLaunchKernelGGL(fwd_kernel, dim3(grid), dim3(NWAVES * 64), LDS_BYTES, stream, a);
}
```

```cpp
#include <hip/hip_runtime.h>
#include <hip/hip_bf16.h>
#include <cstdio>
#include <cstdint>
#include <cmath>
namespace pg8 {
#define PG8_LAS __attribute__((address_space(3)))
typedef unsigned short bf16_t;
typedef short bf16x8 __attribute__((ext_vector_type(8)));
typedef float f32x4 __attribute__((ext_vector_type(4)));
typedef float f32x2 __attribute__((ext_vector_type(2)));
typedef unsigned u32x4 __attribute__((ext_vector_type(4)));
constexpr int BM = 256, BK = 64, HALF = 128, HTB = HALF * BK * 2  , STAGE_BYTES = 8 * HTB, NXCD = 8, WGM = 8;

__host__ __device__ __forceinline__ int lds_byte(int r, int c) { const int st = (r >> 4) * 2 + (c >> 5), rr = r & 15, cc = c & 31, ob = rr * 64 + cc * 2; return st * 1024 + (ob ^ (((ob >> 9) & 1) << 5)); }
__host__ __device__ __forceinline__ void stage_rc(int b, int& R, int& C) { const int st = b / 1024, sb = b % 1024, swz = sb ^ (((sb >> 9) & 1) << 5); R = (st >> 1) * 16 + swz / 64; C = (st & 1) * 32 + (swz % 64) / 2; }
__host__ __device__ __forceinline__ int perm32(int rho) { const int n = rho >> 4, i = rho & 15; return 8 * (i >> 2) + 4 * n + (i & 3); }

struct Unit { int pm, pn, ex; };

struct StaticOrder {
    static constexpr bool GATHER = false;
    const char* A; const char* Bt; int K;
    int nM, nN, nwg, G, c;
    __device__ void init(const void* A_, const void* Bt_, int M, int N, int K_, int G_, int c_) { A = (const char*)A_; Bt = (const char*)Bt_; K = K_; nM = M / BM; nN = N / BM; nwg = nM * nN; G = G_; c = c_; }
    __device__ bool next(int i, Unit& u) const {
        const long L = (long)i * G + c; if (L >= nwg) return false;
        int wgid = (int)L; { const int q = nwg / NXCD, r = nwg % NXCD, xcd = wgid % NXCD, off = wgid / NXCD; wgid = (xcd < r ? xcd * (q + 1) : r * (q + 1) + (xcd - r) * q) + off; }
        const int nig = WGM * nN, gid = wgid / nig, fm = gid * WGM, gsz = (nM - fm) < WGM ? (nM - fm) : WGM;
        u.pm = fm + ((wgid % nig) % gsz); u.pn = (wgid % nig) / gsz; u.ex = 0; return true;
    }
    __device__ __forceinline__ const char* a_ptr(const Unit& u) const { return A + (size_t)u.pm * ((size_t)BM * K * 2); }
    __device__ __forceinline__ const char* b_ptr(const Unit& u) const { return Bt + (size_t)u.pn * ((size_t)BM * K * 2); }
    __device__ __forceinline__ unsigned a_off(int, int, int, int) const { return 0u; }
    __device__ __forceinline__ int kt() const { return K / BK; }
};

__device__ __forceinline__ unsigned cvt_pk_bf16(float lo, float hi) { unsigned r; asm volatile("v_cvt_pk_bf16_f32 %0, %1, %2" : "=v"(r) : "v"(lo), "v"(hi)); return r; }

template <class Epi, class Sched, bool ALIGN_EPI>
__device__ __forceinline__ void gemm_phase(PG8_LAS unsigned char* lds, const Sched& S, const Epi& E, const int tid) {
    constexpr bool GATHER = Sched::GATHER;
    const int wid = __builtin_amdgcn_readfirstlane(tid >> 6), lane = tid & 63, wr = wid >> 2, wc = wid & 3, fr = lane & 15, fq = lane >> 4;
    const int K = S.K, nt = S.kt();
    unsigned voffA[2][2], nvoffA[2][2], voffB[2]; int sR[2], sC[2];
#pragma unroll
    for (int i = 0; i < 2; ++i) { int R, C; stage_rc(tid * 16 + i * 8192, R, C); sR[i] = R; sC[i] = C; const int Rb = Epi::PERM ? ((R & ~31) + perm32(R & 31)) : R;
        voffA[0][i] = (unsigned)(R * K + C) * 2u; voffA[1][i] = voffA[0][i]; nvoffA[0][i] = voffA[0][i]; nvoffA[1][i] = voffA[0][i]; voffB[i] = (unsigned)(Rb * K + C) * 2u; }
    const size_t kstep = (size_t)(BK * 2);
    const size_t hstep = (size_t)HALF * K * 2;
    const size_t ahstep = GATHER ? (size_t)0 : hstep;
    const unsigned ldsw = (unsigned)wid * 1024u;
    const int aoff = lds_byte(wr * 64 + fr, fq * 8), boff = lds_byte(wc * 32 + fr, fq * 8);
#define PG8_SA(b, h) (((b) * 2 + (h)) * HTB)
#define PG8_SB(b, h) ((4 + (b) * 2 + (h)) * HTB)
#define PG8_STAGE(bufoff, gbase, voff) do { _Pragma("unroll") for (int _i = 0; _i < 2; ++_i) \
        __builtin_amdgcn_global_load_lds((const unsigned*)((const char*)(gbase) + (voff)[_i]), (PG8_LAS unsigned*)(lds + (bufoff) + ldsw + _i * 8192), 16, 0, 0); } while (0)
#define PG8_STAGE_A(bufoff, gbase, h, VO) PG8_STAGE(bufoff, (gbase) + (h) * ahstep, (VO)[GATHER ? (h) : 0])
#define PG8_LDA(dst, b, h) do { _Pragma("unroll") for (int m = 0; m < 4; ++m) _Pragma("unroll") for (int k = 0; k < 2; ++k) dst[m][k] = *(const PG8_LAS bf16x8*)(lds + PG8_SA(b, h) + aoff + m * 2048 + k * 1024); } while (0)
#define PG8_LDB(dst, b, h) do { _Pragma("unroll") for (int n = 0; n < 2; ++n) _Pragma("unroll") for (int k = 0; k < 2; ++k) dst[n][k] = *(const PG8_LAS bf16x8*)(lds + PG8_SB(b, h) + boff + n * 2048 + k * 1024); } while (0)
#define PG8_MMA(ai, bj, At, Bt) do { __builtin_amdgcn_s_setprio(1); _Pragma("unroll") for (int m = 0; m < 4; ++m) _Pragma("unroll") for (int n = 0; n < 2; ++n) _Pragma("unroll") for (int k = 0; k < 2; ++k) \
        acc[ai][bj][m][n] = __builtin_amdgcn_mfma_f32_16x16x32_bf16(Bt[n][k], At[m][k], acc[ai][bj][m][n], 0, 0, 0); __builtin_amdgcn_s_setprio(0); } while (0)
#define PG8_WAIT_V(n) asm volatile("s_waitcnt vmcnt(" #n ")" ::: "memory")
#define PG8_WAIT_L(n) asm volatile("s_waitcnt lgkmcnt(" #n ")" ::: "memory")
#define PG8_BAR __builtin_amdgcn_s_barrier()
#define PG8_SCHED __builtin_amdgcn_sched_barrier(0)
    Unit cur, nxt; int ui = 0;
    if (!S.next(0, cur)) return;
    f32x4 acc[2][2][4][2];
#pragma unroll
    for (int a = 0; a < 2; ++a)
#pragma unroll
        for (int b = 0; b < 2; ++b)
#pragma unroll
            for (int m = 0; m < 4; ++m)
#pragma unroll
                for (int n = 0; n < 2; ++n) acc[a][b][m][n] = (f32x4){0.f, 0.f, 0.f, 0.f};
    bf16x8 At[4][2], B0[2][2], B1[2][2];
    const char* cA = S.a_ptr(cur); const char* cB = S.b_ptr(cur);
    if constexpr (GATHER) {
#pragma unroll
        for (int h = 0; h < 2; ++h)
#pragma unroll
            for (int i = 0; i < 2; ++i) voffA[h][i] = S.a_off(0, h * HALF + sR[i], sC[i], 0);
    }
    PG8_STAGE(PG8_SB(0, 0), cB, voffB); PG8_STAGE(PG8_SB(0, 1), cB + hstep, voffB); PG8_STAGE_A(PG8_SA(0, 0), cA, 0, voffA); PG8_STAGE_A(PG8_SA(0, 1), cA, 1, voffA);
    if (wr == 1) PG8_BAR;
    PG8_WAIT_V(2); PG8_BAR;
    PG8_STAGE(PG8_SB(1, 0), cB + kstep, voffB); PG8_STAGE_A(PG8_SA(1, 0), cA + kstep, 0, voffA); PG8_STAGE(PG8_SB(1, 1), cB + hstep + kstep, voffB);
    PG8_WAIT_V(6); PG8_BAR;
    for (;;) {
        const bool has_next = S.next(ui + 1, nxt);
        const char* nA = has_next ? S.a_ptr(nxt) : cA; const char* nB = has_next ? S.b_ptr(nxt) : cB;
        if constexpr (GATHER) {
#pragma unroll
            for (int h = 0; h < 2; ++h)
#pragma unroll
                for (int i = 0; i < 2; ++i) nvoffA[h][i] = has_next ? S.a_off(ui + 1, h * HALF + sR[i], sC[i], 0) : voffA[h][i];
        }
        for (int t = 0; t < nt; t += 2) {
            const bool last = (t == nt - 2);
            const char* a1 = cA + (size_t)(t + 1) * kstep;
            const char* a2 = last ? nA : cA + (size_t)(t + 2) * kstep; const char* b2 = last ? nB : cB + (size_t)(t + 2) * kstep;
            const char* a3 = a2 + kstep; const char* b3 = b2 + kstep;
            unsigned vo2[2][2];
#pragma unroll
            for (int h = 0; h < 2; ++h)
#pragma unroll
                for (int i = 0; i < 2; ++i) vo2[h][i] = (GATHER && last) ? nvoffA[h][i] : voffA[h][i];
            PG8_LDB(B0, 0, 0); PG8_LDB(B1, 0, 1); PG8_SCHED; PG8_LDA(At, 0, 0); PG8_STAGE_A(PG8_SA(1, 1), a1, 1, voffA);
            PG8_WAIT_V(8); PG8_WAIT_L(0); PG8_BAR; PG8_MMA(0, 0, At, B0); PG8_MMA(0, 1, At, B1); PG8_BAR; PG8_SCHED;
            PG8_LDA(At, 0, 1); PG8_STAGE(PG8_SB(0, 0), b2, voffB); PG8_STAGE(PG8_SB(0, 1), b2 + hstep, voffB); PG8_STAGE_A(PG8_SA(0, 0), a2, 0, vo2);
            PG8_WAIT_V(8); PG8_WAIT_L(0); PG8_BAR; PG8_MMA(1, 0, At, B0); PG8_MMA(1, 1, At, B1); PG8_BAR; PG8_SCHED;
            PG8_LDB(B0, 1, 0); PG8_LDB(B1, 1, 1); PG8_SCHED; PG8_LDA(At, 1, 0); PG8_STAGE_A(PG8_SA(0, 1), a2, 1, vo2);
            PG8_WAIT_V(8); PG8_WAIT_L(0); PG8_BAR; PG8_MMA(0, 0, At, B0); PG8_MMA(0, 1, At, B1); PG8_BAR; PG8_SCHED;
            PG8_LDA(At, 1, 1); PG8_STAGE(PG8_SB(1, 0), b3, voffB); PG8_STAGE(PG8_SB(1, 1), b3 + hstep, voffB); PG8_STAGE_A(PG8_SA(1, 0), a3, 0, vo2);
            PG8_WAIT_V(8); PG8_WAIT_L(0); PG8_BAR; PG8_MMA(1, 0, At, B0); PG8_MMA(1, 1, At, B1); PG8_BAR; PG8_SCHED;
        }
        if constexpr (ALIGN_EPI) { if (wr == 0) PG8_BAR; }
        E(acc, cur, wr, wc, fr, fq);
        if (!has_next) break;
#pragma unroll
        for (int a = 0; a < 2; ++a)
#pragma unroll
            for (int b = 0; b < 2; ++b)
#pragma unroll
                for (int m = 0; m < 4; ++m)
#pragma unroll
                    for (int n = 0; n < 2; ++n) acc[a][b][m][n] = (f32x4){0.f, 0.f, 0.f, 0.f};
        cur = nxt; cA = nA; cB = nB; ++ui;
        if constexpr (GATHER) {
#pragma unroll
            for (int h = 0; h < 2; ++h)
#pragma unroll
                for (int i = 0; i < 2; ++i) voffA[h][i] = nvoffA[h][i];
        }
        if constexpr (ALIGN_EPI) { if (wr == 1) PG8_BAR; }
    }
    PG8_WAIT_V(0);
    if constexpr (!ALIGN_EPI) { if (wr == 0) PG8_BAR; }
    PG8_BAR;
#undef PG8_SA
#undef PG8_SB
#undef PG8_STAGE
#undef PG8_STAGE_A
#undef PG8_LDA
#undef PG8_LDB
#undef PG8_MMA
#undef PG8_WAIT_V
#undef PG8_WAIT_L
#undef PG8_BAR
#undef PG8_SCHED
}
__device__ __forceinline__ float silu_f(float x) { return x * __builtin_amdgcn_rcpf(1.0f + __builtin_amdgcn_exp2f(-1.4426950408889634f * x)); }
__device__ __forceinline__ u32x4 pack8v(const f32x4& v0, const f32x4& v1) { u32x4 w; w.x = cvt_pk_bf16(v0[0], v0[1]); w.y = cvt_pk_bf16(v0[2], v0[3]); w.z = cvt_pk_bf16(v1[0], v1[1]); w.w = cvt_pk_bf16(v1[2], v1[3]); return w; }

struct EpiRetProj {
    static constexpr bool PERM = true;
    bf16_t* QD; bf16_t* KH; bf16_t* G; const float* tab;
    __device__ __forceinline__ void operator()(const f32x4 (&acc)[2][2][4][2], const Unit& u, int wr, int wc, int fr, int fq) const {
        const int row0 = u.pm * BM + wr * 64 + fr, cl = wc * 32 + 8 * fq;
        if (u.pn < 8) {
            const bool isq = u.pn < 4; const int h = u.pn & 3;
            const float lg = __builtin_amdgcn_logf(1.0f - __builtin_amdgcn_exp2f((float)(-5 - h)));
            bf16_t* base = (isq ? QD : KH) + h * 256 + cl;
#pragma unroll
            for (int ai = 0; ai < 2; ++ai)
#pragma unroll
                for (int m = 0; m < 4; ++m) { const int row = row0 + ai * HALF + m * 16, pos = row & 16383, ic = row & 127;
                    const float sc = isq ? __builtin_amdgcn_exp2f(lg * (float)(ic + 1)) : 0.0625f * __builtin_amdgcn_exp2f(-lg * (float)(ic + 1));
                    const f32x4* tp = (const f32x4*)(tab + ((size_t)pos * 128 + cl) * 2);
                    const f32x4 t0 = tp[0], t1 = tp[1], t2 = tp[2], t3 = tp[3];
                    const f32x4 a0 = acc[ai][0][m][0], a1 = acc[ai][0][m][1], b0 = acc[ai][1][m][0], b1 = acc[ai][1][m][1];
                    f32x4 o10, o11, o20, o21;
                    o10[0] = (a0[0] * t0[0] - b0[0] * t0[1]) * sc; o20[0] = (b0[0] * t0[0] + a0[0] * t0[1]) * sc;
                    o10[1] = (a0[1] * t0[2] - b0[1] * t0[3]) * sc; o20[1] = (b0[1] * t0[2] + a0[1] * t0[3]) * sc;
                    o10[2] = (a0[2] * t1[0] - b0[2] * t1[1]) * sc; o20[2] = (b0[2] * t1[0] + a0[2] * t1[1]) * sc;
                    o10[3] = (a0[3] * t1[2] - b0[3] * t1[3]) * sc; o20[3] = (b0[3] * t1[2] + a0[3] * t1[3]) * sc;
                    o11[0] = (a1[0] * t2[0] - b1[0] * t2[1]) * sc; o21[0] = (b1[0] * t2[0] + a1[0] * t2[1]) * sc;
                    o11[1] = (a1[1] * t2[2] - b1[1] * t2[3]) * sc; o21[1] = (b1[1] * t2[2] + a1[1] * t2[3]) * sc;
                    o11[2] = (a1[2] * t3[0] - b1[2] * t3[1]) * sc; o21[2] = (b1[2] * t3[0] + a1[2] * t3[1]) * sc;
                    o11[3] = (a1[3] * t3[2] - b1[3] * t3[3]) * sc; o21[3] = (b1[3] * t3[2] + a1[3] * t3[3]) * sc;
                    bf16_t* rp = base + (size_t)row * 1024;
                    *(u32x4*)rp = pack8v(o10, o11); *(u32x4*)(rp + 128) = pack8v(o20, o21); asm volatile("" ::: "memory"); }
        } else {
            bf16_t* base = G + (u.pn - 8) * 256 + cl;
#pragma unroll
            for (int ai = 0; ai < 2; ++ai)
#pragma unroll
                for (int m = 0; m < 4; ++m) { bf16_t* rp = base + (size_t)(row0 + ai * HALF + m * 16) * 2048;
#pragma unroll
                    for (int bj = 0; bj < 2; ++bj) { f32x4 v0 = acc[ai][bj][m][0], v1 = acc[ai][bj][m][1];
#pragma unroll
                        for (int j = 0; j < 4; ++j) { v0[j] = silu_f(v0[j]); v1[j] = silu_f(v1[j]); }
                        *(u32x4*)(rp + bj * HALF) = pack8v(v0, v1); } }
        }
    }
};
struct EpiVT {
    static constexpr bool PERM = true;
    bf16_t* VT;
    __device__ __forceinline__ void operator()(const f32x4 (&acc)[2][2][4][2], const Unit& u, int wr, int wc, int fr, int fq) const {
        const int row0 = u.pm * BM + wr * 64 + fr, c0 = u.pn * BM + wc * 32 + 8 * fq;
#pragma unroll
        for (int ai = 0; ai < 2; ++ai)
#pragma unroll
            for (int m = 0; m < 4; ++m) { const int R = row0 + ai * HALF + m * 16, h = R >> 9, e = R & 511;
#pragma unroll
                for (int bj = 0; bj < 2; ++bj) { const int c = c0 + bj * HALF, b = c >> 14, t = c & 16383, n = t >> 7, oct = (t & 127) >> 3;
                    const size_t off = ((size_t)((b * 4 + h) * 128 + n) << 16) + (size_t)(((((e >> 5) * 8 + (oct >> 1)) * 2 + (oct & 1)) * 32 + (e & 31)) * 8);
                    *(u32x4*)(VT + off) = pack8v(acc[ai][bj][m][0], acc[ai][bj][m][1]); } }
    }
};
struct EpiAddBf16 {
    static constexpr bool PERM = true;
    bf16_t* XB; float alpha;
    __device__ __forceinline__ void operator()(const f32x4 (&acc)[2][2][4][2], const Unit& u, int wr, int wc, int fr, int fq) const {
        const int row0 = u.pm * BM + wr * 64 + fr, col0 = u.pn * BM + wc * 32 + 8 * fq;
#pragma unroll
        for (int ai = 0; ai < 2; ++ai)
#pragma unroll
            for (int m = 0; m < 4; ++m) { bf16_t* rowp = XB + (size_t)(row0 + ai * HALF + m * 16) * 1024 + col0;
#pragma unroll
                for (int bj = 0; bj < 2; ++bj) { const u32x4 x = *(const u32x4*)(rowp + bj * HALF); f32x4 v0 = acc[ai][bj][m][0], v1 = acc[ai][bj][m][1];
                    v0[0] += alpha * __builtin_bit_cast(float, x.x << 16); v0[1] += alpha * __builtin_bit_cast(float, x.x & 0xffff0000u);
                    v0[2] += alpha * __builtin_bit_cast(float, x.y << 16); v0[3] += alpha * __builtin_bit_cast(float, x.y & 0xffff0000u);
                    v1[0] += alpha * __builtin_bit_cast(float, x.z << 16); v1[1] += alpha * __builtin_bit_cast(float, x.z & 0xffff0000u);
                    v1[2] += alpha * __builtin_bit_cast(float, x.w << 16); v1[3] += alpha * __builtin_bit_cast(float, x.w & 0xffff0000u);
                    *(u32x4*)(rowp + bj * HALF) = pack8v(v0, v1); } }
    }
};
struct EpiSwiGLU {
    static constexpr bool PERM = true;
    bf16_t* H;
    __device__ __forceinline__ void operator()(const f32x4 (&acc)[2][2][4][2], const Unit& u, int wr, int wc, int fr, int fq) const {
        const int row0 = u.pm * BM + wr * 64 + fr, col0 = u.pn * HALF + wc * 32 + 8 * fq;
#pragma unroll
        for (int ai = 0; ai < 2; ++ai)
#pragma unroll
            for (int m = 0; m < 4; ++m) { f32x4 v0 = acc[ai][0][m][0], v1 = acc[ai][0][m][1]; const f32x4 u0 = acc[ai][1][m][0], u1 = acc[ai][1][m][1];
#pragma unroll
                for (int j = 0; j < 4; ++j) { v0[j] = silu_f(v0[j]) * u0[j]; v1[j] = silu_f(v1[j]) * u1[j]; }
                *(u32x4*)(H + (size_t)(row0 + ai * HALF + m * 16) * 3584 + col0) = pack8v(v0, v1); }
    }
};
struct EpiQKV {
    static constexpr bool PERM = true;
    bf16_t* P;
    __device__ __forceinline__ void operator()(const f32x4 (&acc)[2][2][4][2], const Unit& u, int wr, int wc, int fr, int fq) const {
        const int row0 = u.pm * BM + wr * 64 + fr, cl = wc * 32 + 8 * fq;
        const int which = u.pn / 6, g = (u.pn % 6) >> 1, hp = u.pn & 1, sh = 2 * g;
#pragma unroll
        for (int ai = 0; ai < 2; ++ai)
#pragma unroll
            for (int m = 0; m < 4; ++m) { const int r = row0 + ai * HALF + m * 16, b = r >> 14, t = r & 16383;
                const int perm = (t & ((1 << sh) - 1)) * (16384 >> sh) + (t >> sh);
#pragma unroll
                for (int bj = 0; bj < 2; ++bj) { const int head = 2 * hp + bj;
                    bf16_t* dst = P + ((size_t)(((which * 3 + g) * 8 + b * 4 + head) * 16384 + perm) << 7) + cl;
                    *(u32x4*)dst = pack8v(acc[ai][bj][m][0], acc[ai][bj][m][1]); } }
    }
};
struct EpiBf16Y {
    static constexpr bool PERM = true;
    bf16_t* Y;
    __device__ __forceinline__ void operator()(const f32x4 (&acc)[2][2][4][2], const Unit& u, int wr, int wc, int fr, int fq) const {
        const int row0 = u.pm * BM + wr * 64 + fr, col0 = u.pn * BM + wc * 32 + 8 * fq;
#pragma unroll
        for (int ai = 0; ai < 2; ++ai)
#pragma unroll
            for (int m = 0; m < 4; ++m) { bf16_t* rp = Y + (size_t)(row0 + ai * HALF + m * 16) * 1024 + col0;
#pragma unroll
                for (int bj = 0; bj < 2; ++bj) *(u32x4*)(rp + bj * HALF) = pack8v(acc[ai][bj][m][0], acc[ai][bj][m][1]); }
    }
};
struct EpiF32Slab {
    static constexpr bool PERM = false;
    float* S;
    __device__ __forceinline__ void operator()(const f32x4 (&acc)[2][2][4][2], const Unit& u, int wr, int wc, int fr, int fq) const {
        float* base = S + ((size_t)u.ex << 16) + (size_t)(wr * 64 + fr) * 256 + wc * 32 + 4 * fq;
#pragma unroll
        for (int ai = 0; ai < 2; ++ai)
#pragma unroll
            for (int m = 0; m < 4; ++m) { float* rowp = base + (size_t)(ai * HALF + m * 16) * 256;
#pragma unroll
                for (int bj = 0; bj < 2; ++bj)
#pragma unroll
                    for (int n = 0; n < 2; ++n) *(f32x4*)(rowp + bj * HALF + n * 16) = acc[ai][bj][m][n]; }
    }
};
}
namespace swa {
constexpr int D = 128; constexpr float THR = 8.f; constexpr bool WSKIP = true; constexpr int LSE_LDS_OFF = 131072;
constexpr float SCALE = 0.08838834764831845f;
constexpr int NW = 8, QBLK = 32, KVBLK = 64, QB = NW * QBLK;
constexpr int SHM_V = KVBLK * D * 2, SHM_K = KVBLK * D * 2;
constexpr int LDS_BYTES = 2 * SHM_V + 2 * SHM_K + NW * 64 * 4;

using bf16 = __hip_bfloat16;
typedef short bf16x8 __attribute__((ext_vector_type(8)));
typedef short s16x4 __attribute__((ext_vector_type(4)));
typedef float f32x16 __attribute__((ext_vector_type(16)));
typedef float f32x4 __attribute__((ext_vector_type(4)));
typedef unsigned u32x4 __attribute__((ext_vector_type(4)));
template <class A, class Bt> struct same_t { static constexpr bool v = false; };
template <class A> struct same_t<A, A> { static constexpr bool v = true; };

#define KSWZ(row, colB) ((row) * 256 + ((colB) ^ (((row) & 7) << 4)))
#define SBAR() __builtin_amdgcn_sched_barrier(0)
__device__ __forceinline__ int v_st(int k, int c) { const int kk = (k & ~0xC) | ((k & 4) << 1) | ((k & 8) >> 1); return ((kk >> 3) * 4 + (c >> 5)) * 512 + ((kk & 7) * 32 + (c & 31)) * 2; }
__device__ __forceinline__ int v_rd_base(int lane) { return ((lane & 3) << 3) | (((lane >> 2) & 3) << 6) | (((lane >> 4) & 1) << 5) | (((lane >> 5) & 1) << 8); }
constexpr int v_rd_off(int d0, int ks, int half) { return d0 * 512 + ks * 4096 + half * 2048; }
__device__ __forceinline__ int crow(int r, int hi) { return (r & 3) + 8 * (r >> 2) + 4 * hi; }
__device__ __forceinline__ unsigned cvtpk(float lo, float hi) {
    unsigned r; asm volatile("v_cvt_pk_bf16_f32 %0, %1, %2" : "=v"(r) : "v"(lo), "v"(hi)); return r;
}
__device__ __forceinline__ bf16x8 pack8(f32x4 a, f32x4 b) {
    u32x4 w = {cvtpk(a[0], a[1]), cvtpk(a[2], a[3]), cvtpk(b[0], b[1]), cvtpk(b[2], b[3])};
    return *reinterpret_cast<bf16x8*>(&w);
}
template <class T> __device__ __forceinline__ bf16x8 load8(const T* p) {
    if constexpr (same_t<T, float>::v) { return pack8(*(const f32x4*)p, *(const f32x4*)(p + 4)); }
    else { return *reinterpret_cast<const bf16x8*>(p); }
}
__device__ __forceinline__ void mask_tile(f32x16& p0, f32x16& p1, int dq, unsigned W) {
    const float NEG = -__builtin_inff();
#pragma unroll
    for (int r = 0; r < 16; ++r) {
        const int c = (r & 3) + 8 * (r >> 2);
        if ((unsigned)(dq - c) >= W) p0[r] = NEG;
        if ((unsigned)(dq - c - 32) >= W) p1[r] = NEG;
    }
}
__device__ __forceinline__ void partialSM(f32x16& p0, f32x16& p1, float& m_reg, float& mn, float& alpha) {
    float pmax = p0[0]; for (int r = 1; r < 16; ++r) pmax = fmaxf(pmax, p0[r]); for (int r = 0; r < 16; ++r) pmax = fmaxf(pmax, p1[r]);
    { auto rr = __builtin_amdgcn_permlane32_swap(__float_as_uint(pmax), __float_as_uint(pmax), false, false);
      pmax = fmaxf(__uint_as_float(rr[0]), __uint_as_float(rr[1])); }
    constexpr float C2 = 1.4426950408889634f * SCALE;
    if (__builtin_expect(__all((pmax - m_reg) * SCALE <= THR), 1)) { mn = m_reg; alpha = 1.f; }
    else { mn = fmaxf(m_reg, pmax); alpha = __builtin_amdgcn_exp2f((m_reg - mn) * C2); m_reg = mn; }
    const float mnL = -mn * C2;
    for (int r = 0; r < 16; ++r) p0[r] = fmaf(p0[r], C2, mnL); for (int r = 0; r < 16; ++r) p1[r] = fmaf(p1[r], C2, mnL);
    for (int r = 0; r < 16; ++r) p0[r] = __builtin_amdgcn_exp2f(p0[r]);
}
__device__ __forceinline__ void finishSM(f32x16& p0, f32x16& p1, float alpha, float& l_reg, bf16x8& pa0, bf16x8& pa1, bf16x8& pa2, bf16x8& pa3) {
    for (int r = 0; r < 16; ++r) p1[r] = __builtin_amdgcn_exp2f(p1[r]);
    float ps = 0; for (int r = 0; r < 16; ++r) ps += p0[r]; for (int r = 0; r < 16; ++r) ps += p1[r];
    { auto rr = __builtin_amdgcn_permlane32_swap(__float_as_uint(ps), __float_as_uint(ps), false, false);
      ps = __uint_as_float(rr[0]) + __uint_as_float(rr[1]); }
    l_reg = l_reg * alpha + ps;
#define PK4(P, B_, OUT) do { unsigned a0 = cvtpk(P[B_+0], P[B_+1]), a1 = cvtpk(P[B_+2], P[B_+3]);                          \
        unsigned b0 = cvtpk(P[B_+4], P[B_+5]), b1 = cvtpk(P[B_+6], P[B_+7]);                                             \
        auto r0 = __builtin_amdgcn_permlane32_swap(a0, b0, false, false); auto r1 = __builtin_amdgcn_permlane32_swap(a1, b1, false, false); \
        u32x4 w = {r0[0], r1[0], r0[1], r1[1]}; OUT = *reinterpret_cast<bf16x8*>(&w); } while (0)
    PK4(p0, 0, pa0); PK4(p0, 8, pa1); PK4(p1, 0, pa2); PK4(p1, 8, pa3);
#undef PK4
}
template <int KB, bool SK>
__device__ __forceinline__ void qkt(f32x16& p0, f32x16& p1, const char* K_lds, int r32, int hi, const bf16x8* qr, bool act) {
    if (SK && !act) { const float NEG = -__builtin_inff();
#pragma unroll
        for (int r = 0; r < 16; ++r) { p0[r] = NEG; p1[r] = NEG; } return; }
    p0 = f32x16{}; p1 = f32x16{};
    const char* kb[4];
#pragma unroll
    for (int dd = 0; dd < 4; ++dd) kb[dd] = K_lds + KB * SHM_K + KSWZ(r32, (dd * 16 + hi * 8) * 2);
#pragma unroll
    for (int d0 = 0; d0 < 8; ++d0) { const char* a = kb[d0 & 3] + (d0 >> 2) * 128;
        bf16x8 b0 = *reinterpret_cast<const bf16x8*>(a);
        bf16x8 b1 = *reinterpret_cast<const bf16x8*>(a + 32 * 256);
        p0 = __builtin_amdgcn_mfma_f32_32x32x16_bf16(b0, qr[d0], p0, 0, 0, 0);
        p1 = __builtin_amdgcn_mfma_f32_32x32x16_bf16(b1, qr[d0], p1, 0, 0, 0); }
}
template <int VB, bool SK>
__device__ __forceinline__ void pv_tile(f32x16* o, int vb0, bf16x8 pa0, bf16x8 pa1, bf16x8 pa2, bf16x8 pa3, bool act) {
    if (SK && !act) return;
#define TRRD(dst, off) asm volatile("ds_read_b64_tr_b16 %0, %1 offset:%2" : "=&v"(dst) : "v"(vb0), "i"(off) : "memory")
#define PV_D0(d0) do { s16x4 l0, l1, l2, l3, h0, h1, h2, h3; constexpr int b_ = VB * SHM_V + v_rd_off(d0, 0, 0);     \
        TRRD(l0, b_); TRRD(h0, b_ + 2048); TRRD(l1, b_ + 4096); TRRD(h1, b_ + 6144); TRRD(l2, b_ + 8192); TRRD(h2, b_ + 10240); TRRD(l3, b_ + 12288); TRRD(h3, b_ + 14336); \
        asm volatile("s_waitcnt lgkmcnt(0)" ::: "memory"); SBAR();                 \
        o[d0] = __builtin_amdgcn_mfma_f32_32x32x16_bf16(pa0, (bf16x8){l0[0], l0[1], l0[2], l0[3], h0[0], h0[1], h0[2], h0[3]}, o[d0], 0, 0, 0);   \
        o[d0] = __builtin_amdgcn_mfma_f32_32x32x16_bf16(pa1, (bf16x8){l1[0], l1[1], l1[2], l1[3], h1[0], h1[1], h1[2], h1[3]}, o[d0], 0, 0, 0);   \
        o[d0] = __builtin_amdgcn_mfma_f32_32x32x16_bf16(pa2, (bf16x8){l2[0], l2[1], l2[2], l2[3], h2[0], h2[1], h2[2], h2[3]}, o[d0], 0, 0, 0);   \
        o[d0] = __builtin_amdgcn_mfma_f32_32x32x16_bf16(pa3, (bf16x8){l3[0], l3[1], l3[2], l3[3], h3[0], h3[1], h3[2], h3[3]}, o[d0], 0, 0, 0); } while (0)
    PV_D0(0); PV_D0(1); PV_D0(2); PV_D0(3);
#undef PV_D0
#undef TRRD
}

template <class TIn, class TOut> struct BlockRef { const TIn* Q; const TIn* K; const TIn* V; TOut* O; int P0; };
template <class TIn> struct Seam {
    int tid;
    bf16x8 qr[8];
    bf16x8 st_v0, st_v1, st_k0, st_k1; f32x4 sf0, sf1, sf2, sf3;
    f32x4 tq[16];
};
__device__ __forceinline__ int swa_jlo(int P0, int W) { const int lowk = P0 - W + 1; return lowk > 0 ? lowk / KVBLK : 0; }
#define ROW(p, k0, rr) ((p) + (size_t)((k0) + (rr)) * D + sc)
#define VMW() asm volatile("s_waitcnt vmcnt(0)" ::: "memory")
#define VMWN(n) asm volatile("s_waitcnt vmcnt(%0)" :: "i"(n) : "memory")
#define SLOAD_H(Kp, Vp, k0) do { S.st_v0 = load8<TIn>(ROW(Vp, k0, sr)); S.st_v1 = load8<TIn>(ROW(Vp, k0, 32 + sr));              \
                         S.st_k0 = load8<TIn>(ROW(Kp, k0, sr)); S.st_k1 = load8<TIn>(ROW(Kp, k0, 32 + sr)); } while (0)
#define SWRITE_HK(bf) do { *(bf16x8*)(K_lds + (bf) * SHM_K + kws) = S.st_k0; *(bf16x8*)(K_lds + (bf) * SHM_K + kws + 32 * 256) = S.st_k1; } while (0)
#define SWRITE_HV(bf) do { *(bf16x8*)(V_lds + (bf) * SHM_V + vst0) = S.st_v0; *(bf16x8*)(V_lds + (bf) * SHM_V + vst1) = S.st_v1; } while (0)
#define SWRITE_H(bf) do { SWRITE_HV(bf); SWRITE_HK(bf); } while (0)
#define SLOAD_F(p, k0) do { S.sf0 = *(const f32x4*)ROW(p, k0, sr); S.sf1 = *(const f32x4*)(ROW(p, k0, sr) + 4);                \
                            S.sf2 = *(const f32x4*)ROW(p, k0, 32 + sr); S.sf3 = *(const f32x4*)(ROW(p, k0, 32 + sr) + 4); } while (0)
#define SWRITE_KF(bf) do { *(bf16x8*)(K_lds + (bf) * SHM_K + kws) = pack8(S.sf0, S.sf1); *(bf16x8*)(K_lds + (bf) * SHM_K + kws + 32 * 256) = pack8(S.sf2, S.sf3); } while (0)
#define SWRITE_VF(bf) do { *(bf16x8*)(V_lds + (bf) * SHM_V + vst0) = pack8(S.sf0, S.sf1); *(bf16x8*)(V_lds + (bf) * SHM_V + vst1) = pack8(S.sf2, S.sf3); } while (0)
template <class TIn, class TOut>
__device__ __forceinline__ void causal_swa_prime(const BlockRef<TIn, TOut>& cur, int W, char* lds, Seam<TIn>& S) {
    constexpr bool F32 = same_t<TIn, float>::v;
    const int tid = S.tid, wid = __builtin_amdgcn_readfirstlane(tid >> 6), lane = tid & 63, r32 = lane & 31, hi = lane >> 5;
    const int sr = tid >> 4, sc = (tid & 15) * 8, kws = KSWZ(sr, sc * 2); char* K_lds = lds + 2 * SHM_V;
    const int kb0 = swa_jlo(cur.P0, W) * KVBLK;
    for (int d0 = 0; d0 < 8; ++d0) S.qr[d0] = load8<TIn>(cur.Q + (size_t)(wid * QBLK + r32) * D + d0 * 16 + hi * 8);
    if constexpr (F32) { SLOAD_F((const float*)cur.K, kb0); VMW(); SWRITE_KF(0); SBAR(); SLOAD_F((const float*)cur.V, kb0); }
    else { SLOAD_H(cur.K, cur.V, kb0); VMW(); SWRITE_HK(0); }
    __syncthreads();
}
template <class TIn, class TOut>
__device__ __forceinline__ void causal_swa_block(const BlockRef<TIn, TOut>& cur, const BlockRef<TIn, TOut>& nxt, int skv, int W, char* lds, Seam<TIn>& S) {
    constexpr bool F32 = same_t<TIn, float>::v;
    const int tid = S.tid, wid = __builtin_amdgcn_readfirstlane(tid >> 6), lane = tid & 63, r32 = lane & 31, hi = lane >> 5;
    const int j_lo = swa_jlo(cur.P0, W);
    int j_hi = (cur.P0 + QB - 1) / KVBLK + 1; if (j_hi > skv / KVBLK) j_hi = skv / KVBLK;
    const int NT = j_hi - j_lo;
    const int kbn = swa_jlo(nxt.P0, W) * KVBLK;
    const int qlo = cur.P0 + wid * QBLK, qm = qlo + r32 - 4 * hi;
    char* V_lds = lds; char* K_lds = lds + 2 * SHM_V;
    float* ws = (float*)(lds + 2 * SHM_V + 2 * SHM_K) + wid * 64; float* li_l = ws, * al_l = ws + 32;
    float m_reg = -1e30f, l_reg = 0; f32x16 o[4] = {};
    const int sr = tid >> 4, sc = (tid & 15) * 8, vst0 = v_st(sr, sc), vst1 = v_st(32 + sr, sc), kws = KSWZ(sr, sc * 2);
    const int vb0 = (int)(uintptr_t)V_lds + v_rd_base(lane);
    const TIn* Kh = cur.K; const TIn* Vh = cur.V;
#define RESC(a) do { if (__any((a) < 1.f)) { if (hi == 0) al_l[r32] = (a); asm volatile("s_waitcnt lgkmcnt(0)" ::: "memory");              \
                     for (int d_ = 0; d_ < 4; ++d_) for (int r = 0; r < 16; ++r) o[d_][r] *= al_l[crow(r, hi)]; } } while (0)
#define KBASE(t) ((j_lo + (t)) * KVBLK)
#define ACT(t) (KBASE(t) <= qlo + QBLK - 1 && KBASE(t) + KVBLK - 1 >= qlo - W + 1)
#define MASKT(P0_, P1_, t) do { const int kb_ = KBASE(t); if ((!SK || ACT(t)) && (kb_ + KVBLK - 1 > qlo || kb_ <= qlo + QBLK - 1 - W)) mask_tile(P0_, P1_, qm - kb_, (unsigned)W); } while (0)
    constexpr int NQL = F32 ? 16 : 8;
    constexpr bool SK = WSKIP && !F32;
#define SEAM_K0() do { VMWN(NQL); if constexpr (F32) { SWRITE_KF(0); SBAR(); SLOAD_F((const float*)nxt.V, kbn); } else { SWRITE_HK(0); } SBAR(); } while (0)
    f32x16 pA0, pA1, pB0, pB1; float mnA, mnB, alA, alB; bf16x8 pa0, pa1, pa2, pa3;
    if constexpr (F32) { VMW(); SWRITE_VF(0); SBAR(); } else { SWRITE_HV(0); SBAR(); }
    if (NT > 1) { if constexpr (F32) SLOAD_F((const float*)Kh, KBASE(1)); else SLOAD_H(Kh, Vh, KBASE(1)); }
    SBAR(); qkt<0, SK>(pA0, pA1, K_lds, r32, hi, S.qr, ACT(0));
    if constexpr (F32) { if (NT > 1) { VMW(); SWRITE_KF(1); SBAR(); SLOAD_F((const float*)Vh, KBASE(1)); } }
    MASKT(pA0, pA1, 0); partialSM(pA0, pA1, m_reg, mnA, alA);
    if (NT > 1) { VMW(); if constexpr (F32) { SWRITE_VF(1); SBAR(); if (NT > 2) SLOAD_F((const float*)Kh, KBASE(2)); } else SWRITE_H(1); }
    __syncthreads();
#define HALF_STEP(PX0, PX1, mnX, alX, PY0, PY1, alY, t, KB, VB, SB) do {                                                      \
        SBAR(); qkt<KB, SK>(PX0, PX1, K_lds, r32, hi, S.qr, ACT(t));                                             \
        finishSM(PY0, PY1, alY, l_reg, pa0, pa1, pa2, pa3); SBAR();                                                           \
        if ((t) + 1 < NT) { if constexpr (F32) { VMW(); SWRITE_KF(SB); SBAR(); SLOAD_F((const float*)Vh, KBASE((t) + 1)); }  \
                            else { SLOAD_H(Kh, Vh, KBASE((t) + 1)); } SBAR(); }                                               \
        pv_tile<VB, SK>(o, vb0, pa0, pa1, pa2, pa3, ACT((t) - 1)); MASKT(PX0, PX1, (t)); partialSM(PX0, PX1, m_reg, mnX, alX);                                        \
        __syncthreads();                                                                                                      \
        if ((t) + 1 < NT) { VMW(); if constexpr (F32) { SWRITE_VF(SB); SBAR(); if ((t) + 2 < NT) SLOAD_F((const float*)Kh, KBASE((t) + 2)); } \
                            else { SWRITE_H(SB); } }                                                                          \
        RESC(alX); __syncthreads(); } while (0)
    for (int t = 1; t + 1 < NT; t += 2) {
        HALF_STEP(pB0, pB1, mnB, alB, pA0, pA1, alA, t, 1, 0, 0);
        HALF_STEP(pA0, pA1, mnA, alA, pB0, pB1, alB, t + 1, 0, 1, 1);
    }
    const bool even = (NT & 1) == 0;
    if (even) { SBAR(); qkt<1, SK>(pB0, pB1, K_lds, r32, hi, S.qr, ACT(NT - 1)); SBAR(); }
#define QROW(e) (nxt.Q + (size_t)(wid * QBLK + r32) * D + ((e) >> 1) * 16 + hi * 8 + ((e) & 1) * 4)
    if constexpr (F32) { SLOAD_F((const float*)nxt.K, kbn); SBAR();
#pragma unroll
        for (int e = 0; e < 8; ++e) S.tq[e] = *(const f32x4*)QROW(e); }
    else { SLOAD_H(nxt.K, nxt.V, kbn); SBAR();
#pragma unroll
        for (int d0 = 0; d0 < 8; ++d0) S.qr[d0] = load8<TIn>(nxt.Q + (size_t)(wid * QBLK + r32) * D + d0 * 16 + hi * 8); }
    SBAR();
    finishSM(pA0, pA1, alA, l_reg, pa0, pa1, pa2, pa3); SBAR();
    if constexpr (F32) {
#pragma unroll
        for (int e = 8; e < 16; ++e) S.tq[e] = *(const f32x4*)QROW(e); SBAR(); }
#undef QROW
    pv_tile<0, SK>(o, vb0, pa0, pa1, pa2, pa3, ACT(even ? NT - 2 : NT - 1));
    if (even) { MASKT(pB0, pB1, NT - 1); partialSM(pB0, pB1, m_reg, mnB, alB); __syncthreads(); RESC(alB);
        finishSM(pB0, pB1, alB, l_reg, pa0, pa1, pa2, pa3); SBAR(); pv_tile<1, SK>(o, vb0, pa0, pa1, pa2, pa3, ACT(NT - 1)); }
    SBAR(); SEAM_K0();
    if (hi == 0) { li_l[r32] = l_reg; ((float*)(lds + LSE_LDS_OFF))[wid * QBLK + r32] = m_reg * SCALE + __logf(l_reg); } asm volatile("s_waitcnt lgkmcnt(0)" ::: "memory");
    float rli[16];
#pragma unroll
    for (int r = 0; r < 16; ++r) rli[r] = __builtin_amdgcn_rcpf(li_l[crow(r, hi)]);
    TOut* Ow = cur.O + (size_t)(wid * QBLK) * D + (size_t)(hi * 4) * D + r32;
#pragma unroll
    for (int r = 0; r < 16; ++r) { const int orow = (r & 3) + 8 * (r >> 2);
#pragma unroll
        for (int d0 = 0; d0 < 4; ++d0) { const float v = o[d0][r] * rli[r];
            if constexpr (same_t<TOut, float>::v) { Ow[orow * D + d0 * 32] = v; }
            else { const float vn = __shfl_xor(v, 1);
                   if ((r32 & 1) == 0) *(unsigned*)(Ow + orow * D + d0 * 32) = cvtpk(v, vn); } } }
    if constexpr (F32) {
#pragma unroll
        for (int d0 = 0; d0 < 8; ++d0) S.qr[d0] = pack8(S.tq[2 * d0], S.tq[2 * d0 + 1]); }
    __syncthreads();
#undef RESC
#undef KBASE
#undef ACT
#undef MASKT
#undef SEAM_K0
#undef HALF_STEP
}
#undef ROW
#undef VMW
#undef VMWN
#undef SLOAD_H
#undef SWRITE_HK
#undef SWRITE_HV
#undef SWRITE_H
#undef SLOAD_F
#undef SWRITE_KF
#undef SWRITE_VF
}
constexpr int T_TOK = 32768, DMODEL = 1024, SEQ = 16384, DFF = 3584, NEXP = 8;
constexpr float ALPHA = 1.6817928305074290f, LN_EPS = 1e-5f;
constexpr int NWAVES = 8;
constexpr size_t MiB = 1u << 20;
constexpr size_t WS_CTL = 0, CTL_ZERO_BYTES = 1 * MiB;
constexpr size_t WS_WIN = 2 * MiB, WS_WRO = 26 * MiB, WS_WQKV = 34 * MiB, WS_WAO = 52 * MiB, WS_WGU = 54 * MiB, WS_WDN = 82 * MiB;
constexpr size_t WS_TAB = 96 * MiB, WS_XB = 112 * MiB;
constexpr size_t WS_LIST = 176 * MiB, WS_TSLOT = 178 * MiB, WS_GATE = 178 * MiB + 256 * 1024, WS_LC = 178 * MiB + 512 * 1024;
constexpr size_t WS_BIG = 179 * MiB;
constexpr size_t BIG_QD = 0, BIG_KH = 64 * MiB, BIG_VT = 128 * MiB, BIG_G = 256 * MiB, BIG_RT = 384 * MiB;
constexpr size_t BIG_HID = 0;
constexpr size_t BIG_QKV = 0, BIG_OP = 288 * MiB, BIG_LSE = 384 * MiB, BIG_O = 386 * MiB;
constexpr size_t BIG_YP = 462 * MiB, BIG_WMGU = 594 * MiB, BIG_WMD = 706 * MiB;
constexpr size_t WS_SLAB = WS_BIG + 762 * MiB;
constexpr size_t WS_END = WS_SLAB + 32 * MiB;
constexpr int CW_TMO = 0, CW_BAR = 4096, CW_CNT = 8192;
constexpr int RING_OFF = 0, RING_BYTES = 131072, AUX_OFF = 131072, AUX_BYTES = 30720, MISC_OFF = AUX_OFF + AUX_BYTES, LDS_BYTES = MISC_OFF + 512;
static_assert(LDS_BYTES <= 163840, "LDS");

#define GAS __attribute__((address_space(1)))
#define LAS __attribute__((address_space(3)))
typedef unsigned short bf16;
typedef unsigned v4u __attribute__((ext_vector_type(4)));
typedef unsigned v2u __attribute__((ext_vector_type(2)));
typedef float f32x4 __attribute__((ext_vector_type(4)));
typedef float f32x16 __attribute__((ext_vector_type(16)));
typedef short bf16x8 __attribute__((ext_vector_type(8)));
typedef short s16x4 __attribute__((ext_vector_type(4)));
typedef GAS unsigned gu32;
#define RLX_AGENT __ATOMIC_RELAXED, __HIP_MEMORY_SCOPE_AGENT
#define LDS_WAIT() asm volatile("s_waitcnt lgkmcnt(0)" ::: "memory")
#define VM_WAIT() asm volatile("s_waitcnt vmcnt(0)" ::: "memory")
__device__ __forceinline__ unsigned f2bf(float f) { unsigned u = __builtin_bit_cast(unsigned, f); return (u + 0x7fffu + ((u >> 16) & 1u)) >> 16; }
__device__ __forceinline__ unsigned pk2(float lo, float hi) { return f2bf(lo) | (f2bf(hi) << 16); }
__device__ __forceinline__ float bflo(unsigned w) { return __builtin_bit_cast(float, w << 16); }
__device__ __forceinline__ float bfhi(unsigned w) { return __builtin_bit_cast(float, w & 0xffff0000u); }
#define XB_TMO      128
#define XB_XCNT(j)  (256  + 64 * (j))
#define XB_XSUB(j)  (1280 + 64 * (j))
#define XB_XGEN(j)  (2304 + 64 * (j))
#define XB_TOP      3328
#define XB_TOPGEN   3392
#define XCD_BAR_WORDS 3456
#define XB_SPIN_CAP (1u << 18)

__device__ __forceinline__ unsigned xb_ld(unsigned* p)              { return __hip_atomic_load(p, __ATOMIC_RELAXED, __HIP_MEMORY_SCOPE_AGENT); }
__device__ __forceinline__ unsigned xb_add(unsigned* p, unsigned v) { return __hip_atomic_fetch_add(p, v, __ATOMIC_RELAXED, __HIP_MEMORY_SCOPE_AGENT); }
__device__ __forceinline__ unsigned xb_xcc_id() { return (unsigned)__builtin_amdgcn_s_getreg((3 << 11) | 20) & 0xFu; }
#define XB_SPIN(cond, bar) do { unsigned _sp = 0; while (cond) { __builtin_amdgcn_s_sleep(1); \
    if ((++_sp & 255u) == 0u) { if (xb_ld(&(bar)[XB_TMO])) break; if (_sp > XB_SPIN_CAP) { atomicAdd(&(bar)[XB_TMO], 1u); break; } } } } while (0)

struct XcdBarrier {
    unsigned* bar; unsigned x;
    volatile LAS unsigned* st;
};

__device__ __forceinline__ XcdBarrier xcd_barrier_post(unsigned* bar, volatile LAS unsigned* st) {
    XcdBarrier b; b.bar = bar; b.x = xb_xcc_id(); b.st = st;
    if (threadIdx.x == 0) (void)xb_add(&bar[XB_XCNT(b.x)], 1u);
    return b;
}
__device__ __forceinline__ void xcd_barrier_complete(unsigned* bar, unsigned x, unsigned& nloc, unsigned& nx) {
    const unsigned G = gridDim.x * gridDim.y * gridDim.z;
    unsigned sum, cnt, mine, sp = 0u;
    for (;;) {
        sum = 0u; cnt = 0u; mine = 0u;
#pragma unroll
        for (unsigned j = 0; j < 16; ++j) { const unsigned c = xb_ld(&bar[XB_XCNT(j)]); sum += c; cnt += (c > 0u) ? 1u : 0u; mine = (j == x) ? c : mine; }
        if (sum == G) break;
        __builtin_amdgcn_s_sleep(1);
        if ((++sp & 255u) == 0u) { if (xb_ld(&bar[XB_TMO])) break; if (sp > XB_SPIN_CAP) { atomicAdd(&bar[XB_TMO], 1u); break; } }
    }
    nloc = mine > 0u ? mine : 1u; nx = cnt > 0u ? cnt : 1u;
}

__device__ __forceinline__ void xcd_barrier(const XcdBarrier& b) {
    asm volatile("s_waitcnt vmcnt(0)" ::: "memory");
    __syncthreads();
    if (threadIdx.x == 0) {
        unsigned* bar = b.bar;
        __builtin_amdgcn_s_waitcnt(0);
        unsigned nloc = b.st[0], nx = b.st[1];
        if (nloc == 0u) { xcd_barrier_complete(bar, b.x, nloc, nx); b.st[0] = nloc; b.st[1] = nx; }
        const unsigned old = xb_add(&bar[XB_XSUB(b.x)], 1u);
        const unsigned gen = old / nloc;
        if (old + 1u == (gen + 1u) * nloc) {
            __builtin_amdgcn_fence(__ATOMIC_RELEASE, "agent");
            asm volatile("s_waitcnt vmcnt(0)" ::: "memory");
            const unsigned og = xb_add(&bar[XB_TOP], 1u);
            const unsigned tg = og / nx;
            if (og + 1u == (tg + 1u) * nx) xb_add(&bar[XB_TOPGEN], 1u);
            else XB_SPIN(xb_ld(&bar[XB_TOPGEN]) == tg, bar);
            __builtin_amdgcn_fence(__ATOMIC_ACQUIRE, "agent");
            xb_add(&bar[XB_XGEN(b.x)], 1u);
            asm volatile("s_waitcnt vmcnt(0)" ::: "memory");
        } else {
            XB_SPIN(xb_ld(&bar[XB_XGEN(b.x)]) == gen, bar);
            __builtin_amdgcn_fence(__ATOMIC_ACQUIRE, "agent");
            asm volatile("s_waitcnt vmcnt(0)" ::: "memory");
        }
    }
    __syncthreads();
}
struct Args { const float* in[15]; float* out; unsigned char* ws; };
struct Frame {
    LAS unsigned char* lds;
    volatile LAS unsigned* MISC;
    int tid, lane, wave, G, c;
};
__device__ __forceinline__ unsigned long long arg_u64(const Frame& F, int k) { const unsigned long long v = ((const LAS unsigned long long*)(F.lds + MISC_OFF + 128))[k];
    return ((unsigned long long)(unsigned)__builtin_amdgcn_readfirstlane((int)(unsigned)(v >> 32)) << 32) | (unsigned long long)(unsigned)__builtin_amdgcn_readfirstlane((int)(unsigned)v); }
#define ARGI(F, k) ((const float*)(const GAS float*)arg_u64(F, (k)))
#define ARGX(F) ((float*)(GAS float*)arg_u64(F, 15))
#define ARGWS(F) ((unsigned char*)(GAS unsigned char*)arg_u64(F, 16))
#define F_CTL(F) ((gu32*)(ARGWS(F) + WS_CTL))
__device__ __forceinline__ void frame_refresh(Frame& F) { int t = F.tid; asm volatile("" : "+v"(t)); F.tid = t; F.lane = t & 63; F.wave = __builtin_amdgcn_readfirstlane(t >> 6); unsigned l = (unsigned)(uintptr_t)F.lds; int c_ = F.c, g_ = F.G; asm volatile("" : "+s"(l), "+s"(c_), "+s"(g_)); F.lds = (LAS unsigned char*)(uintptr_t)l; F.c = c_; F.G = g_; }
__device__ __forceinline__ float wave_sum(float v) {
#pragma unroll
    for (int o = 1; o < 64; o <<= 1) v += __shfl_xor(v, o);
    return v;
}
__device__ __forceinline__ s16x4 vtr(const LAS unsigned char* p) { return __builtin_bit_cast(s16x4, __builtin_amdgcn_ds_read_tr16_b64_v4i16((LAS s16x4*)p)); }
__device__ __forceinline__ int crow(int r, int hi) { return (r & 3) + 8 * (r >> 2) + 4 * hi; }

struct CvItem { const float* src; bf16* dst; int N, K; };
template <int MAP> __device__ __forceinline__ CvItem cv_make(const float* W, int K, int N, bf16* WT, int item) {
    const int nblk = N / 64, kb = item / nblk, nb = item - kb * nblk, n0 = 64 * nb; int dr = n0;
    if (MAP == 1) dr = n0 < 2048 ? n0 : (n0 < 4096 ? n0 + 2048 : n0 - 2048);
    if (MAP == 2) dr = (n0 >> 7) * 256 + (n0 & 127);
    if (MAP == 3) dr = (n0 >> 7) * 256 + 128 + (n0 & 127);
    CvItem c; c.src = W + (size_t)(64 * kb) * N + n0; c.dst = WT + (size_t)dr * K + 64 * kb; c.N = N; c.K = K; return c;
}
__device__ __forceinline__ void cv_load(const CvItem& c, f32x4 (&r)[16], int lane) {
    const float* p = c.src + (size_t)(lane >> 4) * c.N + 4 * (lane & 15);
#pragma unroll
    for (int i = 0; i < 16; ++i) r[i] = *(const GAS f32x4*)(p + (size_t)(4 * i) * c.N);
}
__device__ __forceinline__ void cv_store(const CvItem& c, const f32x4 (&r)[16], LAS float* scr, int lane) {
#pragma unroll
    for (int i = 0; i < 16; ++i) { LAS float* s = scr + (4 * i + (lane >> 4)) * 65 + 4 * (lane & 15); s[0] = r[i].x; s[1] = r[i].y; s[2] = r[i].z; s[3] = r[i].w; }
    LDS_WAIT(); asm volatile("" ::: "memory");
    const int ch = lane & 7;
#pragma unroll
    for (int jj = 0; jj < 8; ++jj) { const int n = (lane >> 3) + 8 * jj; const LAS float* s = scr + (8 * ch) * 65 + n;
        v4u o; o.x = pk2(s[0 * 65], s[1 * 65]); o.y = pk2(s[2 * 65], s[3 * 65]); o.z = pk2(s[4 * 65], s[5 * 65]); o.w = pk2(s[6 * 65], s[7 * 65]);
        *(GAS v4u*)(c.dst + (size_t)n * c.K + 8 * ch) = o; }
    LDS_WAIT(); asm volatile("" ::: "memory");
}
constexpr int CV_SCR_BYTES = 64 * 65 * 4;
__device__ __forceinline__ CvItem cv_dense(Frame& F, int it) {
    constexpr int I_WIN = 16 * 96, I_WRO = 32 * 16, I_QKV = 16 * 72, I_WAO = 8 * 16, I_GU = 16 * 56, I_DN = 56 * 16;
    constexpr int PERJ = I_WIN + I_WRO + I_QKV + I_WAO + 2 * I_GU + I_DN;
    const int j = it / PERJ; int r = it - j * PERJ;
    if (r < I_WIN) return cv_make<1>(ARGI(F, 3) + (size_t)j * 1024 * 6144, 1024, 6144, (bf16*)(ARGWS(F) + WS_WIN) + (size_t)j * 6144 * 1024, r); r -= I_WIN;
    if (r < I_WRO) return cv_make<0>(ARGI(F, 5) + (size_t)j * 2048 * 1024, 2048, 1024, (bf16*)(ARGWS(F) + WS_WRO) + (size_t)j * 1024 * 2048, r); r -= I_WRO;
    if (r < I_QKV) return cv_make<0>(ARGI(F, 6) + (size_t)j * 1024 * 4608, 1024, 4608, (bf16*)(ARGWS(F) + WS_WQKV) + (size_t)j * 4608 * 1024, r); r -= I_QKV;
    if (r < I_WAO) return cv_make<0>(ARGI(F, 7) + (size_t)j * 512 * 1024, 512, 1024, (bf16*)(ARGWS(F) + WS_WAO) + (size_t)j * 1024 * 512, r); r -= I_WAO;
    if (r < I_GU) return cv_make<2>(ARGI(F, 8) + (size_t)j * 1024 * 3584, 1024, 3584, (bf16*)(ARGWS(F) + WS_WGU) + (size_t)j * 7168 * 1024, r); r -= I_GU;
    if (r < I_GU) return cv_make<3>(ARGI(F, 9) + (size_t)j * 1024 * 3584, 1024, 3584, (bf16*)(ARGWS(F) + WS_WGU) + (size_t)j * 7168 * 1024, r); r -= I_GU;
    return cv_make<0>(ARGI(F, 10) + (size_t)j * 3584 * 1024, 3584, 1024, (bf16*)(ARGWS(F) + WS_WDN) + (size_t)j * 1024 * 3584, r);
}
constexpr int CV_DENSE_ITEMS = 2 * (16 * 96 + 32 * 16 + 16 * 72 + 8 * 16 + 2 * 16 * 56 + 56 * 16);
__device__ __forceinline__ CvItem cv_moe(Frame& F, int it, int j) {
    constexpr int I_GU = 16 * 56, I_DN = 56 * 16, PERE = 2 * I_GU + I_DN;
    bf16* WMGU = (bf16*)(ARGWS(F) + WS_BIG + BIG_WMGU); bf16* WMD = (bf16*)(ARGWS(F) + WS_BIG + BIG_WMD);
    const int e = it / PERE; int r = it - e * PERE; const size_t wofs = ((size_t)j * NEXP + e) * 1024 * 3584;
    if (r < I_GU) return cv_make<2>(ARGI(F, 12) + wofs, 1024, 3584, WMGU + (size_t)e * 7168 * 1024, r); r -= I_GU;
    if (r < I_GU) return cv_make<3>(ARGI(F, 13) + wofs, 1024, 3584, WMGU + (size_t)e * 7168 * 1024, r); r -= I_GU;
    return cv_make<0>(ARGI(F, 14) + wofs, 3584, 1024, WMD + (size_t)e * 1024 * 3584, r);
}
constexpr int CV_MOE_ITEMS = NEXP * (2 * 16 * 56 + 56 * 16);
template <bool MOE> __device__ __forceinline__ void cv_run(Frame& F, int first, int stride, int total, int j) {
    LAS float* scr = (LAS float*)(F.lds + RING_OFF + F.wave * CV_SCR_BYTES);
    if (first >= total) return;
    f32x4 ra[16], rb[16];
    CvItem ca = MOE ? cv_moe(F, first, j) : cv_dense(F, first), cb = ca;
    cv_load(ca, ra, F.lane);
    for (int it = first; it < total; it += 2 * stride) {
        const bool hb = it + stride < total;
        if (hb) { cb = MOE ? cv_moe(F, it + stride, j) : cv_dense(F, it + stride); cv_load(cb, rb, F.lane); }
        cv_store(ca, ra, scr, F.lane);
        if (!hb) break;
        const bool ha = it + 2 * stride < total;
        if (ha) { ca = MOE ? cv_moe(F, it + 2 * stride, j) : cv_dense(F, it + 2 * stride); cv_load(ca, ra, F.lane); }
        cv_store(cb, rb, scr, F.lane);
        if (!ha) break;
    }
}
__device__ __forceinline__ void p0_prologue(Frame& F) {
    const int gw = F.c * NWAVES + F.wave, NGW = F.G * NWAVES;
    cv_run<false>(F, gw, NGW, CV_DENSE_ITEMS, 0);
    { float* tab = (float*)(ARGWS(F) + WS_TAB); const int gt = F.c * 512 + F.tid, NT = F.G * 512;
      for (int e = gt; e < SEQ * 128; e += NT) { const int pos = e >> 7, cc = e & 127;
          const double ang = (double)pos * exp(-9.210340371976184 * (double)cc * (1.0 / 128.0)); double sn, cs; sincos(ang, &sn, &cs);
          typedef float f32x2t __attribute__((ext_vector_type(2))); *(GAS f32x2t*)(tab + (size_t)e * 2) = (f32x2t){(float)cs, (float)sn}; } }
    { const float* x = ARGI(F, 0); bf16* XB = (bf16*)(ARGWS(F) + WS_XB);
      for (int m0 = gw; m0 < T_TOK; m0 += 4 * NGW) { f32x4 xv[4][4];
#pragma unroll
          for (int r = 0; r < 4; ++r) { const int m = m0 + r * NGW < T_TOK ? m0 + r * NGW : gw; const GAS f32x4* xr = (const GAS f32x4*)(x + (size_t)m * DMODEL) + F.lane;
#pragma unroll
              for (int jj = 0; jj < 4; ++jj) xv[r][jj] = xr[64 * jj]; }
#pragma unroll
          for (int r = 0; r < 4; ++r) { const int m = m0 + r * NGW; if (m >= T_TOK) break; GAS unsigned long long* o8 = (GAS unsigned long long*)(XB + (size_t)m * DMODEL) + F.lane;
#pragma unroll
              for (int jj = 0; jj < 4; ++jj) { const f32x4 v = xv[r][jj]; o8[64 * jj] = (unsigned long long)pk2(v.x, v.y) | ((unsigned long long)pk2(v.z, v.w) << 32); } } } }
}
template <bool SUB> __device__ __forceinline__ void moe_convert(Frame& F, int j) {
    if (SUB && ((F.c >> 3) & 3) != 0) return;
    const int gw = (SUB ? ((F.c >> 5) * 8 + (F.c & 7)) : F.c) * NWAVES + F.wave, NGW = (SUB ? 64 : F.G) * NWAVES;
    cv_run<true>(F, gw, NGW, CV_MOE_ITEMS, j);
}
__device__ __forceinline__ void moe_prefix_lds(Frame& F, LAS int* PB) {
    const int* LC = (const int*)(ARGWS(F) + WS_LC);
    for (int i = F.tid; i < 2048; i += 512) PB[i] = LC[i];
    __syncthreads();
    { const int e = F.wave, l = F.lane;
      const int v0 = PB[(4 * l) * 8 + e], v1 = PB[(4 * l + 1) * 8 + e], v2 = PB[(4 * l + 2) * 8 + e], v3 = PB[(4 * l + 3) * 8 + e];
      const int tot = v0 + v1 + v2 + v3; int inc = tot;
#pragma unroll
      for (int o = 1; o < 64; o <<= 1) { const int t = __shfl_up(inc, o); inc += (l >= o) ? t : 0; }
      const int ex = inc - tot;
      PB[(4 * l) * 8 + e] = ex; PB[(4 * l + 1) * 8 + e] = ex + v0; PB[(4 * l + 2) * 8 + e] = ex + v0 + v1; PB[(4 * l + 3) * 8 + e] = ex + v0 + v1 + v2;
      if (l == 63) PB[2048 + e] = inc; }
    __syncthreads();
}
__device__ __forceinline__ void unpack8(const v4u w, float (&v)[8]) { v[0] = bflo(w.x); v[1] = bfhi(w.x); v[2] = bflo(w.y); v[3] = bfhi(w.y); v[4] = bflo(w.z); v[5] = bfhi(w.z); v[6] = bflo(w.w); v[7] = bfhi(w.w); }
template <int MODE, bool FINAL> __device__ __forceinline__ void ln_pass(Frame& F, int li  , int sub  , int j) {
    const int gw = F.c * NWAVES + F.wave, NGW = F.G * NWAVES;
    const float* gain = ARGI(F, 1) + (size_t)(li * 2 + sub) * DMODEL; const float* bias = ARGI(F, 2) + (size_t)(li * 2 + sub) * DMODEL;
    float gv[2][8], bv[2][8];
#pragma unroll
    for (int q = 0; q < 2; ++q)
#pragma unroll
        for (int h2 = 0; h2 < 2; ++h2) { const f32x4 g4 = *(const GAS f32x4*)(gain + 512 * q + 8 * F.lane + 4 * h2), b4 = *(const GAS f32x4*)(bias + 512 * q + 8 * F.lane + 4 * h2);
#pragma unroll
            for (int k = 0; k < 4; ++k) { gv[q][4 * h2 + k] = g4[k]; bv[q][4 * h2 + k] = b4[k]; } }
    bf16* XB = (bf16*)(ARGWS(F) + WS_XB);
    int rtb[8]; LAS int* PB = (LAS int*)(F.lds + RING_OFF);
    if (MODE == 2) { moe_prefix_lds(F, PB); int acc = 0;
#pragma unroll
        for (int e = 0; e < 8; ++e) { rtb[e] = acc; acc += (PB[2048 + e] + 255) >> 8; } }
    const unsigned* tslot = (const unsigned*)(ARGWS(F) + WS_TSLOT); const float* gate = (const float*)(ARGWS(F) + WS_GATE); const bf16* YP = (const bf16*)(ARGWS(F) + WS_BIG + BIG_YP);
    for (int m0 = gw; m0 < T_TOK; m0 += 4 * NGW) {
        v4u zr[4][2]; unsigned ts[4][2]; float gk[4][2]; v4u yv[4][2][2]; int yrow[4][2];
#pragma unroll
        for (int r = 0; r < 4; ++r) { const int m = m0 + r * NGW; const bool ok = m < T_TOK; const int mm = ok ? m : gw;
            const GAS v4u* xr = (const GAS v4u*)(XB + (size_t)mm * DMODEL) + F.lane; zr[r][0] = xr[0]; zr[r][1] = xr[64];
            if (MODE == 2) { ts[r][0] = tslot[2 * mm]; ts[r][1] = tslot[2 * mm + 1]; gk[r][0] = gate[2 * mm]; gk[r][1] = gate[2 * mm + 1]; } }
        if (MODE == 2) {
#pragma unroll
            for (int r = 0; r < 4; ++r) { const int m = m0 + r * NGW; const int mm = m < T_TOK ? m : gw;
#pragma unroll
                for (int k2 = 0; k2 < 2; ++k2) { const int e = (int)(ts[r][k2] >> 20), slot = PB[(mm >> 7) * 8 + e] + (int)(ts[r][k2] & 0xfffffu);
                    int rb = 0;
#pragma unroll
                    for (int q = 0; q < 8; ++q) rb = (q == e) ? rtb[q] : rb;
                    yrow[r][k2] = rb * 256 + slot;
                    const GAS v4u* yr = (const GAS v4u*)(YP + (size_t)(yrow[r][k2] < 65536 ? yrow[r][k2] : 0) * DMODEL) + F.lane; yv[r][k2][0] = yr[0]; yv[r][k2][1] = yr[64]; } } }
#pragma unroll
        for (int r = 0; r < 4; ++r) { const int m = m0 + r * NGW; if (m >= T_TOK) break;
            float v[2][8]; float s = 0.f;
#pragma unroll
            for (int q = 0; q < 2; ++q) unpack8(zr[r][q], v[q]);
            if (MODE == 2) {
#pragma unroll
                for (int q = 0; q < 2; ++q)
#pragma unroll
                    for (int k = 0; k < 8; ++k) v[q][k] *= ALPHA;
#pragma unroll
                for (int k2 = 0; k2 < 2; ++k2) { const float g_ = gk[r][k2];
                    if (yrow[r][k2] < 65536) {
#pragma unroll
                        for (int q = 0; q < 2; ++q) { float y[8]; unpack8(yv[r][k2][q], y);
#pragma unroll
                            for (int k = 0; k < 8; ++k) v[q][k] += g_ * y[k]; } }
                    else { const int lr = yrow[r][k2] - 65536, tl = lr >> 8, rr = lr & 255;
                        const float* SL = (const float*)(ARGWS(F) + WS_SLAB);
#pragma unroll
                        for (int q = 0; q < 2; ++q) { const int col = 512 * q + 8 * F.lane, ct = col >> 8, cc = col & 255;
#pragma unroll
                            for (int kp = 0; kp < 4; ++kp) { const GAS f32x4* sp = (const GAS f32x4*)(SL + ((size_t)(kp * 32 + tl * 4 + ct) << 16) + (size_t)rr * 256 + cc); const f32x4 a0 = sp[0], a1 = sp[1];
                                v[q][0] += g_ * a0.x; v[q][1] += g_ * a0.y; v[q][2] += g_ * a0.z; v[q][3] += g_ * a0.w; v[q][4] += g_ * a1.x; v[q][5] += g_ * a1.y; v[q][6] += g_ * a1.z; v[q][7] += g_ * a1.w; } } } }
            }
#pragma unroll
            for (int q = 0; q < 2; ++q)
#pragma unroll
                for (int k = 0; k < 8; ++k) s += v[q][k];
            const float mean = wave_sum(s) * (1.f / DMODEL); float s2 = 0.f;
#pragma unroll
            for (int q = 0; q < 2; ++q)
#pragma unroll
                for (int k = 0; k < 8; ++k) { v[q][k] -= mean; s2 += v[q][k] * v[q][k]; }
            const float rstd = 1.f / sqrtf(wave_sum(s2) * (1.f / DMODEL) + LN_EPS);
            GAS v4u* xw = (GAS v4u*)(XB + (size_t)m * DMODEL) + F.lane;
#pragma unroll
            for (int q = 0; q < 2; ++q) { float o[8];
#pragma unroll
                for (int k = 0; k < 8; ++k) o[k] = v[q][k] * rstd * gv[q][k] + bv[q][k];
                if (FINAL) { GAS f32x4* op = (GAS f32x4*)(ARGX(F) + (size_t)m * DMODEL + 512 * q + 8 * F.lane); op[0] = (f32x4){o[0], o[1], o[2], o[3]}; op[1] = (f32x4){o[4], o[5], o[6], o[7]}; }
                else { v4u w; w.x = pk2(o[0], o[1]); w.y = pk2(o[2], o[3]); w.z = pk2(o[4], o[5]); w.w = pk2(o[6], o[7]); xw[64 * q] = w; } }
        }
    }
}
__device__ __forceinline__ void ln_route_pass(Frame& F, int li, int j) {
    const float* gain = ARGI(F, 1) + (size_t)(li * 2) * DMODEL; const float* bias = ARGI(F, 2) + (size_t)(li * 2) * DMODEL;
    LAS float* WRT = (LAS float*)(F.lds + RING_OFF);
    LAS float* SELG = (LAS float*)(F.lds + RING_OFF + 32768);
    LAS int* SELE = (LAS int*)(F.lds + RING_OFF + 32768 + 1024);
    const float* wr = ARGI(F, 11) + (size_t)j * DMODEL * NEXP;
    for (int i = F.tid; i < DMODEL * NEXP; i += 512) { const int d = i >> 3, e = i & 7; WRT[e * DMODEL + d] = wr[i]; }
    float gv[2][8], bv[2][8];
#pragma unroll
    for (int q = 0; q < 2; ++q)
#pragma unroll
        for (int h2 = 0; h2 < 2; ++h2) { const f32x4 g4 = *(const GAS f32x4*)(gain + 512 * q + 8 * F.lane + 4 * h2), b4 = *(const GAS f32x4*)(bias + 512 * q + 8 * F.lane + 4 * h2);
#pragma unroll
            for (int k = 0; k < 4; ++k) { gv[q][4 * h2 + k] = g4[k]; bv[q][4 * h2 + k] = b4[k]; } }
    bf16* XB = (bf16*)(ARGWS(F) + WS_XB);
    __syncthreads();
    const int ntok = T_TOK / F.G, tok0 = F.c * ntok;
    v4u znx[2]; { const GAS v4u* x0 = (const GAS v4u*)(XB + (size_t)(tok0 + F.wave) * DMODEL) + F.lane; znx[0] = x0[0]; znx[1] = x0[64]; }
    for (int tl = F.wave; tl < ntok; tl += NWAVES) { const int m = tok0 + tl;
        GAS v4u* xr = (GAS v4u*)(XB + (size_t)m * DMODEL) + F.lane;
        float v[2][8]; float s = 0.f;
        const v4u zc0 = znx[0], zc1 = znx[1];
        if (tl + NWAVES < ntok) { const GAS v4u* xn_ = (const GAS v4u*)(XB + (size_t)(m + NWAVES) * DMODEL) + F.lane; znx[0] = xn_[0]; znx[1] = xn_[64]; }
        unpack8(zc0, v[0]); unpack8(zc1, v[1]);
#pragma unroll
        for (int q = 0; q < 2; ++q)
#pragma unroll
            for (int k = 0; k < 8; ++k) s += v[q][k];
        const float mean = wave_sum(s) * (1.f / DMODEL); float s2 = 0.f;
#pragma unroll
        for (int q = 0; q < 2; ++q)
#pragma unroll
            for (int k = 0; k < 8; ++k) { v[q][k] -= mean; s2 += v[q][k] * v[q][k]; }
        const float rstd = 1.f / sqrtf(wave_sum(s2) * (1.f / DMODEL) + LN_EPS);
        float lg[8];
#pragma unroll
        for (int e = 0; e < 8; ++e) lg[e] = 0.f;
#pragma unroll
        for (int q = 0; q < 2; ++q) { float o[8];
#pragma unroll
            for (int k = 0; k < 8; ++k) o[k] = v[q][k] * rstd * gv[q][k] + bv[q][k];
            v4u w; w.x = pk2(o[0], o[1]); w.y = pk2(o[2], o[3]); w.z = pk2(o[4], o[5]); w.w = pk2(o[6], o[7]); xr[64 * q] = w;
#pragma unroll
            for (int e = 0; e < 8; ++e) { const f32x4 w0 = *(const LAS f32x4*)(WRT + e * DMODEL + 512 * q + 8 * F.lane), w1 = *(const LAS f32x4*)(WRT + e * DMODEL + 512 * q + 8 * F.lane + 4);
                lg[e] += ((o[0] * w0.x + o[1] * w0.y) + (o[2] * w0.z + o[3] * w0.w)) + ((o[4] * w1.x + o[5] * w1.y) + (o[6] * w1.z + o[7] * w1.w)); } }
#pragma unroll
        for (int e = 0; e < 8; ++e) lg[e] = wave_sum(lg[e]);
        int e1 = 0; float v1 = lg[0];
#pragma unroll
        for (int e = 1; e < 8; ++e) if (lg[e] > v1) { v1 = lg[e]; e1 = e; }
        int e2 = -1; float v2 = -3.0e38f;
#pragma unroll
        for (int e = 0; e < 8; ++e) if (e != e1 && lg[e] > v2) { v2 = lg[e]; e2 = e; }
        const float g1 = 1.f / (1.f + __expf(v2 - v1)), g2 = 1.f - g1;
        if (F.lane == 0) { SELE[2 * tl] = e1; SELE[2 * tl + 1] = e2; SELG[2 * tl] = g1; SELG[2 * tl + 1] = g2; }
    }
    __syncthreads();
    int myrank = 0, mye = 0;
    if (F.tid < 2 * ntok) { mye = SELE[F.tid];
        for (int i2 = 0; i2 < F.tid; ++i2) myrank += (SELE[i2] == mye) ? 1 : 0; }
    if (F.tid < 8) { int cnt = 0; for (int i2 = 0; i2 < 2 * ntok; ++i2) cnt += (SELE[i2] == F.tid) ? 1 : 0; ((int*)(ARGWS(F) + WS_LC))[F.c * 8 + F.tid] = cnt; }
    if (F.tid < 2 * ntok) { const int tok = tok0 + (F.tid >> 1);
        ((int*)(ARGWS(F) + WS_LIST))[(F.c * 8 + mye) * 256 + myrank] = tok;
        ((unsigned*)(ARGWS(F) + WS_TSLOT))[2 * tok + (F.tid & 1)] = ((unsigned)mye << 20) | (unsigned)myrank;
        ((float*)(ARGWS(F) + WS_GATE))[2 * tok + (F.tid & 1)] = SELG[F.tid]; }
    __syncthreads();
}
#define LDS_BAR() do { asm volatile("s_waitcnt lgkmcnt(0)" ::: "memory"); __builtin_amdgcn_s_barrier(); asm volatile("" ::: "memory"); } while (0)
__device__ __forceinline__ int off64(int row, int colbyte) { return row * 128 + (colbyte ^ ((((row >> 1) & 1) << 6) | (((row >> 3) & 1) << 5))); }
__device__ __forceinline__ float log2_gamma(int h) { return __builtin_amdgcn_logf(1.0f - __builtin_amdgcn_exp2f((float)(-5 - h))); }

__device__ __forceinline__ void ret_state_phase(Frame& F) {
    const int c = F.c; if (c >= 256) return;
    const int dt = c & 3, et = (c >> 2) & 7, h = (c >> 5) & 3, b = c >> 7;
    const int w = F.wave, lane = F.lane, dq = w & 3, eh = w >> 2, g = lane >> 4, l15 = lane & 15, q = l15 >> 2, p = l15 & 3;
    const bf16* KH = (const bf16*)(ARGWS(F) + WS_BIG + BIG_KH) + (size_t)b * SEQ * 1024 + h * 256 + dt * 64;
    const bf16* VT = (const bf16*)(ARGWS(F) + WS_BIG + BIG_VT) + ((size_t)((b * 4 + h) * 128) << 16);
    bf16* RT = (bf16*)(ARGWS(F) + WS_BIG + BIG_RT) + ((size_t)((b * 4 + h) * 128) << 17);
    const float dec = __builtin_amdgcn_exp2f(128.f * log2_gamma(h));
    const int r0 = F.tid >> 3, ch = F.tid & 7;
    const bf16* kp0 = KH + (size_t)r0 * 1024 + ch * 8; const bf16* kp1 = kp0 + (size_t)64 * 1024;
    const int lo0 = off64(r0, ch * 16), lo1 = off64(r0 + 64, ch * 16);
    int vsrc[2];
#pragma unroll
    for (int k = 0; k < 2; ++k) { const int pp = F.tid + 512 * k, oct = pp >> 6, e = 64 * et + (pp & 63); vsrc[k] = ((((e >> 5) * 8 + (oct >> 1)) * 2 + (oct & 1)) * 32 + (e & 31)) * 8; }
    const int vrd = (g * 64 + 32 * eh + l15) * 16;
    int roff[2];
#pragma unroll
    for (int x = 0; x < 2; ++x) { const int e = 64 * et + 16 * (2 * eh + x) + l15, d = 64 * dt + 16 * dq + 4 * g; roff[x] = ((((e >> 5) * 16 + (d >> 4)) * 2 + ((d >> 3) & 1)) * 32 + (e & 31)) * 8 + (d & 7); }
    float z0 = 0.f; asm volatile("" : "+v"(z0));
    f32x4 acc[2] = {(f32x4){z0, z0, z0, z0}, (f32x4){z0, z0, z0, z0}};
    v4u kq[4][2], vs[4][2];
#define R2A_LOAD(st, nn) do { const int n_ = (nn) < 128 ? (nn) : 127; kq[st][0] = *(const GAS v4u*)(kp0 + (size_t)n_ * 128 * 1024); kq[st][1] = *(const GAS v4u*)(kp1 + (size_t)n_ * 128 * 1024); \
        vs[st][0] = *(const GAS v4u*)(VT + ((size_t)n_ << 16) + vsrc[0]); vs[st][1] = *(const GAS v4u*)(VT + ((size_t)n_ << 16) + vsrc[1]); } while (0)
    R2A_LOAD(0, 0); R2A_LOAD(1, 1); R2A_LOAD(2, 2);
    for (int n4 = 0; n4 < 128; n4 += 4) {
#pragma unroll
        for (int u4 = 0; u4 < 4; ++u4) { const int n = n4 + u4;
            LAS unsigned char* buf = F.lds + RING_OFF + (u4 & 1) * 32768; LAS unsigned char* vbuf = buf + 16384;
            *(LAS v4u*)(buf + lo0) = kq[u4][0]; *(LAS v4u*)(buf + lo1) = kq[u4][1];
            *(LAS v4u*)(vbuf + 16 * F.tid) = vs[u4][0]; *(LAS v4u*)(vbuf + 16 * F.tid + 8192) = vs[u4][1];
            R2A_LOAD((u4 + 3) & 3, n + 3);
            LDS_BAR();
            if (n > 0) {
#pragma unroll
                for (int x = 0; x < 2; ++x) { v2u o; o.x = pk2(acc[x][0], acc[x][1]); o.y = pk2(acc[x][2], acc[x][3]); *(GAS v2u*)(RT + ((size_t)n << 17) + roff[x]) = o; } }
#pragma unroll
            for (int ks = 0; ks < 4; ++ks) {
                const s16x4 t0 = vtr(buf + off64(32 * ks + 8 * g + q, 32 * dq + 8 * p)), t1 = vtr(buf + off64(32 * ks + 8 * g + 4 + q, 32 * dq + 8 * p));
                const bf16x8 a = (bf16x8){t0[0], t0[1], t0[2], t0[3], t1[0], t1[1], t1[2], t1[3]};
#pragma unroll
                for (int x = 0; x < 2; ++x) { const bf16x8 bfr = *(const LAS bf16x8*)(vbuf + vrd + ks * 4096 + x * 256); acc[x] = __builtin_amdgcn_mfma_f32_16x16x32_bf16(a, bfr, acc[x], 0, 0, 0); }
            }
#pragma unroll
            for (int x = 0; x < 2; ++x) acc[x] = acc[x] * dec;
        }
    }
#undef R2A_LOAD
    __syncthreads();
}

__device__ __forceinline__ void ret_out_phase(Frame& F, int j, bf16* YOUT) {
    const int w = F.wave, lane = F.lane, r32 = lane & 31, hi = lane >> 5, tid = F.tid;
    LAS unsigned char* QDI = F.lds + RING_OFF;
    LAS unsigned char* KHI = F.lds + RING_OFF + 65536;
    LAS unsigned char* PI = KHI;
    LAS float* STAT = (LAS float*)(F.lds + AUX_OFF);
    LAS unsigned char* YST = F.lds + RING_OFF;
    const bf16* QD = (const bf16*)(ARGWS(F) + WS_BIG + BIG_QD); const bf16* KH = (const bf16*)(ARGWS(F) + WS_BIG + BIG_KH);
    const bf16* VT = (const bf16*)(ARGWS(F) + WS_BIG + BIG_VT); const bf16* RT = (const bf16*)(ARGWS(F) + WS_BIG + BIG_RT);
    const bf16* GIN = (const bf16*)(ARGWS(F) + WS_BIG + BIG_G);
    const float* gn = ARGI(F, 4) + (size_t)j * 2048;
    const int ib = w & 3, jb0 = 2 * (w >> 2), jb1 = jb0 + 1;
    for (int U = F.c; U < 1024; U += F.G) {
        const int n = U & 127, h = (U >> 7) & 3, b = U >> 9;
        const size_t tok0 = (size_t)b * SEQ + (size_t)n * 128;
        { int tid1 = tid; asm volatile("" : "+v"(tid1)); v4u qv[8], kv[8];
#pragma unroll
          for (int k = 0; k < 8; ++k) { const int x = tid1 + 512 * k, row = x >> 5, chk = x & 31; const size_t go = (tok0 + row) * 1024 + h * 256 + chk * 8;
              qv[k] = *(const GAS v4u*)(QD + go); kv[k] = *(const GAS v4u*)(KH + go); }
#pragma unroll
          for (int k = 0; k < 8; ++k) { const int x = tid1 + 512 * k, row = x >> 5, chk = x & 31; const int lo = row * 512 + ((chk * 16) ^ ((row & 7) << 4));
              *(LAS v4u*)(QDI + lo) = qv[k]; *(LAS v4u*)(KHI + lo) = kv[k]; } }
        LDS_BAR();
        f32x16 s0 = {}, s1 = {};
        { const int qrow = 32 * ib + r32, k0row = 32 * jb0 + r32, k1row = 32 * jb1 + r32;
          if (jb0 <= ib) {
#pragma unroll
            for (int ks = 0; ks < 16; ++ks) { const int cb = (16 * ks + 8 * hi) * 2;
                const bf16x8 qf = *(const LAS bf16x8*)(QDI + qrow * 512 + (cb ^ ((qrow & 7) << 4)));
                const bf16x8 kf0 = *(const LAS bf16x8*)(KHI + k0row * 512 + (cb ^ ((k0row & 7) << 4)));
                s0 = __builtin_amdgcn_mfma_f32_32x32x16_bf16(kf0, qf, s0, 0, 0, 0);
                if (jb1 <= ib) { const bf16x8 kf1 = *(const LAS bf16x8*)(KHI + k1row * 512 + (cb ^ ((k1row & 7) << 4))); s1 = __builtin_amdgcn_mfma_f32_32x32x16_bf16(kf1, qf, s1, 0, 0, 0); } } } }
        LDS_BAR();
        { int r32p = r32, hip = hi; asm volatile("" : "+v"(r32p), "+v"(hip)); const int i = 32 * ib + r32p;
#pragma unroll
          for (int qq = 0; qq < 4; ++qq) {
              const int j0 = 32 * jb0 + 8 * qq + 4 * hip, j1 = j0 + 32;
              float a0 = s0[4 * qq], a1 = s0[4 * qq + 1], a2 = s0[4 * qq + 2], a3 = s0[4 * qq + 3];
              float c0 = s1[4 * qq], c1 = s1[4 * qq + 1], c2 = s1[4 * qq + 2], c3 = s1[4 * qq + 3];
              if (j0 + 0 > i) a0 = 0.f; if (j0 + 1 > i) a1 = 0.f; if (j0 + 2 > i) a2 = 0.f; if (j0 + 3 > i) a3 = 0.f;
              if (j1 + 0 > i) c0 = 0.f; if (j1 + 1 > i) c1 = 0.f; if (j1 + 2 > i) c2 = 0.f; if (j1 + 3 > i) c3 = 0.f;
              v2u o; o.x = pk2(a0, a1); o.y = pk2(a2, a3); *(LAS v2u*)(PI + i * 256 + ((j0 * 2) ^ ((i & 7) << 4))) = o;
              v2u o2; o2.x = pk2(c0, c1); o2.y = pk2(c2, c3); *(LAS v2u*)(PI + i * 256 + ((j1 * 2) ^ ((i & 7) << 4))) = o2; } }
        LDS_BAR();
        f32x16 acc[4][2];
#pragma unroll
        for (int rb = 0; rb < 4; ++rb) { acc[rb][0] = (f32x16){}; acc[rb][1] = (f32x16){}; }
        { const int nsteps = n > 0 ? 24 : 8;
          const bf16* vt = VT + ((size_t)((b * 4 + h) * 128 + n) << 16) + (size_t)(((2 * w) * 8 * 2 + hi) * 32 + r32) * 8;
          const bf16* rt = RT + ((size_t)((b * 4 + h) * 128 + n) << 17) + (size_t)(((2 * w) * 16 * 2 + hi) * 32 + r32) * 8;
          const int xr = (r32 & 7) << 4, rowp = r32 * 256;
#define R2B_LOAD(dst, sidx) do { int sp_ = (sidx); sp_ = sp_ < nsteps ? sp_ : nsteps - 1; const bf16* p_ = sp_ < 8 ? vt + sp_ * 512 : rt + (sp_ - 8) * 512; const int o1_ = sp_ < 8 ? 4096 : 8192; \
              dst[0] = *(const GAS bf16x8*)p_; dst[1] = *(const GAS bf16x8*)(p_ + o1_); } while (0)
          bf16x8 Bq[6][2];
          R2B_LOAD(Bq[0], 0); R2B_LOAD(Bq[1], 1); R2B_LOAD(Bq[2], 2); R2B_LOAD(Bq[3], 3); R2B_LOAD(Bq[4], 4);
          for (int s3 = 0; s3 < nsteps; s3 += 6) {
#pragma unroll
              for (int uu = 0; uu < 6; ++uu) { const int st = s3 + uu;
                  R2B_LOAD(Bq[(uu + 5) % 6], st + 5);
                  if (st < nsteps) { const bool pv = st < 8; const int ks = pv ? st : st - 8, cb = ((32 * ks + 16 * hi) ^ xr) + (pv ? 65536 : 0), sh = pv ? 0 : 1;
#pragma unroll
                      for (int rb = 0; rb < 4; ++rb) if (!pv || st <= 2 * rb + 1) {
                          const bf16x8 af = *(const LAS bf16x8*)(QDI + (((32 * 256) * rb + rowp) << sh) + cb);
                          acc[rb][0] = __builtin_amdgcn_mfma_f32_32x32x16_bf16(Bq[uu][0], af, acc[rb][0], 0, 0, 0);
                          acc[rb][1] = __builtin_amdgcn_mfma_f32_32x32x16_bf16(Bq[uu][1], af, acc[rb][1], 0, 0, 0); } } } }
#undef R2B_LOAD
        }
#pragma unroll
        for (int rb = 0; rb < 4; ++rb) { float s = 0.f, qs = 0.f;
#pragma unroll
            for (int et = 0; et < 2; ++et)
#pragma unroll
                for (int r = 0; r < 16; ++r) { const float v = acc[rb][et][r]; s += v; qs += v * v; }
            s += __shfl_xor(s, 32); qs += __shfl_xor(qs, 32);
            if (hi == 0) { STAT[((32 * rb + r32) * 8 + w) * 2] = s; STAT[((32 * rb + r32) * 8 + w) * 2 + 1] = qs; } }
        LDS_BAR();
        int r32b = r32, hib = hi; asm volatile("" : "+v"(r32b), "+v"(hib));
#pragma unroll
        for (int rb = 0; rb < 4; ++rb) { const int i = 32 * rb + r32b; float s = 0.f, qs = 0.f;
#pragma unroll
            for (int ww = 0; ww < 8; ++ww) { s += STAT[(i * 8 + ww) * 2]; qs += STAT[(i * 8 + ww) * 2 + 1]; }
            const float mean = s * (1.f / 512.f), var = qs * (1.f / 512.f) - mean * mean, rstd = 1.f / sqrtf(fmaxf(var, 0.f) + LN_EPS);
#pragma unroll
            for (int et = 0; et < 2; ++et)
#pragma unroll
                for (int qq = 0; qq < 4; ++qq) { const int e = 64 * w + 32 * et + 8 * qq + 4 * hib;
                    v2u o; o.x = pk2((acc[rb][et][4 * qq] - mean) * rstd, (acc[rb][et][4 * qq + 1] - mean) * rstd); o.y = pk2((acc[rb][et][4 * qq + 2] - mean) * rstd, (acc[rb][et][4 * qq + 3] - mean) * rstd);
                    *(LAS v2u*)(YST + i * 1024 + ((e * 2) ^ ((i & 63) << 4))) = o; } }
        LDS_BAR();
        { int tid6 = tid; asm volatile("" : "+v"(tid6)); const int chk = tid6 & 63; const f32x4 g0 = *(const GAS f32x4*)(gn + h * 512 + chk * 8), g1 = *(const GAS f32x4*)(gn + h * 512 + chk * 8 + 4);
#pragma unroll
          for (int k = 0; k < 16; ++k) { const int row = (tid6 >> 6) + 8 * k;
              const v4u y = *(const LAS v4u*)(YST + row * 1024 + ((chk * 16) ^ ((row & 63) << 4)));
              const size_t go6 = (tok0 + row) * 2048 + h * 512 + chk * 8; const v4u gg = *(const GAS v4u*)(GIN + go6);
              v4u o; o.x = pk2(bflo(y.x) * g0.x * bflo(gg.x), bfhi(y.x) * g0.y * bfhi(gg.x)); o.y = pk2(bflo(y.y) * g0.z * bflo(gg.y), bfhi(y.y) * g0.w * bfhi(gg.y));
              o.z = pk2(bflo(y.z) * g1.x * bflo(gg.z), bfhi(y.z) * g1.y * bfhi(gg.z)); o.w = pk2(bflo(y.w) * g1.z * bflo(gg.w), bfhi(y.w) * g1.w * bfhi(gg.w));
              *(GAS v4u*)(YOUT + go6) = o; } }
        __syncthreads();
    }
}
typedef swa::BlockRef<swa::bf16, swa::bf16> ABlk;
__device__ __forceinline__ float* att_lse(Frame& F, int L) {
    const int g = L >> 9, rem = L & 511, sh = 2 * g, seq = rem >> (6 - sh), qb = rem & ((64 >> sh) - 1);
    return (float*)(ARGWS(F) + WS_BIG + BIG_LSE) + (size_t)g * 131072 + (size_t)seq * (size_t)(SEQ >> sh) + (size_t)qb * 256;
}
__device__ __forceinline__ ABlk att_ref(Frame& F, int L) {
    const int g = L >> 9, rem = L & 511, sh = 2 * g, seq = rem >> (6 - sh), qb = rem & ((64 >> sh) - 1);
    const size_t base = (size_t)g * 131072 + (size_t)seq * (size_t)(SEQ >> sh);
    const swa::bf16* P = (const swa::bf16*)(ARGWS(F) + WS_BIG + BIG_QKV); constexpr size_t WH = (size_t)3 * 131072 * 128;
    ABlk r; r.Q = P + (base + (size_t)qb * 256) * 128; r.K = P + WH + base * 128; r.V = P + 2 * WH + base * 128;
    r.O = (swa::bf16*)(ARGWS(F) + WS_BIG + BIG_OP) + (base + (size_t)qb * 256) * 128; r.P0 = qb * 256;
    return r;
}
__device__ __forceinline__ void attn_phase(Frame& F) {
    extern __shared__ __attribute__((aligned(16))) unsigned char lds_dyn[];
    char* const ldsg = (char*)lds_dyn;
    int L = F.c; const int total = 1536, stride = F.G;
    if (L >= total) return;
    ABlk cur = att_ref(F, L);
    const int W = 129 + (F.G >> 20);
    swa::Seam<swa::bf16> S; S.tid = F.tid;
    swa::causal_swa_prime<swa::bf16, swa::bf16>(cur, W, ldsg, S);
    for (;;) {
        const bool last = L + stride >= total;
        const int Ln = last ? L : L + stride;
        const ABlk nxt = last ? cur : att_ref(F, Ln);
        const int skv = SEQ >> (2 * (L >> 9));
        swa::causal_swa_block<swa::bf16, swa::bf16>(cur, nxt, skv, W, ldsg, S);
        if (F.tid < 256) att_lse(F, L)[F.tid] = ((const LAS float*)(F.lds + swa::LSE_LDS_OFF))[F.tid];
        if (last) break;
        cur = nxt; L = Ln;
    }
}
__device__ __forceinline__ void attn_merge_phase(Frame& F) {
    const int gw = F.c * NWAVES + F.wave, NGW = F.G * NWAVES, hd = F.lane >> 4, chk = F.lane & 15;
    const bf16* OP = (const bf16*)(ARGWS(F) + WS_BIG + BIG_OP); const float* LSE = (const float*)(ARGWS(F) + WS_BIG + BIG_LSE); bf16* O = (bf16*)(ARGWS(F) + WS_BIG + BIG_O);
    for (int m0 = gw; m0 < T_TOK; m0 += 4 * NGW) {
        size_t row[4][3]; float ls[4][3]; v4u ov[4][3];
#pragma unroll
        for (int r = 0; r < 4; ++r) { const int m = m0 + r * NGW < T_TOK ? m0 + r * NGW : gw; const int b = m >> 14, t = m & 16383;
#pragma unroll
            for (int g = 0; g < 3; ++g) { const int sh = 2 * g; row[r][g] = (size_t)g * 131072 + (size_t)(b * 4 + hd) * SEQ + (size_t)((t & ((1 << sh) - 1)) * (SEQ >> sh) + (t >> sh));
                ls[r][g] = LSE[row[r][g]]; ov[r][g] = *(const GAS v4u*)(OP + row[r][g] * 128 + chk * 8); } }
#pragma unroll
        for (int r = 0; r < 4; ++r) { const int m = m0 + r * NGW; if (m >= T_TOK) break;
            const float mx = fmaxf(ls[r][0], fmaxf(ls[r][1], ls[r][2])); float wg[3]; float ws = 0.f;
#pragma unroll
            for (int g = 0; g < 3; ++g) { wg[g] = __expf(ls[r][g] - mx); ws += wg[g]; }
            const float inv = 1.f / ws; float o[8] = {0.f, 0.f, 0.f, 0.f, 0.f, 0.f, 0.f, 0.f};
#pragma unroll
            for (int g = 0; g < 3; ++g) { const v4u v = ov[r][g]; const float wt = wg[g] * inv;
                o[0] += wt * bflo(v.x); o[1] += wt * bfhi(v.x); o[2] += wt * bflo(v.y); o[3] += wt * bfhi(v.y); o[4] += wt * bflo(v.z); o[5] += wt * bfhi(v.z); o[6] += wt * bflo(v.w); o[7] += wt * bfhi(v.w); }
            v4u w; w.x = pk2(o[0], o[1]); w.y = pk2(o[2], o[3]); w.z = pk2(o[4], o[5]); w.w = pk2(o[6], o[7]);
            *(GAS v4u*)(O + (size_t)m * 512 + hd * 128 + chk * 8) = w; } }
}
template <bool GATHER_, int NCT> struct MoeOrder {
    static constexpr bool GATHER = GATHER_;
    const char* A; const char* Bt; int K; size_t bstride; int G, c; int rtb[9]; const LAS int* idx;
    __device__ __forceinline__ bool next(int i, pg8::Unit& u) const {
        const int L = i * G + c; if (L >= rtb[8] * NCT) return false;
        const int rt = L / NCT; int e = 0;
#pragma unroll
        for (int k = 1; k < 8; ++k) e += (rtb[k] <= rt) ? 1 : 0;
        u.pm = rt; u.pn = L - rt * NCT; u.ex = e; return true;
    }
    __device__ __forceinline__ const char* a_ptr(const pg8::Unit& u) const { return GATHER ? A : A + (size_t)u.pm * ((size_t)256 * K * 2); }
    __device__ __forceinline__ const char* b_ptr(const pg8::Unit& u) const { return Bt + (size_t)u.ex * bstride + (size_t)u.pn * ((size_t)256 * K * 2); }
    __device__ __forceinline__ unsigned a_off(int ui, int row, int C, int) const { return (unsigned)idx[ui * 256 + row] * (unsigned)(K * 2) + (unsigned)(C * 2); }
    __device__ __forceinline__ int kt() const { return K / 64; }
};
struct MoeDownMain {
    static constexpr bool GATHER = false;
    const char* A; const char* Bt; int K; size_t bstride; int G, c; int rtb[9];
    __device__ __forceinline__ bool next(int i, pg8::Unit& u) const {
        if (G != 256) { const int L = i * G + c; if (L >= 1024) return false; u.pm = L >> 2; u.pn = L & 3; }
        else { if (i >= 4) return false; const int xcd = c & 7, k = c >> 3; u.pm = i * 64 + (xcd << 3) + (k >> 2); u.pn = k & 3; }
        int e = 0;
#pragma unroll
        for (int k2 = 1; k2 < 8; ++k2) e += (rtb[k2] <= u.pm) ? 1 : 0;
        u.ex = e; return true;
    }
    __device__ __forceinline__ const char* a_ptr(const pg8::Unit& u) const { return A + (size_t)u.pm * ((size_t)256 * K * 2); }
    __device__ __forceinline__ const char* b_ptr(const pg8::Unit& u) const { return Bt + (size_t)u.ex * bstride + (size_t)u.pn * ((size_t)256 * K * 2); }
    __device__ __forceinline__ unsigned a_off(int, int, int, int) const { return 0u; }
    __device__ __forceinline__ int kt() const { return K / 64; }
};
struct MoeDownTail {
    static constexpr bool GATHER = false;
    const char* A; const char* Bt; int K; size_t bstride; int G, c; int rtb[9];
    __device__ __forceinline__ bool next(int i, pg8::Unit& u) const {
        const int nl = rtb[8] - 256; if (i > 0 || c >= nl * 16) return false;
        const int t = c >> 2; u.pm = 256 + (t >> 2); u.pn = t & 3; u.ex = (c & 3) * 32 + t; return true;
    }
    __device__ __forceinline__ int expert(const pg8::Unit& u) const { int e = 0;
#pragma unroll
        for (int k2 = 1; k2 < 8; ++k2) e += (rtb[k2] <= u.pm) ? 1 : 0;
        return e; }
    __device__ __forceinline__ const char* a_ptr(const pg8::Unit& u) const { return A + (size_t)u.pm * ((size_t)256 * K * 2) + (size_t)(c & 3) * (896 * 2); }
    __device__ __forceinline__ const char* b_ptr(const pg8::Unit& u) const { return Bt + (size_t)expert(u) * bstride + (size_t)u.pn * ((size_t)256 * K * 2) + (size_t)(c & 3) * (896 * 2); }
    __device__ __forceinline__ unsigned a_off(int, int, int, int) const { return 0u; }
    __device__ __forceinline__ int kt() const { return 14; }
};
__device__ __forceinline__ void moe_rtb(const LAS int* PB, int (&rtb)[9], int (&cnt)[8]) {
    int acc = 0;
#pragma unroll
    for (int e = 0; e < 8; ++e) { rtb[e] = acc; cnt[e] = __builtin_amdgcn_readfirstlane(PB[2048 + e]); acc += (cnt[e] + 255) >> 8; }
    rtb[8] = acc;
}
__global__ void __launch_bounds__(NWAVES * 64, 2) fwd_kernel(Args args) {
    extern __shared__ __attribute__((aligned(16))) unsigned char lds[];
    Frame F;
    F.lds = (LAS unsigned char*)lds;
    F.MISC = (volatile LAS unsigned*)(F.lds + MISC_OFF);
    F.tid = threadIdx.x; F.lane = F.tid & 63; F.wave = __builtin_amdgcn_readfirstlane(F.tid >> 6);
    F.G = gridDim.x; F.c = blockIdx.x;
    for (int u = F.tid; u < 32; u += NWAVES * 64) ((LAS unsigned*)(F.lds + MISC_OFF))[u] = 0u;
    if (F.tid == 0) { LAS unsigned long long* tb = (LAS unsigned long long*)(F.lds + MISC_OFF + 128);
#pragma unroll
        for (int i = 0; i < 15; ++i) tb[i] = (unsigned long long)args.in[i];
        tb[15] = (unsigned long long)args.out; tb[16] = (unsigned long long)args.ws; }
    __syncthreads();
    XcdBarrier bar = xcd_barrier_post((unsigned*)(F_CTL(F) + CW_BAR), F.MISC + 8);
#ifdef STAMP_A
#define STAMP_HERE(idx) do { if (threadIdx.x == 0) ((volatile LAS unsigned long long*)(F.lds + AUX_OFF + 16384))[(idx)] = wall_clock64(); } while (0)
#else
#define STAMP_HERE(idx) do { } while (0)
#endif
#define GRID_BAR(idx) do { XcdBarrier bb_ = bar; asm volatile("" : "+s"(bb_.bar), "+s"(bb_.x)); xcd_barrier(bb_); STAMP_HERE(idx); } while (0)
#define WSP ARGWS(F)
#define BIGP (ARGWS(F) + WS_BIG)
#define XBP ((bf16*)(ARGWS(F) + WS_XB))

#ifndef ONLY
#define ONLY -1
#endif
#define RUN(n) (ONLY < 0 || ONLY == (n))
    STAMP_HERE(0);
#ifndef DBL
#define DBL 0
#endif
    if (DBL & 1) { frame_refresh(F); p0_prologue(F); }
    if (RUN(0)) { frame_refresh(F); p0_prologue(F); }
    GRID_BAR(1);

#pragma unroll
    for (int j = 0; j < 2; ++j) {
        for (int rep_ = 0; rep_ < ((DBL & 256) ? 2 : 1); ++rep_) if (RUN(1)) { frame_refresh(F);
            const bf16* Win = (const bf16*)(WSP + WS_WIN) + (size_t)j * 6144 * 1024;
#ifndef SKIP_RP
            { pg8::StaticOrder S; S.init(XBP, Win, T_TOK, 4096, 1024, F.G, F.c);
              pg8::EpiRetProj E{(bf16*)(BIGP + BIG_QD), (bf16*)(BIGP + BIG_KH), (bf16*)(BIGP + BIG_G), (const float*)(WSP + WS_TAB)};
              pg8::gemm_phase<pg8::EpiRetProj, pg8::StaticOrder, true>(F.lds + RING_OFF, S, E, F.tid); }
#endif
#ifndef SKIP_VT
            { pg8::StaticOrder S; S.init(Win + (size_t)4096 * 1024, XBP, 2048, T_TOK, 1024, F.G, F.c);
              pg8::EpiVT E{(bf16*)(BIGP + BIG_VT)};
              pg8::gemm_phase<pg8::EpiVT, pg8::StaticOrder, true>(F.lds + RING_OFF, S, E, F.tid); }
#endif
        }
        GRID_BAR(1 + 16 * j + 1);
        if (DBL & 4) { frame_refresh(F); ret_state_phase(F); }
        if (RUN(2)) { frame_refresh(F); ret_state_phase(F); }
        GRID_BAR(1 + 16 * j + 2);
        if (DBL & 8) { frame_refresh(F); ret_out_phase(F, j, (bf16*)(BIGP + 640 * MiB)); }
        if (RUN(3)) { frame_refresh(F); ret_out_phase(F, j, (bf16*)(BIGP + BIG_G)); }
        GRID_BAR(1 + 16 * j + 3);
        if (RUN(4)) { frame_refresh(F);
            pg8::StaticOrder S; S.init(BIGP + BIG_G, (const bf16*)(WSP + WS_WRO) + (size_t)j * 1024 * 2048, T_TOK, 1024, 2048, F.G, F.c);
            pg8::EpiAddBf16 E{XBP, ALPHA};
            pg8::gemm_phase<pg8::EpiAddBf16, pg8::StaticOrder, true>(F.lds + RING_OFF, S, E, F.tid);
        }
        GRID_BAR(1 + 16 * j + 4);
        if (RUN(5)) { frame_refresh(F); ln_pass<0, false>(F, 2 * j, 0, j); }
        if (DBL & 2) { frame_refresh(F); moe_convert<false>(F, j); }
        if (RUN(6)) { frame_refresh(F); if (DBL & 1024) moe_convert<true>(F, j); else moe_convert<false>(F, j); }
        GRID_BAR(1 + 16 * j + 5);
        for (int rep_ = 0; rep_ < ((DBL & 64) ? 2 : 1); ++rep_) if (RUN(7)) { frame_refresh(F);
            pg8::StaticOrder S; S.init(XBP, (const bf16*)(WSP + WS_WGU) + (size_t)j * 7168 * 1024, T_TOK, 7168, 1024, F.G, F.c);
            pg8::EpiSwiGLU E{(bf16*)(BIGP + BIG_HID)};
            pg8::gemm_phase<pg8::EpiSwiGLU, pg8::StaticOrder, true>(F.lds + RING_OFF, S, E, F.tid);
        }
        GRID_BAR(1 + 16 * j + 6);
        if (RUN(8)) { frame_refresh(F);
            pg8::StaticOrder S; S.init(BIGP + BIG_HID, (const bf16*)(WSP + WS_WDN) + (size_t)j * 1024 * 3584, T_TOK, 1024, 3584, F.G, F.c);
            pg8::EpiAddBf16 E{XBP, ALPHA};
            pg8::gemm_phase<pg8::EpiAddBf16, pg8::StaticOrder, true>(F.lds + RING_OFF, S, E, F.tid);
        }
        GRID_BAR(1 + 16 * j + 7);
        if (RUN(5)) { frame_refresh(F); ln_pass<0, false>(F, 2 * j, 1, j); }
        GRID_BAR(1 + 16 * j + 8);
        if (RUN(9)) { frame_refresh(F);
            pg8::StaticOrder S; S.init(XBP, (const bf16*)(WSP + WS_WQKV) + (size_t)j * 4608 * 1024, T_TOK, 4608, 1024, F.G, F.c);
            pg8::EpiQKV E{(bf16*)(BIGP + BIG_QKV)};
            pg8::gemm_phase<pg8::EpiQKV, pg8::StaticOrder, true>(F.lds + RING_OFF, S, E, F.tid);
        }
        GRID_BAR(1 + 16 * j + 9);
        if (DBL & 16) { frame_refresh(F); attn_phase(F); }
        if (RUN(10)) { frame_refresh(F); attn_phase(F); }
        GRID_BAR(1 + 16 * j + 10);
        if (DBL & 32) { frame_refresh(F); attn_merge_phase(F); }
        if (RUN(11)) { frame_refresh(F); attn_merge_phase(F); }
        GRID_BAR(1 + 16 * j + 11);
        if (RUN(12)) { frame_refresh(F);
            pg8::StaticOrder S; S.init(BIGP + BIG_O, (const bf16*)(WSP + WS_WAO) + (size_t)j * 1024 * 512, T_TOK, 1024, 512, F.G, F.c);
            pg8::EpiAddBf16 E{XBP, ALPHA};
            pg8::gemm_phase<pg8::EpiAddBf16, pg8::StaticOrder, true>(F.lds + RING_OFF, S, E, F.tid);
        }
        GRID_BAR(1 + 16 * j + 12);
        if (RUN(13)) { frame_refresh(F); ln_route_pass(F, 2 * j + 1, j); }
        GRID_BAR(1 + 16 * j + 13);
        for (int rep_ = 0; rep_ < ((DBL & 512) ? 2 : 1); ++rep_) if (RUN(14)) {
            frame_refresh(F); MoeOrder<true, 28> S; int cnt[8];
            LAS int* PB = (LAS int*)(F.lds + RING_OFF); moe_prefix_lds(F, PB); moe_rtb(PB, S.rtb, cnt);
            S.G = F.G; S.c = F.c; S.idx = (const LAS int*)(F.lds + AUX_OFF);
            S.A = (const char*)XBP; S.Bt = (const char*)(BIGP + BIG_WMGU); S.K = 1024; S.bstride = (size_t)7168 * 1024 * 2;
            const int* BL = (const int*)(WSP + WS_LIST); LAS int* idx = (LAS int*)(F.lds + AUX_OFF);
            pg8::Unit u; int nun = 0;
            for (int ui = 0; S.next(ui, u) && ui < 30; ++ui) { nun = ui + 1;
                if (F.tid < 256) { const int e = u.ex; int rb = 0, ce = 0;
#pragma unroll
                    for (int q = 0; q < 8; ++q) { rb = (q == e) ? S.rtb[q] : rb; ce = (q == e) ? cnt[q] : ce; }
                    int slot = (u.pm - rb) * 256 + F.tid; slot = slot < ce ? slot : 0;
                    int lo = 0;
#pragma unroll
                    for (int st = 128; st > 0; st >>= 1) lo = (PB[(lo + st) * 8 + e] <= slot) ? lo + st : lo;
                    idx[ui * 256 + F.tid] = (lo * 8 + e) * 256 + (slot - PB[lo * 8 + e]); } }
            if (F.tid < 256) {
#pragma unroll 10
                for (int ui = 0; ui < 30; ++ui) if (ui < nun) idx[ui * 256 + F.tid] = BL[idx[ui * 256 + F.tid]]; }
            __syncthreads();
            pg8::EpiSwiGLU E{(bf16*)(BIGP + BIG_HID)};
            pg8::gemm_phase<pg8::EpiSwiGLU, MoeOrder<true, 28>, true>(F.lds + RING_OFF, S, E, F.tid);
        }
        GRID_BAR(1 + 16 * j + 14);
        for (int rep_ = 0; rep_ < ((DBL & 128) ? 2 : 1); ++rep_) if (RUN(15)) {
            frame_refresh(F);
            int rtb5[9], cnt5[8]; { LAS int* PB = (LAS int*)(F.lds + RING_OFF); moe_prefix_lds(F, PB); moe_rtb(PB, rtb5, cnt5); __syncthreads(); }
            { MoeDownMain S;
#pragma unroll
              for (int e = 0; e < 9; ++e) S.rtb[e] = rtb5[e];
              S.G = F.G; S.c = F.c; S.A = (const char*)(BIGP + BIG_HID); S.Bt = (const char*)(BIGP + BIG_WMD); S.K = 3584; S.bstride = (size_t)1024 * 3584 * 2;
              pg8::EpiBf16Y E{(bf16*)(BIGP + BIG_YP)};
              pg8::gemm_phase<pg8::EpiBf16Y, MoeDownMain, true>(F.lds + RING_OFF, S, E, F.tid); }
            frame_refresh(F);
            { MoeDownTail S;
#pragma unroll
              for (int e = 0; e < 9; ++e) S.rtb[e] = rtb5[e];
              S.G = F.G; S.c = F.c; S.A = (const char*)(BIGP + BIG_HID); S.Bt = (const char*)(BIGP + BIG_WMD); S.K = 3584; S.bstride = (size_t)1024 * 3584 * 2;
              pg8::EpiF32Slab E{(float*)(WSP + WS_SLAB)};
              pg8::gemm_phase<pg8::EpiF32Slab, MoeDownTail, false>(F.lds + RING_OFF, S, E, F.tid); }
        }
        GRID_BAR(1 + 16 * j + 15);
        if (RUN(16)) { frame_refresh(F); if (j == 0) ln_pass<2, false>(F, 1, 1, 0); else ln_pass<2, true>(F, 3, 1, 1); }
        if (j == 0) GRID_BAR(1 + 16 * j + 16);
    }
#ifdef STAMP_A
    GRID_BAR(34);
    { if (blockIdx.x == 0 && threadIdx.x == 0) { volatile LAS unsigned long long* ts = (volatile LAS unsigned long long*)(F.lds + AUX_OFF + 16384);
          float* vv = (float*)(ARGWS(F) + 65536); vv[0] = (float)(ts[STAMP_A + STAMP_AN] - ts[STAMP_A]) * 0.01f; vv[1] = (float)(ts[STAMP_B + STAMP_BN] - ts[STAMP_B]) * 0.01f; } }
    GRID_BAR(35);
    { const float* vv = (const float*)(ARGWS(F) + 65536); const float va = vv[0], vb = vv[1];
      float* out = ARGX(F); const float c = sqrtf(va);
      for (size_t i = (size_t)blockIdx.x * 512 + threadIdx.x; i < (size_t)T_TOK * DMODEL; i += (size_t)gridDim.x * 512) out[i] = (i == 0) ? vb : c; }
#endif
}

extern "C" void kernel_launch(void* const* d_in, const int* in_sizes, int n_in, void* d_out, int out_size, void* d_ws, size_t ws_size, hipStream_t stream) {
    static int grid = 0;
    if (grid == 0) {
        if (n_in != 15 || out_size != T_TOK * DMODEL || ws_size < WS_END) { fprintf(stderr, "kernel_launch: unexpected shapes / workspace (n_in %d, out %d, ws %zu < %zu)\n", n_in, out_size, ws_size, (size_t)WS_END); grid = -1; return; }
        int dev = 0, cus = 0, per_cu = 0;
        if (hipGetDevice(&dev) != hipSuccess || hipDeviceGetAttribute(&cus, hipDeviceAttributeMultiprocessorCount, dev) != hipSuccess) { grid = -1; return; }
        if (hipFuncSetAttribute((const void*)fwd_kernel, hipFuncAttributeMaxDynamicSharedMemorySize, LDS_BYTES) != hipSuccess) { fprintf(stderr, "kernel_launch: hipFuncSetAttribute failed\n"); grid = -1; return; }
        if (hipOccupancyMaxActiveBlocksPerMultiprocessor(&per_cu, (const void*)fwd_kernel, NWAVES * 64, LDS_BYTES) != hipSuccess || per_cu < 1) { fprintf(stderr, "kernel_launch: occupancy query says %d\n", per_cu); }
        (void)hipGetLastError();
        if (cus < 256) { fprintf(stderr, "kernel_launch: this kernel needs 256 CUs (found %d)\n", cus); grid = -1; return; }
        grid = 256;
    }
    if (grid < 0) return;
    if (hipMemsetAsync((char*)d_ws + WS_CTL, 0, CTL_ZERO_BYTES, stream) != hipSuccess) return;
    Args a{};
    for (int i = 0; i < 15; ++i) a.in[i] = (const float*)d_in[i];
    a.out = (float*)d_out; a.ws = (unsigned char*)d_ws;
    hipLaunchKernelGGL(fwd_kernel, dim3(grid), dim3(NWAVES * 64), LDS_BYTES, stream, a);
}
```

```cpp
#include <hip/hip_runtime.h>
#include <hip/hip_bf16.h>
#include <cstdio>
#include <cstdint>
#include <cmath>
namespace pg8 {
#define PG8_LAS __attribute__((address_space(3)))
typedef unsigned short bf16_t;
typedef short bf16x8 __attribute__((ext_vector_type(8)));
typedef float f32x4 __attribute__((ext_vector_type(4)));
typedef float f32x2 __attribute__((ext_vector_type(2)));
typedef unsigned u32x4 __attribute__((ext_vector_type(4)));
constexpr int BM = 256, BK = 64, HALF = 128, HTB = HALF * BK * 2  , STAGE_BYTES = 8 * HTB, NXCD = 8, WGM = 8;

__host__ __device__ __forceinline__ int lds_byte(int r, int c) { const int st = (r >> 4) * 2 + (c >> 5), rr = r & 15, cc = c & 31, ob = rr * 64 + cc * 2; return st * 1024 + (ob ^ (((ob >> 9) & 1) << 5)); }
__host__ __device__ __forceinline__ void stage_rc(int b, int& R, int& C) { const int st = b / 1024, sb = b % 1024, swz = sb ^ (((sb >> 9) & 1) << 5); R = (st >> 1) * 16 + swz / 64; C = (st & 1) * 32 + (swz % 64) / 2; }
__host__ __device__ __forceinline__ int perm32(int rho) { const int n = rho >> 4, i = rho & 15; return 8 * (i >> 2) + 4 * n + (i & 3); }

struct Unit { int pm, pn, ex; };

struct StaticOrder {
    static constexpr bool GATHER = false;
    const char* A; const char* Bt; int K;
    int nM, nN, nwg, G, c;
    __device__ void init(const void* A_, const void* Bt_, int M, int N, int K_, int G_, int c_) { A = (const char*)A_; Bt = (const char*)Bt_; K = K_; nM = M / BM; nN = N / BM; nwg = nM * nN; G = G_; c = c_; }
    __device__ bool next(int i, Unit& u) const {
        const long L = (long)i * G + c; if (L >= nwg) return false;
        int wgid = (int)L; { const int q = nwg / NXCD, r = nwg % NXCD, xcd = wgid % NXCD, off = wgid / NXCD; wgid = (xcd < r ? xcd * (q + 1) : r * (q + 1) + (xcd - r) * q) + off; }
        const int nig = WGM * nN, gid = wgid / nig, fm = gid * WGM, gsz = (nM - fm) < WGM ? (nM - fm) : WGM;
        u.pm = fm + ((wgid % nig) % gsz); u.pn = (wgid % nig) / gsz; u.ex = 0; return true;
    }
    __device__ __forceinline__ const char* a_ptr(const Unit& u) const { return A + (size_t)u.pm * ((size_t)BM * K * 2); }
    __device__ __forceinline__ const char* b_ptr(const Unit& u) const { return Bt + (size_t)u.pn * ((size_t)BM * K * 2); }
    __device__ __forceinline__ unsigned a_off(int, int, int, int) const { return 0u; }
    __device__ __forceinline__ int kt() const { return K / BK; }
};

struct SplitOrder : StaticOrder {
    int ug, uc;
    __device__ bool next(int i, Unit& u) const {
        const bool sw = ((c >> 3) & 3) == 0; const int r = sw ? (ug - uc) + i : i; if (i < 0 || r >= ug) return false;
        const long L = r < ug - uc ? (long)r * 192 + ((c >> 5) * 24 + (c & 31) - 8) : (long)(ug - uc) * 192 + (long)(r - (ug - uc)) * 256 + c;
        if (L >= nwg) return false;
        int wgid = (int)L; { const int q = nwg / NXCD, rr = nwg % NXCD, xcd = wgid % NXCD, off = wgid / NXCD; wgid = (xcd < rr ? xcd * (q + 1) : rr * (q + 1) + (xcd - rr) * q) + off; }
        const int nig = WGM * nN, gid = wgid / nig, fm = gid * WGM, gsz = (nM - fm) < WGM ? (nM - fm) : WGM;
        u.pm = fm + ((wgid % nig) % gsz); u.pn = (wgid % nig) / gsz; u.ex = 0; return true;
    }
};

__device__ __forceinline__ unsigned cvt_pk_bf16(float lo, float hi) { unsigned r; asm volatile("v_cvt_pk_bf16_f32 %0, %1, %2" : "=v"(r) : "v"(lo), "v"(hi)); return r; }

template <class Epi, class Sched, bool ALIGN_EPI>
__device__ __forceinline__ void gemm_phase(PG8_LAS unsigned char* lds, const Sched& S, const Epi& E, const int tid) {
    constexpr bool GATHER = Sched::GATHER;
    const int wid = __builtin_amdgcn_readfirstlane(tid >> 6), lane = tid & 63, wr = wid >> 2, wc = wid & 3, fr = lane & 15, fq = lane >> 4;
    const int K = S.K, nt = S.kt();
    unsigned voffA[2][2], nvoffA[2][2], voffB[2]; int sR[2], sC[2];
#pragma unroll
    for (int i = 0; i < 2; ++i) { int R, C; stage_rc(tid * 16 + i * 8192, R, C); sR[i] = R; sC[i] = C; const int Rb = Epi::PERM ? ((R & ~31) + perm32(R & 31)) : R;
        voffA[0][i] = (unsigned)(R * K + C) * 2u; voffA[1][i] = voffA[0][i]; nvoffA[0][i] = voffA[0][i]; nvoffA[1][i] = voffA[0][i]; voffB[i] = (unsigned)(Rb * K + C) * 2u; }
    const size_t kstep = (size_t)(BK * 2);
    const size_t hstep = (size_t)HALF * K * 2;
    const size_t ahstep = GATHER ? (size_t)0 : hstep;
    const unsigned ldsw = (unsigned)wid * 1024u;
    const int aoff = lds_byte(wr * 64 + fr, fq * 8), boff = lds_byte(wc * 32 + fr, fq * 8);
#define PG8_SA(b, h) (((b) * 2 + (h)) * HTB)
#define PG8_SB(b, h) ((4 + (b) * 2 + (h)) * HTB)
#define PG8_STAGE(bufoff, gbase, voff) do { _Pragma("unroll") for (int _i = 0; _i < 2; ++_i) \
        __builtin_amdgcn_global_load_lds((const unsigned*)((const char*)(gbase) + (voff)[_i]), (PG8_LAS unsigned*)(lds + (bufoff) + ldsw + _i * 8192), 16, 0, 0); } while (0)
#define PG8_STAGE_A(bufoff, gbase, h, VO) PG8_STAGE(bufoff, (gbase) + (h) * ahstep, (VO)[GATHER ? (h) : 0])
#define PG8_LDA(dst, b, h) do { _Pragma("unroll") for (int m = 0; m < 4; ++m) _Pragma("unroll") for (int k = 0; k < 2; ++k) dst[m][k] = *(const PG8_LAS bf16x8*)(lds + PG8_SA(b, h) + aoff + m * 2048 + k * 1024); } while (0)
#define PG8_LDB(dst, b, h) do { _Pragma("unroll") for (int n = 0; n < 2; ++n) _Pragma("unroll") for (int k = 0; k < 2; ++k) dst[n][k] = *(const PG8_LAS bf16x8*)(lds + PG8_SB(b, h) + boff + n * 2048 + k * 1024); } while (0)
#define PG8_MMA(ai, bj, At, Bt) do { __builtin_amdgcn_s_setprio(1); _Pragma("unroll") for (int m = 0; m < 4; ++m) _Pragma("unroll") for (int n = 0; n < 2; ++n) _Pragma("unroll") for (int k = 0; k < 2; ++k) \
        acc[ai][bj][m][n] = __builtin_amdgcn_mfma_f32_16x16x32_bf16(Bt[n][k], At[m][k], acc[ai][bj][m][n], 0, 0, 0); __builtin_amdgcn_s_setprio(0); } while (0)
#define PG8_WAIT_V(n) asm volatile("s_waitcnt vmcnt(" #n ")" ::: "memory")
#define PG8_WAIT_L(n) asm volatile("s_waitcnt lgkmcnt(" #n ")" ::: "memory")
#define PG8_BAR __builtin_amdgcn_s_barrier()
#define PG8_SCHED __builtin_amdgcn_sched_barrier(0)
    Unit cur, nxt; int ui = 0;
    if (!S.next(0, cur)) return;
    f32x4 acc[2][2][4][2];
#pragma unroll
    for (int a = 0; a < 2; ++a)
#pragma unroll
        for (int b = 0; b < 2; ++b)
#pragma unroll
            for (int m = 0; m < 4; ++m)
#pragma unroll
                for (int n = 0; n < 2; ++n) acc[a][b][m][n] = (f32x4){0.f, 0.f, 0.f, 0.f};
    bf16x8 At[4][2], B0[2][2], B1[2][2];
    const char* cA = S.a_ptr(cur); const char* cB = S.b_ptr(cur);
    if constexpr (GATHER) {
#pragma unroll
        for (int h = 0; h < 2; ++h)
#pragma unroll
            for (int i = 0; i < 2; ++i) voffA[h][i] = S.a_off(0, h * HALF + sR[i], sC[i], 0);
    }
    PG8_STAGE(PG8_SB(0, 0), cB, voffB); PG8_STAGE(PG8_SB(0, 1), cB + hstep, voffB); PG8_STAGE_A(PG8_SA(0, 0), cA, 0, voffA); PG8_STAGE_A(PG8_SA(0, 1), cA, 1, voffA);
    if (wr == 1) PG8_BAR;
    PG8_WAIT_V(2); PG8_BAR;
    PG8_STAGE(PG8_SB(1, 0), cB + kstep, voffB); PG8_STAGE_A(PG8_SA(1, 0), cA + kstep, 0, voffA); PG8_STAGE(PG8_SB(1, 1), cB + hstep + kstep, voffB);
    PG8_WAIT_V(6); PG8_BAR;
    for (;;) {
        const bool has_next = S.next(ui + 1, nxt);
        const char* nA = has_next ? S.a_ptr(nxt) : cA; const char* nB = has_next ? S.b_ptr(nxt) : cB;
        if constexpr (GATHER) {
#pragma unroll
            for (int h = 0; h < 2; ++h)
#pragma unroll
                for (int i = 0; i < 2; ++i) nvoffA[h][i] = has_next ? S.a_off(ui + 1, h * HALF + sR[i], sC[i], 0) : voffA[h][i];
        }
        for (int t = 0; t < nt; t += 2) {
            const bool last = (t == nt - 2);
            const char* a1 = cA + (size_t)(t + 1) * kstep;
            const char* a2 = last ? nA : cA + (size_t)(t + 2) * kstep; const char* b2 = last ? nB : cB + (size_t)(t + 2) * kstep;
            const char* a3 = a2 + kstep; const char* b3 = b2 + kstep;
            unsigned vo2[2][2];
#pragma unroll
            for (int h = 0; h < 2; ++h)
#pragma unroll
                for (int i = 0; i < 2; ++i) vo2[h][i] = (GATHER && last) ? nvoffA[h][i] : voffA[h][i];
            PG8_LDB(B0, 0, 0); PG8_LDB(B1, 0, 1); PG8_SCHED; PG8_LDA(At, 0, 0); PG8_STAGE_A(PG8_SA(1, 1), a1, 1, voffA);
            PG8_WAIT_V(8); PG8_WAIT_L(0); PG8_BAR; PG8_MMA(0, 0, At, B0); PG8_MMA(0, 1, At, B1); PG8_BAR; PG8_SCHED;
            PG8_LDA(At, 0, 1); PG8_STAGE(PG8_SB(0, 0), b2, voffB); PG8_STAGE(PG8_SB(0, 1), b2 + hstep, voffB); PG8_STAGE_A(PG8_SA(0, 0), a2, 0, vo2);
            PG8_WAIT_V(8); PG8_WAIT_L(0); PG8_BAR; PG8_MMA(1, 0, At, B0); PG8_MMA(1, 1, At, B1); PG8_BAR; PG8_SCHED;
            PG8_LDB(B0, 1, 0); PG8_LDB(B1, 1, 1); PG8_SCHED; PG8_LDA(At, 1, 0); PG8_STAGE_A(PG8_SA(0, 1), a2, 1, vo2);
            PG8_WAIT_V(8); PG8_WAIT_L(0); PG8_BAR; PG8_MMA(0, 0, At, B0); PG8_MMA(0, 1, At, B1); PG8_BAR; PG8_SCHED;
            PG8_LDA(At, 1, 1); PG8_STAGE(PG8_SB(1, 0), b3, voffB); PG8_STAGE(PG8_SB(1, 1), b3 + hstep, voffB); PG8_STAGE_A(PG8_SA(1, 0), a3, 0, vo2);
            PG8_WAIT_V(8); PG8_WAIT_L(0); PG8_BAR; PG8_MMA(1, 0, At, B0); PG8_MMA(1, 1, At, B1); PG8_BAR; PG8_SCHED;
        }
        if constexpr (ALIGN_EPI) { if (wr == 0) PG8_BAR; }
        E(acc, cur, wr, wc, fr, fq);
        if (!has_next) break;
#pragma unroll
        for (int a = 0; a < 2; ++a)
#pragma unroll
            for (int b = 0; b < 2; ++b)
#pragma unroll
                for (int m = 0; m < 4; ++m)
#pragma unroll
                    for (int n = 0; n < 2; ++n) acc[a][b][m][n] = (f32x4){0.f, 0.f, 0.f, 0.f};
        cur = nxt; cA = nA; cB = nB; ++ui;
        if constexpr (GATHER) {
#pragma unroll
            for (int h = 0; h < 2; ++h)
#pragma unroll
                for (int i = 0; i < 2; ++i) voffA[h][i] = nvoffA[h][i];
        }
        if constexpr (ALIGN_EPI) { if (wr == 1) PG8_BAR; }
    }
    PG8_WAIT_V(0);
    if constexpr (!ALIGN_EPI) { if (wr == 0) PG8_BAR; }
    PG8_BAR;
#undef PG8_SA
#undef PG8_SB
#undef PG8_STAGE
#undef PG8_STAGE_A
#undef PG8_LDA
#undef PG8_LDB
#undef PG8_MMA
#undef PG8_WAIT_V
#undef PG8_WAIT_L
#undef PG8_BAR
#undef PG8_SCHED
}
__device__ __forceinline__ float silu_f(float x) { return x * __builtin_amdgcn_rcpf(1.0f + __builtin_amdgcn_exp2f(-1.4426950408889634f * x)); }
__device__ __forceinline__ u32x4 pack8v(const f32x4& v0, const f32x4& v1) { u32x4 w; w.x = cvt_pk_bf16(v0[0], v0[1]); w.y = cvt_pk_bf16(v0[2], v0[3]); w.z = cvt_pk_bf16(v1[0], v1[1]); w.w = cvt_pk_bf16(v1[2], v1[3]); return w; }

struct EpiRetProj {
    static constexpr bool PERM = true;
    bf16_t* QD; bf16_t* KH; bf16_t* G; const float* tab;
    __device__ __forceinline__ void operator()(const f32x4 (&acc)[2][2][4][2], const Unit& u, int wr, int wc, int fr, int fq) const {
        const int row0 = u.pm * BM + wr * 64 + fr, cl = wc * 32 + 8 * fq;
        if (u.pn < 8) {
            const bool isq = u.pn < 4; const int h = u.pn & 3;
            const float lg = __builtin_amdgcn_logf(1.0f - __builtin_amdgcn_exp2f((float)(-5 - h)));
            bf16_t* base = (isq ? QD : KH) + h * 256 + cl;
#pragma unroll
            for (int ai = 0; ai < 2; ++ai)
#pragma unroll
                for (int m = 0; m < 4; ++m) { const int row = row0 + ai * HALF + m * 16, pos = row & 16383, ic = row & 127;
                    const float sc = isq ? __builtin_amdgcn_exp2f(lg * (float)(ic + 1)) : 0.0625f * __builtin_amdgcn_exp2f(-lg * (float)(ic + 1));
                    const f32x4* tp = (const f32x4*)(tab + ((size_t)pos * 128 + cl) * 2);
                    const f32x4 t0 = tp[0], t1 = tp[1], t2 = tp[2], t3 = tp[3];
                    const f32x4 a0 = acc[ai][0][m][0], a1 = acc[ai][0][m][1], b0 = acc[ai][1][m][0], b1 = acc[ai][1][m][1];
                    f32x4 o10, o11, o20, o21;
                    o10[0] = (a0[0] * t0[0] - b0[0] * t0[1]) * sc; o20[0] = (b0[0] * t0[0] + a0[0] * t0[1]) * sc;
                    o10[1] = (a0[1] * t0[2] - b0[1] * t0[3]) * sc; o20[1] = (b0[1] * t0[2] + a0[1] * t0[3]) * sc;
                    o10[2] = (a0[2] * t1[0] - b0[2] * t1[1]) * sc; o20[2] = (b0[2] * t1[0] + a0[2] * t1[1]) * sc;
                    o10[3] = (a0[3] * t1[2] - b0[3] * t1[3]) * sc; o20[3] = (b0[3] * t1[2] + a0[3] * t1[3]) * sc;
                    o11[0] = (a1[0] * t2[0] - b1[0] * t2[1]) * sc; o21[0] = (b1[0] * t2[0] + a1[0] * t2[1]) * sc;
                    o11[1] = (a1[1] * t2[2] - b1[1] * t2[3]) * sc; o21[1] = (b1[1] * t2[2] + a1[1] * t2[3]) * sc;
                    o11[2] = (a1[2] * t3[0] - b1[2] * t3[1]) * sc; o21[2] = (b1[2] * t3[0] + a1[2] * t3[1]) * sc;
                    o11[3] = (a1[3] * t3[2] - b1[3] * t3[3]) * sc; o21[3] = (b1[3] * t3[2] + a1[3] * t3[3]) * sc;
                    bf16_t* rp = base + (size_t)row * 1024;
                    *(u32x4*)rp = pack8v(o10, o11); *(u32x4*)(rp + 128) = pack8v(o20, o21); if (m == 3) asm volatile("" ::: "memory"); }
        } else {
            bf16_t* base = G + (u.pn - 8) * 256 + cl;
#pragma unroll
            for (int ai = 0; ai < 2; ++ai)
#pragma unroll
                for (int m = 0; m < 4; ++m) { bf16_t* rp = base + (size_t)(row0 + ai * HALF + m * 16) * 2048;
#pragma unroll
                    for (int bj = 0; bj < 2; ++bj) { f32x4 v0 = acc[ai][bj][m][0], v1 = acc[ai][bj][m][1];
#pragma unroll
                        for (int j = 0; j < 4; ++j) { v0[j] = silu_f(v0[j]); v1[j] = silu_f(v1[j]); }
                        *(u32x4*)(rp + bj * HALF) = pack8v(v0, v1); } }
        }
    }
};
struct EpiVT {
    static constexpr bool PERM = true;
    bf16_t* VT;
    __device__ __forceinline__ void operator()(const f32x4 (&acc)[2][2][4][2], const Unit& u, int wr, int wc, int fr, int fq) const {
        const int row0 = u.pm * BM + wr * 64 + fr, c0 = u.pn * BM + wc * 32 + 8 * fq;
#pragma unroll
        for (int ai = 0; ai < 2; ++ai)
#pragma unroll
            for (int m = 0; m < 4; ++m) { const int R = row0 + ai * HALF + m * 16, h = R >> 9, e = R & 511;
#pragma unroll
                for (int bj = 0; bj < 2; ++bj) { const int c = c0 + bj * HALF, b = c >> 14, t = c & 16383, n = t >> 7, oct = (t & 127) >> 3;
                    const size_t off = ((size_t)((b * 4 + h) * 128 + n) << 16) + (size_t)(((((e >> 5) * 8 + (oct >> 1)) * 2 + (oct & 1)) * 32 + (e & 31)) * 8);
                    *(u32x4*)(VT + off) = pack8v(acc[ai][bj][m][0], acc[ai][bj][m][1]); } }
    }
};
struct EpiAddBf16 {
    static constexpr bool PERM = true;
    bf16_t* XB; float alpha;
    __device__ __forceinline__ void operator()(const f32x4 (&acc)[2][2][4][2], const Unit& u, int wr, int wc, int fr, int fq) const {
        const int row0 = u.pm * BM + wr * 64 + fr, col0 = u.pn * BM + wc * 32 + 8 * fq;
#pragma unroll
        for (int ai = 0; ai < 2; ++ai)
#pragma unroll
            for (int m = 0; m < 4; ++m) { bf16_t* rowp = XB + (size_t)(row0 + ai * HALF + m * 16) * 1024 + col0;
#pragma unroll
                for (int bj = 0; bj < 2; ++bj) { const u32x4 x = *(const u32x4*)(rowp + bj * HALF); f32x4 v0 = acc[ai][bj][m][0], v1 = acc[ai][bj][m][1];
                    v0[0] += alpha * __builtin_bit_cast(float, x.x << 16); v0[1] += alpha * __builtin_bit_cast(float, x.x & 0xffff0000u);
                    v0[2] += alpha * __builtin_bit_cast(float, x.y << 16); v0[3] += alpha * __builtin_bit_cast(float, x.y & 0xffff0000u);
                    v1[0] += alpha * __builtin_bit_cast(float, x.z << 16); v1[1] += alpha * __builtin_bit_cast(float, x.z & 0xffff0000u);
                    v1[2] += alpha * __builtin_bit_cast(float, x.w << 16); v1[3] += alpha * __builtin_bit_cast(float, x.w & 0xffff0000u);
                    *(u32x4*)(rowp + bj * HALF) = pack8v(v0, v1); } }
    }
};
struct EpiSwiGLU {
    static constexpr bool PERM = true;
    bf16_t* H;
    __device__ __forceinline__ void operator()(const f32x4 (&acc)[2][2][4][2], const Unit& u, int wr, int wc, int fr, int fq) const {
        const int row0 = u.pm * BM + wr * 64 + fr, col0 = u.pn * HALF + wc * 32 + 8 * fq;
#pragma unroll
        for (int ai = 0; ai < 2; ++ai)
#pragma unroll
            for (int m = 0; m < 4; ++m) { f32x4 v0 = acc[ai][0][m][0], v1 = acc[ai][0][m][1]; const f32x4 u0 = acc[ai][1][m][0], u1 = acc[ai][1][m][1];
#pragma unroll
                for (int j = 0; j < 4; ++j) { v0[j] = silu_f(v0[j]) * u0[j]; v1[j] = silu_f(v1[j]) * u1[j]; }
                *(u32x4*)(H + (size_t)(row0 + ai * HALF + m * 16) * 3584 + col0) = pack8v(v0, v1); }
    }
};
struct EpiQKV {
    static constexpr bool PERM = true;
    bf16_t* P;
    __device__ __forceinline__ void operator()(const f32x4 (&acc)[2][2][4][2], const Unit& u, int wr, int wc, int fr, int fq) const {
        const int row0 = u.pm * BM + wr * 64 + fr, cl = wc * 32 + 8 * fq;
        const int which = u.pn / 6, g = (u.pn % 6) >> 1, hp = u.pn & 1, sh = 2 * g;
#pragma unroll
        for (int ai = 0; ai < 2; ++ai)
#pragma unroll
            for (int m = 0; m < 4; ++m) { const int r = row0 + ai * HALF + m * 16, b = r >> 14, t = r & 16383;
                const int perm = (t & ((1 << sh) - 1)) * (16384 >> sh) + (t >> sh);
#pragma unroll
                for (int bj = 0; bj < 2; ++bj) { const int head = 2 * hp + bj;
                    bf16_t* dst = P + ((size_t)(((which * 3 + g) * 8 + b * 4 + head) * 16384 + perm) << 7) + cl;
                    *(u32x4*)dst = pack8v(acc[ai][bj][m][0], acc[ai][bj][m][1]); } }
    }
};
struct EpiBf16Y {
    static constexpr bool PERM = true;
    bf16_t* Y;
    __device__ __forceinline__ void operator()(const f32x4 (&acc)[2][2][4][2], const Unit& u, int wr, int wc, int fr, int fq) const {
        const int row0 = u.pm * BM + wr * 64 + fr, col0 = u.pn * BM + wc * 32 + 8 * fq;
#pragma unroll
        for (int ai = 0; ai < 2; ++ai)
#pragma unroll
            for (int m = 0; m < 4; ++m) { bf16_t* rp = Y + (size_t)(row0 + ai * HALF + m * 16) * 1024 + col0;
#pragma unroll
                for (int bj = 0; bj < 2; ++bj) *(u32x4*)(rp + bj * HALF) = pack8v(acc[ai][bj][m][0], acc[ai][bj][m][1]); }
    }
};
struct EpiF32Slab {
    static constexpr bool PERM = false;
    float* S;
    __device__ __forceinline__ void operator()(const f32x4 (&acc)[2][2][4][2], const Unit& u, int wr, int wc, int fr, int fq) const {
        float* base = S + ((size_t)u.ex << 16) + (size_t)(wr * 64 + fr) * 256 + wc * 32 + 4 * fq;
#pragma unroll
        for (int ai = 0; ai < 2; ++ai)
#pragma unroll
            for (int m = 0; m < 4; ++m) { float* rowp = base + (size_t)(ai * HALF + m * 16) * 256;
#pragma unroll
                for (int bj = 0; bj < 2; ++bj)
#pragma unroll
                    for (int n = 0; n < 2; ++n) *(f32x4*)(rowp + bj * HALF + n * 16) = acc[ai][bj][m][n]; }
    }
};
}
namespace swa {
constexpr int D = 128; constexpr float THR = 8.f; constexpr bool WSKIP = true; constexpr int LSE_LDS_OFF = 131072;
constexpr float SCALE = 0.08838834764831845f;
constexpr int NW = 8, QBLK = 32, KVBLK = 64, QB = NW * QBLK;
constexpr int SHM_V = KVBLK * D * 2, SHM_K = KVBLK * D * 2;
constexpr int LDS_BYTES = 2 * SHM_V + 2 * SHM_K + NW * 64 * 4;

using bf16 = __hip_bfloat16;
typedef short bf16x8 __attribute__((ext_vector_type(8)));
typedef short s16x4 __attribute__((ext_vector_type(4)));
typedef float f32x16 __attribute__((ext_vector_type(16)));
typedef float f32x4 __attribute__((ext_vector_type(4)));
typedef unsigned u32x4 __attribute__((ext_vector_type(4)));
template <class A, class Bt> struct same_t { static constexpr bool v = false; };
template <class A> struct same_t<A, A> { static constexpr bool v = true; };

#define KSWZ(row, colB) ((row) * 256 + ((colB) ^ (((row) & 7) << 4)))
#define SBAR() __builtin_amdgcn_sched_barrier(0)
__device__ __forceinline__ int v_st(int k, int c) { const int kk = (k & ~0xC) | ((k & 4) << 1) | ((k & 8) >> 1); return ((kk >> 3) * 4 + (c >> 5)) * 512 + ((kk & 7) * 32 + (c & 31)) * 2; }
__device__ __forceinline__ int v_rd_base(int lane) { return ((lane & 3) << 3) | (((lane >> 2) & 3) << 6) | (((lane >> 4) & 1) << 5) | (((lane >> 5) & 1) << 8); }
constexpr int v_rd_off(int d0, int ks, int half) { return d0 * 512 + ks * 4096 + half * 2048; }
__device__ __forceinline__ int crow(int r, int hi) { return (r & 3) + 8 * (r >> 2) + 4 * hi; }
__device__ __forceinline__ unsigned cvtpk(float lo, float hi) {
    unsigned r; asm volatile("v_cvt_pk_bf16_f32 %0, %1, %2" : "=v"(r) : "v"(lo), "v"(hi)); return r;
}
__device__ __forceinline__ bf16x8 pack8(f32x4 a, f32x4 b) {
    u32x4 w = {cvtpk(a[0], a[1]), cvtpk(a[2], a[3]), cvtpk(b[0], b[1]), cvtpk(b[2], b[3])};
    return *reinterpret_cast<bf16x8*>(&w);
}
template <class T> __device__ __forceinline__ bf16x8 load8(const T* p) {
    if constexpr (same_t<T, float>::v) { return pack8(*(const f32x4*)p, *(const f32x4*)(p + 4)); }
    else { return *reinterpret_cast<const bf16x8*>(p); }
}
__device__ __forceinline__ void mask_tile(f32x16& p0, f32x16& p1, int dq, unsigned W) {
    const float NEG = -__builtin_inff();
#pragma unroll
    for (int r = 0; r < 16; ++r) {
        const int c = (r & 3) + 8 * (r >> 2);
        if ((unsigned)(dq - c) >= W) p0[r] = NEG;
        if ((unsigned)(dq - c - 32) >= W) p1[r] = NEG;
    }
}
__device__ __forceinline__ void partialSM(f32x16& p0, f32x16& p1, float& m_reg, float& mn, float& alpha) {
    float pmax = p0[0]; for (int r = 1; r < 16; ++r) pmax = fmaxf(pmax, p0[r]); for (int r = 0; r < 16; ++r) pmax = fmaxf(pmax, p1[r]);
    { auto rr = __builtin_amdgcn_permlane32_swap(__float_as_uint(pmax), __float_as_uint(pmax), false, false);
      pmax = fmaxf(__uint_as_float(rr[0]), __uint_as_float(rr[1])); }
    constexpr float C2 = 1.4426950408889634f * SCALE;
    if (__builtin_expect(__all((pmax - m_reg) * SCALE <= THR), 1)) { mn = m_reg; alpha = 1.f; }
    else { mn = fmaxf(m_reg, pmax); alpha = __builtin_amdgcn_exp2f((m_reg - mn) * C2); m_reg = mn; }
    const float mnL = -mn * C2;
    for (int r = 0; r < 16; ++r) p0[r] = fmaf(p0[r], C2, mnL); for (int r = 0; r < 16; ++r) p1[r] = fmaf(p1[r], C2, mnL);
    for (int r = 0; r < 16; ++r) p0[r] = __builtin_amdgcn_exp2f(p0[r]);
}
__device__ __forceinline__ void finishSM(f32x16& p0, f32x16& p1, float alpha, float& l_reg, bf16x8& pa0, bf16x8& pa1, bf16x8& pa2, bf16x8& pa3) {
    for (int r = 0; r < 16; ++r) p1[r] = __builtin_amdgcn_exp2f(p1[r]);
    float ps = 0; for (int r = 0; r < 16; ++r) ps += p0[r]; for (int r = 0; r < 16; ++r) ps += p1[r];
    { auto rr = __builtin_amdgcn_permlane32_swap(__float_as_uint(ps), __float_as_uint(ps), false, false);
      ps = __uint_as_float(rr[0]) + __uint_as_float(rr[1]); }
    l_reg = l_reg * alpha + ps;
#define PK4(P, B_, OUT) do { unsigned a0 = cvtpk(P[B_+0], P[B_+1]), a1 = cvtpk(P[B_+2], P[B_+3]);                          \
        unsigned b0 = cvtpk(P[B_+4], P[B_+5]), b1 = cvtpk(P[B_+6], P[B_+7]);                                             \
        auto r0 = __builtin_amdgcn_permlane32_swap(a0, b0, false, false); auto r1 = __builtin_amdgcn_permlane32_swap(a1, b1, false, false); \
        u32x4 w = {r0[0], r1[0], r0[1], r1[1]}; OUT = *reinterpret_cast<bf16x8*>(&w); } while (0)
    PK4(p0, 0, pa0); PK4(p0, 8, pa1); PK4(p1, 0, pa2); PK4(p1, 8, pa3);
#undef PK4
}
template <int KB, bool SK>
__device__ __forceinline__ void qkt(f32x16& p0, f32x16& p1, const char* K_lds, int r32, int hi, const bf16x8* qr, bool act) {
    if (SK && !act) { const float NEG = -__builtin_inff();
#pragma unroll
        for (int r = 0; r < 16; ++r) { p0[r] = NEG; p1[r] = NEG; } return; }
    p0 = f32x16{}; p1 = f32x16{};
    const char* kb[4];
#pragma unroll
    for (int dd = 0; dd < 4; ++dd) kb[dd] = K_lds + KB * SHM_K + KSWZ(r32, (dd * 16 + hi * 8) * 2);
#pragma unroll
    for (int d0 = 0; d0 < 8; ++d0) { const char* a = kb[d0 & 3] + (d0 >> 2) * 128;
        bf16x8 b0 = *reinterpret_cast<const bf16x8*>(a);
        bf16x8 b1 = *reinterpret_cast<const bf16x8*>(a + 32 * 256);
        p0 = __builtin_amdgcn_mfma_f32_32x32x16_bf16(b0, qr[d0], p0, 0, 0, 0);
        p1 = __builtin_amdgcn_mfma_f32_32x32x16_bf16(b1, qr[d0], p1, 0, 0, 0); }
}
template <int VB, bool SK>
__device__ __forceinline__ void pv_tile(f32x16* o, int vb0, bf16x8 pa0, bf16x8 pa1, bf16x8 pa2, bf16x8 pa3, bool act) {
    if (SK && !act) return;
#define TRRD(dst, off) asm volatile("ds_read_b64_tr_b16 %0, %1 offset:%2" : "=&v"(dst) : "v"(vb0), "i"(off) : "memory")
#define PV_D0(d0) do { s16x4 l0, l1, l2, l3, h0, h1, h2, h3; constexpr int b_ = VB * SHM_V + v_rd_off(d0, 0, 0);     \
        TRRD(l0, b_); TRRD(h0, b_ + 2048); TRRD(l1, b_ + 4096); TRRD(h1, b_ + 6144); TRRD(l2, b_ + 8192); TRRD(h2, b_ + 10240); TRRD(l3, b_ + 12288); TRRD(h3, b_ + 14336); \
        asm volatile("s_waitcnt lgkmcnt(0)" ::: "memory"); SBAR();                 \
        o[d0] = __builtin_amdgcn_mfma_f32_32x32x16_bf16(pa0, (bf16x8){l0[0], l0[1], l0[2], l0[3], h0[0], h0[1], h0[2], h0[3]}, o[d0], 0, 0, 0);   \
        o[d0] = __builtin_amdgcn_mfma_f32_32x32x16_bf16(pa1, (bf16x8){l1[0], l1[1], l1[2], l1[3], h1[0], h1[1], h1[2], h1[3]}, o[d0], 0, 0, 0);   \
        o[d0] = __builtin_amdgcn_mfma_f32_32x32x16_bf16(pa2, (bf16x8){l2[0], l2[1], l2[2], l2[3], h2[0], h2[1], h2[2], h2[3]}, o[d0], 0, 0, 0);   \
        o[d0] = __builtin_amdgcn_mfma_f32_32x32x16_bf16(pa3, (bf16x8){l3[0], l3[1], l3[2], l3[3], h3[0], h3[1], h3[2], h3[3]}, o[d0], 0, 0, 0); } while (0)
    PV_D0(0); PV_D0(1); PV_D0(2); PV_D0(3);
#undef PV_D0
#undef TRRD
}

template <class TIn, class TOut> struct BlockRef { const TIn* Q; const TIn* K; const TIn* V; TOut* O; int P0; };
template <class TIn> struct Seam {
    int tid;
    bf16x8 qr[8];
    bf16x8 st_v0, st_v1, st_k0, st_k1; f32x4 sf0, sf1, sf2, sf3;
    f32x4 tq[16];
};
__device__ __forceinline__ int swa_jlo(int P0, int W) { const int lowk = P0 - W + 1; return lowk > 0 ? lowk / KVBLK : 0; }
#define ROW(p, k0, rr) ((p) + (size_t)((k0) + (rr)) * D + sc)
#define VMW() asm volatile("s_waitcnt vmcnt(0)" ::: "memory")
#define VMWN(n) asm volatile("s_waitcnt vmcnt(%0)" :: "i"(n) : "memory")
#define SLOAD_H(Kp, Vp, k0) do { S.st_v0 = load8<TIn>(ROW(Vp, k0, sr)); S.st_v1 = load8<TIn>(ROW(Vp, k0, 32 + sr));              \
                         S.st_k0 = load8<TIn>(ROW(Kp, k0, sr)); S.st_k1 = load8<TIn>(ROW(Kp, k0, 32 + sr)); } while (0)
#define SWRITE_HK(bf) do { *(bf16x8*)(K_lds + (bf) * SHM_K + kws) = S.st_k0; *(bf16x8*)(K_lds + (bf) * SHM_K + kws + 32 * 256) = S.st_k1; } while (0)
#define SWRITE_HV(bf) do { *(bf16x8*)(V_lds + (bf) * SHM_V + vst0) = S.st_v0; *(bf16x8*)(V_lds + (bf) * SHM_V + vst1) = S.st_v1; } while (0)
#define SWRITE_H(bf) do { SWRITE_HV(bf); SWRITE_HK(bf); } while (0)
#define SLOAD_F(p, k0) do { S.sf0 = *(const f32x4*)ROW(p, k0, sr); S.sf1 = *(const f32x4*)(ROW(p, k0, sr) + 4);                \
                            S.sf2 = *(const f32x4*)ROW(p, k0, 32 + sr); S.sf3 = *(const f32x4*)(ROW(p, k0, 32 + sr) + 4); } while (0)
#define SWRITE_KF(bf) do { *(bf16x8*)(K_lds + (bf) * SHM_K + kws) = pack8(S.sf0, S.sf1); *(bf16x8*)(K_lds + (bf) * SHM_K + kws + 32 * 256) = pack8(S.sf2, S.sf3); } while (0)
#define SWRITE_VF(bf) do { *(bf16x8*)(V_lds + (bf) * SHM_V + vst0) = pack8(S.sf0, S.sf1); *(bf16x8*)(V_lds + (bf) * SHM_V + vst1) = pack8(S.sf2, S.sf3); } while (0)
template <class TIn, class TOut>
__device__ __forceinline__ void causal_swa_prime(const BlockRef<TIn, TOut>& cur, int W, char* lds, Seam<TIn>& S) {
    constexpr bool F32 = same_t<TIn, float>::v;
    const int tid = S.tid, wid = __builtin_amdgcn_readfirstlane(tid >> 6), lane = tid & 63, r32 = lane & 31, hi = lane >> 5;
    const int sr = tid >> 4, sc = (tid & 15) * 8, kws = KSWZ(sr, sc * 2); char* K_lds = lds + 2 * SHM_V;
    const int kb0 = swa_jlo(cur.P0, W) * KVBLK;
    for (int d0 = 0; d0 < 8; ++d0) S.qr[d0] = load8<TIn>(cur.Q + (size_t)(wid * QBLK + r32) * D + d0 * 16 + hi * 8);
    if constexpr (F32) { SLOAD_F((const float*)cur.K, kb0); VMW(); SWRITE_KF(0); SBAR(); SLOAD_F((const float*)cur.V, kb0); }
    else { SLOAD_H(cur.K, cur.V, kb0); VMW(); SWRITE_HK(0); }
    __syncthreads();
}
template <class TIn, class TOut>
__device__ __forceinline__ void causal_swa_block(const BlockRef<TIn, TOut>& cur, const BlockRef<TIn, TOut>& nxt, int skv, int W, char* lds, Seam<TIn>& S) {
    constexpr bool F32 = same_t<TIn, float>::v;
    const int tid = S.tid, wid = __builtin_amdgcn_readfirstlane(tid >> 6), lane = tid & 63, r32 = lane & 31, hi = lane >> 5;
    const int j_lo = swa_jlo(cur.P0, W);
    int j_hi = (cur.P0 + QB - 1) / KVBLK + 1; if (j_hi > skv / KVBLK) j_hi = skv / KVBLK;
    const int NT = j_hi - j_lo;
    const int kbn = swa_jlo(nxt.P0, W) * KVBLK;
    const int qlo = cur.P0 + wid * QBLK, qm = qlo + r32 - 4 * hi;
    char* V_lds = lds; char* K_lds = lds + 2 * SHM_V;
    float* ws = (float*)(lds + 2 * SHM_V + 2 * SHM_K) + wid * 64; float* li_l = ws, * al_l = ws + 32;
    float m_reg = -1e30f, l_reg = 0; f32x16 o[4] = {};
    const int sr = tid >> 4, sc = (tid & 15) * 8, vst0 = v_st(sr, sc), vst1 = v_st(32 + sr, sc), kws = KSWZ(sr, sc * 2);
    const int vb0 = (int)(uintptr_t)V_lds + v_rd_base(lane);
    const TIn* Kh = cur.K; const TIn* Vh = cur.V;
#define RESC(a) do { if (__any((a) < 1.f)) { if (hi == 0) al_l[r32] = (a); asm volatile("s_waitcnt lgkmcnt(0)" ::: "memory");              \
                     for (int d_ = 0; d_ < 4; ++d_) for (int r = 0; r < 16; ++r) o[d_][r] *= al_l[crow(r, hi)]; } } while (0)
#define KBASE(t) ((j_lo + (t)) * KVBLK)
#define ACT(t) (KBASE(t) <= qlo + QBLK - 1 && KBASE(t) + KVBLK - 1 >= qlo - W + 1)
#define MASKT(P0_, P1_, t) do { const int kb_ = KBASE(t); if ((!SK || ACT(t)) && (kb_ + KVBLK - 1 > qlo || kb_ <= qlo + QBLK - 1 - W)) mask_tile(P0_, P1_, qm - kb_, (unsigned)W); } while (0)
    constexpr int NQL = F32 ? 16 : 8;
    constexpr bool SK = WSKIP && !F32;
#define SEAM_K0() do { VMWN(NQL); if constexpr (F32) { SWRITE_KF(0); SBAR(); SLOAD_F((const float*)nxt.V, kbn); } else { SWRITE_HK(0); } SBAR(); } while (0)
    f32x16 pA0, pA1, pB0, pB1; float mnA, mnB, alA, alB; bf16x8 pa0, pa1, pa2, pa3;
    if constexpr (F32) { VMW(); SWRITE_VF(0); SBAR(); } else { SWRITE_HV(0); SBAR(); }
    if (NT > 1) { if constexpr (F32) SLOAD_F((const float*)Kh, KBASE(1)); else SLOAD_H(Kh, Vh, KBASE(1)); }
    SBAR(); qkt<0, SK>(pA0, pA1, K_lds, r32, hi, S.qr, ACT(0));
    if constexpr (F32) { if (NT > 1) { VMW(); SWRITE_KF(1); SBAR(); SLOAD_F((const float*)Vh, KBASE(1)); } }
    MASKT(pA0, pA1, 0); partialSM(pA0, pA1, m_reg, mnA, alA);
    if (NT > 1) { VMW(); if constexpr (F32) { SWRITE_VF(1); SBAR(); if (NT > 2) SLOAD_F((const float*)Kh, KBASE(2)); } else SWRITE_H(1); }
    __syncthreads();
#define HALF_STEP(PX0, PX1, mnX, alX, PY0, PY1, alY, t, KB, VB, SB) do {                                                      \
        SBAR(); qkt<KB, SK>(PX0, PX1, K_lds, r32, hi, S.qr, ACT(t));                                             \
        finishSM(PY0, PY1, alY, l_reg, pa0, pa1, pa2, pa3); SBAR();                                                           \
        if ((t) + 1 < NT) { if constexpr (F32) { VMW(); SWRITE_KF(SB); SBAR(); SLOAD_F((const float*)Vh, KBASE((t) + 1)); }  \
                            else { SLOAD_H(Kh, Vh, KBASE((t) + 1)); } SBAR(); }                                               \
        pv_tile<VB, SK>(o, vb0, pa0, pa1, pa2, pa3, ACT((t) - 1)); MASKT(PX0, PX1, (t)); partialSM(PX0, PX1, m_reg, mnX, alX);                                        \
        __syncthreads();                                                                                                      \
        if ((t) + 1 < NT) { VMW(); if constexpr (F32) { SWRITE_VF(SB); SBAR(); if ((t) + 2 < NT) SLOAD_F((const float*)Kh, KBASE((t) + 2)); } \
                            else { SWRITE_H(SB); } }                                                                          \
        RESC(alX); __syncthreads(); } while (0)
    for (int t = 1; t + 1 < NT; t += 2) {
        HALF_STEP(pB0, pB1, mnB, alB, pA0, pA1, alA, t, 1, 0, 0);
        HALF_STEP(pA0, pA1, mnA, alA, pB0, pB1, alB, t + 1, 0, 1, 1);
    }
    const bool even = (NT & 1) == 0;
    if (even) { SBAR(); qkt<1, SK>(pB0, pB1, K_lds, r32, hi, S.qr, ACT(NT - 1)); SBAR(); }
#define QROW(e) (nxt.Q + (size_t)(wid * QBLK + r32) * D + ((e) >> 1) * 16 + hi * 8 + ((e) & 1) * 4)
    if constexpr (F32) { SLOAD_F((const float*)nxt.K, kbn); SBAR();
#pragma unroll
        for (int e = 0; e < 8; ++e) S.tq[e] = *(const f32x4*)QROW(e); }
    else { SLOAD_H(nxt.K, nxt.V, kbn); SBAR();
#pragma unroll
        for (int d0 = 0; d0 < 8; ++d0) S.qr[d0] = load8<TIn>(nxt.Q + (size_t)(wid * QBLK + r32) * D + d0 * 16 + hi * 8); }
    SBAR();
    finishSM(pA0, pA1, alA, l_reg, pa0, pa1, pa2, pa3); SBAR();
    if constexpr (F32) {
#pragma unroll
        for (int e = 8; e < 16; ++e) S.tq[e] = *(const f32x4*)QROW(e); SBAR(); }
#undef QROW
    pv_tile<0, SK>(o, vb0, pa0, pa1, pa2, pa3, ACT(even ? NT - 2 : NT - 1));
    if (even) { MASKT(pB0, pB1, NT - 1); partialSM(pB0, pB1, m_reg, mnB, alB); __syncthreads(); RESC(alB);
        finishSM(pB0, pB1, alB, l_reg, pa0, pa1, pa2, pa3); SBAR(); pv_tile<1, SK>(o, vb0, pa0, pa1, pa2, pa3, ACT(NT - 1)); }
    SBAR(); SEAM_K0();
    if (hi == 0) { li_l[r32] = l_reg; ((float*)(lds + LSE_LDS_OFF))[wid * QBLK + r32] = m_reg * SCALE + __logf(l_reg); } asm volatile("s_waitcnt lgkmcnt(0)" ::: "memory");
    float rli[16];
#pragma unroll
    for (int r = 0; r < 16; ++r) rli[r] = __builtin_amdgcn_rcpf(li_l[crow(r, hi)]);
    TOut* Ow = cur.O + (size_t)(wid * QBLK) * D + (size_t)(hi * 4) * D + r32;
#pragma unroll
    for (int r = 0; r < 16; ++r) { const int orow = (r & 3) + 8 * (r >> 2);
#pragma unroll
        for (int d0 = 0; d0 < 4; ++d0) { const float v = o[d0][r] * rli[r];
            if constexpr (same_t<TOut, float>::v) { Ow[orow * D + d0 * 32] = v; }
            else { const float vn = __shfl_xor(v, 1);
                   if ((r32 & 1) == 0) *(unsigned*)(Ow + orow * D + d0 * 32) = cvtpk(v, vn); } } }
    if constexpr (F32) {
#pragma unroll
        for (int d0 = 0; d0 < 8; ++d0) S.qr[d0] = pack8(S.tq[2 * d0], S.tq[2 * d0 + 1]); }
    __syncthreads();
#undef RESC
#undef KBASE
#undef ACT
#undef MASKT
#undef SEAM_K0
#undef HALF_STEP
}
#undef ROW
#undef VMW
#undef VMWN
#undef SLOAD_H
#undef SWRITE_HK
#undef SWRITE_HV
#undef SWRITE_H
#undef SLOAD_F
#undef SWRITE_KF
#undef SWRITE_VF
}
constexpr int T_TOK = 32768, DMODEL = 1024, SEQ = 16384, DFF = 3584, NEXP = 8;
constexpr float ALPHA = 1.6817928305074290f, LN_EPS = 1e-5f;
constexpr int NWAVES = 8;
constexpr size_t MiB = 1u << 20;
constexpr size_t WS_CTL = 0, CTL_ZERO_BYTES = 1 * MiB;
constexpr size_t WS_WIN = 2 * MiB, WS_WRO = 26 * MiB, WS_WQKV = 34 * MiB, WS_WAO = 52 * MiB, WS_WGU = 54 * MiB, WS_WDN = 82 * MiB;
constexpr size_t WS_TAB = 96 * MiB, WS_XB = 112 * MiB;
constexpr size_t WS_LIST = 176 * MiB, WS_TSLOT = 178 * MiB, WS_GATE = 178 * MiB + 256 * 1024, WS_LC = 178 * MiB + 512 * 1024;
constexpr size_t WS_BIG = 179 * MiB;
constexpr size_t BIG_QD = 0, BIG_KH = 64 * MiB, BIG_VT = 128 * MiB, BIG_G = 256 * MiB, BIG_RT = 384 * MiB;
constexpr size_t BIG_HID = 0;
constexpr size_t BIG_QKV = 0, BIG_OP = 288 * MiB, BIG_LSE = 384 * MiB, BIG_O = 386 * MiB;
constexpr size_t BIG_YP = 462 * MiB, BIG_WMGU = 594 * MiB, BIG_WMD = 706 * MiB;
constexpr size_t WS_SLAB = WS_BIG + 762 * MiB;
constexpr size_t WS_END = WS_SLAB + 32 * MiB;
constexpr int CW_TMO = 0, CW_BAR = 4096, CW_CNT = 8192;
constexpr int RING_OFF = 0, RING_BYTES = 131072, AUX_OFF = 131072, AUX_BYTES = 30720, MISC_OFF = AUX_OFF + AUX_BYTES, LDS_BYTES = MISC_OFF + 512;
static_assert(LDS_BYTES <= 163840, "LDS");

#define GAS __attribute__((address_space(1)))
#define LAS __attribute__((address_space(3)))
typedef unsigned short bf16;
typedef unsigned v4u __attribute__((ext_vector_type(4)));
typedef unsigned v2u __attribute__((ext_vector_type(2)));
typedef float f32x4 __attribute__((ext_vector_type(4)));
typedef float f32x16 __attribute__((ext_vector_type(16)));
typedef short bf16x8 __attribute__((ext_vector_type(8)));
typedef short s16x4 __attribute__((ext_vector_type(4)));
typedef GAS unsigned gu32;
#define RLX_AGENT __ATOMIC_RELAXED, __HIP_MEMORY_SCOPE_AGENT
#define LDS_WAIT() asm volatile("s_waitcnt lgkmcnt(0)" ::: "memory")
#define VM_WAIT() asm volatile("s_waitcnt vmcnt(0)" ::: "memory")
__device__ __forceinline__ unsigned f2bf(float f) { unsigned u = __builtin_bit_cast(unsigned, f); return (u + 0x7fffu + ((u >> 16) & 1u)) >> 16; }
__device__ __forceinline__ unsigned pk2(float lo, float hi) { return f2bf(lo) | (f2bf(hi) << 16); }
__device__ __forceinline__ float bflo(unsigned w) { return __builtin_bit_cast(float, w << 16); }
__device__ __forceinline__ float bfhi(unsigned w) { return __builtin_bit_cast(float, w & 0xffff0000u); }
#define XB_TMO      128
#define XB_XCNT(j)  (256  + 64 * (j))
#define XB_XSUB(j)  (1280 + 64 * (j))
#define XB_XGEN(j)  (2304 + 64 * (j))
#define XB_TOP      3328
#define XB_TOPGEN   3392
#define XCD_BAR_WORDS 3456
#define XB_SPIN_CAP (1u << 18)

__device__ __forceinline__ unsigned xb_ld(unsigned* p)              { return __hip_atomic_load(p, __ATOMIC_RELAXED, __HIP_MEMORY_SCOPE_AGENT); }
__device__ __forceinline__ unsigned xb_add(unsigned* p, unsigned v) { return __hip_atomic_fetch_add(p, v, __ATOMIC_RELAXED, __HIP_MEMORY_SCOPE_AGENT); }
__device__ __forceinline__ unsigned xb_xcc_id() { return (unsigned)__builtin_amdgcn_s_getreg((3 << 11) | 20) & 0xFu; }
#define XB_SPIN(cond, bar) do { unsigned _sp = 0; while (cond) { __builtin_amdgcn_s_sleep(1); \
    if ((++_sp & 255u) == 0u) { if (xb_ld(&(bar)[XB_TMO])) break; if (_sp > XB_SPIN_CAP) { atomicAdd(&(bar)[XB_TMO], 1u); break; } } } } while (0)

struct XcdBarrier {
    unsigned* bar; unsigned x;
    volatile LAS unsigned* st;
};

__device__ __forceinline__ XcdBarrier xcd_barrier_post(unsigned* bar, volatile LAS unsigned* st) {
    XcdBarrier b; b.bar = bar; b.x = xb_xcc_id(); b.st = st;
    if (threadIdx.x == 0) (void)xb_add(&bar[XB_XCNT(b.x)], 1u);
    return b;
}
__device__ __forceinline__ void xcd_barrier_complete(unsigned* bar, unsigned x, unsigned& nloc, unsigned& nx) {
    const unsigned G = gridDim.x * gridDim.y * gridDim.z;
    unsigned sum, cnt, mine, sp = 0u;
    for (;;) {
        sum = 0u; cnt = 0u; mine = 0u;
#pragma unroll
        for (unsigned j = 0; j < 16; ++j) { const unsigned c = xb_ld(&bar[XB_XCNT(j)]); sum += c; cnt += (c > 0u) ? 1u : 0u; mine = (j == x) ? c : mine; }
        if (sum == G) break;
        __builtin_amdgcn_s_sleep(1);
        if ((++sp & 255u) == 0u) { if (xb_ld(&bar[XB_TMO])) break; if (sp > XB_SPIN_CAP) { atomicAdd(&bar[XB_TMO], 1u); break; } }
    }
    nloc = mine > 0u ? mine : 1u; nx = cnt > 0u ? cnt : 1u;
}

__device__ __forceinline__ void xcd_barrier(const XcdBarrier& b) {
    asm volatile("s_waitcnt vmcnt(0)" ::: "memory");
    __syncthreads();
    if (threadIdx.x == 0) {
        unsigned* bar = b.bar;
        __builtin_amdgcn_s_waitcnt(0);
        unsigned nloc = b.st[0], nx = b.st[1];
        if (nloc == 0u) { xcd_barrier_complete(bar, b.x, nloc, nx); b.st[0] = nloc; b.st[1] = nx; }
        const unsigned old = xb_add(&bar[XB_XSUB(b.x)], 1u);
        const unsigned gen = old / nloc;
        if (old + 1u == (gen + 1u) * nloc) {
            __builtin_amdgcn_fence(__ATOMIC_RELEASE, "agent");
            asm volatile("s_waitcnt vmcnt(0)" ::: "memory");
            const unsigned og = xb_add(&bar[XB_TOP], 1u);
            const unsigned tg = og / nx;
            if (og + 1u == (tg + 1u) * nx) xb_add(&bar[XB_TOPGEN], 1u);
            else XB_SPIN(xb_ld(&bar[XB_TOPGEN]) == tg, bar);
            __builtin_amdgcn_fence(__ATOMIC_ACQUIRE, "agent");
            xb_add(&bar[XB_XGEN(b.x)], 1u);
            asm volatile("s_waitcnt vmcnt(0)" ::: "memory");
        } else {
            XB_SPIN(xb_ld(&bar[XB_XGEN(b.x)]) == gen, bar);
            __builtin_amdgcn_fence(__ATOMIC_ACQUIRE, "agent");
            asm volatile("s_waitcnt vmcnt(0)" ::: "memory");
        }
    }
    __syncthreads();
}
struct Args { const float* in[15]; float* out; unsigned char* ws; };
struct Frame {
    LAS unsigned char* lds;
    volatile LAS unsigned* MISC;
    int tid, lane, wave, G, c;
};
__device__ __forceinline__ unsigned long long arg_u64(const Frame& F, int k) { const unsigned long long v = ((const LAS unsigned long long*)(F.lds + MISC_OFF + 128))[k];
    return ((unsigned long long)(unsigned)__builtin_amdgcn_readfirstlane((int)(unsigned)(v >> 32)) << 32) | (unsigned long long)(unsigned)__builtin_amdgcn_readfirstlane((int)(unsigned)v); }
#define ARGI(F, k) ((const float*)(const GAS float*)arg_u64(F, (k)))
#define ARGX(F) ((float*)(GAS float*)arg_u64(F, 15))
#define ARGWS(F) ((unsigned char*)(GAS unsigned char*)arg_u64(F, 16))
#define F_CTL(F) ((gu32*)(ARGWS(F) + WS_CTL))
__device__ __forceinline__ void frame_refresh(Frame& F) { int t = F.tid; asm volatile("" : "+v"(t)); F.tid = t; F.lane = t & 63; F.wave = __builtin_amdgcn_readfirstlane(t >> 6); unsigned l = (unsigned)(uintptr_t)F.lds; int c_ = F.c, g_ = F.G; asm volatile("" : "+s"(l), "+s"(c_), "+s"(g_)); F.lds = (LAS unsigned char*)(uintptr_t)l; F.c = c_; F.G = g_; }
__device__ __forceinline__ float wave_sum(float v) {
#pragma unroll
    for (int o = 1; o < 64; o <<= 1) v += __shfl_xor(v, o);
    return v;
}
__device__ __forceinline__ s16x4 vtr(const LAS unsigned char* p) { return __builtin_bit_cast(s16x4, __builtin_amdgcn_ds_read_tr16_b64_v4i16((LAS s16x4*)p)); }
__device__ __forceinline__ int crow(int r, int hi) { return (r & 3) + 8 * (r >> 2) + 4 * hi; }

struct CvItem { const float* src; bf16* dst; int N, K; };
template <int MAP> __device__ __forceinline__ CvItem cv_make(const float* W, int K, int N, bf16* WT, int item) {
    const int nblk = N / 64, kb = item / nblk, nb = item - kb * nblk, n0 = 64 * nb; int dr = n0;
    if (MAP == 1) dr = n0 < 2048 ? n0 : (n0 < 4096 ? n0 + 2048 : n0 - 2048);
    if (MAP == 2) dr = (n0 >> 7) * 256 + (n0 & 127);
    if (MAP == 3) dr = (n0 >> 7) * 256 + 128 + (n0 & 127);
    CvItem c; c.src = W + (size_t)(64 * kb) * N + n0; c.dst = WT + (size_t)dr * K + 64 * kb; c.N = N; c.K = K; return c;
}
__device__ __forceinline__ void cv_load(const CvItem& c, f32x4 (&r)[16], int lane) {
    const float* p = c.src + (size_t)(lane >> 4) * c.N + 4 * (lane & 15);
#pragma unroll
    for (int i = 0; i < 16; ++i) r[i] = *(const GAS f32x4*)(p + (size_t)(4 * i) * c.N);
}
__device__ __forceinline__ void cv_store(const CvItem& c, const f32x4 (&r)[16], LAS float* scr, int lane) {
#pragma unroll
    for (int i = 0; i < 16; ++i) { LAS float* s = scr + (4 * i + (lane >> 4)) * 65 + 4 * (lane & 15); s[0] = r[i].x; s[1] = r[i].y; s[2] = r[i].z; s[3] = r[i].w; }
    LDS_WAIT(); asm volatile("" ::: "memory");
    const int ch = lane & 7;
#pragma unroll
    for (int jj = 0; jj < 8; ++jj) { const int n = (lane >> 3) + 8 * jj; const LAS float* s = scr + (8 * ch) * 65 + n;
        v4u o; o.x = pk2(s[0 * 65], s[1 * 65]); o.y = pk2(s[2 * 65], s[3 * 65]); o.z = pk2(s[4 * 65], s[5 * 65]); o.w = pk2(s[6 * 65], s[7 * 65]);
        *(GAS v4u*)(c.dst + (size_t)n * c.K + 8 * ch) = o; }
    LDS_WAIT(); asm volatile("" ::: "memory");
}
constexpr int CV_SCR_BYTES = 64 * 65 * 4;
__device__ __forceinline__ CvItem cv_dense(Frame& F, int it) {
    constexpr int I_WIN = 16 * 96, I_WRO = 32 * 16, I_QKV = 16 * 72, I_WAO = 8 * 16, I_GU = 16 * 56, I_DN = 56 * 16;
    constexpr int PERJ = I_WIN + I_WRO + I_QKV + I_WAO + 2 * I_GU + I_DN;
    const int j = it / PERJ; int r = it - j * PERJ;
    if (r < I_WIN) return cv_make<1>(ARGI(F, 3) + (size_t)j * 1024 * 6144, 1024, 6144, (bf16*)(ARGWS(F) + WS_WIN) + (size_t)j * 6144 * 1024, r); r -= I_WIN;
    if (r < I_WRO) return cv_make<0>(ARGI(F, 5) + (size_t)j * 2048 * 1024, 2048, 1024, (bf16*)(ARGWS(F) + WS_WRO) + (size_t)j * 1024 * 2048, r); r -= I_WRO;
    if (r < I_QKV) return cv_make<0>(ARGI(F, 6) + (size_t)j * 1024 * 4608, 1024, 4608, (bf16*)(ARGWS(F) + WS_WQKV) + (size_t)j * 4608 * 1024, r); r -= I_QKV;
    if (r < I_WAO) return cv_make<0>(ARGI(F, 7) + (size_t)j * 512 * 1024, 512, 1024, (bf16*)(ARGWS(F) + WS_WAO) + (size_t)j * 1024 * 512, r); r -= I_WAO;
    if (r < I_GU) return cv_make<2>(ARGI(F, 8) + (size_t)j * 1024 * 3584, 1024, 3584, (bf16*)(ARGWS(F) + WS_WGU) + (size_t)j * 7168 * 1024, r); r -= I_GU;
    if (r < I_GU) return cv_make<3>(ARGI(F, 9) + (size_t)j * 1024 * 3584, 1024, 3584, (bf16*)(ARGWS(F) + WS_WGU) + (size_t)j * 7168 * 1024, r); r -= I_GU;
    return cv_make<0>(ARGI(F, 10) + (size_t)j * 3584 * 1024, 3584, 1024, (bf16*)(ARGWS(F) + WS_WDN) + (size_t)j * 1024 * 3584, r);
}
constexpr int CV_DENSE_ITEMS = 2 * (16 * 96 + 32 * 16 + 16 * 72 + 8 * 16 + 2 * 16 * 56 + 56 * 16), CV_DENSE_EARLY = 16 * 96;
__device__ __forceinline__ CvItem cv_moe(Frame& F, int it, int j) {
    constexpr int I_GU = 16 * 56, I_DN = 56 * 16, PERE = 2 * I_GU + I_DN;
    bf16* WMGU = (bf16*)(ARGWS(F) + WS_BIG + BIG_WMGU); bf16* WMD = (bf16*)(ARGWS(F) + WS_BIG + BIG_WMD);
    const int e = it / PERE; int r = it - e * PERE; const size_t wofs = ((size_t)j * NEXP + e) * 1024 * 3584;
    if (r < I_GU) return cv_make<2>(ARGI(F, 12) + wofs, 1024, 3584, WMGU + (size_t)e * 7168 * 1024, r); r -= I_GU;
    if (r < I_GU) return cv_make<3>(ARGI(F, 13) + wofs, 1024, 3584, WMGU + (size_t)e * 7168 * 1024, r); r -= I_GU;
    return cv_make<0>(ARGI(F, 14) + wofs, 3584, 1024, WMD + (size_t)e * 1024 * 3584, r);
}
constexpr int CV_MOE_ITEMS = NEXP * (2 * 16 * 56 + 56 * 16);
template <bool MOE> __device__ __forceinline__ void cv_run(Frame& F, int first, int stride, int total, int j) {
    LAS float* scr = (LAS float*)(F.lds + RING_OFF + F.wave * CV_SCR_BYTES);
    if (first >= total) return;
    f32x4 ra[16], rb[16];
    CvItem ca = MOE ? cv_moe(F, first, j) : cv_dense(F, first), cb = ca;
    cv_load(ca, ra, F.lane);
    for (int it = first; it < total; it += 2 * stride) {
        const bool hb = it + stride < total;
        if (hb) { cb = MOE ? cv_moe(F, it + stride, j) : cv_dense(F, it + stride); cv_load(cb, rb, F.lane); }
        cv_store(ca, ra, scr, F.lane);
        if (!hb) break;
        const bool ha = it + 2 * stride < total;
        if (ha) { ca = MOE ? cv_moe(F, it + 2 * stride, j) : cv_dense(F, it + 2 * stride); cv_load(ca, ra, F.lane); }
        cv_store(cb, rb, scr, F.lane);
        if (!ha) break;
    }
}
__device__ __forceinline__ void p0_prologue(Frame& F) {
    const int gw = F.c * NWAVES + F.wave, NGW = F.G * NWAVES;
    cv_run<false>(F, gw, NGW, CV_DENSE_EARLY, 0);
    { float* tab = (float*)(ARGWS(F) + WS_TAB); const int gt = F.c * 512 + F.tid, NT = F.G * 512;
      for (int e = gt; e < SEQ * 128; e += NT) { const int pos = e >> 7, cc = e & 127;
          const double ang = (double)pos * exp(-9.210340371976184 * (double)cc * (1.0 / 128.0)); double sn, cs; sincos(ang, &sn, &cs);
          typedef float f32x2t __attribute__((ext_vector_type(2))); *(GAS f32x2t*)(tab + (size_t)e * 2) = (f32x2t){(float)cs, (float)sn}; } }
    { const float* x = ARGI(F, 0); bf16* XB = (bf16*)(ARGWS(F) + WS_XB);
      for (int m0 = gw; m0 < T_TOK; m0 += 4 * NGW) { f32x4 xv[4][4];
#pragma unroll
          for (int r = 0; r < 4; ++r) { const int m = m0 + r * NGW < T_TOK ? m0 + r * NGW : gw; const GAS f32x4* xr = (const GAS f32x4*)(x + (size_t)m * DMODEL) + F.lane;
#pragma unroll
              for (int jj = 0; jj < 4; ++jj) xv[r][jj] = xr[64 * jj]; }
#pragma unroll
          for (int r = 0; r < 4; ++r) { const int m = m0 + r * NGW; if (m >= T_TOK) break; GAS unsigned long long* o8 = (GAS unsigned long long*)(XB + (size_t)m * DMODEL) + F.lane;
#pragma unroll
              for (int jj = 0; jj < 4; ++jj) { const f32x4 v = xv[r][jj]; o8[64 * jj] = (unsigned long long)pk2(v.x, v.y) | ((unsigned long long)pk2(v.z, v.w) << 32); } } } }
}
__device__ __forceinline__ void p0_late(Frame& F) {
    if (((F.c >> 3) & 3) != 0) return;
    const int gw = ((F.c >> 5) * 8 + (F.c & 7)) * NWAVES + F.wave;
    cv_run<false>(F, CV_DENSE_EARLY + gw, 64 * NWAVES, CV_DENSE_ITEMS, 0);
}
template <bool SUB> __device__ __forceinline__ void moe_convert(Frame& F, int j) {
    if (SUB && ((F.c >> 3) & 3) != 0) return;
    const int gw = (SUB ? ((F.c >> 5) * 8 + (F.c & 7)) : F.c) * NWAVES + F.wave, NGW = (SUB ? 64 : F.G) * NWAVES;
    cv_run<true>(F, gw, NGW, CV_MOE_ITEMS, j);
}
__device__ __forceinline__ void moe_prefix_lds(Frame& F, LAS int* PB) {
    const int* LC = (const int*)(ARGWS(F) + WS_LC);
    for (int i = F.tid; i < 2048; i += 512) PB[i] = LC[i];
    __syncthreads();
    { const int e = F.wave, l = F.lane;
      const int v0 = PB[(4 * l) * 8 + e], v1 = PB[(4 * l + 1) * 8 + e], v2 = PB[(4 * l + 2) * 8 + e], v3 = PB[(4 * l + 3) * 8 + e];
      const int tot = v0 + v1 + v2 + v3; int inc = tot;
#pragma unroll
      for (int o = 1; o < 64; o <<= 1) { const int t = __shfl_up(inc, o); inc += (l >= o) ? t : 0; }
      const int ex = inc - tot;
      PB[(4 * l) * 8 + e] = ex; PB[(4 * l + 1) * 8 + e] = ex + v0; PB[(4 * l + 2) * 8 + e] = ex + v0 + v1; PB[(4 * l + 3) * 8 + e] = ex + v0 + v1 + v2;
      if (l == 63) PB[2048 + e] = inc; }
    __syncthreads();
}
__device__ __forceinline__ void unpack8(const v4u w, float (&v)[8]) { v[0] = bflo(w.x); v[1] = bfhi(w.x); v[2] = bflo(w.y); v[3] = bfhi(w.y); v[4] = bflo(w.z); v[5] = bfhi(w.z); v[6] = bflo(w.w); v[7] = bfhi(w.w); }
template <int MODE, bool FINAL> __device__ __forceinline__ void ln_pass(Frame& F, int li  , int sub  , int j) {
    const int gw = F.c * NWAVES + F.wave, NGW = F.G * NWAVES;
    const float* gain = ARGI(F, 1) + (size_t)(li * 2 + sub) * DMODEL; const float* bias = ARGI(F, 2) + (size_t)(li * 2 + sub) * DMODEL;
    float gv[2][8], bv[2][8];
#pragma unroll
    for (int q = 0; q < 2; ++q)
#pragma unroll
        for (int h2 = 0; h2 < 2; ++h2) { const f32x4 g4 = *(const GAS f32x4*)(gain + 512 * q + 8 * F.lane + 4 * h2), b4 = *(const GAS f32x4*)(bias + 512 * q + 8 * F.lane + 4 * h2);
#pragma unroll
            for (int k = 0; k < 4; ++k) { gv[q][4 * h2 + k] = g4[k]; bv[q][4 * h2 + k] = b4[k]; } }
    bf16* XB = (bf16*)(ARGWS(F) + WS_XB);
    int rtb[8]; LAS int* PB = (LAS int*)(F.lds + RING_OFF);
    if (MODE == 2) { moe_prefix_lds(F, PB); int acc = 0;
#pragma unroll
        for (int e = 0; e < 8; ++e) { rtb[e] = acc; acc += (PB[2048 + e] + 255) >> 8; } }
    const unsigned* tslot = (const unsigned*)(ARGWS(F) + WS_TSLOT); const float* gate = (const float*)(ARGWS(F) + WS_GATE); const bf16* YP = (const bf16*)(ARGWS(F) + WS_BIG + BIG_YP);
    for (int m0 = gw; m0 < T_TOK; m0 += 4 * NGW) {
        v4u zr[4][2]; unsigned ts[4][2]; float gk[4][2]; v4u yv[4][2][2]; int yrow[4][2];
#pragma unroll
        for (int r = 0; r < 4; ++r) { const int m = m0 + r * NGW; const bool ok = m < T_TOK; const int mm = ok ? m : gw;
            const GAS v4u* xr = (const GAS v4u*)(XB + (size_t)mm * DMODEL) + F.lane; zr[r][0] = xr[0]; zr[r][1] = xr[64];
            if (MODE == 2) { ts[r][0] = tslot[2 * mm]; ts[r][1] = tslot[2 * mm + 1]; gk[r][0] = gate[2 * mm]; gk[r][1] = gate[2 * mm + 1]; } }
        if (MODE == 2) {
#pragma unroll
            for (int r = 0; r < 4; ++r) { const int m = m0 + r * NGW; const int mm = m < T_TOK ? m : gw;
#pragma unroll
                for (int k2 = 0; k2 < 2; ++k2) { const int e = (int)(ts[r][k2] >> 20), slot = PB[(mm >> 7) * 8 + e] + (int)(ts[r][k2] & 0xfffffu);
                    int rb = 0;
#pragma unroll
                    for (int q = 0; q < 8; ++q) rb = (q == e) ? rtb[q] : rb;
                    yrow[r][k2] = rb * 256 + slot;
                    const GAS v4u* yr = (const GAS v4u*)(YP + (size_t)(yrow[r][k2] < 65536 ? yrow[r][k2] : 0) * DMODEL) + F.lane; yv[r][k2][0] = yr[0]; yv[r][k2][1] = yr[64]; } } }
#pragma unroll
        for (int r = 0; r < 4; ++r) { const int m = m0 + r * NGW; if (m >= T_TOK) break;
            float v[2][8]; float s = 0.f;
#pragma unroll
            for (int q = 0; q < 2; ++q) unpack8(zr[r][q], v[q]);
            if (MODE == 2) {
#pragma unroll
                for (int q = 0; q < 2; ++q)
#pragma unroll
                    for (int k = 0; k < 8; ++k) v[q][k] *= ALPHA;
#pragma unroll
                for (int k2 = 0; k2 < 2; ++k2) { const float g_ = gk[r][k2];
                    if (yrow[r][k2] < 65536) {
#pragma unroll
                        for (int q = 0; q < 2; ++q) { float y[8]; unpack8(yv[r][k2][q], y);
#pragma unroll
                            for (int k = 0; k < 8; ++k) v[q][k] += g_ * y[k]; } }
                    else { const int lr = yrow[r][k2] - 65536, tl = lr >> 8, rr = lr & 255;
                        const float* SL = (const float*)(ARGWS(F) + WS_SLAB);
#pragma unroll
                        for (int q = 0; q < 2; ++q) { const int col = 512 * q + 8 * F.lane, ct = col >> 8, cc = col & 255;
#pragma unroll
                            for (int kp = 0; kp < 4; ++kp) { const GAS f32x4* sp = (const GAS f32x4*)(SL + ((size_t)(kp * 32 + tl * 4 + ct) << 16) + (size_t)rr * 256 + cc); const f32x4 a0 = sp[0], a1 = sp[1];
                                v[q][0] += g_ * a0.x; v[q][1] += g_ * a0.y; v[q][2] += g_ * a0.z; v[q][3] += g_ * a0.w; v[q][4] += g_ * a1.x; v[q][5] += g_ * a1.y; v[q][6] += g_ * a1.z; v[q][7] += g_ * a1.w; } } } }
            }
#pragma unroll
            for (int q = 0; q < 2; ++q)
#pragma unroll
                for (int k = 0; k < 8; ++k) s += v[q][k];
            const float mean = wave_sum(s) * (1.f / DMODEL); float s2 = 0.f;
#pragma unroll
            for (int q = 0; q < 2; ++q)
#pragma unroll
                for (int k = 0; k < 8; ++k) { v[q][k] -= mean; s2 += v[q][k] * v[q][k]; }
            const float rstd = 1.f / sqrtf(wave_sum(s2) * (1.f / DMODEL) + LN_EPS);
            GAS v4u* xw = (GAS v4u*)(XB + (size_t)m * DMODEL) + F.lane;
#pragma unroll
            for (int q = 0; q < 2; ++q) { float o[8];
#pragma unroll
                for (int k = 0; k < 8; ++k) o[k] = v[q][k] * rstd * gv[q][k] + bv[q][k];
                if (FINAL) { GAS f32x4* op = (GAS f32x4*)(ARGX(F) + (size_t)m * DMODEL + 512 * q + 8 * F.lane); op[0] = (f32x4){o[0], o[1], o[2], o[3]}; op[1] = (f32x4){o[4], o[5], o[6], o[7]}; }
                else { v4u w; w.x = pk2(o[0], o[1]); w.y = pk2(o[2], o[3]); w.z = pk2(o[4], o[5]); w.w = pk2(o[6], o[7]); xw[64 * q] = w; } }
        }
    }
}
__device__ __forceinline__ void ln_route_pass(Frame& F, int li, int j) {
    const float* gain = ARGI(F, 1) + (size_t)(li * 2) * DMODEL; const float* bias = ARGI(F, 2) + (size_t)(li * 2) * DMODEL;
    LAS float* WRT = (LAS float*)(F.lds + RING_OFF);
    LAS float* SELG = (LAS float*)(F.lds + RING_OFF + 32768);
    LAS int* SELE = (LAS int*)(F.lds + RING_OFF + 32768 + 1024);
    const float* wr = ARGI(F, 11) + (size_t)j * DMODEL * NEXP;
    for (int i = F.tid; i < DMODEL * NEXP; i += 512) { const int d = i >> 3, e = i & 7; WRT[e * DMODEL + d] = wr[i]; }
    float gv[2][8], bv[2][8];
#pragma unroll
    for (int q = 0; q < 2; ++q)
#pragma unroll
        for (int h2 = 0; h2 < 2; ++h2) { const f32x4 g4 = *(const GAS f32x4*)(gain + 512 * q + 8 * F.lane + 4 * h2), b4 = *(const GAS f32x4*)(bias + 512 * q + 8 * F.lane + 4 * h2);
#pragma unroll
            for (int k = 0; k < 4; ++k) { gv[q][4 * h2 + k] = g4[k]; bv[q][4 * h2 + k] = b4[k]; } }
    bf16* XB = (bf16*)(ARGWS(F) + WS_XB);
    __syncthreads();
    const int ntok = T_TOK / F.G, tok0 = F.c * ntok;
    v4u znx[2]; { const GAS v4u* x0 = (const GAS v4u*)(XB + (size_t)(tok0 + F.wave) * DMODEL) + F.lane; znx[0] = x0[0]; znx[1] = x0[64]; }
    for (int tl = F.wave; tl < ntok; tl += NWAVES) { const int m = tok0 + tl;
        GAS v4u* xr = (GAS v4u*)(XB + (size_t)m * DMODEL) + F.lane;
        float v[2][8]; float s = 0.f;
        const v4u zc0 = znx[0], zc1 = znx[1];
        if (tl + NWAVES < ntok) { const GAS v4u* xn_ = (const GAS v4u*)(XB + (size_t)(m + NWAVES) * DMODEL) + F.lane; znx[0] = xn_[0]; znx[1] = xn_[64]; }
        unpack8(zc0, v[0]); unpack8(zc1, v[1]);
#pragma unroll
        for (int q = 0; q < 2; ++q)
#pragma unroll
            for (int k = 0; k < 8; ++k) s += v[q][k];
        const float mean = wave_sum(s) * (1.f / DMODEL); float s2 = 0.f;
#pragma unroll
        for (int q = 0; q < 2; ++q)
#pragma unroll
            for (int k = 0; k < 8; ++k) { v[q][k] -= mean; s2 += v[q][k] * v[q][k]; }
        const float rstd = 1.f / sqrtf(wave_sum(s2) * (1.f / DMODEL) + LN_EPS);
        float lg[8];
#pragma unroll
        for (int e = 0; e < 8; ++e) lg[e] = 0.f;
#pragma unroll
        for (int q = 0; q < 2; ++q) { float o[8];
#pragma unroll
            for (int k = 0; k < 8; ++k) o[k] = v[q][k] * rstd * gv[q][k] + bv[q][k];
            v4u w; w.x = pk2(o[0], o[1]); w.y = pk2(o[2], o[3]); w.z = pk2(o[4], o[5]); w.w = pk2(o[6], o[7]); xr[64 * q] = w;
#pragma unroll
            for (int e = 0; e < 8; ++e) { const f32x4 w0 = *(const LAS f32x4*)(WRT + e * DMODEL + 512 * q + 8 * F.lane), w1 = *(const LAS f32x4*)(WRT + e * DMODEL + 512 * q + 8 * F.lane + 4);
                lg[e] += ((o[0] * w0.x + o[1] * w0.y) + (o[2] * w0.z + o[3] * w0.w)) + ((o[4] * w1.x + o[5] * w1.y) + (o[6] * w1.z + o[7] * w1.w)); } }
#pragma unroll
        for (int e = 0; e < 8; ++e) lg[e] = wave_sum(lg[e]);
        int e1 = 0; float v1 = lg[0];
#pragma unroll
        for (int e = 1; e < 8; ++e) if (lg[e] > v1) { v1 = lg[e]; e1 = e; }
        int e2 = -1; float v2 = -3.0e38f;
#pragma unroll
        for (int e = 0; e < 8; ++e) if (e != e1 && lg[e] > v2) { v2 = lg[e]; e2 = e; }
        const float g1 = 1.f / (1.f + __expf(v2 - v1)), g2 = 1.f - g1;
        if (F.lane == 0) { SELE[2 * tl] = e1; SELE[2 * tl + 1] = e2; SELG[2 * tl] = g1; SELG[2 * tl + 1] = g2; }
    }
    __syncthreads();
    int myrank = 0, mye = 0;
    if (F.tid < 2 * ntok) { mye = SELE[F.tid];
        for (int i2 = 0; i2 < F.tid; ++i2) myrank += (SELE[i2] == mye) ? 1 : 0; }
    if (F.tid < 8) { int cnt = 0; for (int i2 = 0; i2 < 2 * ntok; ++i2) cnt += (SELE[i2] == F.tid) ? 1 : 0; ((int*)(ARGWS(F) + WS_LC))[F.c * 8 + F.tid] = cnt; }
    if (F.tid < 2 * ntok) { const int tok = tok0 + (F.tid >> 1);
        ((int*)(ARGWS(F) + WS_LIST))[(F.c * 8 + mye) * 256 + myrank] = tok;
        ((unsigned*)(ARGWS(F) + WS_TSLOT))[2 * tok + (F.tid & 1)] = ((unsigned)mye << 20) | (unsigned)myrank;
        ((float*)(ARGWS(F) + WS_GATE))[2 * tok + (F.tid & 1)] = SELG[F.tid]; }
    __syncthreads();
}
#define LDS_BAR() do { asm volatile("s_waitcnt lgkmcnt(0)" ::: "memory"); __builtin_amdgcn_s_barrier(); asm volatile("" ::: "memory"); } while (0)
__device__ __forceinline__ int off64(int row, int colbyte) { return row * 128 + (colbyte ^ ((((row >> 1) & 1) << 6) | (((row >> 3) & 1) << 5))); }
__device__ __forceinline__ float log2_gamma(int h) { return __builtin_amdgcn_logf(1.0f - __builtin_amdgcn_exp2f((float)(-5 - h))); }

__device__ __forceinline__ void ret_state_phase(Frame& F) {
    const int c = F.c; if (c >= 256) return;
    const int dt = c & 3, et = (c >> 2) & 7, h = (c >> 5) & 3, b = c >> 7;
    const int w = F.wave, lane = F.lane, dq = w & 3, eh = w >> 2, g = lane >> 4, l15 = lane & 15, q = l15 >> 2, p = l15 & 3;
    const bf16* KH = (const bf16*)(ARGWS(F) + WS_BIG + BIG_KH) + (size_t)b * SEQ * 1024 + h * 256 + dt * 64;
    const bf16* VT = (const bf16*)(ARGWS(F) + WS_BIG + BIG_VT) + ((size_t)((b * 4 + h) * 128) << 16);
    bf16* RT = (bf16*)(ARGWS(F) + WS_BIG + BIG_RT) + ((size_t)((b * 4 + h) * 128) << 17);
    const float dec = __builtin_amdgcn_exp2f(128.f * log2_gamma(h));
    const int r0 = F.tid >> 3, ch = F.tid & 7;
    const bf16* kp0 = KH + (size_t)r0 * 1024 + ch * 8; const bf16* kp1 = kp0 + (size_t)64 * 1024;
    const int lo0 = off64(r0, ch * 16), lo1 = off64(r0 + 64, ch * 16);
    int vsrc[2];
#pragma unroll
    for (int k = 0; k < 2; ++k) { const int pp = F.tid + 512 * k, oct = pp >> 6, e = 64 * et + (pp & 63); vsrc[k] = ((((e >> 5) * 8 + (oct >> 1)) * 2 + (oct & 1)) * 32 + (e & 31)) * 8; }
    const int vrd = (g * 64 + 32 * eh + l15) * 16;
    int roff[2];
#pragma unroll
    for (int x = 0; x < 2; ++x) { const int e = 64 * et + 16 * (2 * eh + x) + l15, d = 64 * dt + 16 * dq + 4 * g; roff[x] = ((((e >> 5) * 16 + (d >> 4)) * 2 + ((d >> 3) & 1)) * 32 + (e & 31)) * 8 + (d & 7); }
    float z0 = 0.f; asm volatile("" : "+v"(z0));
    f32x4 acc[2] = {(f32x4){z0, z0, z0, z0}, (f32x4){z0, z0, z0, z0}};
    v4u kq[4][2], vs[4][2];
#define R2A_LOAD(st, nn) do { const int n_ = (nn) < 128 ? (nn) : 127; kq[st][0] = *(const GAS v4u*)(kp0 + (size_t)n_ * 128 * 1024); kq[st][1] = *(const GAS v4u*)(kp1 + (size_t)n_ * 128 * 1024); \
        vs[st][0] = *(const GAS v4u*)(VT + ((size_t)n_ << 16) + vsrc[0]); vs[st][1] = *(const GAS v4u*)(VT + ((size_t)n_ << 16) + vsrc[1]); } while (0)
    R2A_LOAD(0, 0); R2A_LOAD(1, 1); R2A_LOAD(2, 2);
    for (int n4 = 0; n4 < 128; n4 += 4) {
#pragma unroll
        for (int u4 = 0; u4 < 4; ++u4) { const int n = n4 + u4;
            LAS unsigned char* buf = F.lds + RING_OFF + (u4 & 1) * 32768; LAS unsigned char* vbuf = buf + 16384;
            *(LAS v4u*)(buf + lo0) = kq[u4][0]; *(LAS v4u*)(buf + lo1) = kq[u4][1];
            *(LAS v4u*)(vbuf + 16 * F.tid) = vs[u4][0]; *(LAS v4u*)(vbuf + 16 * F.tid + 8192) = vs[u4][1];
            R2A_LOAD((u4 + 3) & 3, n + 3);
            LDS_BAR();
            if (n > 0) {
#pragma unroll
                for (int x = 0; x < 2; ++x) { v2u o; o.x = pk2(acc[x][0], acc[x][1]); o.y = pk2(acc[x][2], acc[x][3]); *(GAS v2u*)(RT + ((size_t)n << 17) + roff[x]) = o;
#ifdef R2A_DUMMY_STORE
                    *(GAS v2u*)((bf16*)(ARGWS(F) + WS_BIG + 640 * MiB) + ((((size_t)((b * 4 + h) * 128 + n) << 17) + roff[x]) & ((size_t)(32 * MiB) - 1))) = o;
#endif
                } }
#pragma unroll
            for (int ks = 0; ks < 4; ++ks) {
                const s16x4 t0 = vtr(buf + off64(32 * ks + 8 * g + q, 32 * dq + 8 * p)), t1 = vtr(buf + off64(32 * ks + 8 * g + 4 + q, 32 * dq + 8 * p));
                const bf16x8 a = (bf16x8){t0[0], t0[1], t0[2], t0[3], t1[0], t1[1], t1[2], t1[3]};
#pragma unroll
                for (int x = 0; x < 2; ++x) { const bf16x8 bfr = *(const LAS bf16x8*)(vbuf + vrd + ks * 4096 + x * 256); acc[x] = __builtin_amdgcn_mfma_f32_16x16x32_bf16(a, bfr, acc[x], 0, 0, 0); }
            }
#pragma unroll
            for (int x = 0; x < 2; ++x) acc[x] = acc[x] * dec;
        }
    }
#undef R2A_LOAD
    __syncthreads();
}

__device__ __forceinline__ int off128(int row, int colbyte) { return row * 256 + (colbyte ^ ((((row & 3) | (((row >> 3) & 1) << 2))) << 5)); }
__device__ __forceinline__ void ret_state_phase_big(Frame& F, int s) {
    const int dt = s & 1, et = (s >> 1) & 3, h = (s >> 3) & 3, b = s >> 5;
    const int w = F.wave, lane = F.lane, g = lane >> 4, l15 = lane & 15, q = l15 >> 2, p = l15 & 3;
    const bf16* KH = (const bf16*)(ARGWS(F) + WS_BIG + BIG_KH) + (size_t)b * SEQ * 1024 + h * 256 + dt * 128;
    const bf16* VT = (const bf16*)(ARGWS(F) + WS_BIG + BIG_VT) + ((size_t)((b * 4 + h) * 128) << 16);
    bf16* RT = (bf16*)(ARGWS(F) + WS_BIG + BIG_RT) + ((size_t)((b * 4 + h) * 128) << 17);
    const float dec = __builtin_amdgcn_exp2f(128.f * log2_gamma(h));
    int ksrc[4], klds[4], vsrc[4];
#pragma unroll
    for (int k = 0; k < 4; ++k) { const int pp = F.tid + 512 * k; { const int row = pp >> 4, ch = pp & 15; ksrc[k] = row * 1024 + ch * 8; klds[k] = off128(row, ch * 16); }
        { const int oct = pp >> 7, e = 128 * et + (pp & 127); vsrc[k] = ((((e >> 5) * 8 + (oct >> 1)) * 2 + (oct & 1)) * 32 + (e & 31)) * 8; } }
    const int vrd = g * 2048 + l15 * 16;
    int roff[8];
#pragma unroll
    for (int x = 0; x < 8; ++x) { const int e = 128 * et + 16 * x + l15, d = 128 * dt + 16 * w + 4 * g; roff[x] = ((((e >> 5) * 16 + (d >> 4)) * 2 + ((d >> 3) & 1)) * 32 + (e & 31)) * 8 + (d & 7); }
    float z0 = 0.f; asm volatile("" : "+v"(z0));
    f32x4 acc[8];
#pragma unroll
    for (int x = 0; x < 8; ++x) acc[x] = (f32x4){z0, z0, z0, z0};
    v4u kq[4][4], vs[4][4];
#define R2A_LOAD(st, nn) do { const int n_ = (nn) < 128 ? (nn) : 127; _Pragma("unroll") for (int k = 0; k < 4; ++k) { kq[st][k] = *(const GAS v4u*)(KH + (size_t)n_ * 128 * 1024 + ksrc[k]); vs[st][k] = *(const GAS v4u*)(VT + ((size_t)n_ << 16) + vsrc[k]); } } while (0)
    R2A_LOAD(0, 0); R2A_LOAD(1, 1); R2A_LOAD(2, 2);
    for (int n4 = 0; n4 < 128; n4 += 4) {
#pragma unroll
        for (int u4 = 0; u4 < 4; ++u4) { const int n = n4 + u4;
            LAS unsigned char* buf = F.lds + RING_OFF + (u4 & 1) * 65536; LAS unsigned char* vbuf = buf + 32768;
#pragma unroll
            for (int k = 0; k < 4; ++k) { *(LAS v4u*)(buf + klds[k]) = kq[u4][k]; *(LAS v4u*)(vbuf + 16 * F.tid + 8192 * k) = vs[u4][k]; }
            R2A_LOAD((u4 + 3) & 3, n + 3);
            LDS_BAR();
            if (n > 0) {
#pragma unroll
                for (int x = 0; x < 8; ++x) { v2u o; o.x = pk2(acc[x][0], acc[x][1]); o.y = pk2(acc[x][2], acc[x][3]); *(GAS v2u*)(RT + ((size_t)n << 17) + roff[x]) = o; } }
#pragma unroll
            for (int ks = 0; ks < 4; ++ks) {
                const s16x4 t0 = vtr(buf + off128(32 * ks + 8 * g + q, 32 * w + 8 * p)), t1 = vtr(buf + off128(32 * ks + 8 * g + 4 + q, 32 * w + 8 * p));
                const bf16x8 a = (bf16x8){t0[0], t0[1], t0[2], t0[3], t1[0], t1[1], t1[2], t1[3]};
#pragma unroll
                for (int x = 0; x < 8; ++x) { const bf16x8 bfr = *(const LAS bf16x8*)(vbuf + vrd + ks * 8192 + x * 256); acc[x] = __builtin_amdgcn_mfma_f32_16x16x32_bf16(a, bfr, acc[x], 0, 0, 0); }
            }
#pragma unroll
            for (int x = 0; x < 8; ++x) acc[x] = acc[x] * dec;
        }
    }
#undef R2A_LOAD
    __syncthreads();
}

__device__ __forceinline__ void ret_out_phase(Frame& F, int j, bf16* YOUT) {
    const int w = F.wave, lane = F.lane, r32 = lane & 31, hi = lane >> 5, tid = F.tid;
    LAS unsigned char* QDI = F.lds + RING_OFF;
    LAS unsigned char* KHI = F.lds + RING_OFF + 65536;
    LAS unsigned char* PI = KHI;
    LAS float* STAT = (LAS float*)(F.lds + AUX_OFF);
    LAS unsigned char* YST = F.lds + RING_OFF;
    const bf16* QD = (const bf16*)(ARGWS(F) + WS_BIG + BIG_QD); const bf16* KH = (const bf16*)(ARGWS(F) + WS_BIG + BIG_KH);
    const bf16* VT = (const bf16*)(ARGWS(F) + WS_BIG + BIG_VT); const bf16* RT = (const bf16*)(ARGWS(F) + WS_BIG + BIG_RT);
    const bf16* GIN = (const bf16*)(ARGWS(F) + WS_BIG + BIG_G);
    const float* gn = ARGI(F, 4) + (size_t)j * 2048;
    const int ib = w & 3, jb0 = 2 * (w >> 2), jb1 = jb0 + 1;
    v4u qv[8], kv[8];
#define R2B_STAGE_LOAD(UU) do { const int n_ = (UU) & 127, h_ = ((UU) >> 7) & 3, b_ = (UU) >> 9; const size_t t0_ = (size_t)b_ * SEQ + (size_t)n_ * 128; int tq_ = tid; asm volatile("" : "+v"(tq_)); \
        _Pragma("unroll") for (int k = 0; k < 8; ++k) { const int x = tq_ + 512 * k, row = x >> 5, chk = x & 31; const size_t go = (t0_ + row) * 1024 + h_ * 256 + chk * 8; \
            qv[k] = *(const GAS v4u*)(QD + go); kv[k] = *(const GAS v4u*)(KH + go); } } while (0)
    if (F.c < 1024) R2B_STAGE_LOAD(F.c);
    for (int U = F.c; U < 1024; U += F.G) {
        const int n = U & 127, h = (U >> 7) & 3, b = U >> 9;
        const size_t tok0 = (size_t)b * SEQ + (size_t)n * 128;
        { int tid1 = tid; asm volatile("" : "+v"(tid1));
#pragma unroll
          for (int k = 0; k < 8; ++k) { const int x = tid1 + 512 * k, row = x >> 5, chk = x & 31; const int lo = row * 512 + ((chk * 16) ^ ((row & 7) << 4));
              *(LAS v4u*)(QDI + lo) = qv[k]; *(LAS v4u*)(KHI + lo) = kv[k]; } }
        LDS_BAR();
        f32x16 s0 = {}, s1 = {};
        { const int qrow = 32 * ib + r32, k0row = 32 * jb0 + r32, k1row = 32 * jb1 + r32;
          if (jb0 <= ib) {
#pragma unroll
            for (int ks = 0; ks < 16; ++ks) { const int cb = (16 * ks + 8 * hi) * 2;
                const bf16x8 qf = *(const LAS bf16x8*)(QDI + qrow * 512 + (cb ^ ((qrow & 7) << 4)));
                const bf16x8 kf0 = *(const LAS bf16x8*)(KHI + k0row * 512 + (cb ^ ((k0row & 7) << 4)));
                s0 = __builtin_amdgcn_mfma_f32_32x32x16_bf16(kf0, qf, s0, 0, 0, 0);
                if (jb1 <= ib) { const bf16x8 kf1 = *(const LAS bf16x8*)(KHI + k1row * 512 + (cb ^ ((k1row & 7) << 4))); s1 = __builtin_amdgcn_mfma_f32_32x32x16_bf16(kf1, qf, s1, 0, 0, 0); } } } }
        LDS_BAR();
        { int r32p = r32, hip = hi; asm volatile("" : "+v"(r32p), "+v"(hip)); const int i = 32 * ib + r32p;
#pragma unroll
          for (int qq = 0; qq < 4; ++qq) {
              const int j0 = 32 * jb0 + 8 * qq + 4 * hip, j1 = j0 + 32;
              float a0 = s0[4 * qq], a1 = s0[4 * qq + 1], a2 = s0[4 * qq + 2], a3 = s0[4 * qq + 3];
              float c0 = s1[4 * qq], c1 = s1[4 * qq + 1], c2 = s1[4 * qq + 2], c3 = s1[4 * qq + 3];
              if (j0 + 0 > i) a0 = 0.f; if (j0 + 1 > i) a1 = 0.f; if (j0 + 2 > i) a2 = 0.f; if (j0 + 3 > i) a3 = 0.f;
              if (j1 + 0 > i) c0 = 0.f; if (j1 + 1 > i) c1 = 0.f; if (j1 + 2 > i) c2 = 0.f; if (j1 + 3 > i) c3 = 0.f;
              v2u o; o.x = pk2(a0, a1); o.y = pk2(a2, a3); *(LAS v2u*)(PI + i * 256 + ((j0 * 2) ^ ((i & 7) << 4))) = o;
              v2u o2; o2.x = pk2(c0, c1); o2.y = pk2(c2, c3); *(LAS v2u*)(PI + i * 256 + ((j1 * 2) ^ ((i & 7) << 4))) = o2; } }
        LDS_BAR();
        f32x16 acc[4][2];
#pragma unroll
        for (int rb = 0; rb < 4; ++rb) { acc[rb][0] = (f32x16){}; acc[rb][1] = (f32x16){}; }
        { const int nsteps = n > 0 ? 24 : 8;
          const bf16* vt = VT + ((size_t)((b * 4 + h) * 128 + n) << 16) + (size_t)(((2 * w) * 8 * 2 + hi) * 32 + r32) * 8;
          const bf16* rt = RT + ((size_t)((b * 4 + h) * 128 + n) << 17) + (size_t)(((2 * w) * 16 * 2 + hi) * 32 + r32) * 8;
          const int xr = (r32 & 7) << 4, rowp = r32 * 256;
#define R2B_LOAD(dst, sidx) do { int sp_ = (sidx); sp_ = sp_ < nsteps ? sp_ : nsteps - 1; const bf16* p_ = sp_ < 8 ? vt + sp_ * 512 : rt + (sp_ - 8) * 512; const int o1_ = sp_ < 8 ? 4096 : 8192; \
              dst[0] = *(const GAS bf16x8*)p_; dst[1] = *(const GAS bf16x8*)(p_ + o1_); } while (0)
          bf16x8 Bq[6][2];
          R2B_LOAD(Bq[0], 0); R2B_LOAD(Bq[1], 1); R2B_LOAD(Bq[2], 2); R2B_LOAD(Bq[3], 3); R2B_LOAD(Bq[4], 4);
          for (int s3 = 0; s3 < nsteps; s3 += 6) {
#pragma unroll
              for (int uu = 0; uu < 6; ++uu) { const int st = s3 + uu;
                  R2B_LOAD(Bq[(uu + 5) % 6], st + 5);
                  if (st < nsteps) { const bool pv = st < 8; const int ks = pv ? st : st - 8, cb = ((32 * ks + 16 * hi) ^ xr) + (pv ? 65536 : 0), sh = pv ? 0 : 1;
#pragma unroll
                      for (int rb = 0; rb < 4; ++rb) if (!pv || st <= 2 * rb + 1) {
                          const bf16x8 af = *(const LAS bf16x8*)(QDI + (((32 * 256) * rb + rowp) << sh) + cb);
                          acc[rb][0] = __builtin_amdgcn_mfma_f32_32x32x16_bf16(Bq[uu][0], af, acc[rb][0], 0, 0, 0);
                          acc[rb][1] = __builtin_amdgcn_mfma_f32_32x32x16_bf16(Bq[uu][1], af, acc[rb][1], 0, 0, 0); } } } }
#undef R2B_LOAD
        }
#pragma unroll
        for (int rb = 0; rb < 4; ++rb) { float s = 0.f, qs = 0.f;
#pragma unroll
            for (int et = 0; et < 2; ++et)
#pragma unroll
                for (int r = 0; r < 16; ++r) { const float v = acc[rb][et][r]; s += v; qs += v * v; }
            s += __shfl_xor(s, 32); qs += __shfl_xor(qs, 32);
            if (hi == 0) { STAT[((32 * rb + r32) * 8 + w) * 2] = s; STAT[((32 * rb + r32) * 8 + w) * 2 + 1] = qs; } }
        LDS_BAR();
        int r32b = r32, hib = hi; asm volatile("" : "+v"(r32b), "+v"(hib));
#pragma unroll
        for (int rb = 0; rb < 4; ++rb) { const int i = 32 * rb + r32b; float s = 0.f, qs = 0.f;
#pragma unroll
            for (int ww = 0; ww < 8; ++ww) { s += STAT[(i * 8 + ww) * 2]; qs += STAT[(i * 8 + ww) * 2 + 1]; }
            const float mean = s * (1.f / 512.f), var = qs * (1.f / 512.f) - mean * mean, rstd = 1.f / sqrtf(fmaxf(var, 0.f) + LN_EPS);
#pragma unroll
            for (int et = 0; et < 2; ++et)
#pragma unroll
                for (int qq = 0; qq < 4; ++qq) { const int e = 64 * w + 32 * et + 8 * qq + 4 * hib;
                    v2u o; o.x = pk2((acc[rb][et][4 * qq] - mean) * rstd, (acc[rb][et][4 * qq + 1] - mean) * rstd); o.y = pk2((acc[rb][et][4 * qq + 2] - mean) * rstd, (acc[rb][et][4 * qq + 3] - mean) * rstd);
                    *(LAS v2u*)(YST + i * 1024 + ((e * 2) ^ ((i & 63) << 4))) = o; } }
        LDS_BAR();
        { const int Un = U + F.G < 1024 ? U + F.G : U; R2B_STAGE_LOAD(Un); }
        { int tid6 = tid; asm volatile("" : "+v"(tid6)); const int chk = tid6 & 63; const f32x4 g0 = *(const GAS f32x4*)(gn + h * 512 + chk * 8), g1 = *(const GAS f32x4*)(gn + h * 512 + chk * 8 + 4);
#pragma unroll 8
          for (int k = 0; k < 16; ++k) { const int row = (tid6 >> 6) + 8 * k;
              const v4u y = *(const LAS v4u*)(YST + row * 1024 + ((chk * 16) ^ ((row & 63) << 4)));
              const size_t go6 = (tok0 + row) * 2048 + h * 512 + chk * 8; const v4u gg = *(const GAS v4u*)(GIN + go6);
              v4u o; o.x = pk2(bflo(y.x) * g0.x * bflo(gg.x), bfhi(y.x) * g0.y * bfhi(gg.x)); o.y = pk2(bflo(y.y) * g0.z * bflo(gg.y), bfhi(y.y) * g0.w * bfhi(gg.y));
              o.z = pk2(bflo(y.z) * g1.x * bflo(gg.z), bfhi(y.z) * g1.y * bfhi(gg.z)); o.w = pk2(bflo(y.w) * g1.z * bflo(gg.w), bfhi(y.w) * g1.w * bfhi(gg.w));
              *(GAS v4u*)(YOUT + go6) = o; } }
        __syncthreads();
    }
}
typedef swa::BlockRef<swa::bf16, swa::bf16> ABlk;
__device__ __forceinline__ float* att_lse(Frame& F, int L) {
    const int g = L >> 9, rem = L & 511, sh = 2 * g, seq = rem >> (6 - sh), qb = rem & ((64 >> sh) - 1);
    return (float*)(ARGWS(F) + WS_BIG + BIG_LSE) + (size_t)g * 131072 + (size_t)seq * (size_t)(SEQ >> sh) + (size_t)qb * 256;
}
__device__ __forceinline__ ABlk att_ref(Frame& F, int L) {
    const int g = L >> 9, rem = L & 511, sh = 2 * g, seq = rem >> (6 - sh), qb = rem & ((64 >> sh) - 1);
    const size_t base = (size_t)g * 131072 + (size_t)seq * (size_t)(SEQ >> sh);
    const swa::bf16* P = (const swa::bf16*)(ARGWS(F) + WS_BIG + BIG_QKV); constexpr size_t WH = (size_t)3 * 131072 * 128;
    ABlk r; r.Q = P + (base + (size_t)qb * 256) * 128; r.K = P + WH + base * 128; r.V = P + 2 * WH + base * 128;
    r.O = (swa::bf16*)(ARGWS(F) + WS_BIG + BIG_OP) + (base + (size_t)qb * 256) * 128; r.P0 = qb * 256;
    return r;
}
__device__ __forceinline__ void attn_phase(Frame& F) {
    extern __shared__ __attribute__((aligned(16))) unsigned char lds_dyn[];
    char* const ldsg = (char*)lds_dyn;
    int L = F.c; const int total = 1536, stride = F.G;
    if (L >= total) return;
    ABlk cur = att_ref(F, L);
    const int W = 129 + (F.G >> 20);
    swa::Seam<swa::bf16> S; S.tid = F.tid;
    swa::causal_swa_prime<swa::bf16, swa::bf16>(cur, W, ldsg, S);
    for (;;) {
        const bool last = L + stride >= total;
        const int Ln = last ? L : L + stride;
        const ABlk nxt = last ? cur : att_ref(F, Ln);
        const int skv = SEQ >> (2 * (L >> 9));
        swa::causal_swa_block<swa::bf16, swa::bf16>(cur, nxt, skv, W, ldsg, S);
        if (F.tid < 256) att_lse(F, L)[F.tid] = ((const LAS float*)(F.lds + swa::LSE_LDS_OFF))[F.tid];
        if (last) break;
        cur = nxt; L = Ln;
    }
}
__device__ __forceinline__ void attn_merge_phase(Frame& F) {
    const int gw = F.c * NWAVES + F.wave, NGW = F.G * NWAVES, hd = F.lane >> 4, chk = F.lane & 15;
    const bf16* OP = (const bf16*)(ARGWS(F) + WS_BIG + BIG_OP); const float* LSE = (const float*)(ARGWS(F) + WS_BIG + BIG_LSE); bf16* O = (bf16*)(ARGWS(F) + WS_BIG + BIG_O);
    for (int m0 = gw; m0 < T_TOK; m0 += 4 * NGW) {
        size_t row[4][3]; float ls[4][3]; v4u ov[4][3];
#pragma unroll
        for (int r = 0; r < 4; ++r) { const int m = m0 + r * NGW < T_TOK ? m0 + r * NGW : gw; const int b = m >> 14, t = m & 16383;
#pragma unroll
            for (int g = 0; g < 3; ++g) { const int sh = 2 * g; row[r][g] = (size_t)g * 131072 + (size_t)(b * 4 + hd) * SEQ + (size_t)((t & ((1 << sh) - 1)) * (SEQ >> sh) + (t >> sh));
                ls[r][g] = LSE[row[r][g]]; ov[r][g] = *(const GAS v4u*)(OP + row[r][g] * 128 + chk * 8); } }
#pragma unroll
        for (int r = 0; r < 4; ++r) { const int m = m0 + r * NGW; if (m >= T_TOK) break;
            const float mx = fmaxf(ls[r][0], fmaxf(ls[r][1], ls[r][2])); float wg[3]; float ws = 0.f;
#pragma unroll
            for (int g = 0; g < 3; ++g) { wg[g] = __expf(ls[r][g] - mx); ws += wg[g]; }
            const float inv = 1.f / ws; float o[8] = {0.f, 0.f, 0.f, 0.f, 0.f, 0.f, 0.f, 0.f};
#pragma unroll
            for (int g = 0; g < 3; ++g) { const v4u v = ov[r][g]; const float wt = wg[g] * inv;
                o[0] += wt * bflo(v.x); o[1] += wt * bfhi(v.x); o[2] += wt * bflo(v.y); o[3] += wt * bfhi(v.y); o[4] += wt * bflo(v.z); o[5] += wt * bfhi(v.z); o[6] += wt * bflo(v.w); o[7] += wt * bfhi(v.w); }
            v4u w; w.x = pk2(o[0], o[1]); w.y = pk2(o[2], o[3]); w.z = pk2(o[4], o[5]); w.w = pk2(o[6], o[7]);
            *(GAS v4u*)(O + (size_t)m * 512 + hd * 128 + chk * 8) = w; } }
}
template <bool GATHER_, int NCT> struct MoeOrder {
    static constexpr bool GATHER = GATHER_;
    const char* A; const char* Bt; int K; size_t bstride; int G, c; int rtb[9]; const LAS int* idx;
    __device__ __forceinline__ bool next(int i, pg8::Unit& u) const {
        const int L = i * G + c; if (L >= rtb[8] * NCT) return false;
        const int rt = L / NCT; int e = 0;
#pragma unroll
        for (int k = 1; k < 8; ++k) e += (rtb[k] <= rt) ? 1 : 0;
        u.pm = rt; u.pn = L - rt * NCT; u.ex = e; return true;
    }
    __device__ __forceinline__ const char* a_ptr(const pg8::Unit& u) const { return GATHER ? A : A + (size_t)u.pm * ((size_t)256 * K * 2); }
    __device__ __forceinline__ const char* b_ptr(const pg8::Unit& u) const { return Bt + (size_t)u.ex * bstride + (size_t)u.pn * ((size_t)256 * K * 2); }
    __device__ __forceinline__ unsigned a_off(int ui, int row, int C, int) const { return (unsigned)idx[ui * 256 + row] * (unsigned)(K * 2) + (unsigned)(C * 2); }
    __device__ __forceinline__ int kt() const { return K / 64; }
};
struct MoeDownMain {
    static constexpr bool GATHER = false;
    const char* A; const char* Bt; int K; size_t bstride; int G, c; int rtb[9];
    __device__ __forceinline__ bool next(int i, pg8::Unit& u) const {
        if (G != 256) { const int L = i * G + c; if (L >= 1024) return false; u.pm = L >> 2; u.pn = L & 3; }
        else { if (i >= 4) return false; const int xcd = c & 7, k = c >> 3; u.pm = i * 64 + (xcd << 3) + (k >> 2); u.pn = k & 3; }
        int e = 0;
#pragma unroll
        for (int k2 = 1; k2 < 8; ++k2) e += (rtb[k2] <= u.pm) ? 1 : 0;
        u.ex = e; return true;
    }
    __device__ __forceinline__ const char* a_ptr(const pg8::Unit& u) const { return A + (size_t)u.pm * ((size_t)256 * K * 2); }
    __device__ __forceinline__ const char* b_ptr(const pg8::Unit& u) const { return Bt + (size_t)u.ex * bstride + (size_t)u.pn * ((size_t)256 * K * 2); }
    __device__ __forceinline__ unsigned a_off(int, int, int, int) const { return 0u; }
    __device__ __forceinline__ int kt() const { return K / 64; }
};
struct MoeDownTail {
    static constexpr bool GATHER = false;
    const char* A; const char* Bt; int K; size_t bstride; int G, c; int rtb[9];
    __device__ __forceinline__ bool next(int i, pg8::Unit& u) const {
        const int nl = rtb[8] - 256; if (i > 0 || c >= nl * 16) return false;
        const int t = c >> 2; u.pm = 256 + (t >> 2); u.pn = t & 3; u.ex = (c & 3) * 32 + t; return true;
    }
    __device__ __forceinline__ int expert(const pg8::Unit& u) const { int e = 0;
#pragma unroll
        for (int k2 = 1; k2 < 8; ++k2) e += (rtb[k2] <= u.pm) ? 1 : 0;
        return e; }
    __device__ __forceinline__ const char* a_ptr(const pg8::Unit& u) const { return A + (size_t)u.pm * ((size_t)256 * K * 2) + (size_t)(c & 3) * (896 * 2); }
    __device__ __forceinline__ const char* b_ptr(const pg8::Unit& u) const { return Bt + (size_t)expert(u) * bstride + (size_t)u.pn * ((size_t)256 * K * 2) + (size_t)(c & 3) * (896 * 2); }
    __device__ __forceinline__ unsigned a_off(int, int, int, int) const { return 0u; }
    __device__ __forceinline__ int kt() const { return 14; }
};
__device__ __forceinline__ void moe_rtb(const LAS int* PB, int (&rtb)[9], int (&cnt)[8]) {
    int acc = 0;
#pragma unroll
    for (int e = 0; e < 8; ++e) { rtb[e] = acc; cnt[e] = __builtin_amdgcn_readfirstlane(PB[2048 + e]); acc += (cnt[e] + 255) >> 8; }
    rtb[8] = acc;
}
__global__ void __launch_bounds__(NWAVES * 64, 2) fwd_kernel(Args args) {
    extern __shared__ __attribute__((aligned(16))) unsigned char lds[];
    Frame F;
    F.lds = (LAS unsigned char*)lds;
    F.MISC = (volatile LAS unsigned*)(F.lds + MISC_OFF);
    F.tid = threadIdx.x; F.lane = F.tid & 63; F.wave = __builtin_amdgcn_readfirstlane(F.tid >> 6);
    F.G = gridDim.x; F.c = blockIdx.x;
    for (int u = F.tid; u < 32; u += NWAVES * 64) ((LAS unsigned*)(F.lds + MISC_OFF))[u] = 0u;
    if (F.tid == 0) { LAS unsigned long long* tb = (LAS unsigned long long*)(F.lds + MISC_OFF + 128);
#pragma unroll
        for (int i = 0; i < 15; ++i) tb[i] = (unsigned long long)args.in[i];
        tb[15] = (unsigned long long)args.out; tb[16] = (unsigned long long)args.ws; }
    __syncthreads();
    XcdBarrier bar = xcd_barrier_post((unsigned*)(F_CTL(F) + CW_BAR), F.MISC + 8);
#ifdef STAMP_A
#define STAMP_HERE(idx) do { if (threadIdx.x == 0) ((volatile LAS unsigned long long*)(F.lds + AUX_OFF + 16384))[(idx)] = wall_clock64(); } while (0)
#else
#define STAMP_HERE(idx) do { } while (0)
#endif
#define GRID_BAR(idx) do { XcdBarrier bb_ = bar; asm volatile("" : "+s"(bb_.bar), "+s"(bb_.x)); xcd_barrier(bb_); STAMP_HERE(idx); } while (0)
#define WSP ARGWS(F)
#define BIGP (ARGWS(F) + WS_BIG)
#define XBP ((bf16*)(ARGWS(F) + WS_XB))

#ifndef ONLY
#define ONLY -1
#endif
#define RUN(n) (ONLY < 0 || ONLY == (n))
    STAMP_HERE(0);
#ifndef DBL
#define DBL 0
#endif
    if (DBL & 1) { frame_refresh(F); p0_prologue(F); }
    if (RUN(0)) { frame_refresh(F); p0_prologue(F); }
    GRID_BAR(1);

#pragma unroll
    for (int j = 0; j < 2; ++j) {
        for (int rep_ = 0; rep_ < ((DBL & 256) ? 2 : 1); ++rep_) if (RUN(1)) { frame_refresh(F);
            const bf16* Win = (const bf16*)(WSP + WS_WIN) + (size_t)j * 6144 * 1024;
#ifndef SKIP_RP
            if (j == 0) { p0_late(F); __syncthreads(); frame_refresh(F); }
            { pg8::SplitOrder S; S.init(XBP, Win, T_TOK, 4096, 1024, F.G, F.c); S.ug = j == 0 ? 9 : 8; S.uc = j == 0 ? 5 : 8;
              pg8::EpiRetProj E{(bf16*)(BIGP + BIG_QD), (bf16*)(BIGP + BIG_KH), (bf16*)(BIGP + BIG_G), (const float*)(WSP + WS_TAB)};
              pg8::gemm_phase<pg8::EpiRetProj, pg8::SplitOrder, true>(F.lds + RING_OFF, S, E, F.tid); }
#endif
#ifndef SKIP_VT
            { pg8::StaticOrder S; S.init(Win + (size_t)4096 * 1024, XBP, 2048, T_TOK, 1024, F.G, F.c);
              pg8::EpiVT E{(bf16*)(BIGP + BIG_VT)};
              pg8::gemm_phase<pg8::EpiVT, pg8::StaticOrder, true>(F.lds + RING_OFF, S, E, F.tid); }
#endif
        }
        GRID_BAR(1 + 16 * j + 1);
        if (DBL & 4) { frame_refresh(F); ret_state_phase(F); }
        if (RUN(2)) { frame_refresh(F); if (DBL & 2048) { if (((F.c >> 3) & 3) == 0) ret_state_phase_big(F, (F.c >> 5) * 8 + (F.c & 7)); } else ret_state_phase(F); }
        GRID_BAR(1 + 16 * j + 2);
        if (DBL & 8) { frame_refresh(F); ret_out_phase(F, j, (bf16*)(BIGP + 640 * MiB)); }
        if (RUN(3)) { frame_refresh(F); ret_out_phase(F, j, (bf16*)(BIGP + BIG_G)); }
        GRID_BAR(1 + 16 * j + 3);
        if (RUN(4)) { frame_refresh(F);
            pg8::StaticOrder S; S.init(BIGP + BIG_G, (const bf16*)(WSP + WS_WRO) + (size_t)j * 1024 * 2048, T_TOK, 1024, 2048, F.G, F.c);
            pg8::EpiAddBf16 E{XBP, ALPHA};
            pg8::gemm_phase<pg8::EpiAddBf16, pg8::StaticOrder, true>(F.lds + RING_OFF, S, E, F.tid);
        }
        GRID_BAR(1 + 16 * j + 4);
        if (RUN(5)) { frame_refresh(F); ln_pass<0, false>(F, 2 * j, 0, j); }
        GRID_BAR(1 + 16 * j + 5);
        for (int rep_ = 0; rep_ < ((DBL & 64) ? 2 : 1); ++rep_) if (RUN(7)) { frame_refresh(F);
            if (rep_ == 0) { moe_convert<true>(F, j); __syncthreads(); frame_refresh(F); }
            pg8::SplitOrder S; S.init(XBP, (const bf16*)(WSP + WS_WGU) + (size_t)j * 7168 * 1024, T_TOK, 7168, 1024, F.G, F.c); S.ug = 16; S.uc = 8;
            pg8::EpiSwiGLU E{(bf16*)(BIGP + BIG_HID)};
            pg8::gemm_phase<pg8::EpiSwiGLU, pg8::SplitOrder, true>(F.lds + RING_OFF, S, E, F.tid);
        }
        GRID_BAR(1 + 16 * j + 6);
        if (RUN(8)) { frame_refresh(F);
            pg8::StaticOrder S; S.init(BIGP + BIG_HID, (const bf16*)(WSP + WS_WDN) + (size_t)j * 1024 * 3584, T_TOK, 1024, 3584, F.G, F.c);
            pg8::EpiAddBf16 E{XBP, ALPHA};
            pg8::gemm_phase<pg8::EpiAddBf16, pg8::StaticOrder, true>(F.lds + RING_OFF, S, E, F.tid);
        }
        GRID_BAR(1 + 16 * j + 7);
        if (RUN(5)) { frame_refresh(F); ln_pass<0, false>(F, 2 * j, 1, j); }
        GRID_BAR(1 + 16 * j + 8);
        if (RUN(9)) { frame_refresh(F);
            pg8::StaticOrder S; S.init(XBP, (const bf16*)(WSP + WS_WQKV) + (size_t)j * 4608 * 1024, T_TOK, 4608, 1024, F.G, F.c);
            pg8::EpiQKV E{(bf16*)(BIGP + BIG_QKV)};
            pg8::gemm_phase<pg8::EpiQKV, pg8::StaticOrder, true>(F.lds + RING_OFF, S, E, F.tid);
        }
        GRID_BAR(1 + 16 * j + 9);
        if (DBL & 16) { frame_refresh(F); attn_phase(F); }
        if (RUN(10)) { frame_refresh(F); attn_phase(F); }
        GRID_BAR(1 + 16 * j + 10);
        if (DBL & 32) { frame_refresh(F); attn_merge_phase(F); }
        if (RUN(11)) { frame_refresh(F); attn_merge_phase(F); }
        GRID_BAR(1 + 16 * j + 11);
        if (RUN(12)) { frame_refresh(F);
            pg8::StaticOrder S; S.init(BIGP + BIG_O, (const bf16*)(WSP + WS_WAO) + (size_t)j * 1024 * 512, T_TOK, 1024, 512, F.G, F.c);
            pg8::EpiAddBf16 E{XBP, ALPHA};
            pg8::gemm_phase<pg8::EpiAddBf16, pg8::StaticOrder, true>(F.lds + RING_OFF, S, E, F.tid);
        }
        GRID_BAR(1 + 16 * j + 12);
        if (RUN(13)) { frame_refresh(F); ln_route_pass(F, 2 * j + 1, j); }
        GRID_BAR(1 + 16 * j + 13);
        for (int rep_ = 0; rep_ < ((DBL & 512) ? 2 : 1); ++rep_) if (RUN(14)) {
            frame_refresh(F); MoeOrder<true, 28> S; int cnt[8];
            LAS int* PB = (LAS int*)(F.lds + RING_OFF); moe_prefix_lds(F, PB); moe_rtb(PB, S.rtb, cnt);
            S.G = F.G; S.c = F.c; S.idx = (const LAS int*)(F.lds + AUX_OFF);
            S.A = (const char*)XBP; S.Bt = (const char*)(BIGP + BIG_WMGU); S.K = 1024; S.bstride = (size_t)7168 * 1024 * 2;
            const int* BL = (const int*)(WSP + WS_LIST); LAS int* idx = (LAS int*)(F.lds + AUX_OFF);
            pg8::Unit u; int nun = 0;
            for (int ui = 0; S.next(ui, u) && ui < 30; ++ui) { nun = ui + 1;
                if (F.tid < 256) { const int e = u.ex; int rb = 0, ce = 0;
#pragma unroll
                    for (int q = 0; q < 8; ++q) { rb = (q == e) ? S.rtb[q] : rb; ce = (q == e) ? cnt[q] : ce; }
                    int slot = (u.pm - rb) * 256 + F.tid; slot = slot < ce ? slot : 0;
                    int lo = 0;
#pragma unroll
                    for (int st = 128; st > 0; st >>= 1) lo = (PB[(lo + st) * 8 + e] <= slot) ? lo + st : lo;
                    idx[ui * 256 + F.tid] = (lo * 8 + e) * 256 + (slot - PB[lo * 8 + e]); } }
            if (F.tid < 256) {
#pragma unroll 10
                for (int ui = 0; ui < 30; ++ui) if (ui < nun) idx[ui * 256 + F.tid] = BL[idx[ui * 256 + F.tid]]; }
            __syncthreads();
            pg8::EpiSwiGLU E{(bf16*)(BIGP + BIG_HID)};
            pg8::gemm_phase<pg8::EpiSwiGLU, MoeOrder<true, 28>, true>(F.lds + RING_OFF, S, E, F.tid);
        }
        GRID_BAR(1 + 16 * j + 14);
        for (int rep_ = 0; rep_ < ((DBL & 128) ? 2 : 1); ++rep_) if (RUN(15)) {
            frame_refresh(F);
            int rtb5[9], cnt5[8]; { LAS int* PB = (LAS int*)(F.lds + RING_OFF); moe_prefix_lds(F, PB); moe_rtb(PB, rtb5, cnt5); __syncthreads(); }
            { MoeDownMain S;
#pragma unroll
              for (int e = 0; e < 9; ++e) S.rtb[e] = rtb5[e];
              S.G = F.G; S.c = F.c; S.A = (const char*)(BIGP + BIG_HID); S.Bt = (const char*)(BIGP + BIG_WMD); S.K = 3584; S.bstride = (size_t)1024 * 3584 * 2;
              pg8::EpiBf16Y E{(bf16*)(BIGP + BIG_YP)};
              pg8::gemm_phase<pg8::EpiBf16Y, MoeDownMain, true>(F.lds + RING_OFF, S, E, F.tid); }
            frame_refresh(F);
            { MoeDownTail S;
#pragma unroll
              for (int e = 0; e < 9; ++e) S.rtb[e] = rtb5[e];
              S.G = F.G; S.c = F.c; S.A = (const char*)(BIGP + BIG_HID); S.Bt = (const char*)(BIGP + BIG_WMD); S.K = 3584; S.bstride = (size_t)1024 * 3584 * 2;
              pg8::EpiF32Slab E{(float*)(WSP + WS_SLAB)};
              pg8::gemm_phase<pg8::EpiF32Slab, MoeDownTail, false>(F.lds + RING_OFF, S, E, F.tid); }
        }
        GRID_BAR(1 + 16 * j + 15);
        if (RUN(16)) { frame_refresh(F); if (j == 0) ln_pass<2, false>(F, 1, 1, 0); else ln_pass<2, true>(F, 3, 1, 1); }
        if (j == 0) GRID_BAR(1 + 16 * j + 16);
    }
#ifdef STAMP_A
    GRID_BAR(34);
    { if (blockIdx.x == 0 && threadIdx.x == 0) { volatile LAS unsigned long long* ts = (volatile LAS unsigned long long*)(F.lds + AUX_OFF + 16384);
          float* vv = (float*)(ARGWS(F) + 65536); vv[0] = (float)(ts[STAMP_A + STAMP_AN] - ts[STAMP_A]) * 0.01f; vv[1] = (float)(ts[STAMP_B + STAMP_BN] - ts[STAMP_B]) * 0.01f; } }
    GRID_BAR(35);
    { const float* vv = (const float*)(ARGWS(F) + 65536); const float va = vv[0], vb = vv[1];
      float* out = ARGX(F); const float c = sqrtf(va);
      for (size_t i = (size_t)blockIdx.x * 512 + threadIdx.x; i < (size_t)T_TOK * DMODEL; i += (size_t)gridDim.x * 512) out[i] = (i == 0) ? vb : c; }
#endif
}

extern "C" void kernel_launch(void* const* d_in, const int* in_sizes, int n_in, void* d_out, int out_size, void* d_ws, size_t ws_size, hipStream_t stream) {
    static int grid = 0;
    if (grid == 0) {
        if (n_in != 15 || out_size != T_TOK * DMODEL || ws_size < WS_END) { fprintf(stderr, "kernel_launch: unexpected shapes / workspace (n_in %d, out %d, ws %zu < %zu)\n", n_in, out_size, ws_size, (size_t)WS_END); grid = -1; return; }
        int dev = 0, cus = 0, per_cu = 0;
        if (hipGetDevice(&dev) != hipSuccess || hipDeviceGetAttribute(&cus, hipDeviceAttributeMultiprocessorCount, dev) != hipSuccess) { grid = -1; return; }
        if (hipFuncSetAttribute((const void*)fwd_kernel, hipFuncAttributeMaxDynamicSharedMemorySize, LDS_BYTES) != hipSuccess) { fprintf(stderr, "kernel_launch: hipFuncSetAttribute failed\n"); grid = -1; return; }
        if (hipOccupancyMaxActiveBlocksPerMultiprocessor(&per_cu, (const void*)fwd_kernel, NWAVES * 64, LDS_BYTES) != hipSuccess || per_cu < 1) { fprintf(stderr, "kernel_launch: occupancy query says %d\n", per_cu); }
        (void)hipGetLastError();
        if (cus < 256) { fprintf(stderr, "kernel_launch: this kernel needs 256 CUs (found %d)\n", cus); grid = -1; return; }
        grid = 256;
    }
    if (grid < 0) return;
    if (hipMemsetAsync((char*)d_ws + WS_CTL, 0, CTL_ZERO_BYTES, stream) != hipSuccess) return;
    Args a{};
    for (int i = 0; i < 15; ++i) a.in[i] = (const float*)d_in[i];
    a.out = (float*)d_out; a.ws = (unsigned char*)d_ws;
    hipLaunchKernelGGL(fwd_kernel, dim3(grid), dim3(NWAVES * 64), LDS_BYTES, stream, a);
}
```
